# Optimizing an MI355X kernel written in HIP

```python
import math
import jax, jax.numpy as jnp
from jax import lax
import numpy as np

D_MODEL = 1024
BATCH = 2
SEQ = 8192
DEPTH = 1

N_HEADS = 8
HEAD_DIM = 64
ATTN_WIDTH = N_HEADS * HEAD_DIM
IDX_HEADS = 8
IDX_DIM = 64
TOPK_MAX = 256
Q_BLOCK = 128
N_BUCKETS = 32
MAX_DISTANCE = 128
CONV_WIDTH = 512
CONV_K = 3
N_BRANCH = 2
N_GROUPS = 4
EXPERTS_PER_GROUP = 8
N_EXPERTS = N_GROUPS * EXPERTS_PER_GROUP
TOP_K_EXPERTS = 2
D_EXPERT = 512
EPS = 1e-6

SPLITS = (ATTN_WIDTH, ATTN_WIDTH, ATTN_WIDTH,
          IDX_HEADS * IDX_DIM, IDX_DIM, IDX_HEADS,
          CONV_WIDTH, CONV_WIDTH, CONV_WIDTH,
          N_BRANCH * D_MODEL)
IN_COLS = sum(SPLITS)

kernel_name = "hybrid_dsa_shortconv_hmoe_block"


def rms_norm(x, g):
    xf = x.astype(jnp.float32)
    y = xf * lax.rsqrt(jnp.mean(xf * xf, axis=-1, keepdims=True) + EPS)
    return y * g.astype(jnp.float32)


def t5_bucket(rel):
    n = jnp.maximum(rel, 0)
    max_exact = N_BUCKETS // 2
    nf = jnp.maximum(n, 1).astype(jnp.float32)
    large = max_exact + (jnp.log(nf / max_exact) / math.log(MAX_DISTANCE / max_exact)
                         * (N_BUCKETS - max_exact)).astype(jnp.int32)
    large = jnp.minimum(large, N_BUCKETS - 1)
    return jnp.where(n < max_exact, n, large)


def dsa_attention(q, k, v, q_idx, k_idx, w_idx, rel_bias):
    B, S, H, Dh = q.shape
    K = min(TOPK_MAX, S // 4)
    nb = S // Q_BLOCK
    key_pos = jnp.arange(S)
    k_idx_f = k_idx.astype(jnp.float32)
    neg = jnp.finfo(jnp.float32).min

    def to_blocks(a):
        return a.reshape(B, nb, Q_BLOCK, *a.shape[2:]).swapaxes(0, 1)

    def block(args):
        qb, qib, wb, start = args
        qpos = start + jnp.arange(Q_BLOCK)
        dots = jnp.einsum('bqhd,bsd->bqhs', qib.astype(jnp.float32), k_idx_f) * (IDX_DIM ** -0.5)
        score = jnp.einsum('bqh,bqhs->bqs', wb.astype(jnp.float32), jax.nn.relu(dots)) * (IDX_HEADS ** -0.5)
        causal = key_pos[None, :] <= qpos[:, None]
        score = jnp.where(causal[None], score, neg)
        _, idx = lax.top_k(score, K)
        gather = jax.vmap(lambda kb, ib: kb[ib])
        kg = gather(k, idx).astype(jnp.float32)
        vg = gather(v, idx).astype(jnp.float32)
        logits = jnp.einsum('bqhd,bqkhd->bqhk', qb.astype(jnp.float32), kg) * (Dh ** -0.5)
        rel = qpos[None, :, None] - idx
        bias = rel_bias.astype(jnp.float32)[t5_bucket(rel)]
        logits = logits + bias.transpose(0, 1, 3, 2)
        logits = jnp.where((rel >= 0)[:, :, None, :], logits, -jnp.inf)
        p = jax.nn.softmax(logits, axis=-1)
        return jnp.einsum('bqhk,bqkhd->bqhd', p, vg)

    outs = lax.map(block, (to_blocks(q), to_blocks(q_idx), to_blocks(w_idx),
                           jnp.arange(nb, dtype=jnp.int32) * Q_BLOCK))
    return outs.swapaxes(0, 1).reshape(B, S, H * Dh)


def causal_short_conv(u, w):
    S = u.shape[1]
    up = jnp.pad(u, ((0, 0), (CONV_K - 1, 0), (0, 0)))
    return sum(w[j] * up[:, j:j + S] for j in range(CONV_K))


def hier_moe(h, wg, bg, we, be, w_gate, w_up, w_down):
    B, S, D = h.shape
    t = h.reshape(-1, D)
    T = t.shape[0]
    g_logits = t @ wg.astype(jnp.float32) + bg.astype(jnp.float32)
    g_prob = jax.nn.softmax(g_logits, axis=-1)
    g_sel = jnp.argmax(g_logits, axis=-1)
    g_w = jnp.take_along_axis(g_prob, g_sel[:, None], axis=1)[:, 0]
    e_logits = (t @ we.astype(jnp.float32) + be.astype(jnp.float32)).reshape(T, N_GROUPS, EXPERTS_PER_GROUP)
    e_sel_logits = e_logits[jnp.arange(T), g_sel]
    e_prob = jax.nn.softmax(e_sel_logits, axis=-1)
    top_p, top_i = lax.top_k(e_prob, TOP_K_EXPERTS)
    top_p = top_p / jnp.sum(top_p, axis=-1, keepdims=True)
    expert_id = g_sel[:, None] * EXPERTS_PER_GROUP + top_i
    weights = g_w[:, None] * top_p
    gate_dense = jnp.einsum('tk,tke->te', weights, jax.nn.one_hot(expert_id, N_EXPERTS, dtype=jnp.float32))

    def expert_step(acc, params):
        wg_e, wu_e, wd_e, gcol = params
        hid = jax.nn.silu(t @ wg_e.astype(jnp.float32)) * (t @ wu_e.astype(jnp.float32))
        return acc + gcol[:, None] * (hid @ wd_e.astype(jnp.float32)), None

    acc, _ = lax.scan(expert_step, jnp.zeros((T, D), jnp.float32),
                      (w_gate, w_up, w_down, gate_dense.T))
    return acc.reshape(B, S, D)


def setup_inputs(seed: int = 0) -> dict:
    key = jax.random.key(seed)
    ks = jax.random.split(key, 24)
    f32 = jnp.float32
    D = D_MODEL
    nrm = lambda k, shape, s: jax.random.normal(k, shape, f32) * s
    return {
        "x": nrm(ks[0], (BATCH, SEQ, D), 1.0),
        "c": nrm(ks[1], (BATCH, D), 1.0),
        "w_ada": nrm(ks[2], (DEPTH, D, 6 * D), 0.5 * D ** -0.5),
        "b_ada": nrm(ks[3], (DEPTH, 6 * D), 0.01),
        "norm1_g": 1.0 + nrm(ks[4], (DEPTH, D), 0.01),
        "w_in": nrm(ks[5], (DEPTH, D, IN_COLS), D ** -0.5),
        "rel_bias": nrm(ks[6], (N_BUCKETS, N_HEADS), 0.5),
        "conv_w": nrm(ks[7], (DEPTH, CONV_K, CONV_WIDTH), CONV_K ** -0.5),
        "w_attn_branch": nrm(ks[8], (DEPTH, ATTN_WIDTH, D), ATTN_WIDTH ** -0.5),
        "w_conv_branch": nrm(ks[9], (DEPTH, CONV_WIDTH, D), CONV_WIDTH ** -0.5),
        "w_out": nrm(ks[10], (DEPTH, D, D), D ** -0.5),
        "norm2_g": 1.0 + nrm(ks[11], (DEPTH, D), 0.01),
        "w_router_group": nrm(ks[12], (DEPTH, D, N_GROUPS), D ** -0.5),
        "b_router_group": nrm(ks[13], (DEPTH, N_GROUPS), 0.01),
        "w_router_expert": nrm(ks[14], (DEPTH, D, N_EXPERTS), D ** -0.5),
        "b_router_expert": nrm(ks[15], (DEPTH, N_EXPERTS), 0.01),
        "w_gate_e": nrm(ks[16], (DEPTH, N_EXPERTS, D, D_EXPERT), D ** -0.5),
        "w_up_e": nrm(ks[17], (DEPTH, N_EXPERTS, D, D_EXPERT), D ** -0.5),
        "w_down_e": nrm(ks[18], (DEPTH, N_EXPERTS, D_EXPERT, D), D_EXPERT ** -0.5),
        "norm_f_g": 1.0 + nrm(ks[19], (D,), 0.01),
    }


def reference(x, c, w_ada, b_ada, norm1_g, w_in, rel_bias, conv_w, w_attn_branch, w_conv_branch,
              w_out, norm2_g, w_router_group, b_router_group, w_router_expert, b_router_expert,
              w_gate_e, w_up_e, w_down_e, norm_f_g):
    B, S, D = x.shape
    offsets = np.cumsum(SPLITS)[:-1].tolist()
    h_res = x.astype(jnp.float32)
    c_act = jax.nn.silu(c.astype(jnp.float32))
    for l in range(DEPTH):
        mod = c_act @ w_ada[l].astype(jnp.float32) + b_ada[l].astype(jnp.float32)
        shift1, scale1, gate1, shift2, scale2, gate2 = [m[:, None, :] for m in jnp.split(mod, 6, axis=-1)]

        h = rms_norm(h_res, norm1_g[l]) * (1.0 + scale1) + shift1
        proj = h @ w_in[l].astype(jnp.float32)
        q, k, v, qi, ki, wi, cb, cc, cx, gl = jnp.split(proj, offsets, axis=-1)
        attn = dsa_attention(q.reshape(B, S, N_HEADS, HEAD_DIM), k.reshape(B, S, N_HEADS, HEAD_DIM),
                             v.reshape(B, S, N_HEADS, HEAD_DIM), qi.reshape(B, S, IDX_HEADS, IDX_DIM),
                             ki, wi, rel_bias)
        y_attn = attn @ w_attn_branch[l].astype(jnp.float32)
        conv = causal_short_conv(cc * cx, conv_w[l].astype(jnp.float32))
        y_conv = (cb * conv) @ w_conv_branch[l].astype(jnp.float32)
        gates = jax.nn.sigmoid(gl).reshape(B, S, N_BRANCH, D)
        merged = gates[:, :, 0] * y_attn + gates[:, :, 1] * y_conv
        h_res = h_res + gate1 * (merged @ w_out[l].astype(jnp.float32))

        h2 = rms_norm(h_res, norm2_g[l]) * (1.0 + scale2) + shift2
        h_res = h_res + gate2 * hier_moe(h2, w_router_group[l], b_router_group[l], w_router_expert[l],
                                         b_router_expert[l], w_gate_e[l], w_up_e[l], w_down_e[l])
    return rms_norm(h_res, norm_f_g).astype(x.dtype)
```

```cpp
#include <hip/hip_runtime.h>
#include <cstdio>
#include <cstdint>

namespace pg8 {
#define PG8_LAS __attribute__((address_space(3)))
typedef unsigned short bf16_t;
typedef short bf16x8 __attribute__((ext_vector_type(8)));
typedef float f32x4 __attribute__((ext_vector_type(4)));
typedef unsigned u32x4 __attribute__((ext_vector_type(4)));
constexpr int BM = 256, BK = 64, HALF = 128, HTB = HALF * BK * 2  , STAGE_BYTES = 8 * HTB, NXCD = 8, WGM = 8;

__host__ __device__ __forceinline__ int lds_byte(int r, int c) { const int st = (r >> 4) * 2 + (c >> 5), rr = r & 15, cc = c & 31, ob = rr * 64 + cc * 2; return st * 1024 + (ob ^ (((ob >> 9) & 1) << 5)); }
__host__ __device__ __forceinline__ void stage_rc(int b, int& R, int& C) { const int st = b / 1024, sb = b % 1024, swz = sb ^ (((sb >> 9) & 1) << 5); R = (st >> 1) * 16 + swz / 64; C = (st & 1) * 32 + (swz % 64) / 2; }
__host__ __device__ __forceinline__ int perm32(int rho) { const int n = rho >> 4, i = rho & 15; return 8 * (i >> 2) + 4 * n + (i & 3); }

struct Unit { int pm, pn; };
struct Gemm { const bf16_t* A; const bf16_t* Bt; int M, N, K; };

struct StaticOrder {
    int nM, nN, nwg, G, c;
    __host__ __device__ void init(int M, int N, int G_, int c_) { nM = M / BM; nN = N / BM; nwg = nM * nN; G = G_; c = c_; }
    __host__ __device__ bool next(int i, Unit& u) const {
        const long L = (long)i * G + c; if (L >= nwg) return false;
        int wgid = (int)L; { const int q = nwg / NXCD, r = nwg % NXCD, xcd = wgid % NXCD, off = wgid / NXCD; wgid = (xcd < r ? xcd * (q + 1) : r * (q + 1) + (xcd - r) * q) + off; }
        const int nig = WGM * nN, gid = wgid / nig, fm = gid * WGM, gsz = (nM - fm) < WGM ? (nM - fm) : WGM;
        u.pm = fm + ((wgid % nig) % gsz); u.pn = (wgid % nig) / gsz; return true;
    }
    __device__ __forceinline__ void a_ready(const Unit&) const {}
    __device__ __forceinline__ void done(const Unit&) const {}
};
__device__ __forceinline__ unsigned cvt_pk_bf16(float lo, float hi) { unsigned r; asm volatile("v_cvt_pk_bf16_f32 %0, %1, %2" : "=v"(r) : "v"(lo), "v"(hi)); return r; }

template <class Epi, class Sched, bool ALIGN_EPI = false, bool SP2 = false>
__device__ __forceinline__ void gemm_phase(PG8_LAS unsigned char* lds, const Gemm g, const Sched& S, const Epi& E) {
    const int tid = threadIdx.x, wid = __builtin_amdgcn_readfirstlane(tid >> 6), lane = tid & 63, wr = wid >> 2, wc = wid & 3, fr = lane & 15, fq = lane >> 4;
    const int K = g.K, nt = K / BK;
    unsigned voffA[2], voffB[2];
#pragma unroll
    for (int i = 0; i < 2; ++i) { int R, C; stage_rc(tid * 16 + i * 8192, R, C); const int Rb = Epi::PERM ? ((R & ~31) + perm32(R & 31)) : R;
        voffA[i] = (unsigned)(R * K + C) * 2u; voffB[i] = (unsigned)(Rb * K + C) * 2u; }
    const size_t kstep = (size_t)(BK * 2);
    const size_t hstep = (size_t)HALF * K * 2;
    const size_t tstep = 2 * hstep;
    const unsigned ldsw = (unsigned)wid * 1024u;
    const int aoff = lds_byte(wr * 64 + fr, fq * 8), boff = lds_byte(wc * 32 + fr, fq * 8);
#define PG8_SA(b, h) (((b) * 2 + (h)) * HTB)
#define PG8_SB(b, h) ((4 + (b) * 2 + (h)) * HTB)
#define PG8_STAGE(bufoff, gbase, voff) do { _Pragma("unroll") for (int _i = 0; _i < 2; ++_i) \
        __builtin_amdgcn_global_load_lds((const unsigned*)((const char*)(gbase) + (voff)[_i]), (PG8_LAS unsigned*)(lds + (bufoff) + ldsw + _i * 8192), 16, 0, 0); } while (0)
#define PG8_LDA(dst, b, h) do { _Pragma("unroll") for (int m = 0; m < 4; ++m) _Pragma("unroll") for (int k = 0; k < 2; ++k) dst[m][k] = *(const PG8_LAS bf16x8*)(lds + PG8_SA(b, h) + aoff + m * 2048 + k * 1024); } while (0)
#define PG8_LDB(dst, b, h) do { _Pragma("unroll") for (int n = 0; n < 2; ++n) _Pragma("unroll") for (int k = 0; k < 2; ++k) dst[n][k] = *(const PG8_LAS bf16x8*)(lds + PG8_SB(b, h) + boff + n * 2048 + k * 1024); } while (0)
#define PG8_MMA(ai, bj, At, Bt) do { __builtin_amdgcn_s_setprio(1); _Pragma("unroll") for (int m = 0; m < 4; ++m) _Pragma("unroll") for (int n = 0; n < 2; ++n) _Pragma("unroll") for (int k = 0; k < 2; ++k) \
        acc[ai][bj][m][n] = __builtin_amdgcn_mfma_f32_16x16x32_bf16(Bt[n][k], At[m][k], acc[ai][bj][m][n], 0, 0, 0); __builtin_amdgcn_s_setprio(0); } while (0)
#define PG8_WAIT_V(n) asm volatile("s_waitcnt vmcnt(" #n ")" ::: "memory")
#define PG8_WAIT_L(n) asm volatile("s_waitcnt lgkmcnt(" #n ")" ::: "memory")
#define PG8_BAR __builtin_amdgcn_s_barrier()
#define PG8_SCHED __builtin_amdgcn_sched_barrier(0)
    Unit cur, nxt; int ui = 0;
    if (!S.next(0, cur)) return;
    f32x4 acc[2][2][4][2];
#pragma unroll
    for (int a = 0; a < 2; ++a)
#pragma unroll
        for (int b = 0; b < 2; ++b)
#pragma unroll
            for (int m = 0; m < 4; ++m)
#pragma unroll
                for (int n = 0; n < 2; ++n) acc[a][b][m][n] = (f32x4){0.f, 0.f, 0.f, 0.f};
    bf16x8 At[4][2], B0[2][2], B1[2][2];
    const char* cA = (const char*)g.A + (size_t)cur.pm * tstep; const char* cB = (const char*)g.Bt + (size_t)cur.pn * tstep;
    S.a_ready(cur);
    if constexpr (SP2) {
        PG8_STAGE(PG8_SB(0, 0), cB, voffB); PG8_STAGE(PG8_SB(0, 1), cB + hstep, voffB); PG8_STAGE(PG8_SA(0, 0), cA, voffA); PG8_STAGE(PG8_SA(0, 1), cA + hstep, voffA);
        if (wr == 1) PG8_BAR;
        PG8_WAIT_V(2); PG8_BAR;
        PG8_STAGE(PG8_SB(1, 0), cB + kstep, voffB); PG8_STAGE(PG8_SA(1, 0), cA + kstep, voffA); PG8_STAGE(PG8_SB(1, 1), cB + hstep + kstep, voffB);
        PG8_WAIT_V(6); PG8_BAR;
    } else {
        PG8_STAGE(PG8_SB(0, 0), cB, voffB); PG8_STAGE(PG8_SA(0, 0), cA, voffA); PG8_STAGE(PG8_SB(0, 1), cB + hstep, voffB); PG8_STAGE(PG8_SA(0, 1), cA + hstep, voffA);
        if (wr == 1) PG8_BAR;
        PG8_WAIT_V(4); PG8_BAR;
        PG8_STAGE(PG8_SB(1, 0), cB + kstep, voffB); PG8_STAGE(PG8_SA(1, 0), cA + kstep, voffA); PG8_STAGE(PG8_SB(1, 1), cB + hstep + kstep, voffB);
        PG8_WAIT_V(6); PG8_BAR;
    }
    for (;;) {
        const bool has_next = S.next(ui + 1, nxt);
        const char* nA = has_next ? (const char*)g.A + (size_t)nxt.pm * tstep : cA; const char* nB = has_next ? (const char*)g.Bt + (size_t)nxt.pn * tstep : cB;
        for (int t = 0; t < nt; t += 2) {
            const bool last = (t == nt - 2);
            const char* a1 = cA + (size_t)(t + 1) * kstep;
            const char* a2 = last ? nA : cA + (size_t)(t + 2) * kstep; const char* b2 = last ? nB : cB + (size_t)(t + 2) * kstep;
            const char* a3 = a2 + kstep; const char* b3 = b2 + kstep;
            if (last && has_next) S.a_ready(nxt);
            if constexpr (SP2) {
            PG8_LDB(B0, 0, 0); PG8_LDB(B1, 0, 1); PG8_SCHED; PG8_LDA(At, 0, 0); PG8_STAGE(PG8_SA(1, 1), a1 + hstep, voffA);
            PG8_WAIT_V(8); PG8_WAIT_L(0); PG8_BAR; PG8_MMA(0, 0, At, B0); PG8_MMA(0, 1, At, B1); PG8_BAR; PG8_SCHED;
            PG8_LDA(At, 0, 1); PG8_STAGE(PG8_SB(0, 0), b2, voffB); PG8_STAGE(PG8_SB(0, 1), b2 + hstep, voffB); PG8_STAGE(PG8_SA(0, 0), a2, voffA);
            PG8_WAIT_V(8); PG8_WAIT_L(0); PG8_BAR; PG8_MMA(1, 0, At, B0); PG8_MMA(1, 1, At, B1); PG8_BAR; PG8_SCHED;
            PG8_LDB(B0, 1, 0); PG8_LDB(B1, 1, 1); PG8_SCHED; PG8_LDA(At, 1, 0); PG8_STAGE(PG8_SA(0, 1), a2 + hstep, voffA);
            PG8_WAIT_V(8); PG8_WAIT_L(0); PG8_BAR; PG8_MMA(0, 0, At, B0); PG8_MMA(0, 1, At, B1); PG8_BAR; PG8_SCHED;
            PG8_LDA(At, 1, 1); PG8_STAGE(PG8_SB(1, 0), b3, voffB); PG8_STAGE(PG8_SB(1, 1), b3 + hstep, voffB); PG8_STAGE(PG8_SA(1, 0), a3, voffA);
            PG8_WAIT_V(8); PG8_WAIT_L(0); PG8_BAR; PG8_MMA(1, 0, At, B0); PG8_MMA(1, 1, At, B1); PG8_BAR; PG8_SCHED;
            } else {
            PG8_LDB(B0, 0, 0); PG8_SCHED; PG8_LDA(At, 0, 0); PG8_STAGE(PG8_SA(1, 1), a1 + hstep, voffA);
            PG8_WAIT_L(8); PG8_BAR; PG8_WAIT_L(0); PG8_MMA(0, 0, At, B0); PG8_BAR; PG8_SCHED;
            PG8_LDB(B1, 0, 1); PG8_STAGE(PG8_SB(0, 0), b2, voffB);
            PG8_BAR; PG8_WAIT_L(0); PG8_MMA(0, 1, At, B1); PG8_BAR;
            PG8_LDA(At, 0, 1); PG8_STAGE(PG8_SA(0, 0), a2, voffA);
            PG8_BAR; PG8_WAIT_L(0); PG8_MMA(1, 0, At, B0); PG8_BAR; PG8_SCHED;
            PG8_STAGE(PG8_SB(0, 1), b2 + hstep, voffB);
            PG8_WAIT_V(6); PG8_BAR; PG8_MMA(1, 1, At, B1); PG8_BAR;
            PG8_LDB(B0, 1, 0); PG8_SCHED; PG8_LDA(At, 1, 0); PG8_STAGE(PG8_SA(0, 1), a2 + hstep, voffA);
            PG8_WAIT_L(8); PG8_BAR; PG8_WAIT_L(0); PG8_MMA(0, 0, At, B0); PG8_BAR; PG8_SCHED;
            PG8_LDB(B1, 1, 1); PG8_STAGE(PG8_SB(1, 0), b3, voffB);
            PG8_BAR; PG8_WAIT_L(0); PG8_MMA(0, 1, At, B1); PG8_BAR;
            PG8_LDA(At, 1, 1); PG8_STAGE(PG8_SA(1, 0), a3, voffA);
            PG8_BAR; PG8_WAIT_L(0); PG8_MMA(1, 0, At, B0); PG8_BAR; PG8_SCHED;
            PG8_STAGE(PG8_SB(1, 1), b3 + hstep, voffB);
            PG8_WAIT_V(6); PG8_BAR; PG8_MMA(1, 1, At, B1); PG8_BAR;
            }
        }
        if constexpr (ALIGN_EPI) { if (wr == 0) PG8_BAR; }
        if constexpr (!Epi::AFTER_DRAIN) { E(acc, cur, wr, wc, fr, fq); S.done(cur); }
        if (!has_next) break;
#pragma unroll
        for (int a = 0; a < 2; ++a)
#pragma unroll
            for (int b = 0; b < 2; ++b)
#pragma unroll
                for (int m = 0; m < 4; ++m)
#pragma unroll
                    for (int n = 0; n < 2; ++n) acc[a][b][m][n] = (f32x4){0.f, 0.f, 0.f, 0.f};
        cur = nxt; cA = nA; cB = nB; ++ui;
        if constexpr (ALIGN_EPI) { if (wr == 1) PG8_BAR; }
    }
    PG8_WAIT_V(0);
    if constexpr (!ALIGN_EPI) { if (wr == 0) PG8_BAR; }
    PG8_BAR;
    if constexpr (Epi::AFTER_DRAIN) { E.fused(acc, cur, wr, wc, fr, fq, lds, wid, lane); S.done(cur); }
#undef PG8_SA
#undef PG8_SB
#undef PG8_STAGE
#undef PG8_LDA
#undef PG8_LDB
#undef PG8_MMA
#undef PG8_WAIT_V
#undef PG8_WAIT_L
#undef PG8_BAR
#undef PG8_SCHED
}
}

constexpr int NWAVES = 8;
#ifndef MK_PER_PHASE
#define MK_PER_PHASE 0
#endif
#ifndef MK_NAIVE_ATTN
#define MK_NAIVE_ATTN 1
#endif
#ifndef DBG_SKIP_ATTN
#define DBG_SKIP_ATTN 0
#endif
#ifndef DBG_SKIP_MOE
#define DBG_SKIP_MOE 0
#endif
#ifndef DBG_SKIP_MIX
#define DBG_SKIP_MIX 0
#endif
#ifndef DBG_PROBE
#define DBG_PROBE 0
#endif
constexpr int N_PHASES = 14;

constexpr int BATCH = 2, SEQ = 8192, D = 1024, T = BATCH * SEQ;
constexpr int NH = 8, HD = 64, AW = 512, IDXH = 8, IDXD = 64, TOPK = 256;
constexpr int NIN = 5704, NINP = 5888;
constexpr int NEXP = 32, DEXP = 512;
constexpr int XPROWS = 40960;
constexpr float EPS = 1e-6f;
constexpr float LOG2E = 1.4426950408889634f;
constexpr float C2 = 0.125f * LOG2E;

constexpr size_t MiB = 1u << 20;
constexpr size_t WS_CTL = 0, CTL_ZERO_BYTES = 1 * MiB;
constexpr size_t WS_SMALL = 1 * MiB;
constexpr size_t SM_MOD = WS_SMALL + 0;
constexpr size_t SM_WRT = WS_SMALL + 65536;
constexpr size_t SM_EID = WS_SMALL + 262144;
constexpr size_t SM_EWT = WS_SMALL + 393216;
constexpr size_t SM_SLOT = WS_SMALL + 524288;
constexpr size_t SM_AT = WS_SMALL + 655360;
constexpr size_t WS_WIN = 3 * MiB;
constexpr size_t WS_WA = 15 * MiB, WS_WC = 16 * MiB, WS_WOUT = 17 * MiB;
constexpr size_t WS_H1 = 19 * MiB;
constexpr size_t WS_AC = 19 * MiB, WS_ATT = 35 * MiB;
constexpr size_t WS_Q = 51 * MiB, WS_K = 67 * MiB, WS_V = 83 * MiB, WS_MASK = 83 * MiB, WS_VT = 99 * MiB, WS_QI = 115 * MiB, WS_KI = 131 * MiB;
constexpr size_t WS_WI = 133 * MiB, WS_QL = 133 * MiB + 524288;
constexpr size_t WS_CB = 136 * MiB, WS_U = 152 * MiB, WS_TMPC = 136 * MiB, WS_G = 168 * MiB;
constexpr size_t WS_MERGED = 51 * MiB;
constexpr size_t WS_WGU = 51 * MiB, WS_WD = 115 * MiB;
constexpr size_t WS_XP = 147 * MiB, WS_Y = 147 * MiB;
constexpr size_t WS_HID = 3 * MiB;
constexpr size_t WS_END = 232 * MiB;
constexpr int CW_TMO = 0, CW_CODE = 1, CW_KMAX = 64, CW_ECNT = 1024  , CW_BAR = 4096;

constexpr int RING_OFF = 0, RING_BYTES = 131072;
constexpr int LDSCTL_OFF = RING_BYTES, MISC_OFF = LDSCTL_OFF + 320;
constexpr int LDS_BYTES = 147456;

#define GAS __attribute__((address_space(1)))
#define LAS __attribute__((address_space(3)))
typedef unsigned short bf16;
typedef unsigned v4u __attribute__((ext_vector_type(4)));
typedef unsigned v2u __attribute__((ext_vector_type(2)));
typedef float f32x4 __attribute__((ext_vector_type(4)));
typedef short bf16x8 __attribute__((ext_vector_type(8)));
typedef GAS unsigned gu32;
#define RLX_AGENT __ATOMIC_RELAXED, __HIP_MEMORY_SCOPE_AGENT
#define LDS_WAIT() asm volatile("s_waitcnt lgkmcnt(0)" ::: "memory")
#define VM_WAIT() asm volatile("s_waitcnt vmcnt(0)" ::: "memory")
__device__ __forceinline__ unsigned f2bf(float f) { unsigned u = __builtin_bit_cast(unsigned, f); return (u + 0x7fffu + ((u >> 16) & 1u)) >> 16; }
__device__ __forceinline__ unsigned pk2(float lo, float hi) { return f2bf(lo) | (f2bf(hi) << 16); }
__device__ __forceinline__ float bflo(unsigned u) { return __builtin_bit_cast(float, u << 16); }
__device__ __forceinline__ float bfhi(unsigned u) { return __builtin_bit_cast(float, u & 0xffff0000u); }
__device__ __forceinline__ float bf1(bf16 h) { return __builtin_bit_cast(float, (unsigned)h << 16); }
__device__ __forceinline__ float wave_sum(float v) {
#pragma unroll
    for (int o = 1; o < 64; o <<= 1) v += __shfl_xor(v, o);
    return v;
}
__device__ __forceinline__ float wave_max(float v) {
#pragma unroll
    for (int o = 1; o < 64; o <<= 1) v = fmaxf(v, __shfl_xor(v, o));
    return v;
}

#define XB_TMO      128
#define XB_XCNT(j)  (256  + 64 * (j))
#define XB_XSUB(j)  (1280 + 64 * (j))
#define XB_XGEN(j)  (2304 + 64 * (j))
#define XB_TOP      3328
#define XB_TOPGEN   3392
#define XCD_BAR_WORDS 3456
#define XB_SPIN_CAP (1u << 18)

__device__ __forceinline__ unsigned xb_ld(unsigned* p)              { return __hip_atomic_load(p, __ATOMIC_RELAXED, __HIP_MEMORY_SCOPE_AGENT); }
__device__ __forceinline__ unsigned xb_add(unsigned* p, unsigned v) { return __hip_atomic_fetch_add(p, v, __ATOMIC_RELAXED, __HIP_MEMORY_SCOPE_AGENT); }
__device__ __forceinline__ unsigned xb_xcc_id() { return (unsigned)__builtin_amdgcn_s_getreg((3 << 11) | 20) & 0xFu; }
#define XB_SPIN(cond, bar) do { unsigned _sp = 0; while (cond) { __builtin_amdgcn_s_sleep(1); \
    if ((++_sp & 255u) == 0u) { if (xb_ld(&(bar)[XB_TMO])) break; if (_sp > XB_SPIN_CAP) { atomicAdd(&(bar)[XB_TMO], 1u); break; } } } } while (0)

struct XcdBarrier { unsigned* bar; unsigned x; volatile LAS unsigned* st; };

__device__ __forceinline__ XcdBarrier xcd_barrier_post(unsigned* bar, volatile LAS unsigned* st) {
    XcdBarrier b; b.bar = bar; b.x = xb_xcc_id(); b.st = st;
    if (threadIdx.x == 0) (void)xb_add(&bar[XB_XCNT(b.x)], 1u);
    return b;
}
__device__ __forceinline__ void xcd_barrier_complete(unsigned* bar, unsigned x, unsigned& nloc, unsigned& nx) {
    const unsigned G = gridDim.x * gridDim.y * gridDim.z;
    unsigned sum, cnt, mine, sp = 0u;
    for (;;) {
        sum = 0u; cnt = 0u; mine = 0u;
#pragma unroll
        for (unsigned j = 0; j < 16; ++j) { const unsigned c = xb_ld(&bar[XB_XCNT(j)]); sum += c; cnt += (c > 0u) ? 1u : 0u; mine = (j == x) ? c : mine; }
        if (sum == G) break;
        __builtin_amdgcn_s_sleep(1);
        if ((++sp & 255u) == 0u) { if (xb_ld(&bar[XB_TMO])) break; if (sp > XB_SPIN_CAP) { atomicAdd(&bar[XB_TMO], 1u); break; } }
    }
    nloc = mine > 0u ? mine : 1u; nx = cnt > 0u ? cnt : 1u;
}
__device__ __forceinline__ void xcd_barrier(const XcdBarrier& b) {
    asm volatile("s_waitcnt vmcnt(0)" ::: "memory");
    __syncthreads();
    if (threadIdx.x == 0) {
        unsigned* bar = b.bar;
        __builtin_amdgcn_s_waitcnt(0);
        unsigned nloc = b.st[0], nx = b.st[1];
        if (nloc == 0u) { xcd_barrier_complete(bar, b.x, nloc, nx); b.st[0] = nloc; b.st[1] = nx; }
        const unsigned old = xb_add(&bar[XB_XSUB(b.x)], 1u);
        const unsigned gen = old / nloc;
        if (old + 1u == (gen + 1u) * nloc) {
            __builtin_amdgcn_fence(__ATOMIC_RELEASE, "agent");
            asm volatile("s_waitcnt vmcnt(0)" ::: "memory");
            const unsigned og = xb_add(&bar[XB_TOP], 1u);
            const unsigned tg = og / nx;
            if (og + 1u == (tg + 1u) * nx) xb_add(&bar[XB_TOPGEN], 1u);
            else XB_SPIN(xb_ld(&bar[XB_TOPGEN]) == tg, bar);
            __builtin_amdgcn_fence(__ATOMIC_ACQUIRE, "agent");
            xb_add(&bar[XB_XGEN(b.x)], 1u);
            asm volatile("s_waitcnt vmcnt(0)" ::: "memory");
        } else {
            XB_SPIN(xb_ld(&bar[XB_XGEN(b.x)]) == gen, bar);
            __builtin_amdgcn_fence(__ATOMIC_ACQUIRE, "agent");
            asm volatile("s_waitcnt vmcnt(0)" ::: "memory");
        }
    }
    __syncthreads();
}

struct Frame {
    LAS unsigned char* lds;
    volatile LAS unsigned* MISC;
    gu32* ctl;
    unsigned char* ws;
    int tid, lane, wave;
    int vcu, G;
    const float *x, *c, *w_ada, *b_ada, *norm1_g, *w_in, *rel_bias, *conv_w, *w_attn, *w_conv, *w_out, *norm2_g, *wrg, *brg, *wre, *bre, *w_gate_e, *w_up_e, *w_down_e, *norm_f_g;
    float* out;
};
#define WSP(T_, off) ((T_*)(F.ws + (off)))

template <class RowMap>
__device__ __forceinline__ void transpose_item(const float* W, int K, int N, bf16* WT, LAS float* scr, int item, int lane, RowMap rm) {
    const int nblk = (N + 31) / 32, kb = item / nblk, nb = item % nblk, k0 = 64 * kb, n0 = 32 * nb;
    const int nn = n0 + (lane & 31);
#pragma unroll 8
    for (int i = 0; i < 32; ++i) { const int kk = 2 * i + (lane >> 5); scr[kk * 33 + (lane & 31)] = (nn < N) ? W[(size_t)(k0 + kk) * N + nn] : 0.f; }
    LDS_WAIT(); asm volatile("" ::: "memory");
    const int c = lane & 7;
#pragma unroll
    for (int j = 0; j < 4; ++j) { const int n = (lane >> 3) + 8 * j; const LAS float* s = scr + (8 * c) * 33 + n;
        v4u o; o.x = pk2(s[0 * 33], s[1 * 33]); o.y = pk2(s[2 * 33], s[3 * 33]); o.z = pk2(s[4 * 33], s[5 * 33]); o.w = pk2(s[6 * 33], s[7 * 33]);
        if (n0 + n < N) *(GAS v4u*)(WT + (size_t)rm(n0 + n) * K + k0 + 8 * c) = o; }
    LDS_WAIT(); asm volatile("" ::: "memory");
}
struct RmId { __device__ __forceinline__ int operator()(int n) const { return n; } };
struct RmWin { __device__ __forceinline__ int operator()(int n) const {
    if (n < 2120) return n;
    if (n < 2632) return n + 184;
    if (n < 3144) { const int j = n - 2632; return 2816 + 256 * (j >> 7) + (j & 127); }
    if (n < 3656) { const int j = n - 3144; return 2816 + 256 * (j >> 7) + 128 + (j & 127); }
    return n + 184; } };
struct RmGU { int half; __device__ __forceinline__ int operator()(int n) const { return 256 * (n >> 7) + 128 * half + (n & 127); } };

__device__ __forceinline__ void p0_prologue(Frame& F) {
    LAS float* scr = (LAS float*)(F.lds + RING_OFF + F.wave * 16384);
    const int gw = F.vcu * NWAVES + F.wave, NGW = F.G * NWAVES;
    if (F.vcu < 96) {
        const int n = F.vcu * 64 + F.lane; float a0 = 0.f, a1 = 0.f;
        for (int k = F.wave * 128; k < F.wave * 128 + 128; ++k) {
            const float c0 = F.c[k], c1 = F.c[D + k];
            const float s0 = c0 / (1.f + __expf(-c0)), s1 = c1 / (1.f + __expf(-c1));
            const float w = F.w_ada[(size_t)k * 6144 + n];
            a0 += s0 * w; a1 += s1 * w;
        }
        LAS float* red = (LAS float*)(F.lds + RING_OFF + 8448);
        red[(F.wave * 2 + 0) * 64 + F.lane] = a0; red[(F.wave * 2 + 1) * 64 + F.lane] = a1;
        __syncthreads();
        if (F.wave < 2) { float s = F.b_ada[n];
#pragma unroll
            for (int w = 0; w < 8; ++w) s += red[(w * 2 + F.wave) * 64 + F.lane];
            WSP(float, SM_MOD)[F.wave * 6144 + n] = s; }
        __syncthreads();
    }
    constexpr int I_IN = 16 * 179, I_A = 8 * 32, I_C = 8 * 32, I_O = 16 * 32;
    constexpr int NITEMS = I_IN + I_A + I_C + I_O;
    for (int it = gw; it < NITEMS; it += NGW) {
        int r = it;
        if (r < I_IN) { transpose_item(F.w_in, D, NIN, WSP(bf16, WS_WIN), scr, r, F.lane, RmWin()); continue; } r -= I_IN;
        if (r < I_A) { transpose_item(F.w_attn, AW, D, WSP(bf16, WS_WA), scr, r, F.lane, RmId()); continue; } r -= I_A;
        if (r < I_C) { transpose_item(F.w_conv, AW, D, WSP(bf16, WS_WC), scr, r, F.lane, RmId()); continue; } r -= I_C;
        transpose_item(F.w_out, D, D, WSP(bf16, WS_WOUT), scr, r, F.lane, RmId());
    }
    for (int i = gw * 64 + F.lane; i < 184 * 128; i += NGW * 64) { *(GAS v4u*)(WSP(bf16, WS_WIN) + (size_t)2120 * D + (size_t)i * 8) = (v4u){0u, 0u, 0u, 0u}; }
    for (int i = gw * 64 + F.lane; i < 36 * D; i += NGW * 64) { const int n = i / D, k = i % D; WSP(float, SM_WRT)[i] = (n < 4) ? F.wrg[k * 4 + n] : F.wre[k * 32 + (n - 4)]; }
}

__device__ __forceinline__ void p1_norm1(Frame& F) {
    const int gw = F.vcu * NWAVES + F.wave, NGW = F.G * NWAVES;
    const float* mod = WSP(float, SM_MOD);
    int curb = -1; f32x4 ca[4], cb[4];
    for (int m = gw; m < T; m += NGW) {
        const int b = m / SEQ;
        if (b != curb) { curb = b;
#pragma unroll
            for (int j = 0; j < 4; ++j) { const int k = 4 * F.lane + 256 * j;
                const f32x4 g = *(const f32x4*)(F.norm1_g + k), sc = *(const f32x4*)(mod + b * 6144 + 1024 + k), sh = *(const f32x4*)(mod + b * 6144 + k);
                ca[j] = g * (sc + 1.0f); cb[j] = sh; } }
        const GAS f32x4* xr = (const GAS f32x4*)(F.x + (size_t)m * D) + F.lane;
        f32x4 v[4]; float s = 0.f;
#pragma unroll
        for (int j = 0; j < 4; ++j) { v[j] = xr[64 * j]; s += (v[j].x * v[j].x + v[j].y * v[j].y) + (v[j].z * v[j].z + v[j].w * v[j].w); }
        const float rstd = 1.f / sqrtf(wave_sum(s) * (1.f / D) + EPS);
        GAS v2u* o8 = (GAS v2u*)(WSP(bf16, WS_H1) + (size_t)m * D) + F.lane;
#pragma unroll
        for (int j = 0; j < 4; ++j) { const f32x4 h = v[j] * rstd * ca[j] + cb[j]; o8[64 * j] = (v2u){pk2(h.x, h.y), pk2(h.z, h.w)}; }
    }
}

using pg8::Unit;
typedef float f32x2_t __attribute__((ext_vector_type(2))); typedef __bf16 bf16x2_t __attribute__((ext_vector_type(2)));
__device__ __forceinline__ unsigned cvtpk(float lo, float hi) { f32x2_t v = {lo, hi}; bf16x2_t b = __builtin_convertvector(v, bf16x2_t); return __builtin_bit_cast(unsigned, b); }
__device__ __forceinline__ v4u pack8(const f32x4 a, const f32x4 b) { v4u w; w.x = cvtpk(a[0], a[1]); w.y = cvtpk(a[2], a[3]); w.z = cvtpk(b[0], b[1]); w.w = cvtpk(b[2], b[3]); return w; }
__device__ __forceinline__ float sigmoidf_(float x) { return __builtin_amdgcn_rcpf(1.f + __builtin_amdgcn_exp2f(-x * LOG2E)); }
__device__ __forceinline__ f32x4 sig4(f32x4 v) { return (f32x4){sigmoidf_(v[0]), sigmoidf_(v[1]), sigmoidf_(v[2]), sigmoidf_(v[3])}; }
__device__ __forceinline__ void unpack8(const v4u w, f32x4& a, f32x4& b) { a = (f32x4){bflo(w.x), bfhi(w.x), bflo(w.y), bfhi(w.y)}; b = (f32x4){bflo(w.z), bfhi(w.z), bflo(w.w), bfhi(w.w)}; }

struct EpiProj {
    static constexpr bool PERM = true, AFTER_DRAIN = false;
    bf16 *Q, *K, *V, *QI, *KI, *CB, *U, *G; float* WI;
    __device__ __forceinline__ void operator()(const f32x4 (&acc)[2][2][4][2], const Unit& u, int wr, int wc, int fr, int fq) const {
        const int pn = u.pn, row0 = u.pm * 256 + wr * 64 + fr, cb8 = wc * 32 + 8 * fq;
        if (pn < 8 || pn == 9 || pn == 10) {
            bf16* base; int coff; float sc = 1.f;
            if (pn < 2) { base = Q; coff = 256 * pn; sc = C2; } else if (pn < 4) { base = K; coff = 256 * (pn - 2); } else if (pn < 6) { base = V; coff = 256 * (pn - 4); }
            else if (pn < 8) { base = QI; coff = 256 * (pn - 6); } else { base = CB; coff = 256 * (pn - 9); }
#pragma unroll
            for (int ai = 0; ai < 2; ++ai)
#pragma unroll
                for (int m = 0; m < 4; ++m) { bf16* rowp = base + (size_t)(row0 + ai * 128 + m * 16) * 512 + coff + cb8;
#pragma unroll
                    for (int bj = 0; bj < 2; ++bj) *(v4u*)(rowp + bj * 128) = pack8(acc[ai][bj][m][0] * sc, acc[ai][bj][m][1] * sc); }
        } else if (pn == 8) {
#pragma unroll
            for (int ai = 0; ai < 2; ++ai)
#pragma unroll
                for (int m = 0; m < 4; ++m) { const size_t row = (size_t)(row0 + ai * 128 + m * 16);
                    if (wc < 2) *(v4u*)(KI + row * 64 + cb8) = pack8(acc[ai][0][m][0], acc[ai][0][m][1]);
                    else if (wc == 2 && fq == 0) { *(f32x4*)(WI + row * 8) = acc[ai][0][m][0]; *(f32x4*)(WI + row * 8 + 4) = acc[ai][0][m][1]; } }
        } else if (pn < 15) {
#pragma unroll
            for (int ai = 0; ai < 2; ++ai)
#pragma unroll
                for (int m = 0; m < 4; ++m) { const size_t row = (size_t)(row0 + ai * 128 + m * 16);
                    *(v4u*)(U + row * 512 + 128 * (pn - 11) + cb8) = pack8(acc[ai][0][m][0] * acc[ai][1][m][0], acc[ai][0][m][1] * acc[ai][1][m][1]); }
        } else {
#pragma unroll
            for (int ai = 0; ai < 2; ++ai)
#pragma unroll
                for (int m = 0; m < 4; ++m) { bf16* rowp = G + (size_t)(row0 + ai * 128 + m * 16) * 2048 + 256 * (pn - 15) + cb8;
#pragma unroll
                    for (int bj = 0; bj < 2; ++bj) *(v4u*)(rowp + bj * 128) = pack8(sig4(acc[ai][bj][m][0]), sig4(acc[ai][bj][m][1])); }
        }
    }
};
struct EpiConv {
    static constexpr bool PERM = true, AFTER_DRAIN = false;
    const bf16* G; bf16* O;
    __device__ __forceinline__ void operator()(const f32x4 (&acc)[2][2][4][2], const Unit& u, int wr, int wc, int fr, int fq) const {
        const int row0 = u.pm * 256 + wr * 64 + fr, col0 = u.pn * 256 + wc * 32 + 8 * fq;
#pragma unroll
        for (int ai = 0; ai < 2; ++ai)
#pragma unroll
            for (int m = 0; m < 4; ++m) { const size_t row = (size_t)(row0 + ai * 128 + m * 16);
#pragma unroll
                for (int bj = 0; bj < 2; ++bj) { f32x4 g0, g1; unpack8(*(const v4u*)(G + row * 2048 + 1024 + col0 + bj * 128), g0, g1);
                    *(v4u*)(O + row * 1024 + col0 + bj * 128) = pack8(g0 * acc[ai][bj][m][0], g1 * acc[ai][bj][m][1]); } }
    }
};
struct EpiAttn {
    static constexpr bool PERM = true, AFTER_DRAIN = false;
    const bf16* G; const bf16* Tc; bf16* O;
    __device__ __forceinline__ void operator()(const f32x4 (&acc)[2][2][4][2], const Unit& u, int wr, int wc, int fr, int fq) const {
        const int row0 = u.pm * 256 + wr * 64 + fr, col0 = u.pn * 256 + wc * 32 + 8 * fq;
#pragma unroll
        for (int ai = 0; ai < 2; ++ai)
#pragma unroll
            for (int m = 0; m < 4; ++m) { const size_t row = (size_t)(row0 + ai * 128 + m * 16);
#pragma unroll
                for (int bj = 0; bj < 2; ++bj) { f32x4 g0, g1, t0, t1; unpack8(*(const v4u*)(G + row * 2048 + col0 + bj * 128), g0, g1); unpack8(*(const v4u*)(Tc + row * 1024 + col0 + bj * 128), t0, t1);
                    *(v4u*)(O + row * 1024 + col0 + bj * 128) = pack8(g0 * acc[ai][bj][m][0] + t0, g1 * acc[ai][bj][m][1] + t1); } }
    }
};
struct EpiOut {
    static constexpr bool PERM = false, AFTER_DRAIN = false;
    const float* X; const float* mod; float* O;
    __device__ __forceinline__ void operator()(const f32x4 (&acc)[2][2][4][2], const Unit& u, int wr, int wc, int fr, int fq) const {
        const int row0 = u.pm * 256 + wr * 64 + fr, col0 = u.pn * 256 + wc * 32 + 4 * fq;
        const float* g1 = mod + ((u.pm * 256) / SEQ) * 6144 + 2048;
#pragma unroll
        for (int bj = 0; bj < 2; ++bj)
#pragma unroll
            for (int n = 0; n < 2; ++n) { const int col = col0 + bj * 128 + n * 16; const f32x4 gv = *(const f32x4*)(g1 + col);
#pragma unroll
                for (int ai = 0; ai < 2; ++ai)
#pragma unroll
                    for (int m = 0; m < 4; ++m) { const size_t off = (size_t)(row0 + ai * 128 + m * 16) * D + col;
                        *(f32x4*)(O + off) = *(const f32x4*)(X + off) + gv * acc[ai][bj][m][n]; } }
    }
};
__device__ __forceinline__ f32x4 silu_mul4(f32x4 g, f32x4 u) { return (f32x4){g[0] * sigmoidf_(g[0]) * u[0], g[1] * sigmoidf_(g[1]) * u[1], g[2] * sigmoidf_(g[2]) * u[2], g[3] * sigmoidf_(g[3]) * u[3]}; }
struct EpiHid {
    static constexpr bool PERM = true, AFTER_DRAIN = false;
    bf16* O;
    __device__ __forceinline__ void operator()(const f32x4 (&acc)[2][2][4][2], const Unit& u, int wr, int wc, int fr, int fq) const {
        const int row0 = u.pm * 256 + wr * 64 + fr, col0 = 128 * (u.pn & 3) + wc * 32 + 8 * fq;
#pragma unroll
        for (int ai = 0; ai < 2; ++ai)
#pragma unroll
            for (int m = 0; m < 4; ++m) { const size_t row = (size_t)(row0 + ai * 128 + m * 16);
                *(v4u*)(O + row * 512 + col0) = pack8(silu_mul4(acc[ai][0][m][0], acc[ai][1][m][0]), silu_mul4(acc[ai][0][m][1], acc[ai][1][m][1])); }
    }
};
struct EpiY {
    static constexpr bool PERM = true, AFTER_DRAIN = false;
    bf16* O;
    __device__ __forceinline__ void operator()(const f32x4 (&acc)[2][2][4][2], const Unit& u, int wr, int wc, int fr, int fq) const {
        const int row0 = u.pm * 256 + wr * 64 + fr, col0 = 256 * (u.pn & 3) + wc * 32 + 8 * fq;
#pragma unroll
        for (int ai = 0; ai < 2; ++ai)
#pragma unroll
            for (int m = 0; m < 4; ++m) { const size_t row = (size_t)(row0 + ai * 128 + m * 16);
#pragma unroll
                for (int bj = 0; bj < 2; ++bj) *(v4u*)(O + row * 1024 + col0 + bj * 128) = pack8(acc[ai][bj][m][0], acc[ai][bj][m][1]); }
    }
};
struct MoeOrder {
    const LAS int* tile_e; int ntiles, G, c;
    __device__ __forceinline__ bool next(int i, Unit& u) const {
        const int L = i * G + c; if (L >= ntiles * 4) return false;
        const int rt = L >> 2, j = L & 3; u.pm = rt; u.pn = 4 * tile_e[rt] + j; return true; }
    __device__ __forceinline__ void a_ready(const Unit&) const {}
    __device__ __forceinline__ void done(const Unit&) const {}
};

__device__ __forceinline__ void p3_prep(Frame& F) {
    const int gw = F.vcu * NWAVES + F.wave, NGW = F.G * NWAVES;
    {
        LAS bf16* tl = (LAS bf16*)(F.lds + RING_OFF + F.wave * 16384);
        const bf16* V = WSP(bf16, WS_V); bf16* VT = WSP(bf16, WS_VT);
        for (int it = gw; it < BATCH * NH * (SEQ / 64); it += NGW) {
            const int kt = it % (SEQ / 64), h = (it / (SEQ / 64)) % NH, b = it / (NH * (SEQ / 64));
            const bf16* src = V + (size_t)(b * SEQ + kt * 64 + F.lane) * 512 + h * 64;
#pragma unroll
            for (int c = 0; c < 8; ++c) { const v4u w = *(const v4u*)(src + c * 8);
                LAS unsigned* d = (LAS unsigned*)(tl + F.lane * 66 + c * 8); d[0] = w.x; d[1] = w.y; d[2] = w.z; d[3] = w.w; }
            LDS_WAIT(); asm volatile("" ::: "memory");
            unsigned o[32];
#pragma unroll
            for (int p = 0; p < 64; p += 2) {
                const int i0 = p & 15, i1 = (p + 1) & 15, g = p & ~15;
                const int k0 = g + ((i0 < 4 || i0 >= 12) ? i0 : (i0 < 8 ? i0 + 4 : i0 - 4)), k1 = g + ((i1 < 4 || i1 >= 12) ? i1 : (i1 < 8 ? i1 + 4 : i1 - 4));
                o[p >> 1] = (unsigned)tl[k0 * 66 + F.lane] | ((unsigned)tl[k1 * 66 + F.lane] << 16); }
            bf16* dst = VT + ((size_t)((b * NH + h) * 64 + F.lane)) * SEQ + kt * 64;
#pragma unroll
            for (int c = 0; c < 8; ++c) *(v4u*)(dst + c * 8) = (v4u){o[4 * c], o[4 * c + 1], o[4 * c + 2], o[4 * c + 3]};
            LDS_WAIT(); asm volatile("" ::: "memory");
        }
    }
    {
        const bf16* CB = WSP(bf16, WS_CB); const bf16* U = WSP(bf16, WS_U); bf16* AC = WSP(bf16, WS_AC);
        for (int i = (gw * 64 + F.lane); i < T * 64; i += NGW * 64) {
            const int t = i >> 6, j = (i & 63) * 8, tt = t % SEQ;
            f32x4 c0, c1, u0, u1, a0, a1;
            unpack8(*(const v4u*)(CB + (size_t)t * 512 + j), c0, c1);
            unpack8(*(const v4u*)(U + (size_t)t * 512 + j), u0, u1);
            a0 = u0 * *(const f32x4*)(F.conv_w + 1024 + j); a1 = u1 * *(const f32x4*)(F.conv_w + 1024 + j + 4);
            if (tt >= 1) { unpack8(*(const v4u*)(U + (size_t)(t - 1) * 512 + j), u0, u1); a0 += u0 * *(const f32x4*)(F.conv_w + 512 + j); a1 += u1 * *(const f32x4*)(F.conv_w + 512 + j + 4); }
            if (tt >= 2) { unpack8(*(const v4u*)(U + (size_t)(t - 2) * 512 + j), u0, u1); a0 += u0 * *(const f32x4*)(F.conv_w + j); a1 += u1 * *(const f32x4*)(F.conv_w + j + 4); }
            *(v4u*)(AC + (size_t)t * 512 + j) = pack8(c0 * a0, c1 * a1);
        }
    }
    {
        const bf16* QI = WSP(bf16, WS_QI); const float* WI = WSP(float, WS_WI); bf16* QL = WSP(bf16, WS_QL); float* AT = WSP(float, SM_AT);
        for (int t = gw; t < T; t += NGW) {
            float ql = 0.f, a = 0.f;
#pragma unroll
            for (int h = 0; h < 8; ++h) { const float w = WI[(size_t)t * 8 + h]; const float v = bf1(QI[(size_t)t * 512 + h * 64 + F.lane]); ql += w * v; a += fabsf(w) * sqrtf(wave_sum(v * v)); }
            QL[(size_t)t * 64 + F.lane] = (bf16)f2bf(ql);
            if (F.lane == 0) AT[t] = a;
        }
    }
    {
        const bf16* KI = WSP(bf16, WS_KI); float mx = 0.f;
        for (int s = gw * 64 + F.lane; s < T; s += NGW * 64) { float q = 0.f;
#pragma unroll
            for (int c = 0; c < 8; ++c) { f32x4 a, b; unpack8(*(const v4u*)(KI + (size_t)s * 64 + c * 8), a, b); q += (a[0] * a[0] + a[1] * a[1]) + (a[2] * a[2] + a[3] * a[3]) + (b[0] * b[0] + b[1] * b[1]) + (b[2] * b[2] + b[3] * b[3]); }
            mx = fmaxf(mx, q); }
        mx = wave_max(mx);
        if (F.lane == 0) atomicMax((unsigned*)(F.ctl + CW_KMAX), __builtin_bit_cast(unsigned, sqrtf(mx)));
    }
}

__device__ __forceinline__ unsigned ord_key(float x) { if (x == 0.f) x = 0.f; const unsigned u = __builtin_bit_cast(unsigned, x); return (u & 0x80000000u) ? ~u : (u | 0x80000000u); }
__device__ __forceinline__ int t5_bucket(int n) {
    if (n < 16) return n;
    const int v = 16 + (int)(logf((float)n / 16.f) / 2.0794415416798357f * 16.f);
    return v < 31 ? v : 31;
}
__device__ __forceinline__ void pn_naive_dsa(Frame& F) {
    LAS float* sc = (LAS float*)(F.lds + RING_OFF);
    LAS float* qf = (LAS float*)(F.lds + RING_OFF + 32768);
    LAS float* wq = qf + 512;
    LAS unsigned* hist = (LAS unsigned*)(F.lds + RING_OFF + 36864);
    LAS int* sel = (LAS int*)(F.lds + RING_OFF + 40960);
    LAS float* pbuf = (LAS float*)(F.lds + RING_OFF + 45056);
    LAS int* wcnt = (LAS int*)(F.lds + RING_OFF + 53248);
    LAS int* bkt = (LAS int*)(F.lds + RING_OFF + 53248 + 256);
    const bf16* QI = WSP(bf16, WS_QI); const bf16* KI = WSP(bf16, WS_KI); const float* WI = WSP(float, WS_WI);
    const bf16* Qb = WSP(bf16, WS_Q); const bf16* Kb = WSP(bf16, WS_K); const bf16* Vb = WSP(bf16, WS_V); bf16* ATT = WSP(bf16, WS_ATT);
    if (F.tid < 128) bkt[F.tid] = t5_bucket(F.tid);
    __syncthreads();
    for (int qi_ = 0; qi_ < T / F.G + 1; ++qi_) {
        const int qidx = qi_ * F.G + F.vcu; if (qidx >= T) break;
        const int b = qidx / SEQ, t = qidx % SEQ, n = t + 1;
        qf[F.tid] = bf1(QI[(size_t)qidx * 512 + F.tid]);
        if (F.tid < 8) wq[F.tid] = WI[(size_t)qidx * 8 + F.tid];
        __syncthreads();
        for (int s = F.tid; s < n; s += 512) {
            float kf[64]; const bf16* kr = KI + (size_t)(b * SEQ + s) * 64;
#pragma unroll
            for (int c = 0; c < 8; ++c) { f32x4 a, bb; unpack8(*(const v4u*)(kr + c * 8), a, bb); kf[8 * c] = a[0]; kf[8 * c + 1] = a[1]; kf[8 * c + 2] = a[2]; kf[8 * c + 3] = a[3]; kf[8 * c + 4] = bb[0]; kf[8 * c + 5] = bb[1]; kf[8 * c + 6] = bb[2]; kf[8 * c + 7] = bb[3]; }
            float score = 0.f;
#pragma unroll 1
            for (int h = 0; h < 8; ++h) { float dsum = 0.f;
#pragma unroll
                for (int d4 = 0; d4 < 16; ++d4) { const f32x4 q4 = *(const LAS f32x4*)(qf + h * 64 + d4 * 4); dsum += q4[0] * kf[4 * d4] + q4[1] * kf[4 * d4 + 1] + q4[2] * kf[4 * d4 + 2] + q4[3] * kf[4 * d4 + 3]; }
                score += wq[h] * fmaxf(dsum, 0.f); }
            sc[s] = score;
        }
        __syncthreads();
        unsigned prefix = 0u, pmask = 0u; int need = TOPK;
        if (n > TOPK) {
            for (int pass = 0; pass < 4; ++pass) {
                const int shift = 24 - 8 * pass;
                if (F.tid < 256) hist[F.tid] = 0u;
                __syncthreads();
                for (int s = F.tid; s < n; s += 512) { const unsigned u = ord_key(sc[s]); if ((u & pmask) == prefix) atomicAdd((unsigned*)&hist[(u >> shift) & 255u], 1u); }
                __syncthreads();
                if (F.wave == 0) {
                    int c4[4]; int tot = 0;
#pragma unroll
                    for (int j = 0; j < 4; ++j) { c4[j] = (int)hist[4 * F.lane + j]; tot += c4[j]; }
                    int incl = tot;
#pragma unroll
                    for (int o = 1; o < 64; o <<= 1) { const int v = __shfl_down(incl, o); if (F.lane + o < 64) incl += v; }
                    const int above = incl - tot;
                    if (above < need && need <= incl) { int run = above;
#pragma unroll
                        for (int j = 3; j >= 0; --j) { if (run < need && need <= run + c4[j]) { wcnt[16] = 4 * F.lane + j; wcnt[17] = need - run; } run += c4[j]; } }
                }
                __syncthreads();
                prefix |= (unsigned)wcnt[16] << shift; pmask |= 255u << shift; need = wcnt[17];
                __syncthreads();
            }
        }
        int cg = 0, ce = 0;
        for (int i = 0; i < 16; ++i) { const int s = F.wave * 1024 + i * 64 + F.lane; bool gt = false, eq = false;
            if (s < n) { if (n <= TOPK) gt = true; else { const unsigned u = ord_key(sc[s]); gt = u > prefix; eq = (u == prefix); } }
            cg += __popcll(__ballot(gt)); ce += __popcll(__ballot(eq)); }
        if (F.lane == 0) { wcnt[2 * F.wave] = cg; wcnt[2 * F.wave + 1] = ce; }
        __syncthreads();
        int eqb = 0, tkb = 0, nsel = 0;
        { int eq_before = 0;
          for (int w = 0; w < 8; ++w) { const int g = wcnt[2 * w], e = wcnt[2 * w + 1];
              int take_e = need - eq_before; take_e = take_e < 0 ? 0 : (take_e > e ? e : take_e); if (n <= TOPK) take_e = 0;
              if (w < F.wave) { eqb += e; tkb += g + take_e; }
              nsel += g + take_e; eq_before += e; } }
        for (int i = 0; i < 16; ++i) { const int s = F.wave * 1024 + i * 64 + F.lane; bool gt = false, eq = false;
            if (s < n) { if (n <= TOPK) gt = true; else { const unsigned u = ord_key(sc[s]); gt = u > prefix; eq = (u == prefix); } }
            const unsigned long long mg = __ballot(gt), me = __ballot(eq), lt = (1ull << F.lane) - 1ull;
            const int erank = eqb + __popcll(me & lt);
            const bool take = gt || (eq && erank < need);
            const unsigned long long mt = __ballot(take);
            if (take) sel[tkb + __popcll(mt & lt)] = s;
            eqb += __popcll(me); tkb += __popcll(mt); (void)mg; }
        __syncthreads();
        {
            const int h = F.wave;
            qf[F.tid] = bf1(Qb[(size_t)qidx * 512 + F.tid]);
            __syncthreads();
            float lg[4]; float mx = -INFINITY;
#pragma unroll
            for (int i = 0; i < 4; ++i) { const int j = F.lane + 64 * i; lg[i] = -INFINITY;
                if (j < nsel) { const int s = sel[j]; const bf16* kr = Kb + (size_t)(b * SEQ + s) * 512 + h * 64; float dsum = 0.f;
#pragma unroll
                    for (int c = 0; c < 8; ++c) { f32x4 a, bb; unpack8(*(const v4u*)(kr + c * 8), a, bb); const f32x4 q0 = *(const LAS f32x4*)(qf + h * 64 + c * 8), q1 = *(const LAS f32x4*)(qf + h * 64 + c * 8 + 4);
                        dsum += (q0[0] * a[0] + q0[1] * a[1]) + (q0[2] * a[2] + q0[3] * a[3]) + (q1[0] * bb[0] + q1[1] * bb[1]) + (q1[2] * bb[2] + q1[3] * bb[3]); }
                    const int dist = t - s; const int bk = dist < 128 ? bkt[dist] : 31;
                    lg[i] = dsum + F.rel_bias[bk * 8 + h] * LOG2E; mx = fmaxf(mx, lg[i]); } }
            mx = wave_max(mx); float sum = 0.f;
#pragma unroll
            for (int i = 0; i < 4; ++i) { const int j = F.lane + 64 * i; const float p = (j < nsel) ? __builtin_amdgcn_exp2f(lg[i] - mx) : 0.f; sum += p; pbuf[h * 256 + j] = p; }
            sum = wave_sum(sum);
            LDS_WAIT(); asm volatile("" ::: "memory");
            float o = 0.f;
            for (int j = 0; j < nsel; ++j) o += pbuf[h * 256 + j] * bf1(Vb[(size_t)(b * SEQ + sel[j]) * 512 + h * 64 + F.lane]);
            ATT[(size_t)qidx * 512 + h * 64 + F.lane] = (bf16)f2bf(o / sum);
        }
        __syncthreads();
    }
}

__device__ __forceinline__ void p9_norm2_route(Frame& F, const float* HRES) {
    const int gw = F.vcu * NWAVES + F.wave, NGW = F.G * NWAVES;
    const float* mod = WSP(float, SM_MOD); const float* WRT = WSP(float, SM_WRT);
    LAS float* lg = (LAS float*)(F.lds + RING_OFF + F.wave * 16384 + 8448);
    int* EID = WSP(int, SM_EID); float* EWT = WSP(float, SM_EWT); int* SLOT = WSP(int, SM_SLOT); bf16* H2 = WSP(bf16, WS_H1);
    for (int m4 = gw; m4 < T / 4; m4 += NGW) {
        const int m0 = m4 * 4, b = m0 / SEQ;
        f32x4 hv[4][4];
#pragma unroll
        for (int r = 0; r < 4; ++r) {
            const GAS f32x4* xr = (const GAS f32x4*)(HRES + (size_t)(m0 + r) * D) + F.lane; float s = 0.f;
#pragma unroll
            for (int j = 0; j < 4; ++j) { hv[r][j] = xr[64 * j]; s += (hv[r][j].x * hv[r][j].x + hv[r][j].y * hv[r][j].y) + (hv[r][j].z * hv[r][j].z + hv[r][j].w * hv[r][j].w); }
            const float rstd = 1.f / sqrtf(wave_sum(s) * (1.f / D) + EPS);
            GAS v2u* o8 = (GAS v2u*)(H2 + (size_t)(m0 + r) * D) + F.lane;
#pragma unroll
            for (int j = 0; j < 4; ++j) { const int k = 4 * F.lane + 256 * j;
                const f32x4 g = *(const f32x4*)(F.norm2_g + k), scl = *(const f32x4*)(mod + b * 6144 + 4096 + k), sh = *(const f32x4*)(mod + b * 6144 + 3072 + k);
                hv[r][j] = hv[r][j] * rstd * (g * (scl + 1.0f)) + sh; o8[64 * j] = (v2u){pk2(hv[r][j].x, hv[r][j].y), pk2(hv[r][j].z, hv[r][j].w)}; }
        }
        for (int n = 0; n < 36; ++n) {
            f32x4 w[4];
#pragma unroll
            for (int j = 0; j < 4; ++j) w[j] = *(const f32x4*)(WRT + n * D + 4 * F.lane + 256 * j);
            float p[4];
#pragma unroll
            for (int r = 0; r < 4; ++r) { float a = 0.f;
#pragma unroll
                for (int j = 0; j < 4; ++j) a += (hv[r][j].x * w[j].x + hv[r][j].y * w[j].y) + (hv[r][j].z * w[j].z + hv[r][j].w * w[j].w);
                p[r] = wave_sum(a); }
            if (F.lane < 4) lg[F.lane * 36 + n] = (F.lane == 0 ? p[0] : F.lane == 1 ? p[1] : F.lane == 2 ? p[2] : p[3]) + (n < 4 ? F.brg[n] : F.bre[n - 4]);
        }
        LDS_WAIT(); asm volatile("" ::: "memory");
        if (F.lane < 4) {
            const LAS float* l = lg + F.lane * 36; const int tkn = m0 + F.lane;
            int gs = 0; float gm = l[0];
#pragma unroll
            for (int j = 1; j < 4; ++j) if (l[j] > gm) { gm = l[j]; gs = j; }
            float gsum = 0.f;
#pragma unroll
            for (int j = 0; j < 4; ++j) gsum += __expf(l[j] - gm);
            const float gwt = 1.f / gsum;
            const LAS float* el = l + 4 + 8 * gs;
            int i0 = 0; float l0 = el[0];
#pragma unroll
            for (int j = 1; j < 8; ++j) if (el[j] > l0) { l0 = el[j]; i0 = j; }
            int i1 = -1; float l1 = -INFINITY;
#pragma unroll
            for (int j = 0; j < 8; ++j) if (j != i0 && el[j] > l1) { l1 = el[j]; i1 = j; }
            const float e1 = __expf(l1 - l0), p0 = 1.f / (1.f + e1), p1 = e1 * p0;
            const int e0id = gs * 8 + i0, e1id = gs * 8 + i1;
            EID[tkn * 2] = e0id; EID[tkn * 2 + 1] = e1id; EWT[tkn * 2] = gwt * p0; EWT[tkn * 2 + 1] = gwt * p1;
            SLOT[tkn * 2] = (int)atomicAdd((unsigned*)(F.ctl + CW_ECNT + 16 * e0id), 1u);
            SLOT[tkn * 2 + 1] = (int)atomicAdd((unsigned*)(F.ctl + CW_ECNT + 16 * e1id), 1u);
        }
        LDS_WAIT(); asm volatile("" ::: "memory");
    }
    {
        LAS float* scr = (LAS float*)(F.lds + RING_OFF + F.wave * 16384);
        for (int it = gw; it < NEXP * 768; it += NGW) {
            const int e = it / 768, r = it % 768;
            if (r < 256) transpose_item(F.w_gate_e + (size_t)e * D * DEXP, D, DEXP, WSP(bf16, WS_WGU) + (size_t)e * 1024 * D, scr, r, F.lane, RmGU{0});
            else if (r < 512) transpose_item(F.w_up_e + (size_t)e * D * DEXP, D, DEXP, WSP(bf16, WS_WGU) + (size_t)e * 1024 * D, scr, r - 256, F.lane, RmGU{1});
            else transpose_item(F.w_down_e + (size_t)e * DEXP * D, DEXP, D, WSP(bf16, WS_WD) + (size_t)e * D * DEXP, scr, r - 512, F.lane, RmId());
        }
    }
}
__device__ __forceinline__ int moe_tables(Frame& F, LAS int* off, LAS int* tile_e) {
    if (F.tid == 0) { int o = 0, nt = 0;
        for (int e = 0; e < NEXP; ++e) { const int c = (int)__hip_atomic_load(F.ctl + CW_ECNT + 16 * e, RLX_AGENT); off[e] = o; const int tl = (c + 255) >> 8; for (int j = 0; j < tl; ++j) tile_e[nt++] = e; o += tl * 256; }
        off[NEXP] = nt; }
    __syncthreads();
    return off[NEXP];
}
__device__ __forceinline__ void p10_gather(Frame& F, LAS int* off) {
    const int gw = F.vcu * NWAVES + F.wave, NGW = F.G * NWAVES;
    const int* EID = WSP(int, SM_EID); int* SLOT = WSP(int, SM_SLOT); const bf16* H2 = WSP(bf16, WS_H1); bf16* XP = WSP(bf16, WS_XP);
    for (int t = gw; t < T; t += NGW) {
        const v4u a = *(const v4u*)(H2 + (size_t)t * D + F.lane * 16), b = *(const v4u*)(H2 + (size_t)t * D + F.lane * 16 + 8);
#pragma unroll
        for (int k = 0; k < 2; ++k) { const int row = off[EID[t * 2 + k]] + SLOT[t * 2 + k];
            *(v4u*)(XP + (size_t)row * D + F.lane * 16) = a; *(v4u*)(XP + (size_t)row * D + F.lane * 16 + 8) = b;
            if (F.lane == 0) SLOT[t * 2 + k] = row; }
    }
}
__device__ __forceinline__ void p13_combine(Frame& F, const float* HRES) {
    const int gw = F.vcu * NWAVES + F.wave, NGW = F.G * NWAVES;
    const float* mod = WSP(float, SM_MOD); const int* SLOT = WSP(int, SM_SLOT); const float* EWT = WSP(float, SM_EWT); const bf16* Y = WSP(bf16, WS_Y);
    for (int m = gw; m < T; m += NGW) {
#if DBG_SKIP_MOE
        const int b = m / SEQ; const int r0 = 0, r1 = 0; const float w0 = 0.f, w1 = 0.f; (void)SLOT; (void)EWT;
#else
        const int b = m / SEQ; const int r0 = SLOT[m * 2], r1 = SLOT[m * 2 + 1]; const float w0 = EWT[m * 2], w1 = EWT[m * 2 + 1];
#endif
        const GAS f32x4* xr = (const GAS f32x4*)(HRES + (size_t)m * D) + F.lane;
        const GAS v2u* y0 = (const GAS v2u*)(Y + (size_t)r0 * D) + F.lane; const GAS v2u* y1 = (const GAS v2u*)(Y + (size_t)r1 * D) + F.lane;
        f32x4 v[4]; float s = 0.f;
#pragma unroll
        for (int j = 0; j < 4; ++j) { const int k = 4 * F.lane + 256 * j; const v2u a = y0[64 * j], c = y1[64 * j];
            const f32x4 ya = (f32x4){bflo(a.x), bfhi(a.x), bflo(a.y), bfhi(a.y)}, yb = (f32x4){bflo(c.x), bfhi(c.x), bflo(c.y), bfhi(c.y)};
            const f32x4 g2 = *(const f32x4*)(mod + b * 6144 + 5120 + k);
#if DBG_SKIP_MOE
            v[j] = xr[64 * j]; (void)g2; (void)ya; (void)yb;
#else
            v[j] = xr[64 * j] + g2 * (ya * w0 + yb * w1);
#endif
            s += (v[j].x * v[j].x + v[j].y * v[j].y) + (v[j].z * v[j].z + v[j].w * v[j].w); }
        const float rstd = 1.f / sqrtf(wave_sum(s) * (1.f / D) + EPS);
        GAS f32x4* o = (GAS f32x4*)(F.out + (size_t)m * D) + F.lane;
#pragma unroll
        for (int j = 0; j < 4; ++j) o[64 * j] = v[j] * rstd * *(const f32x4*)(F.norm_f_g + 4 * F.lane + 256 * j);
    }
}

struct Args { const float* in[20]; float* out; unsigned char* ws; int ph_lo, ph_hi, li, pad; };
__global__ void __launch_bounds__(NWAVES * 64, 2) fwd_kernel(Args args) {
    extern __shared__ __attribute__((aligned(16))) unsigned char lds[];
    Frame F;
    F.lds = (LAS unsigned char*)lds;
    F.MISC = (volatile LAS unsigned*)(F.lds + MISC_OFF);
    F.tid = threadIdx.x; F.lane = F.tid & 63; F.wave = __builtin_amdgcn_readfirstlane(F.tid >> 6);
    F.G = gridDim.x; { const int bx = blockIdx.x; F.vcu = (F.G % 8 == 0) ? (bx % 8) * (F.G / 8) + bx / 8 : bx; }
    F.ws = args.ws; F.ctl = (gu32*)(args.ws + WS_CTL);
    F.x = args.in[0]; F.c = args.in[1]; F.w_ada = args.in[2]; F.b_ada = args.in[3]; F.norm1_g = args.in[4]; F.w_in = args.in[5]; F.rel_bias = args.in[6]; F.conv_w = args.in[7];
    F.w_attn = args.in[8]; F.w_conv = args.in[9]; F.w_out = args.in[10]; F.norm2_g = args.in[11]; F.wrg = args.in[12]; F.brg = args.in[13]; F.wre = args.in[14]; F.bre = args.in[15];
    F.w_gate_e = args.in[16]; F.w_up_e = args.in[17]; F.w_down_e = args.in[18]; F.norm_f_g = args.in[19]; F.out = args.out;
    for (int u = F.tid; u < (LDS_BYTES - LDSCTL_OFF) / 4; u += NWAVES * 64) ((LAS unsigned*)(F.lds + LDSCTL_OFF))[u] = 0u;
    __syncthreads();
    XcdBarrier bar; bar.bar = (unsigned*)(F.ctl + CW_BAR); bar.x = 0; bar.st = nullptr;
    if (!MK_PER_PHASE) bar = xcd_barrier_post((unsigned*)(F.ctl + CW_BAR), F.MISC + 8);
#define GRID_BAR() do { if (MK_PER_PHASE) { if (F.tid == 0) __hip_atomic_store(F.ctl + CW_TMO, 0xBADBA0u, RLX_AGENT); } else { xcd_barrier(bar); } } while (0)
    const int lo = args.ph_lo, hi = args.ph_hi;
#ifndef ONLY_PHASE
#define ONLY_PHASE -1
#endif
#define IN(k) ((ONLY_PHASE < 0 || ONLY_PHASE == (k)) && lo <= (k) && (k) < hi)
#define BOTH(k) (IN(k) && IN((k) + 1))
    float* HRES = F.out;
    LAS int* moe_off = (LAS int*)(F.lds + LDSCTL_OFF + 1024);
    LAS int* moe_tile = (LAS int*)(F.lds + LDSCTL_OFF + 1024 + 256);

    if (IN(0)) { p0_prologue(F); if (BOTH(0)) GRID_BAR(); }
    if (IN(1)) { p1_norm1(F); if (BOTH(1)) GRID_BAR(); }
    if (IN(2)) {
        pg8::Gemm g{WSP(bf16, WS_H1), WSP(bf16, WS_WIN), T, NINP, D}; pg8::StaticOrder S; S.init(T, NINP, F.G, (int)blockIdx.x);
        EpiProj E{WSP(bf16, WS_Q), WSP(bf16, WS_K), WSP(bf16, WS_V), WSP(bf16, WS_QI), WSP(bf16, WS_KI), WSP(bf16, WS_CB), WSP(bf16, WS_U), WSP(bf16, WS_G), WSP(float, WS_WI)};
        pg8::gemm_phase<EpiProj, pg8::StaticOrder, true, true>(F.lds + RING_OFF, g, S, E);
        if (BOTH(2)) GRID_BAR();
    }
    if (IN(3)) { p3_prep(F); if (BOTH(3)) GRID_BAR(); }
    if (IN(4)) {
        pg8::Gemm g{WSP(bf16, WS_AC), WSP(bf16, WS_WC), T, D, AW}; pg8::StaticOrder S; S.init(T, D, F.G, (int)blockIdx.x);
        EpiConv E{WSP(bf16, WS_G), WSP(bf16, WS_TMPC)};
        pg8::gemm_phase<EpiConv, pg8::StaticOrder, true, true>(F.lds + RING_OFF, g, S, E);
        if (BOTH(4)) GRID_BAR();
    }
    if (IN(5)) {
#if DBG_SKIP_ATTN
        for (size_t i = (size_t)blockIdx.x * 512 + F.tid; i < (size_t)T * 512 / 8; i += (size_t)F.G * 512) *(v4u*)(WSP(bf16, WS_ATT) + i * 8) = (v4u){0u, 0u, 0u, 0u};
#else
        pn_naive_dsa(F);
#endif
        if (BOTH(5)) GRID_BAR(); }
    if (IN(6)) { if (BOTH(6)) GRID_BAR(); }
    if (IN(7)) {
        pg8::Gemm g{WSP(bf16, WS_ATT), WSP(bf16, WS_WA), T, D, AW}; pg8::StaticOrder S; S.init(T, D, F.G, (int)blockIdx.x);
        EpiAttn E{WSP(bf16, WS_G), WSP(bf16, WS_TMPC), WSP(bf16, WS_MERGED)};
        pg8::gemm_phase<EpiAttn, pg8::StaticOrder, true, true>(F.lds + RING_OFF, g, S, E);
        if (BOTH(7)) GRID_BAR();
    }
    if (IN(8)) {
        pg8::Gemm g{WSP(bf16, WS_MERGED), WSP(bf16, WS_WOUT), T, D, D}; pg8::StaticOrder S; S.init(T, D, F.G, (int)blockIdx.x);
        EpiOut E{F.x, WSP(float, SM_MOD), HRES};
        pg8::gemm_phase<EpiOut, pg8::StaticOrder, true, true>(F.lds + RING_OFF, g, S, E);
        if (BOTH(8)) GRID_BAR();
    }
#if DBG_SKIP_MOE
    if (0) {
#endif
    if (IN(9)) { p9_norm2_route(F, HRES); if (BOTH(9)) GRID_BAR(); }
    if (IN(10)) { (void)moe_tables(F, moe_off, moe_tile); p10_gather(F, moe_off); if (BOTH(10)) GRID_BAR(); }
    if (IN(11)) {
        const int nt = moe_tables(F, moe_off, moe_tile);
        pg8::Gemm g{WSP(bf16, WS_XP), WSP(bf16, WS_WGU), XPROWS, NEXP * 1024, D}; MoeOrder S{moe_tile, nt, F.G, (int)blockIdx.x};
        EpiHid E{WSP(bf16, WS_HID)};
        pg8::gemm_phase<EpiHid, MoeOrder, true, true>(F.lds + RING_OFF, g, S, E);
        if (BOTH(11)) GRID_BAR();
    }
    if (IN(12)) {
        const int nt = moe_tables(F, moe_off, moe_tile);
        pg8::Gemm g{WSP(bf16, WS_HID), WSP(bf16, WS_WD), XPROWS, NEXP * 1024, DEXP}; MoeOrder S{moe_tile, nt, F.G, (int)blockIdx.x};
        EpiY E{WSP(bf16, WS_Y)};
        pg8::gemm_phase<EpiY, MoeOrder, true, true>(F.lds + RING_OFF, g, S, E);
        if (BOTH(12)) GRID_BAR();
    }
#if DBG_SKIP_MOE
    }
#endif
#if DBG_PROBE
    if (IN(13)) {
        const bf16* src = nullptr; int pitch = 1024;
        if (DBG_PROBE == 1) { src = WSP(bf16, WS_MERGED); pitch = 1024; }
        if (DBG_PROBE == 2) { src = WSP(bf16, WS_TMPC); pitch = 1024; }
        if (DBG_PROBE == 3) { src = WSP(bf16, WS_AC); pitch = 512; }
        if (DBG_PROBE == 4) { src = WSP(bf16, WS_G); pitch = 2048; }
        if (DBG_PROBE == 5) { src = WSP(bf16, WS_H1); pitch = 1024; }
        if (DBG_PROBE == 6) { src = WSP(bf16, WS_WIN); pitch = 1024; }
        if (DBG_PROBE == 7) { src = WSP(bf16, WS_QI); pitch = 512; }
        for (size_t i = (size_t)blockIdx.x * 512 + F.tid; i < (size_t)T * D; i += (size_t)F.G * 512) { const size_t m = i / D, j = i % D;
            float v;
            if (DBG_PROBE == 8) v = WSP(float, SM_MOD)[i % 12288];
            else if (DBG_PROBE == 4) v = bf1(src[m * 2048 + j]) + bf1(src[m * 2048 + 1024 + j]);
            else if (DBG_PROBE >= 40 && DBG_PROBE < 48) v = bf1(WSP(bf16, WS_G)[m * 2048 + (DBG_PROBE - 40) * 256 + (j & 255)]);
            else if (DBG_PROBE == 6) v = bf1(src[(m % 5888) * 1024 + j]);
            else v = bf1(src[m * pitch + (j % pitch)]);
            F.out[i] = v; }
    }
#else
    if (IN(13)) { p13_combine(F, DBG_SKIP_MIX ? F.x : HRES); }
#endif
#undef IN
#undef BOTH
}

extern "C" void kernel_launch(void* const* d_in, const int* in_sizes, int n_in, void* d_out, int out_size, void* d_ws, size_t ws_size, hipStream_t stream) {
    static int grid = 0;
    if (grid == 0) {
        if (n_in != 20 || in_sizes[0] != T * D || out_size != T * D || ws_size < WS_END) { fprintf(stderr, "kernel_launch: unexpected shapes: n_in %d in0 %d out %d ws %zu (need %zu)\n", n_in, n_in > 0 ? in_sizes[0] : -1, out_size, ws_size, (size_t)WS_END); grid = -1; return; }
        int dev = 0, cus = 0, per_cu = 0;
        if (hipGetDevice(&dev) != hipSuccess || hipDeviceGetAttribute(&cus, hipDeviceAttributeMultiprocessorCount, dev) != hipSuccess) { grid = -1; return; }
        if (hipFuncSetAttribute((const void*)fwd_kernel, hipFuncAttributeMaxDynamicSharedMemorySize, LDS_BYTES) != hipSuccess) { fprintf(stderr, "kernel_launch: hipFuncSetAttribute failed\n"); grid = -1; return; }
        if (hipOccupancyMaxActiveBlocksPerMultiprocessor(&per_cu, (const void*)fwd_kernel, NWAVES * 64, LDS_BYTES) != hipSuccess || per_cu < 1)
            fprintf(stderr, "kernel_launch: note: occupancy query reports %d workgroups per CU\n", per_cu);
        (void)hipGetLastError();
        grid = cus;
    }
    if (grid < 0) return;
    if (hipMemsetAsync((char*)d_ws + WS_CTL, 0, CTL_ZERO_BYTES, stream) != hipSuccess) return;
    Args a{};
    for (int i = 0; i < 20; ++i) a.in[i] = (const float*)d_in[i];
    a.out = (float*)d_out; a.ws = (unsigned char*)d_ws;
#if MK_PER_PHASE
    for (int li = 0; li < N_PHASES; ++li) { a.ph_lo = li; a.ph_hi = li + 1; a.li = li; hipLaunchKernelGGL(fwd_kernel, dim3(grid), dim3(NWAVES * 64), LDS_BYTES, stream, a); }
#else
    a.ph_lo = 0; a.ph_hi = N_PHASES; a.li = 0;
    hipLaunchKernelGGL(fwd_kernel, dim3(grid), dim3(NWAVES * 64), LDS_BYTES, stream, a);
#endif
}
```

```cpp
#include <hip/hip_runtime.h>
#include <cstdio>
#include <cstdint>

namespace pg8 {
#define PG8_LAS __attribute__((address_space(3)))
typedef unsigned short bf16_t;
typedef short bf16x8 __attribute__((ext_vector_type(8)));
typedef float f32x4 __attribute__((ext_vector_type(4)));
typedef unsigned u32x4 __attribute__((ext_vector_type(4)));
constexpr int BM = 256, BK = 64, HALF = 128, HTB = HALF * BK * 2  , STAGE_BYTES = 8 * HTB, NXCD = 8, WGM = 8;

__host__ __device__ __forceinline__ int lds_byte(int r, int c) { const int st = (r >> 4) * 2 + (c >> 5), rr = r & 15, cc = c & 31, ob = rr * 64 + cc * 2; return st * 1024 + (ob ^ (((ob >> 9) & 1) << 5)); }
__host__ __device__ __forceinline__ void stage_rc(int b, int& R, int& C) { const int st = b / 1024, sb = b % 1024, swz = sb ^ (((sb >> 9) & 1) << 5); R = (st >> 1) * 16 + swz / 64; C = (st & 1) * 32 + (swz % 64) / 2; }
__host__ __device__ __forceinline__ int perm32(int rho) { const int n = rho >> 4, i = rho & 15; return 8 * (i >> 2) + 4 * n + (i & 3); }

struct Unit { int pm, pn; };
struct Gemm { const bf16_t* A; const bf16_t* Bt; int M, N, K; };

struct StaticOrder {
    int nM, nN, nwg, G, c;
    __host__ __device__ void init(int M, int N, int G_, int c_) { nM = M / BM; nN = N / BM; nwg = nM * nN; G = G_; c = c_; }
    __host__ __device__ bool next(int i, Unit& u) const {
        const long L = (long)i * G + c; if (L >= nwg) return false;
        int wgid = (int)L; { const int q = nwg / NXCD, r = nwg % NXCD, xcd = wgid % NXCD, off = wgid / NXCD; wgid = (xcd < r ? xcd * (q + 1) : r * (q + 1) + (xcd - r) * q) + off; }
        const int nig = WGM * nN, gid = wgid / nig, fm = gid * WGM, gsz = (nM - fm) < WGM ? (nM - fm) : WGM;
        u.pm = fm + ((wgid % nig) % gsz); u.pn = (wgid % nig) / gsz; return true;
    }
    __device__ __forceinline__ void a_ready(const Unit&) const {}
    __device__ __forceinline__ void done(const Unit&) const {}
};
__device__ __forceinline__ unsigned cvt_pk_bf16(float lo, float hi) { unsigned r; asm volatile("v_cvt_pk_bf16_f32 %0, %1, %2" : "=v"(r) : "v"(lo), "v"(hi)); return r; }

template <class Epi, class Sched, bool ALIGN_EPI = false, bool SP2 = false>
__device__ __forceinline__ void gemm_phase(PG8_LAS unsigned char* lds, const Gemm g, const Sched& S, const Epi& E) {
    const int tid = threadIdx.x, wid = __builtin_amdgcn_readfirstlane(tid >> 6), lane = tid & 63, wr = wid >> 2, wc = wid & 3, fr = lane & 15, fq = lane >> 4;
    const int K = g.K, nt = K / BK;
    unsigned voffA[2], voffB[2];
#pragma unroll
    for (int i = 0; i < 2; ++i) { int R, C; stage_rc(tid * 16 + i * 8192, R, C); const int Rb = Epi::PERM ? ((R & ~31) + perm32(R & 31)) : R;
        voffA[i] = (unsigned)(R * K + C) * 2u; voffB[i] = (unsigned)(Rb * K + C) * 2u; }
    const size_t kstep = (size_t)(BK * 2);
    const size_t hstep = (size_t)HALF * K * 2;
    const size_t tstep = 2 * hstep;
    const unsigned ldsw = (unsigned)wid * 1024u;
    const int aoff = lds_byte(wr * 64 + fr, fq * 8), boff = lds_byte(wc * 32 + fr, fq * 8);
#define PG8_SA(b, h) (((b) * 2 + (h)) * HTB)
#define PG8_SB(b, h) ((4 + (b) * 2 + (h)) * HTB)
#define PG8_STAGE(bufoff, gbase, voff) do { _Pragma("unroll") for (int _i = 0; _i < 2; ++_i) \
        __builtin_amdgcn_global_load_lds((const unsigned*)((const char*)(gbase) + (voff)[_i]), (PG8_LAS unsigned*)(lds + (bufoff) + ldsw + _i * 8192), 16, 0, 0); } while (0)
#define PG8_LDA(dst, b, h) do { _Pragma("unroll") for (int m = 0; m < 4; ++m) _Pragma("unroll") for (int k = 0; k < 2; ++k) dst[m][k] = *(const PG8_LAS bf16x8*)(lds + PG8_SA(b, h) + aoff + m * 2048 + k * 1024); } while (0)
#define PG8_LDB(dst, b, h) do { _Pragma("unroll") for (int n = 0; n < 2; ++n) _Pragma("unroll") for (int k = 0; k < 2; ++k) dst[n][k] = *(const PG8_LAS bf16x8*)(lds + PG8_SB(b, h) + boff + n * 2048 + k * 1024); } while (0)
#define PG8_MMA(ai, bj, At, Bt) do { __builtin_amdgcn_s_setprio(1); _Pragma("unroll") for (int m = 0; m < 4; ++m) _Pragma("unroll") for (int n = 0; n < 2; ++n) _Pragma("unroll") for (int k = 0; k < 2; ++k) \
        acc[ai][bj][m][n] = __builtin_amdgcn_mfma_f32_16x16x32_bf16(Bt[n][k], At[m][k], acc[ai][bj][m][n], 0, 0, 0); __builtin_amdgcn_s_setprio(0); } while (0)
#define PG8_WAIT_V(n) asm volatile("s_waitcnt vmcnt(" #n ")" ::: "memory")
#define PG8_WAIT_L(n) asm volatile("s_waitcnt lgkmcnt(" #n ")" ::: "memory")
#define PG8_BAR __builtin_amdgcn_s_barrier()
#define PG8_SCHED __builtin_amdgcn_sched_barrier(0)
    Unit cur, nxt; int ui = 0;
    if (!S.next(0, cur)) return;
    f32x4 acc[2][2][4][2];
#pragma unroll
    for (int a = 0; a < 2; ++a)
#pragma unroll
        for (int b = 0; b < 2; ++b)
#pragma unroll
            for (int m = 0; m < 4; ++m)
#pragma unroll
                for (int n = 0; n < 2; ++n) acc[a][b][m][n] = (f32x4){0.f, 0.f, 0.f, 0.f};
    bf16x8 At[4][2], B0[2][2], B1[2][2];
    const char* cA = (const char*)g.A + (size_t)cur.pm * tstep; const char* cB = (const char*)g.Bt + (size_t)cur.pn * tstep;
    S.a_ready(cur);
    if constexpr (SP2) {
        PG8_STAGE(PG8_SB(0, 0), cB, voffB); PG8_STAGE(PG8_SB(0, 1), cB + hstep, voffB); PG8_STAGE(PG8_SA(0, 0), cA, voffA); PG8_STAGE(PG8_SA(0, 1), cA + hstep, voffA);
        if (wr == 1) PG8_BAR;
        PG8_WAIT_V(2); PG8_BAR;
        PG8_STAGE(PG8_SB(1, 0), cB + kstep, voffB); PG8_STAGE(PG8_SA(1, 0), cA + kstep, voffA); PG8_STAGE(PG8_SB(1, 1), cB + hstep + kstep, voffB);
        PG8_WAIT_V(6); PG8_BAR;
    } else {
        PG8_STAGE(PG8_SB(0, 0), cB, voffB); PG8_STAGE(PG8_SA(0, 0), cA, voffA); PG8_STAGE(PG8_SB(0, 1), cB + hstep, voffB); PG8_STAGE(PG8_SA(0, 1), cA + hstep, voffA);
        if (wr == 1) PG8_BAR;
        PG8_WAIT_V(4); PG8_BAR;
        PG8_STAGE(PG8_SB(1, 0), cB + kstep, voffB); PG8_STAGE(PG8_SA(1, 0), cA + kstep, voffA); PG8_STAGE(PG8_SB(1, 1), cB + hstep + kstep, voffB);
        PG8_WAIT_V(6); PG8_BAR;
    }
    for (;;) {
        const bool has_next = S.next(ui + 1, nxt);
        const char* nA = has_next ? (const char*)g.A + (size_t)nxt.pm * tstep : cA; const char* nB = has_next ? (const char*)g.Bt + (size_t)nxt.pn * tstep : cB;
        for (int t = 0; t < nt; t += 2) {
            const bool last = (t == nt - 2);
            const char* a1 = cA + (size_t)(t + 1) * kstep;
            const char* a2 = last ? nA : cA + (size_t)(t + 2) * kstep; const char* b2 = last ? nB : cB + (size_t)(t + 2) * kstep;
            const char* a3 = a2 + kstep; const char* b3 = b2 + kstep;
            if (last && has_next) S.a_ready(nxt);
            if constexpr (SP2) {
            PG8_LDB(B0, 0, 0); PG8_LDB(B1, 0, 1); PG8_SCHED; PG8_LDA(At, 0, 0); PG8_STAGE(PG8_SA(1, 1), a1 + hstep, voffA);
            PG8_WAIT_V(8); PG8_WAIT_L(0); PG8_BAR; PG8_MMA(0, 0, At, B0); PG8_MMA(0, 1, At, B1); PG8_BAR; PG8_SCHED;
            PG8_LDA(At, 0, 1); PG8_STAGE(PG8_SB(0, 0), b2, voffB); PG8_STAGE(PG8_SB(0, 1), b2 + hstep, voffB); PG8_STAGE(PG8_SA(0, 0), a2, voffA);
            PG8_WAIT_V(8); PG8_WAIT_L(0); PG8_BAR; PG8_MMA(1, 0, At, B0); PG8_MMA(1, 1, At, B1); PG8_BAR; PG8_SCHED;
            PG8_LDB(B0, 1, 0); PG8_LDB(B1, 1, 1); PG8_SCHED; PG8_LDA(At, 1, 0); PG8_STAGE(PG8_SA(0, 1), a2 + hstep, voffA);
            PG8_WAIT_V(8); PG8_WAIT_L(0); PG8_BAR; PG8_MMA(0, 0, At, B0); PG8_MMA(0, 1, At, B1); PG8_BAR; PG8_SCHED;
            PG8_LDA(At, 1, 1); PG8_STAGE(PG8_SB(1, 0), b3, voffB); PG8_STAGE(PG8_SB(1, 1), b3 + hstep, voffB); PG8_STAGE(PG8_SA(1, 0), a3, voffA);
            PG8_WAIT_V(8); PG8_WAIT_L(0); PG8_BAR; PG8_MMA(1, 0, At, B0); PG8_MMA(1, 1, At, B1); PG8_BAR; PG8_SCHED;
            } else {
            PG8_LDB(B0, 0, 0); PG8_SCHED; PG8_LDA(At, 0, 0); PG8_STAGE(PG8_SA(1, 1), a1 + hstep, voffA);
            PG8_WAIT_L(8); PG8_BAR; PG8_WAIT_L(0); PG8_MMA(0, 0, At, B0); PG8_BAR; PG8_SCHED;
            PG8_LDB(B1, 0, 1); PG8_STAGE(PG8_SB(0, 0), b2, voffB);
            PG8_BAR; PG8_WAIT_L(0); PG8_MMA(0, 1, At, B1); PG8_BAR;
            PG8_LDA(At, 0, 1); PG8_STAGE(PG8_SA(0, 0), a2, voffA);
            PG8_BAR; PG8_WAIT_L(0); PG8_MMA(1, 0, At, B0); PG8_BAR; PG8_SCHED;
            PG8_STAGE(PG8_SB(0, 1), b2 + hstep, voffB);
            PG8_WAIT_V(6); PG8_BAR; PG8_MMA(1, 1, At, B1); PG8_BAR;
            PG8_LDB(B0, 1, 0); PG8_SCHED; PG8_LDA(At, 1, 0); PG8_STAGE(PG8_SA(0, 1), a2 + hstep, voffA);
            PG8_WAIT_L(8); PG8_BAR; PG8_WAIT_L(0); PG8_MMA(0, 0, At, B0); PG8_BAR; PG8_SCHED;
            PG8_LDB(B1, 1, 1); PG8_STAGE(PG8_SB(1, 0), b3, voffB);
            PG8_BAR; PG8_WAIT_L(0); PG8_MMA(0, 1, At, B1); PG8_BAR;
            PG8_LDA(At, 1, 1); PG8_STAGE(PG8_SA(1, 0), a3, voffA);
            PG8_BAR; PG8_WAIT_L(0); PG8_MMA(1, 0, At, B0); PG8_BAR; PG8_SCHED;
            PG8_STAGE(PG8_SB(1, 1), b3 + hstep, voffB);
            PG8_WAIT_V(6); PG8_BAR; PG8_MMA(1, 1, At, B1); PG8_BAR;
            }
        }
        if constexpr (ALIGN_EPI) { if (wr == 0) PG8_BAR; }
        if constexpr (!Epi::AFTER_DRAIN) { E(acc, cur, wr, wc, fr, fq); S.done(cur); }
        if (!has_next) break;
#pragma unroll
        for (int a = 0; a < 2; ++a)
#pragma unroll
            for (int b = 0; b < 2; ++b)
#pragma unroll
                for (int m = 0; m < 4; ++m)
#pragma unroll
                    for (int n = 0; n < 2; ++n) acc[a][b][m][n] = (f32x4){0.f, 0.f, 0.f, 0.f};
        cur = nxt; cA = nA; cB = nB; ++ui;
        if constexpr (ALIGN_EPI) { if (wr == 1) PG8_BAR; }
    }
    PG8_WAIT_V(0);
    if constexpr (!ALIGN_EPI) { if (wr == 0) PG8_BAR; }
    PG8_BAR;
    if constexpr (Epi::AFTER_DRAIN) { E.fused(acc, cur, wr, wc, fr, fq, lds, wid, lane); S.done(cur); }
#undef PG8_SA
#undef PG8_SB
#undef PG8_STAGE
#undef PG8_LDA
#undef PG8_LDB
#undef PG8_MMA
#undef PG8_WAIT_V
#undef PG8_WAIT_L
#undef PG8_BAR
#undef PG8_SCHED
}
}

constexpr int NWAVES = 8;
#ifndef MK_PER_PHASE
#define MK_PER_PHASE 0
#endif
#ifndef MK_NAIVE_ATTN
#define MK_NAIVE_ATTN 0
#endif
#ifndef DBG_SKIP_ATTN
#define DBG_SKIP_ATTN 0
#endif
#ifndef DBG_SKIP_MOE
#define DBG_SKIP_MOE 0
#endif
#ifndef DBG_SKIP_MIX
#define DBG_SKIP_MIX 0
#endif
#ifndef DBG_CMP_ATT
#define DBG_CMP_ATT 0
#endif
#ifndef DBG_PROBE
#define DBG_PROBE 0
#endif
constexpr int N_PHASES = 14;

constexpr int BATCH = 2, SEQ = 8192, D = 1024, T = BATCH * SEQ;
constexpr int NH = 8, HD = 64, AW = 512, IDXH = 8, IDXD = 64, TOPK = 256;
constexpr int NIN = 5704, NINP = 5888;
constexpr int NEXP = 32, DEXP = 512;
constexpr int XPROWS = 40960;
constexpr float EPS = 1e-6f;
constexpr float LOG2E = 1.4426950408889634f;
constexpr float C2 = 0.125f * LOG2E;

constexpr size_t MiB = 1u << 20;
constexpr size_t WS_CTL = 0, CTL_ZERO_BYTES = 1 * MiB;
constexpr size_t WS_SMALL = 1 * MiB;
constexpr size_t SM_MOD = WS_SMALL + 0;
constexpr size_t SM_WRT = WS_SMALL + 65536;
constexpr size_t SM_EID = WS_SMALL + 262144;
constexpr size_t SM_EWT = WS_SMALL + 393216;
constexpr size_t SM_SLOT = WS_SMALL + 524288;
constexpr size_t SM_AT = WS_SMALL + 655360;
constexpr size_t WS_WIN = 3 * MiB;
constexpr size_t WS_WA = 15 * MiB, WS_WC = 16 * MiB, WS_WOUT = 17 * MiB;
constexpr size_t WS_H1 = 19 * MiB;
constexpr size_t WS_AC = 19 * MiB, WS_ATT = 35 * MiB;
constexpr size_t WS_Q = 51 * MiB, WS_K = 67 * MiB, WS_V = 83 * MiB, WS_MASK = 83 * MiB, WS_VT = 99 * MiB, WS_QI = 115 * MiB, WS_KI = 131 * MiB;
constexpr size_t WS_WI = 133 * MiB, WS_QL = 133 * MiB + 524288;
constexpr size_t WS_CB = 136 * MiB, WS_U = 152 * MiB, WS_TMPC = 136 * MiB, WS_G = 168 * MiB;
constexpr size_t WS_MERGED = 51 * MiB;
constexpr size_t WS_WGU = 51 * MiB, WS_WD = 115 * MiB;
constexpr size_t WS_XP = 147 * MiB, WS_Y = 147 * MiB;
constexpr size_t WS_HID = 3 * MiB;
constexpr size_t WS_END = DBG_CMP_ATT ? 272 * MiB : 232 * MiB;
constexpr size_t WS_MASK_DBG = 240 * MiB, WS_ATT2 = 256 * MiB;
constexpr int CW_CMP = 2048;
constexpr int CW_TMO = 0, CW_CODE = 1, CW_KMAX = 64, CW_ECNT = 1024  , CW_BAR = 4096;

constexpr int RING_OFF = 0, RING_BYTES = 131072;
constexpr int LDSCTL_OFF = RING_BYTES, MISC_OFF = LDSCTL_OFF + 320;
constexpr int LDS_BYTES = 147456;

#define GAS __attribute__((address_space(1)))
#define LAS __attribute__((address_space(3)))
typedef unsigned short bf16;
typedef unsigned v4u __attribute__((ext_vector_type(4)));
typedef unsigned v2u __attribute__((ext_vector_type(2)));
typedef float f32x4 __attribute__((ext_vector_type(4)));
typedef short bf16x8 __attribute__((ext_vector_type(8)));
typedef GAS unsigned gu32;
#define RLX_AGENT __ATOMIC_RELAXED, __HIP_MEMORY_SCOPE_AGENT
#define LDS_WAIT() asm volatile("s_waitcnt lgkmcnt(0)" ::: "memory")
#define VM_WAIT() asm volatile("s_waitcnt vmcnt(0)" ::: "memory")
__device__ __forceinline__ unsigned f2bf(float f) { unsigned u = __builtin_bit_cast(unsigned, f); return (u + 0x7fffu + ((u >> 16) & 1u)) >> 16; }
__device__ __forceinline__ unsigned pk2(float lo, float hi) { return f2bf(lo) | (f2bf(hi) << 16); }
__device__ __forceinline__ float bflo(unsigned u) { return __builtin_bit_cast(float, u << 16); }
__device__ __forceinline__ float bfhi(unsigned u) { return __builtin_bit_cast(float, u & 0xffff0000u); }
__device__ __forceinline__ float bf1(bf16 h) { return __builtin_bit_cast(float, (unsigned)h << 16); }
__device__ __forceinline__ float wave_sum(float v) {
#pragma unroll
    for (int o = 1; o < 64; o <<= 1) v += __shfl_xor(v, o);
    return v;
}
__device__ __forceinline__ float wave_max(float v) {
#pragma unroll
    for (int o = 1; o < 64; o <<= 1) v = fmaxf(v, __shfl_xor(v, o));
    return v;
}

#define XB_TMO      128
#define XB_XCNT(j)  (256  + 64 * (j))
#define XB_XSUB(j)  (1280 + 64 * (j))
#define XB_XGEN(j)  (2304 + 64 * (j))
#define XB_TOP      3328
#define XB_TOPGEN   3392
#define XCD_BAR_WORDS 3456
#define XB_SPIN_CAP (1u << 18)

__device__ __forceinline__ unsigned xb_ld(unsigned* p)              { return __hip_atomic_load(p, __ATOMIC_RELAXED, __HIP_MEMORY_SCOPE_AGENT); }
__device__ __forceinline__ unsigned xb_add(unsigned* p, unsigned v) { return __hip_atomic_fetch_add(p, v, __ATOMIC_RELAXED, __HIP_MEMORY_SCOPE_AGENT); }
__device__ __forceinline__ unsigned xb_xcc_id() { return (unsigned)__builtin_amdgcn_s_getreg((3 << 11) | 20) & 0xFu; }
#define XB_SPIN(cond, bar) do { unsigned _sp = 0; while (cond) { __builtin_amdgcn_s_sleep(1); \
    if ((++_sp & 255u) == 0u) { if (xb_ld(&(bar)[XB_TMO])) break; if (_sp > XB_SPIN_CAP) { atomicAdd(&(bar)[XB_TMO], 1u); break; } } } } while (0)

struct XcdBarrier { unsigned* bar; unsigned x; volatile LAS unsigned* st; };

__device__ __forceinline__ XcdBarrier xcd_barrier_post(unsigned* bar, volatile LAS unsigned* st) {
    XcdBarrier b; b.bar = bar; b.x = xb_xcc_id(); b.st = st;
    if (threadIdx.x == 0) (void)xb_add(&bar[XB_XCNT(b.x)], 1u);
    return b;
}
__device__ __forceinline__ void xcd_barrier_complete(unsigned* bar, unsigned x, unsigned& nloc, unsigned& nx) {
    const unsigned G = gridDim.x * gridDim.y * gridDim.z;
    unsigned sum, cnt, mine, sp = 0u;
    for (;;) {
        sum = 0u; cnt = 0u; mine = 0u;
#pragma unroll
        for (unsigned j = 0; j < 16; ++j) { const unsigned c = xb_ld(&bar[XB_XCNT(j)]); sum += c; cnt += (c > 0u) ? 1u : 0u; mine = (j == x) ? c : mine; }
        if (sum == G) break;
        __builtin_amdgcn_s_sleep(1);
        if ((++sp & 255u) == 0u) { if (xb_ld(&bar[XB_TMO])) break; if (sp > XB_SPIN_CAP) { atomicAdd(&bar[XB_TMO], 1u); break; } }
    }
    nloc = mine > 0u ? mine : 1u; nx = cnt > 0u ? cnt : 1u;
}
__device__ __forceinline__ void xcd_barrier(const XcdBarrier& b) {
    asm volatile("s_waitcnt vmcnt(0)" ::: "memory");
    __syncthreads();
    if (threadIdx.x == 0) {
        unsigned* bar = b.bar;
        __builtin_amdgcn_s_waitcnt(0);
        unsigned nloc = b.st[0], nx = b.st[1];
        if (nloc == 0u) { xcd_barrier_complete(bar, b.x, nloc, nx); b.st[0] = nloc; b.st[1] = nx; }
        const unsigned old = xb_add(&bar[XB_XSUB(b.x)], 1u);
        const unsigned gen = old / nloc;
        if (old + 1u == (gen + 1u) * nloc) {
            __builtin_amdgcn_fence(__ATOMIC_RELEASE, "agent");
            asm volatile("s_waitcnt vmcnt(0)" ::: "memory");
            const unsigned og = xb_add(&bar[XB_TOP], 1u);
            const unsigned tg = og / nx;
            if (og + 1u == (tg + 1u) * nx) xb_add(&bar[XB_TOPGEN], 1u);
            else XB_SPIN(xb_ld(&bar[XB_TOPGEN]) == tg, bar);
            __builtin_amdgcn_fence(__ATOMIC_ACQUIRE, "agent");
            xb_add(&bar[XB_XGEN(b.x)], 1u);
            asm volatile("s_waitcnt vmcnt(0)" ::: "memory");
        } else {
            XB_SPIN(xb_ld(&bar[XB_XGEN(b.x)]) == gen, bar);
            __builtin_amdgcn_fence(__ATOMIC_ACQUIRE, "agent");
            asm volatile("s_waitcnt vmcnt(0)" ::: "memory");
        }
    }
    __syncthreads();
}

struct Frame {
    LAS unsigned char* lds;
    volatile LAS unsigned* MISC;
    gu32* ctl;
    unsigned char* ws;
    int tid, lane, wave;
    int vcu, G;
    const float *x, *c, *w_ada, *b_ada, *norm1_g, *w_in, *rel_bias, *conv_w, *w_attn, *w_conv, *w_out, *norm2_g, *wrg, *brg, *wre, *bre, *w_gate_e, *w_up_e, *w_down_e, *norm_f_g;
    float* out;
};
#define WSP(T_, off) ((T_*)(F.ws + (off)))

template <class RowMap>
__device__ __forceinline__ void transpose_item(const float* W, int K, int N, bf16* WT, LAS float* scr, int item, int lane, RowMap rm) {
    const int nblk = (N + 31) / 32, kb = item / nblk, nb = item % nblk, k0 = 64 * kb, n0 = 32 * nb;
    const int nn = n0 + (lane & 31);
#pragma unroll 8
    for (int i = 0; i < 32; ++i) { const int kk = 2 * i + (lane >> 5); scr[kk * 33 + (lane & 31)] = (nn < N) ? W[(size_t)(k0 + kk) * N + nn] : 0.f; }
    LDS_WAIT(); asm volatile("" ::: "memory");
    const int c = lane & 7;
#pragma unroll
    for (int j = 0; j < 4; ++j) { const int n = (lane >> 3) + 8 * j; const LAS float* s = scr + (8 * c) * 33 + n;
        v4u o; o.x = pk2(s[0 * 33], s[1 * 33]); o.y = pk2(s[2 * 33], s[3 * 33]); o.z = pk2(s[4 * 33], s[5 * 33]); o.w = pk2(s[6 * 33], s[7 * 33]);
        if (n0 + n < N) *(GAS v4u*)(WT + (size_t)rm(n0 + n) * K + k0 + 8 * c) = o; }
    LDS_WAIT(); asm volatile("" ::: "memory");
}
struct RmId { __device__ __forceinline__ int operator()(int n) const { return n; } };
struct RmWin { __device__ __forceinline__ int operator()(int n) const {
    if (n < 2120) return n;
    if (n < 2632) return n + 184;
    if (n < 3144) { const int j = n - 2632; return 2816 + 256 * (j >> 7) + (j & 127); }
    if (n < 3656) { const int j = n - 3144; return 2816 + 256 * (j >> 7) + 128 + (j & 127); }
    return n + 184; } };
struct RmGU { int half; __device__ __forceinline__ int operator()(int n) const { return 256 * (n >> 7) + 128 * half + (n & 127); } };

__device__ __forceinline__ void p0_prologue(Frame& F) {
    LAS float* scr = (LAS float*)(F.lds + RING_OFF + F.wave * 16384);
    const int gw = F.vcu * NWAVES + F.wave, NGW = F.G * NWAVES;
    if (F.vcu < 96) {
        const int n = F.vcu * 64 + F.lane; float a0 = 0.f, a1 = 0.f;
        for (int k = F.wave * 128; k < F.wave * 128 + 128; ++k) {
            const float c0 = F.c[k], c1 = F.c[D + k];
            const float s0 = c0 / (1.f + __expf(-c0)), s1 = c1 / (1.f + __expf(-c1));
            const float w = F.w_ada[(size_t)k * 6144 + n];
            a0 += s0 * w; a1 += s1 * w;
        }
        LAS float* red = (LAS float*)(F.lds + RING_OFF + 8448);
        red[(F.wave * 2 + 0) * 64 + F.lane] = a0; red[(F.wave * 2 + 1) * 64 + F.lane] = a1;
        __syncthreads();
        if (F.wave < 2) { float s = F.b_ada[n];
#pragma unroll
            for (int w = 0; w < 8; ++w) s += red[(w * 2 + F.wave) * 64 + F.lane];
            WSP(float, SM_MOD)[F.wave * 6144 + n] = s; }
        __syncthreads();
    }
    constexpr int I_IN = 16 * 179, I_A = 8 * 32, I_C = 8 * 32, I_O = 16 * 32;
    constexpr int NITEMS = I_IN + I_A + I_C + I_O;
    for (int it = gw; it < NITEMS; it += NGW) {
        int r = it;
        if (r < I_IN) { transpose_item(F.w_in, D, NIN, WSP(bf16, WS_WIN), scr, r, F.lane, RmWin()); continue; } r -= I_IN;
        if (r < I_A) { transpose_item(F.w_attn, AW, D, WSP(bf16, WS_WA), scr, r, F.lane, RmId()); continue; } r -= I_A;
        if (r < I_C) { transpose_item(F.w_conv, AW, D, WSP(bf16, WS_WC), scr, r, F.lane, RmId()); continue; } r -= I_C;
        transpose_item(F.w_out, D, D, WSP(bf16, WS_WOUT), scr, r, F.lane, RmId());
    }
    for (int i = gw * 64 + F.lane; i < 184 * 128; i += NGW * 64) { *(GAS v4u*)(WSP(bf16, WS_WIN) + (size_t)2120 * D + (size_t)i * 8) = (v4u){0u, 0u, 0u, 0u}; }
    for (int i = gw * 64 + F.lane; i < 36 * D; i += NGW * 64) { const int n = i / D, k = i % D; WSP(float, SM_WRT)[i] = (n < 4) ? F.wrg[k * 4 + n] : F.wre[k * 32 + (n - 4)]; }
}

__device__ __forceinline__ void p1_norm1(Frame& F) {
    const int gw = F.vcu * NWAVES + F.wave, NGW = F.G * NWAVES;
    const float* mod = WSP(float, SM_MOD);
    int curb = -1; f32x4 ca[4], cb[4];
    for (int m = gw; m < T; m += NGW) {
        const int b = m / SEQ;
        if (b != curb) { curb = b;
#pragma unroll
            for (int j = 0; j < 4; ++j) { const int k = 4 * F.lane + 256 * j;
                const f32x4 g = *(const f32x4*)(F.norm1_g + k), sc = *(const f32x4*)(mod + b * 6144 + 1024 + k), sh = *(const f32x4*)(mod + b * 6144 + k);
                ca[j] = g * (sc + 1.0f); cb[j] = sh; } }
        const GAS f32x4* xr = (const GAS f32x4*)(F.x + (size_t)m * D) + F.lane;
        f32x4 v[4]; float s = 0.f;
#pragma unroll
        for (int j = 0; j < 4; ++j) { v[j] = xr[64 * j]; s += (v[j].x * v[j].x + v[j].y * v[j].y) + (v[j].z * v[j].z + v[j].w * v[j].w); }
        const float rstd = 1.f / sqrtf(wave_sum(s) * (1.f / D) + EPS);
        GAS v2u* o8 = (GAS v2u*)(WSP(bf16, WS_H1) + (size_t)m * D) + F.lane;
#pragma unroll
        for (int j = 0; j < 4; ++j) { const f32x4 h = v[j] * rstd * ca[j] + cb[j]; o8[64 * j] = (v2u){pk2(h.x, h.y), pk2(h.z, h.w)}; }
    }
}

using pg8::Unit;
typedef float f32x2_t __attribute__((ext_vector_type(2))); typedef __bf16 bf16x2_t __attribute__((ext_vector_type(2)));
__device__ __forceinline__ unsigned cvtpk(float lo, float hi) { f32x2_t v = {lo, hi}; bf16x2_t b = __builtin_convertvector(v, bf16x2_t); return __builtin_bit_cast(unsigned, b); }
__device__ __forceinline__ v4u pack8(const f32x4 a, const f32x4 b) { v4u w; w.x = cvtpk(a[0], a[1]); w.y = cvtpk(a[2], a[3]); w.z = cvtpk(b[0], b[1]); w.w = cvtpk(b[2], b[3]); return w; }
__device__ __forceinline__ float sigmoidf_(float x) { return __builtin_amdgcn_rcpf(1.f + __builtin_amdgcn_exp2f(-x * LOG2E)); }
__device__ __forceinline__ f32x4 sig4(f32x4 v) { return (f32x4){sigmoidf_(v[0]), sigmoidf_(v[1]), sigmoidf_(v[2]), sigmoidf_(v[3])}; }
__device__ __forceinline__ void unpack8(const v4u w, f32x4& a, f32x4& b) { a = (f32x4){bflo(w.x), bfhi(w.x), bflo(w.y), bfhi(w.y)}; b = (f32x4){bflo(w.z), bfhi(w.z), bflo(w.w), bfhi(w.w)}; }

struct EpiProj {
    static constexpr bool PERM = true, AFTER_DRAIN = false;
    bf16 *Q, *K, *V, *QI, *KI, *CB, *U, *G; float* WI;
    __device__ __forceinline__ void operator()(const f32x4 (&acc)[2][2][4][2], const Unit& u, int wr, int wc, int fr, int fq) const {
        const int pn = u.pn, row0 = u.pm * 256 + wr * 64 + fr, cb8 = wc * 32 + 8 * fq;
        if (pn < 8 || pn == 9 || pn == 10) {
            bf16* base; int coff; float sc = 1.f;
            if (pn < 2) { base = Q; coff = 256 * pn; sc = C2; } else if (pn < 4) { base = K; coff = 256 * (pn - 2); } else if (pn < 6) { base = V; coff = 256 * (pn - 4); }
            else if (pn < 8) { base = QI; coff = 256 * (pn - 6); } else { base = CB; coff = 256 * (pn - 9); }
#pragma unroll
            for (int ai = 0; ai < 2; ++ai)
#pragma unroll
                for (int m = 0; m < 4; ++m) { bf16* rowp = base + (size_t)(row0 + ai * 128 + m * 16) * 512 + coff + cb8;
#pragma unroll
                    for (int bj = 0; bj < 2; ++bj) *(v4u*)(rowp + bj * 128) = pack8(acc[ai][bj][m][0] * sc, acc[ai][bj][m][1] * sc); }
        } else if (pn == 8) {
#pragma unroll
            for (int ai = 0; ai < 2; ++ai)
#pragma unroll
                for (int m = 0; m < 4; ++m) { const size_t row = (size_t)(row0 + ai * 128 + m * 16);
                    if (wc < 2) *(v4u*)(KI + row * 64 + cb8) = pack8(acc[ai][0][m][0], acc[ai][0][m][1]);
                    else if (wc == 2 && fq == 0) { *(f32x4*)(WI + row * 8) = acc[ai][0][m][0]; *(f32x4*)(WI + row * 8 + 4) = acc[ai][0][m][1]; } }
        } else if (pn < 15) {
#pragma unroll
            for (int ai = 0; ai < 2; ++ai)
#pragma unroll
                for (int m = 0; m < 4; ++m) { const size_t row = (size_t)(row0 + ai * 128 + m * 16);
                    *(v4u*)(U + row * 512 + 128 * (pn - 11) + cb8) = pack8(acc[ai][0][m][0] * acc[ai][1][m][0], acc[ai][0][m][1] * acc[ai][1][m][1]); }
        } else {
#pragma unroll
            for (int ai = 0; ai < 2; ++ai)
#pragma unroll
                for (int m = 0; m < 4; ++m) { bf16* rowp = G + (size_t)(row0 + ai * 128 + m * 16) * 2048 + 256 * (pn - 15) + cb8;
#pragma unroll
                    for (int bj = 0; bj < 2; ++bj) *(v4u*)(rowp + bj * 128) = pack8(sig4(acc[ai][bj][m][0]), sig4(acc[ai][bj][m][1])); }
        }
    }
};
struct EpiConv {
    static constexpr bool PERM = true, AFTER_DRAIN = false;
    const bf16* G; bf16* O;
    __device__ __forceinline__ void operator()(const f32x4 (&acc)[2][2][4][2], const Unit& u, int wr, int wc, int fr, int fq) const {
        const int row0 = u.pm * 256 + wr * 64 + fr, col0 = u.pn * 256 + wc * 32 + 8 * fq;
#pragma unroll
        for (int ai = 0; ai < 2; ++ai)
#pragma unroll
            for (int m = 0; m < 4; ++m) { const size_t row = (size_t)(row0 + ai * 128 + m * 16);
#pragma unroll
                for (int bj = 0; bj < 2; ++bj) { f32x4 g0, g1; unpack8(*(const v4u*)(G + row * 2048 + 1024 + col0 + bj * 128), g0, g1);
                    *(v4u*)(O + row * 1024 + col0 + bj * 128) = pack8(g0 * acc[ai][bj][m][0], g1 * acc[ai][bj][m][1]); } }
    }
};
struct EpiAttn {
    static constexpr bool PERM = true, AFTER_DRAIN = false;
    const bf16* G; const bf16* Tc; bf16* O;
    __device__ __forceinline__ void operator()(const f32x4 (&acc)[2][2][4][2], const Unit& u, int wr, int wc, int fr, int fq) const {
        const int row0 = u.pm * 256 + wr * 64 + fr, col0 = u.pn * 256 + wc * 32 + 8 * fq;
#pragma unroll
        for (int ai = 0; ai < 2; ++ai)
#pragma unroll
            for (int m = 0; m < 4; ++m) { const size_t row = (size_t)(row0 + ai * 128 + m * 16);
#pragma unroll
                for (int bj = 0; bj < 2; ++bj) { f32x4 g0, g1, t0, t1; unpack8(*(const v4u*)(G + row * 2048 + col0 + bj * 128), g0, g1); unpack8(*(const v4u*)(Tc + row * 1024 + col0 + bj * 128), t0, t1);
                    *(v4u*)(O + row * 1024 + col0 + bj * 128) = pack8(g0 * acc[ai][bj][m][0] + t0, g1 * acc[ai][bj][m][1] + t1); } }
    }
};
struct EpiOut {
    static constexpr bool PERM = false, AFTER_DRAIN = false;
    const float* X; const float* mod; float* O;
    __device__ __forceinline__ void operator()(const f32x4 (&acc)[2][2][4][2], const Unit& u, int wr, int wc, int fr, int fq) const {
        const int row0 = u.pm * 256 + wr * 64 + fr, col0 = u.pn * 256 + wc * 32 + 4 * fq;
        const float* g1 = mod + ((u.pm * 256) / SEQ) * 6144 + 2048;
#pragma unroll
        for (int bj = 0; bj < 2; ++bj)
#pragma unroll
            for (int n = 0; n < 2; ++n) { const int col = col0 + bj * 128 + n * 16; const f32x4 gv = *(const f32x4*)(g1 + col);
#pragma unroll
                for (int ai = 0; ai < 2; ++ai)
#pragma unroll
                    for (int m = 0; m < 4; ++m) { const size_t off = (size_t)(row0 + ai * 128 + m * 16) * D + col;
                        *(f32x4*)(O + off) = *(const f32x4*)(X + off) + gv * acc[ai][bj][m][n]; } }
    }
};
__device__ __forceinline__ f32x4 silu_mul4(f32x4 g, f32x4 u) { return (f32x4){g[0] * sigmoidf_(g[0]) * u[0], g[1] * sigmoidf_(g[1]) * u[1], g[2] * sigmoidf_(g[2]) * u[2], g[3] * sigmoidf_(g[3]) * u[3]}; }
struct EpiHid {
    static constexpr bool PERM = true, AFTER_DRAIN = false;
    bf16* O;
    __device__ __forceinline__ void operator()(const f32x4 (&acc)[2][2][4][2], const Unit& u, int wr, int wc, int fr, int fq) const {
        const int row0 = u.pm * 256 + wr * 64 + fr, col0 = 128 * (u.pn & 3) + wc * 32 + 8 * fq;
#pragma unroll
        for (int ai = 0; ai < 2; ++ai)
#pragma unroll
            for (int m = 0; m < 4; ++m) { const size_t row = (size_t)(row0 + ai * 128 + m * 16);
                *(v4u*)(O + row * 512 + col0) = pack8(silu_mul4(acc[ai][0][m][0], acc[ai][1][m][0]), silu_mul4(acc[ai][0][m][1], acc[ai][1][m][1])); }
    }
};
struct EpiY {
    static constexpr bool PERM = true, AFTER_DRAIN = false;
    bf16* O;
    __device__ __forceinline__ void operator()(const f32x4 (&acc)[2][2][4][2], const Unit& u, int wr, int wc, int fr, int fq) const {
        const int row0 = u.pm * 256 + wr * 64 + fr, col0 = 256 * (u.pn & 3) + wc * 32 + 8 * fq;
#pragma unroll
        for (int ai = 0; ai < 2; ++ai)
#pragma unroll
            for (int m = 0; m < 4; ++m) { const size_t row = (size_t)(row0 + ai * 128 + m * 16);
#pragma unroll
                for (int bj = 0; bj < 2; ++bj) *(v4u*)(O + row * 1024 + col0 + bj * 128) = pack8(acc[ai][bj][m][0], acc[ai][bj][m][1]); }
    }
};
struct MoeOrder {
    const LAS int* tile_e; int ntiles, G, c;
    __device__ __forceinline__ bool next(int i, Unit& u) const {
        const int L = i * G + c; if (L >= ntiles * 4) return false;
        const int rt = L >> 2, j = L & 3; u.pm = rt; u.pn = 4 * tile_e[rt] + j; return true; }
    __device__ __forceinline__ void a_ready(const Unit&) const {}
    __device__ __forceinline__ void done(const Unit&) const {}
};

__device__ __forceinline__ void p3_prep(Frame& F) {
    const int gw = F.vcu * NWAVES + F.wave, NGW = F.G * NWAVES;
    {
        LAS bf16* tl = (LAS bf16*)(F.lds + RING_OFF + F.wave * 16384);
        const bf16* V = WSP(bf16, WS_V); bf16* VT = WSP(bf16, WS_VT);
        for (int it = gw; it < BATCH * NH * (SEQ / 64); it += NGW) {
            const int kt = it % (SEQ / 64), h = (it / (SEQ / 64)) % NH, b = it / (NH * (SEQ / 64));
            const bf16* src = V + (size_t)(b * SEQ + kt * 64 + F.lane) * 512 + h * 64;
#pragma unroll
            for (int c = 0; c < 8; ++c) { const v4u w = *(const v4u*)(src + c * 8);
                LAS unsigned* d = (LAS unsigned*)(tl + F.lane * 66 + c * 8); d[0] = w.x; d[1] = w.y; d[2] = w.z; d[3] = w.w; }
            LDS_WAIT(); asm volatile("" ::: "memory");
            unsigned o[32];
#pragma unroll
            for (int p = 0; p < 64; p += 2) {
                const int i0 = p & 15, i1 = (p + 1) & 15, g = p & ~15;
                const int k0 = g + ((i0 < 4 || i0 >= 12) ? i0 : (i0 < 8 ? i0 + 4 : i0 - 4)), k1 = g + ((i1 < 4 || i1 >= 12) ? i1 : (i1 < 8 ? i1 + 4 : i1 - 4));
                o[p >> 1] = (unsigned)tl[k0 * 66 + F.lane] | ((unsigned)tl[k1 * 66 + F.lane] << 16); }
            bf16* dst = VT + ((size_t)((b * NH + h) * 64 + F.lane)) * SEQ + kt * 64;
#pragma unroll
            for (int c = 0; c < 8; ++c) *(v4u*)(dst + c * 8) = (v4u){o[4 * c], o[4 * c + 1], o[4 * c + 2], o[4 * c + 3]};
            LDS_WAIT(); asm volatile("" ::: "memory");
        }
    }
    {
        const bf16* CB = WSP(bf16, WS_CB); const bf16* U = WSP(bf16, WS_U); bf16* AC = WSP(bf16, WS_AC);
        for (int i = (gw * 64 + F.lane); i < T * 64; i += NGW * 64) {
            const int t = i >> 6, j = (i & 63) * 8, tt = t % SEQ;
            f32x4 c0, c1, u0, u1, a0, a1;
            unpack8(*(const v4u*)(CB + (size_t)t * 512 + j), c0, c1);
            unpack8(*(const v4u*)(U + (size_t)t * 512 + j), u0, u1);
            a0 = u0 * *(const f32x4*)(F.conv_w + 1024 + j); a1 = u1 * *(const f32x4*)(F.conv_w + 1024 + j + 4);
            if (tt >= 1) { unpack8(*(const v4u*)(U + (size_t)(t - 1) * 512 + j), u0, u1); a0 += u0 * *(const f32x4*)(F.conv_w + 512 + j); a1 += u1 * *(const f32x4*)(F.conv_w + 512 + j + 4); }
            if (tt >= 2) { unpack8(*(const v4u*)(U + (size_t)(t - 2) * 512 + j), u0, u1); a0 += u0 * *(const f32x4*)(F.conv_w + j); a1 += u1 * *(const f32x4*)(F.conv_w + j + 4); }
            *(v4u*)(AC + (size_t)t * 512 + j) = pack8(c0 * a0, c1 * a1);
        }
    }
    {
        const bf16* QI = WSP(bf16, WS_QI); const float* WI = WSP(float, WS_WI); bf16* QL = WSP(bf16, WS_QL); float* AT = WSP(float, SM_AT);
        for (int t = gw; t < T; t += NGW) {
            float ql = 0.f, a = 0.f;
#pragma unroll
            for (int h = 0; h < 8; ++h) { const float w = WI[(size_t)t * 8 + h]; const float v = bf1(QI[(size_t)t * 512 + h * 64 + F.lane]); ql += w * v; a += fabsf(w) * sqrtf(wave_sum(v * v)); }
            QL[(size_t)t * 64 + F.lane] = (bf16)f2bf(ql);
            if (F.lane == 0) AT[t] = a;
        }
    }
    {
        const bf16* KI = WSP(bf16, WS_KI); float mx = 0.f;
        for (int s = gw * 64 + F.lane; s < T; s += NGW * 64) { float q = 0.f;
#pragma unroll
            for (int c = 0; c < 8; ++c) { f32x4 a, b; unpack8(*(const v4u*)(KI + (size_t)s * 64 + c * 8), a, b); q += (a[0] * a[0] + a[1] * a[1]) + (a[2] * a[2] + a[3] * a[3]) + (b[0] * b[0] + b[1] * b[1]) + (b[2] * b[2] + b[3] * b[3]); }
            mx = fmaxf(mx, q); }
        mx = wave_max(mx);
        if (F.lane == 0) atomicMax((unsigned*)(F.ctl + CW_KMAX), __builtin_bit_cast(unsigned, sqrtf(mx)));
    }
}

__device__ __forceinline__ unsigned ord_key(float x) { if (x == 0.f) x = 0.f; const unsigned u = __builtin_bit_cast(unsigned, x); return (u & 0x80000000u) ? ~u : (u | 0x80000000u); }
__device__ __forceinline__ int t5_bucket(int n) {
    if (n < 16) return n;
    const int v = 16 + (int)(logf((float)n / 16.f) / 2.0794415416798357f * 16.f);
    return v < 31 ? v : 31;
}
__device__ __forceinline__ void pn_naive_dsa(Frame& F) {
    LAS float* sc = (LAS float*)(F.lds + RING_OFF);
    LAS float* qf = (LAS float*)(F.lds + RING_OFF + 32768);
    LAS float* wq = qf + 512;
    LAS unsigned* hist = (LAS unsigned*)(F.lds + RING_OFF + 36864);
    LAS int* sel = (LAS int*)(F.lds + RING_OFF + 40960);
    LAS float* pbuf = (LAS float*)(F.lds + RING_OFF + 45056);
    LAS int* wcnt = (LAS int*)(F.lds + RING_OFF + 53248);
    LAS int* bkt = (LAS int*)(F.lds + RING_OFF + 53248 + 256);
    const bf16* QI = WSP(bf16, WS_QI); const bf16* KI = WSP(bf16, WS_KI); const float* WI = WSP(float, WS_WI);
    const bf16* Qb = WSP(bf16, WS_Q); const bf16* Kb = WSP(bf16, WS_K); const bf16* Vb = WSP(bf16, WS_V); bf16* ATT = WSP(bf16, WS_ATT);
    if (F.tid < 128) bkt[F.tid] = t5_bucket(F.tid);
    __syncthreads();
    for (int qi_ = 0; qi_ < T / F.G + 1; ++qi_) {
        const int qidx = qi_ * F.G + F.vcu; if (qidx >= T) break;
        const int b = qidx / SEQ, t = qidx % SEQ, n = t + 1;
        qf[F.tid] = bf1(QI[(size_t)qidx * 512 + F.tid]);
        if (F.tid < 8) wq[F.tid] = WI[(size_t)qidx * 8 + F.tid];
        __syncthreads();
        for (int s = F.tid; s < n; s += 512) {
            float kf[64]; const bf16* kr = KI + (size_t)(b * SEQ + s) * 64;
#pragma unroll
            for (int c = 0; c < 8; ++c) { f32x4 a, bb; unpack8(*(const v4u*)(kr + c * 8), a, bb); kf[8 * c] = a[0]; kf[8 * c + 1] = a[1]; kf[8 * c + 2] = a[2]; kf[8 * c + 3] = a[3]; kf[8 * c + 4] = bb[0]; kf[8 * c + 5] = bb[1]; kf[8 * c + 6] = bb[2]; kf[8 * c + 7] = bb[3]; }
            float score = 0.f;
#pragma unroll 1
            for (int h = 0; h < 8; ++h) { float dsum = 0.f;
#pragma unroll
                for (int d4 = 0; d4 < 16; ++d4) { const f32x4 q4 = *(const LAS f32x4*)(qf + h * 64 + d4 * 4); dsum += q4[0] * kf[4 * d4] + q4[1] * kf[4 * d4 + 1] + q4[2] * kf[4 * d4 + 2] + q4[3] * kf[4 * d4 + 3]; }
                score += wq[h] * fmaxf(dsum, 0.f); }
            sc[s] = score;
        }
        __syncthreads();
        unsigned prefix = 0u, pmask = 0u; int need = TOPK;
        if (n > TOPK) {
            for (int pass = 0; pass < 4; ++pass) {
                const int shift = 24 - 8 * pass;
                if (F.tid < 256) hist[F.tid] = 0u;
                __syncthreads();
                for (int s = F.tid; s < n; s += 512) { const unsigned u = ord_key(sc[s]); if ((u & pmask) == prefix) atomicAdd((unsigned*)&hist[(u >> shift) & 255u], 1u); }
                __syncthreads();
                if (F.wave == 0) {
                    int c4[4]; int tot = 0;
#pragma unroll
                    for (int j = 0; j < 4; ++j) { c4[j] = (int)hist[4 * F.lane + j]; tot += c4[j]; }
                    int incl = tot;
#pragma unroll
                    for (int o = 1; o < 64; o <<= 1) { const int v = __shfl_down(incl, o); if (F.lane + o < 64) incl += v; }
                    const int above = incl - tot;
                    if (above < need && need <= incl) { int run = above;
#pragma unroll
                        for (int j = 3; j >= 0; --j) { if (run < need && need <= run + c4[j]) { wcnt[16] = 4 * F.lane + j; wcnt[17] = need - run; } run += c4[j]; } }
                }
                __syncthreads();
                prefix |= (unsigned)wcnt[16] << shift; pmask |= 255u << shift; need = wcnt[17];
                __syncthreads();
            }
        }
        int cg = 0, ce = 0;
        for (int i = 0; i < 16; ++i) { const int s = F.wave * 1024 + i * 64 + F.lane; bool gt = false, eq = false;
            if (s < n) { if (n <= TOPK) gt = true; else { const unsigned u = ord_key(sc[s]); gt = u > prefix; eq = (u == prefix); } }
            cg += __popcll(__ballot(gt)); ce += __popcll(__ballot(eq)); }
        if (F.lane == 0) { wcnt[2 * F.wave] = cg; wcnt[2 * F.wave + 1] = ce; }
        __syncthreads();
        int eqb = 0, tkb = 0, nsel = 0;
        { int eq_before = 0;
          for (int w = 0; w < 8; ++w) { const int g = wcnt[2 * w], e = wcnt[2 * w + 1];
              int take_e = need - eq_before; take_e = take_e < 0 ? 0 : (take_e > e ? e : take_e); if (n <= TOPK) take_e = 0;
              if (w < F.wave) { eqb += e; tkb += g + take_e; }
              nsel += g + take_e; eq_before += e; } }
        for (int i = 0; i < 16; ++i) { const int s = F.wave * 1024 + i * 64 + F.lane; bool gt = false, eq = false;
            if (s < n) { if (n <= TOPK) gt = true; else { const unsigned u = ord_key(sc[s]); gt = u > prefix; eq = (u == prefix); } }
            const unsigned long long mg = __ballot(gt), me = __ballot(eq), lt = (1ull << F.lane) - 1ull;
            const int erank = eqb + __popcll(me & lt);
            const bool take = gt || (eq && erank < need);
            const unsigned long long mt = __ballot(take);
            if (take) sel[tkb + __popcll(mt & lt)] = s;
            eqb += __popcll(me); tkb += __popcll(mt); (void)mg; }
        __syncthreads();
        {
            const int h = F.wave;
            qf[F.tid] = bf1(Qb[(size_t)qidx * 512 + F.tid]);
            __syncthreads();
            float lg[4]; float mx = -INFINITY;
#pragma unroll
            for (int i = 0; i < 4; ++i) { const int j = F.lane + 64 * i; lg[i] = -INFINITY;
                if (j < nsel) { const int s = sel[j]; const bf16* kr = Kb + (size_t)(b * SEQ + s) * 512 + h * 64; float dsum = 0.f;
#pragma unroll
                    for (int c = 0; c < 8; ++c) { f32x4 a, bb; unpack8(*(const v4u*)(kr + c * 8), a, bb); const f32x4 q0 = *(const LAS f32x4*)(qf + h * 64 + c * 8), q1 = *(const LAS f32x4*)(qf + h * 64 + c * 8 + 4);
                        dsum += (q0[0] * a[0] + q0[1] * a[1]) + (q0[2] * a[2] + q0[3] * a[3]) + (q1[0] * bb[0] + q1[1] * bb[1]) + (q1[2] * bb[2] + q1[3] * bb[3]); }
                    const int dist = t - s; const int bk = dist < 128 ? bkt[dist] : 31;
                    lg[i] = dsum + F.rel_bias[bk * 8 + h] * LOG2E; mx = fmaxf(mx, lg[i]); } }
            mx = wave_max(mx); float sum = 0.f;
#pragma unroll
            for (int i = 0; i < 4; ++i) { const int j = F.lane + 64 * i; const float p = (j < nsel) ? __builtin_amdgcn_exp2f(lg[i] - mx) : 0.f; sum += p; pbuf[h * 256 + j] = p; }
            sum = wave_sum(sum);
            LDS_WAIT(); asm volatile("" ::: "memory");
            float o = 0.f;
            for (int j = 0; j < nsel; ++j) o += pbuf[h * 256 + j] * bf1(Vb[(size_t)(b * SEQ + sel[j]) * 512 + h * 64 + F.lane]);
            ATT[(size_t)qidx * 512 + h * 64 + F.lane] = (bf16)f2bf(o / sum);
        }
        __syncthreads();
    }
}


typedef float f32x16 __attribute__((ext_vector_type(16)));
#define MFMA32(a, b, c) __builtin_amdgcn_mfma_f32_32x32x16_bf16((a), (b), (c), 0, 0, 0)
__device__ __forceinline__ int crow(int r, int hi) { return (r & 3) + 8 * (r >> 2) + 4 * hi; }
constexpr int IDX_CTL = LDSCTL_OFF + 2048;

#define MFMA16(a, b, c) __builtin_amdgcn_mfma_f32_16x16x32_bf16((a), (b), (c), 0, 0, 0)
__device__ __forceinline__ void idx_tile(const bf16x8 (&kf)[4][2], const bf16x8 (&ql)[2], const bf16x8 (&qf)[8][2], const float (&w)[8], float invA, unsigned (&key)[4][4]) {
    f32x4 sc[4];
#pragma unroll
    for (int a = 0; a < 4; ++a) { sc[a] = (f32x4){0.f, 0.f, 0.f, 0.f}; sc[a] = MFMA16(kf[a][0], ql[0], sc[a]); sc[a] = MFMA16(kf[a][1], ql[1], sc[a]); }
#pragma unroll
    for (int hf = 0; hf < 2; ++hf)
#pragma unroll
    for (int h = 0; h < 8; ++h) {
        f32x4 d[2];
#pragma unroll
        for (int a = 0; a < 2; ++a) { d[a] = (f32x4){0.f, 0.f, 0.f, 0.f}; d[a] = MFMA16(kf[2 * hf + a][0], qf[h][0], d[a]); d[a] = MFMA16(kf[2 * hf + a][1], qf[h][1], d[a]); }
#pragma unroll
        for (int a = 0; a < 2; ++a)
#pragma unroll
            for (int i = 0; i < 4; ++i) sc[2 * hf + a][i] = __builtin_fmaf(w[h], __builtin_fabsf(d[a][i]), sc[2 * hf + a][i]);
        asm volatile("" : "+v"(sc[2 * hf]), "+v"(sc[2 * hf + 1]));
    }
#pragma unroll
    for (int a = 0; a < 4; ++a)
#pragma unroll
        for (int i = 0; i < 4; ++i) { float v = __builtin_fmaf(sc[a][i], invA, 3.0f); v = fminf(fmaxf(v, 2.0f), 3.9999998f); key[a][i] = (__builtin_bit_cast(unsigned, v) & 0x7fffffu) >> 1; }
}
__device__ __forceinline__ void idx_load_k(bf16x8 (&kf)[4][2], const bf16* KItile  , unsigned voff  ) {
#pragma unroll
    for (int a = 0; a < 4; ++a)
#pragma unroll
        for (int ks = 0; ks < 2; ++ks) kf[a][ks] = *(const bf16x8*)((const char*)KItile + voff + a * 2048 + ks * 64);
}
template <int MODE>
__device__ __forceinline__ void idx_pass(Frame& F, int ln, const bf16* KIb, unsigned* MASKg, int t0, int nt_idx, int nt_att, const bf16x8 (&ql)[2], const bf16x8 (&qf)[8][2], const float (&w)[8], float invA, int b1, unsigned thr) {
    const int qc = ln & 15, fq = ln >> 4, qh = F.wave & 1, kp = F.wave >> 1, ql_ = 16 * qh + qc, t = t0 + ql_;
    LAS unsigned* hist = (LAS unsigned*)(F.lds + RING_OFF);
    const int ntl = (MODE == 2) ? nt_att : nt_idx;
    bf16x8 kcur[4][2];
    const unsigned voff = (unsigned)(qc * 64 + fq * 8) * 2u;
#pragma unroll
    for (int a = 0; a < 4; ++a)
#pragma unroll
        for (int ks = 0; ks < 2; ++ks) kcur[a][ks] = (bf16x8){0, 0, 0, 0, 0, 0, 0, 0};
    if (kp < nt_idx) idx_load_k(kcur, KIb + (size_t)(64 * kp) * 64, voff);
    for (int kt = kp; kt < ntl; kt += 4) {
        unsigned m16 = 0u;
        if (kt < nt_idx) {
            unsigned key[4][4];
            idx_tile(kcur, ql, qf, w, invA, key);
            if (kt + 4 < nt_idx) idx_load_k(kcur, KIb + (size_t)(64 * (kt + 4)) * 64, voff);
#pragma unroll
            for (int a = 0; a < 4; ++a)
#pragma unroll
                for (int i = 0; i < 4; ++i) {
                    const int s = 64 * kt + 16 * a + 4 * fq + i; const bool valid = s <= t; const unsigned k22 = key[a][i];
                    if (MODE == 0) { const unsigned bin = k22 >> 11; __hip_atomic_fetch_add(hist + ql_ * 1024 + (((bin >> 1) + ql_) & 1023u), valid ? (1u << (16 * (bin & 1u))) : 0u, __ATOMIC_RELAXED, __HIP_MEMORY_SCOPE_WORKGROUP); }
                    else if (MODE == 1) { const unsigned bin = k22 & 2047u; __hip_atomic_fetch_add(hist + ql_ * 1024 + (((bin >> 1) + ql_) & 1023u), (valid && (int)(k22 >> 11) == b1) ? (1u << (16 * (bin & 1u))) : 0u, __ATOMIC_RELAXED, __HIP_MEMORY_SCOPE_WORKGROUP); }
                    else { if (valid && k22 >= thr) m16 |= 1u << (4 * a + i); }
                }
        }
        if (MODE == 2) {
            unsigned word = ((m16 & 0xFu) | ((m16 & 0xF0u) << 4) | ((m16 & 0xF00u) << 8) | ((m16 & 0xF000u) << 12)) << (4 * (fq >> 1));
            word |= (unsigned)__shfl_xor((int)word, 32);
            if (ln < 32) MASKg[(size_t)kt * 64 + fq * 32 + ql_] = word;
        }
    }
}
template <int LEVEL>
__device__ __forceinline__ void idx_scan(Frame& F) {
    LAS unsigned* hist = (LAS unsigned*)(F.lds + RING_OFF);
    LAS int* ctl = (LAS int*)(F.lds + IDX_CTL);
#pragma unroll 1
    for (int qi = 0; qi < 4; ++qi) {
        const int q = 4 * F.wave + qi;
        const int need = (LEVEL == 0) ? TOPK : TOPK - ctl[32 + q];
        unsigned wv[16]; int tot = 0;
#pragma unroll
        for (int j = 0; j < 16; ++j) { wv[j] = hist[q * 1024 + ((16 * F.lane + j + q) & 1023)]; tot += (int)(wv[j] & 0xffffu) + (int)(wv[j] >> 16); }
        int incl = tot;
#pragma unroll
        for (int o = 1; o < 64; o <<= 1) { const int v = __shfl_down(incl, o); if (F.lane + o < 64) incl += v; }
        const int above = incl - tot;
        if (above < need && need <= incl) {
            int run = above, B = 0, cab = 0; bool found = false;
#pragma unroll
            for (int j = 15; j >= 0; --j) {
                const int ch = (int)(wv[j] >> 16), cl = (int)(wv[j] & 0xffffu);
                if (!found && need <= run + ch) { found = true; B = 2 * (16 * F.lane + j) + 1; cab = run; } run += ch;
                if (!found && need <= run + cl) { found = true; B = 2 * (16 * F.lane + j); cab = run; } run += cl;
            }
            if (LEVEL == 0) { ctl[q] = B; ctl[32 + q] = cab; } else ctl[64 + q] = (ctl[q] << 11) | B;
        }
    }
}
__device__ __forceinline__ void p5_indexer(Frame& F, unsigned* MASK) {
    const bf16* QI = WSP(bf16, WS_QI); const bf16* KI = WSP(bf16, WS_KI); const float* WI = WSP(float, WS_WI); const bf16* QL = WSP(bf16, WS_QL); const float* AT = WSP(float, SM_AT);
    const float kmax = __builtin_bit_cast(float, __hip_atomic_load(F.ctl + CW_KMAX, RLX_AGENT));
    LAS int* ctl = (LAS int*)(F.lds + IDX_CTL);
    for (int p = F.vcu; p < 256; p += F.G) {
        const int b = p >> 7, j = p & 127;
#pragma unroll 1
        for (int side = 0; side < 2; ++side) {
            const int g = side ? j : 255 - j, t0 = 32 * g;
            const int nt_idx = (g + 2) >> 1, nt_att = 4 * (g >> 3) + 4;
            int ln = F.lane; asm volatile("" : "+v"(ln));
            const int qc = ln & 15, fq = ln >> 4, ql_ = 16 * (F.wave & 1) + qc;
            const size_t trow = (size_t)b * SEQ + t0 + ql_;
            bf16x8 qf[8][2], ql[2]; float w[8];
#pragma unroll
            for (int h = 0; h < 8; ++h)
#pragma unroll
                for (int ks = 0; ks < 2; ++ks) qf[h][ks] = *(const bf16x8*)(QI + trow * 512 + h * 64 + ks * 32 + fq * 8);
#pragma unroll
            for (int ks = 0; ks < 2; ++ks) ql[ks] = *(const bf16x8*)(QL + trow * 64 + ks * 32 + fq * 8);
            { const f32x4 w0 = *(const f32x4*)(WI + trow * 8), w1 = *(const f32x4*)(WI + trow * 8 + 4); w[0] = w0[0]; w[1] = w0[1]; w[2] = w0[2]; w[3] = w0[3]; w[4] = w1[0]; w[5] = w1[1]; w[6] = w1[2]; w[7] = w1[3]; }
            const float a2 = 2.0f * AT[trow] * kmax; const float invA = a2 > 0.f ? 1.0f / a2 : 0.f;
            const bf16* KIb = KI + (size_t)b * SEQ * 64;
            unsigned* MASKg = MASK + ((size_t)(b * 256 + g) * 128) * 64;
            for (int i = F.tid; i < 8192; i += 512) ((LAS v4u*)(F.lds + RING_OFF))[i] = (v4u){0u, 0u, 0u, 0u};
            if (F.tid < 96) ctl[F.tid] = 0;
            __syncthreads();
            idx_pass<0>(F, ln, KIb, MASKg, t0, nt_idx, nt_att, ql, qf, w, invA, 0, 0u);
            __syncthreads();
            idx_scan<0>(F);
            __syncthreads();
            const int b1 = ctl[ql_];
            for (int i = F.tid; i < 8192; i += 512) ((LAS v4u*)(F.lds + RING_OFF))[i] = (v4u){0u, 0u, 0u, 0u};
            __syncthreads();
            idx_pass<1>(F, ln, KIb, MASKg, t0, nt_idx, nt_att, ql, qf, w, invA, b1, 0u);
            __syncthreads();
            idx_scan<1>(F);
            __syncthreads();
            const unsigned thr = (unsigned)ctl[64 + ql_];
            idx_pass<2>(F, ln, KIb, MASKg, t0, nt_idx, nt_att, ql, qf, w, invA, b1, thr);
            __syncthreads();
        }
    }
}

__device__ __forceinline__ void p6_attention(Frame& F, const unsigned* MASK, bf16* ATTo) {
    const bf16* Qb = WSP(bf16, WS_Q); const bf16* Kb = WSP(bf16, WS_K); const bf16* VT = WSP(bf16, WS_VT);
    LAS unsigned char* Kt = F.lds + RING_OFF;
    LAS unsigned char* Vt = F.lds + RING_OFF + 18432;
    LAS float* biasd = (LAS float*)(F.lds + RING_OFF + 36864);
    const int r32 = F.lane & 31, hi = F.lane >> 5;
    const int lrow = F.tid >> 3, lch = F.tid & 7;
    for (int p = F.vcu; p < 256; p += F.G) {
        const int bh = p >> 4, j = p & 15, b = bh >> 3, h = bh & 7;
#pragma unroll 1
        for (int side = 0; side < 2; ++side) {
            const int qb = side ? j : 31 - j, q0 = 256 * qb, NT = 4 * qb + 4;
            const int tq = q0 + 32 * F.wave + r32;
            if (F.tid < 128) { const int bk = t5_bucket(F.tid); biasd[F.tid] = (F.rel_bias[bk * 8 + h] - F.rel_bias[31 * 8 + h]) * LOG2E; }
            const bf16* Kg = Kb + (size_t)(b * SEQ + lrow) * 512 + h * 64 + lch * 8;
            const bf16* Vg = VT + ((size_t)((b * NH + h) * 64 + lrow)) * SEQ + lch * 8;
            const unsigned* Mg = MASK + ((size_t)(b * 256 + 8 * qb + F.wave) * 128) * 64 + F.lane;
            bf16x8 qf[4];
#pragma unroll
            for (int ks = 0; ks < 4; ++ks) qf[ks] = *(const bf16x8*)(Qb + (size_t)(b * SEQ + tq) * 512 + h * 64 + ks * 16 + hi * 8);
            f32x16 o0, o1;
#pragma unroll
            for (int r = 0; r < 16; ++r) { o0[r] = 0.f; o1[r] = 0.f; }
            float m_run = -1e30f, l_run = 0.f;
            v4u kreg = *(const v4u*)(Kg), vreg = *(const v4u*)(Vg); unsigned mw = Mg[0], mwn = 0u;
            *(LAS v4u*)(Kt + lrow * 144 + lch * 16) = kreg; *(LAS v4u*)(Vt + lrow * 144 + lch * 16) = vreg;
            __syncthreads();
            for (int kt = 0; kt < NT; ++kt) {
                const int buf = kt & 1;
                if (kt + 1 < NT) { kreg = *(const v4u*)(Kg + (size_t)(kt + 1) * 64 * 512); vreg = *(const v4u*)(Vg + (kt + 1) * 64); mwn = Mg[(size_t)(kt + 1) * 64]; }
                LAS unsigned char* kb_ = Kt + buf * 9216; LAS unsigned char* vb_ = Vt + buf * 9216;
                f32x16 s0, s1;
#pragma unroll
                for (int r = 0; r < 16; ++r) { s0[r] = 0.f; s1[r] = 0.f; }
#pragma unroll
                for (int ks = 0; ks < 4; ++ks) {
                    const bf16x8 k0 = *(const LAS bf16x8*)(kb_ + r32 * 144 + ks * 32 + hi * 16);
                    const bf16x8 k1 = *(const LAS bf16x8*)(kb_ + (32 + r32) * 144 + ks * 32 + hi * 16);
                    s0 = MFMA32(k0, qf[ks], s0); s1 = MFMA32(k1, qf[ks], s1);
                }
                if (kt >= NT - 6) {
#pragma unroll
                    for (int r = 0; r < 16; ++r) { const int d0 = tq - (64 * kt + crow(r, hi)), d1 = d0 - 32;
                        if ((unsigned)d0 < 128u) s0[r] += biasd[d0];
                        if ((unsigned)d1 < 128u) s1[r] += biasd[d1]; }
                }
                float mx = fmaxf(s0[0], s1[0]);
#pragma unroll
                for (int r = 1; r < 16; ++r) mx = fmaxf(mx, fmaxf(s0[r], s1[r]));
                mx = fmaxf(mx, __shfl_xor(mx, 32));
                if (__any(mx > m_run + 8.0f)) {
                    const float mn = fmaxf(m_run, mx), f = __builtin_amdgcn_exp2f(m_run - mn);
#pragma unroll
                    for (int r = 0; r < 16; ++r) { o0[r] *= f; o1[r] *= f; }
                    l_run *= f; m_run = mn;
                }
                unsigned pk[16];
#pragma unroll
                for (int r = 0; r < 16; r += 2) {
                    float p0 = __builtin_amdgcn_exp2f(s0[r] - m_run), p1 = __builtin_amdgcn_exp2f(s0[r + 1] - m_run);
                    p0 = __builtin_bit_cast(float, __builtin_bit_cast(unsigned, p0) & (unsigned)(-(int)((mw >> r) & 1u)));
                    p1 = __builtin_bit_cast(float, __builtin_bit_cast(unsigned, p1) & (unsigned)(-(int)((mw >> (r + 1)) & 1u)));
                    l_run += p0 + p1; pk[r >> 1] = cvtpk(p0, p1);
                    float p2 = __builtin_amdgcn_exp2f(s1[r] - m_run), p3 = __builtin_amdgcn_exp2f(s1[r + 1] - m_run);
                    p2 = __builtin_bit_cast(float, __builtin_bit_cast(unsigned, p2) & (unsigned)(-(int)((mw >> (16 + r)) & 1u)));
                    p3 = __builtin_bit_cast(float, __builtin_bit_cast(unsigned, p3) & (unsigned)(-(int)((mw >> (17 + r)) & 1u)));
                    l_run += p2 + p3; pk[8 + (r >> 1)] = cvtpk(p2, p3);
                }
#pragma unroll
                for (int kb = 0; kb < 2; ++kb)
#pragma unroll
                    for (int s = 0; s < 2; ++s) {
                        const bf16x8 pf = __builtin_bit_cast(bf16x8, (v4u){pk[8 * kb + 4 * s], pk[8 * kb + 4 * s + 1], pk[8 * kb + 4 * s + 2], pk[8 * kb + 4 * s + 3]});
                        const bf16x8 v0 = *(const LAS bf16x8*)(vb_ + r32 * 144 + (2 * kb + s) * 32 + hi * 16);
                        const bf16x8 v1 = *(const LAS bf16x8*)(vb_ + (32 + r32) * 144 + (2 * kb + s) * 32 + hi * 16);
                        o0 = MFMA32(v0, pf, o0); o1 = MFMA32(v1, pf, o1);
                    }
                if (kt + 1 < NT) { *(LAS v4u*)(Kt + (buf ^ 1) * 9216 + lrow * 144 + lch * 16) = kreg; *(LAS v4u*)(Vt + (buf ^ 1) * 9216 + lrow * 144 + lch * 16) = vreg; }
                mw = mwn;
                __syncthreads();
            }
            const float lt = l_run + __shfl_xor(l_run, 32), inv = 1.0f / lt;
            bf16* orow = ATTo + (size_t)(b * SEQ + tq) * 512 + h * 64 + 4 * hi;
#pragma unroll
            for (int g4 = 0; g4 < 4; ++g4) {
                *(v2u*)(orow + 8 * g4) = (v2u){cvtpk(o0[4 * g4] * inv, o0[4 * g4 + 1] * inv), cvtpk(o0[4 * g4 + 2] * inv, o0[4 * g4 + 3] * inv)};
                *(v2u*)(orow + 32 + 8 * g4) = (v2u){cvtpk(o1[4 * g4] * inv, o1[4 * g4 + 1] * inv), cvtpk(o1[4 * g4 + 2] * inv, o1[4 * g4 + 3] * inv)};
            }
        }
    }
}

__device__ __forceinline__ void p9_norm2_route(Frame& F, const float* HRES) {
    const int gw = F.vcu * NWAVES + F.wave, NGW = F.G * NWAVES;
    const float* mod = WSP(float, SM_MOD); const float* WRT = WSP(float, SM_WRT);
    LAS float* lg = (LAS float*)(F.lds + RING_OFF + F.wave * 16384 + 8448);
    int* EID = WSP(int, SM_EID); float* EWT = WSP(float, SM_EWT); int* SLOT = WSP(int, SM_SLOT); bf16* H2 = WSP(bf16, WS_H1);
    for (int m4 = gw; m4 < T / 4; m4 += NGW) {
        const int m0 = m4 * 4, b = m0 / SEQ;
        f32x4 hv[4][4];
#pragma unroll
        for (int r = 0; r < 4; ++r) {
            const GAS f32x4* xr = (const GAS f32x4*)(HRES + (size_t)(m0 + r) * D) + F.lane; float s = 0.f;
#pragma unroll
            for (int j = 0; j < 4; ++j) { hv[r][j] = xr[64 * j]; s += (hv[r][j].x * hv[r][j].x + hv[r][j].y * hv[r][j].y) + (hv[r][j].z * hv[r][j].z + hv[r][j].w * hv[r][j].w); }
            const float rstd = 1.f / sqrtf(wave_sum(s) * (1.f / D) + EPS);
            GAS v2u* o8 = (GAS v2u*)(H2 + (size_t)(m0 + r) * D) + F.lane;
#pragma unroll
            for (int j = 0; j < 4; ++j) { const int k = 4 * F.lane + 256 * j;
                const f32x4 g = *(const f32x4*)(F.norm2_g + k), scl = *(const f32x4*)(mod + b * 6144 + 4096 + k), sh = *(const f32x4*)(mod + b * 6144 + 3072 + k);
                hv[r][j] = hv[r][j] * rstd * (g * (scl + 1.0f)) + sh; o8[64 * j] = (v2u){pk2(hv[r][j].x, hv[r][j].y), pk2(hv[r][j].z, hv[r][j].w)}; }
        }
        for (int n = 0; n < 36; ++n) {
            f32x4 w[4];
#pragma unroll
            for (int j = 0; j < 4; ++j) w[j] = *(const f32x4*)(WRT + n * D + 4 * F.lane + 256 * j);
            float p[4];
#pragma unroll
            for (int r = 0; r < 4; ++r) { float a = 0.f;
#pragma unroll
                for (int j = 0; j < 4; ++j) a += (hv[r][j].x * w[j].x + hv[r][j].y * w[j].y) + (hv[r][j].z * w[j].z + hv[r][j].w * w[j].w);
                p[r] = wave_sum(a); }
            if (F.lane < 4) lg[F.lane * 36 + n] = (F.lane == 0 ? p[0] : F.lane == 1 ? p[1] : F.lane == 2 ? p[2] : p[3]) + (n < 4 ? F.brg[n] : F.bre[n - 4]);
        }
        LDS_WAIT(); asm volatile("" ::: "memory");
        if (F.lane < 4) {
            const LAS float* l = lg + F.lane * 36; const int tkn = m0 + F.lane;
            int gs = 0; float gm = l[0];
#pragma unroll
            for (int j = 1; j < 4; ++j) if (l[j] > gm) { gm = l[j]; gs = j; }
            float gsum = 0.f;
#pragma unroll
            for (int j = 0; j < 4; ++j) gsum += __expf(l[j] - gm);
            const float gwt = 1.f / gsum;
            const LAS float* el = l + 4 + 8 * gs;
            int i0 = 0; float l0 = el[0];
#pragma unroll
            for (int j = 1; j < 8; ++j) if (el[j] > l0) { l0 = el[j]; i0 = j; }
            int i1 = -1; float l1 = -INFINITY;
#pragma unroll
            for (int j = 0; j < 8; ++j) if (j != i0 && el[j] > l1) { l1 = el[j]; i1 = j; }
            const float e1 = __expf(l1 - l0), p0 = 1.f / (1.f + e1), p1 = e1 * p0;
            const int e0id = gs * 8 + i0, e1id = gs * 8 + i1;
            EID[tkn * 2] = e0id; EID[tkn * 2 + 1] = e1id; EWT[tkn * 2] = gwt * p0; EWT[tkn * 2 + 1] = gwt * p1;
            SLOT[tkn * 2] = (int)atomicAdd((unsigned*)(F.ctl + CW_ECNT + 16 * e0id), 1u);
            SLOT[tkn * 2 + 1] = (int)atomicAdd((unsigned*)(F.ctl + CW_ECNT + 16 * e1id), 1u);
        }
        LDS_WAIT(); asm volatile("" ::: "memory");
    }
    {
        LAS float* scr = (LAS float*)(F.lds + RING_OFF + F.wave * 16384);
        for (int it = gw; it < NEXP * 768; it += NGW) {
            const int e = it / 768, r = it % 768;
            if (r < 256) transpose_item(F.w_gate_e + (size_t)e * D * DEXP, D, DEXP, WSP(bf16, WS_WGU) + (size_t)e * 1024 * D, scr, r, F.lane, RmGU{0});
            else if (r < 512) transpose_item(F.w_up_e + (size_t)e * D * DEXP, D, DEXP, WSP(bf16, WS_WGU) + (size_t)e * 1024 * D, scr, r - 256, F.lane, RmGU{1});
            else transpose_item(F.w_down_e + (size_t)e * DEXP * D, DEXP, D, WSP(bf16, WS_WD) + (size_t)e * D * DEXP, scr, r - 512, F.lane, RmId());
        }
    }
}
__device__ __forceinline__ int moe_tables(Frame& F, LAS int* off, LAS int* tile_e) {
    if (F.tid == 0) { int o = 0, nt = 0;
        for (int e = 0; e < NEXP; ++e) { const int c = (int)__hip_atomic_load(F.ctl + CW_ECNT + 16 * e, RLX_AGENT); off[e] = o; const int tl = (c + 255) >> 8; for (int j = 0; j < tl; ++j) tile_e[nt++] = e; o += tl * 256; }
        off[NEXP] = nt; }
    __syncthreads();
    return off[NEXP];
}
__device__ __forceinline__ void p10_gather(Frame& F, LAS int* off) {
    const int gw = F.vcu * NWAVES + F.wave, NGW = F.G * NWAVES;
    const int* EID = WSP(int, SM_EID); int* SLOT = WSP(int, SM_SLOT); const bf16* H2 = WSP(bf16, WS_H1); bf16* XP = WSP(bf16, WS_XP);
    for (int t = gw; t < T; t += NGW) {
        const v4u a = *(const v4u*)(H2 + (size_t)t * D + F.lane * 16), b = *(const v4u*)(H2 + (size_t)t * D + F.lane * 16 + 8);
#pragma unroll
        for (int k = 0; k < 2; ++k) { const int row = off[EID[t * 2 + k]] + SLOT[t * 2 + k];
            *(v4u*)(XP + (size_t)row * D + F.lane * 16) = a; *(v4u*)(XP + (size_t)row * D + F.lane * 16 + 8) = b;
            if (F.lane == 0) SLOT[t * 2 + k] = row; }
    }
}
__device__ __forceinline__ void p13_combine(Frame& F, const float* HRES) {
    const int gw = F.vcu * NWAVES + F.wave, NGW = F.G * NWAVES;
    const float* mod = WSP(float, SM_MOD); const int* SLOT = WSP(int, SM_SLOT); const float* EWT = WSP(float, SM_EWT); const bf16* Y = WSP(bf16, WS_Y);
    for (int m = gw; m < T; m += NGW) {
#if DBG_SKIP_MOE
        const int b = m / SEQ; const int r0 = 0, r1 = 0; const float w0 = 0.f, w1 = 0.f; (void)SLOT; (void)EWT;
#else
        const int b = m / SEQ; const int r0 = SLOT[m * 2], r1 = SLOT[m * 2 + 1]; const float w0 = EWT[m * 2], w1 = EWT[m * 2 + 1];
#endif
        const GAS f32x4* xr = (const GAS f32x4*)(HRES + (size_t)m * D) + F.lane;
        const GAS v2u* y0 = (const GAS v2u*)(Y + (size_t)r0 * D) + F.lane; const GAS v2u* y1 = (const GAS v2u*)(Y + (size_t)r1 * D) + F.lane;
        f32x4 v[4]; float s = 0.f;
#pragma unroll
        for (int j = 0; j < 4; ++j) { const int k = 4 * F.lane + 256 * j; const v2u a = y0[64 * j], c = y1[64 * j];
            const f32x4 ya = (f32x4){bflo(a.x), bfhi(a.x), bflo(a.y), bfhi(a.y)}, yb = (f32x4){bflo(c.x), bfhi(c.x), bflo(c.y), bfhi(c.y)};
            const f32x4 g2 = *(const f32x4*)(mod + b * 6144 + 5120 + k);
#if DBG_SKIP_MOE
            v[j] = xr[64 * j]; (void)g2; (void)ya; (void)yb;
#else
            v[j] = xr[64 * j] + g2 * (ya * w0 + yb * w1);
#endif
            s += (v[j].x * v[j].x + v[j].y * v[j].y) + (v[j].z * v[j].z + v[j].w * v[j].w); }
        const float rstd = 1.f / sqrtf(wave_sum(s) * (1.f / D) + EPS);
        GAS f32x4* o = (GAS f32x4*)(F.out + (size_t)m * D) + F.lane;
#if DBG_CMP_ATT
        const float escale = 1.0f + sqrtf(__builtin_bit_cast(float, __hip_atomic_load(F.ctl + CW_CMP, RLX_AGENT)) / __builtin_bit_cast(float, __hip_atomic_load(F.ctl + CW_CMP + 1, RLX_AGENT)));
#else
        const float escale = 1.0f;
#endif
#pragma unroll
        for (int j = 0; j < 4; ++j) o[64 * j] = v[j] * (rstd * escale) * *(const f32x4*)(F.norm_f_g + 4 * F.lane + 256 * j);
    }
}

struct Args { const float* in[20]; float* out; unsigned char* ws; int ph_lo, ph_hi, li, pad; };
__global__ void __launch_bounds__(NWAVES * 64, 2) fwd_kernel(Args args) {
    extern __shared__ __attribute__((aligned(16))) unsigned char lds[];
    Frame F;
    F.lds = (LAS unsigned char*)lds;
    F.MISC = (volatile LAS unsigned*)(F.lds + MISC_OFF);
    F.tid = threadIdx.x; F.lane = F.tid & 63; F.wave = __builtin_amdgcn_readfirstlane(F.tid >> 6);
    F.G = gridDim.x; { const int bx = blockIdx.x; F.vcu = (F.G % 8 == 0) ? (bx % 8) * (F.G / 8) + bx / 8 : bx; }
    F.ws = args.ws; F.ctl = (gu32*)(args.ws + WS_CTL);
    F.x = args.in[0]; F.c = args.in[1]; F.w_ada = args.in[2]; F.b_ada = args.in[3]; F.norm1_g = args.in[4]; F.w_in = args.in[5]; F.rel_bias = args.in[6]; F.conv_w = args.in[7];
    F.w_attn = args.in[8]; F.w_conv = args.in[9]; F.w_out = args.in[10]; F.norm2_g = args.in[11]; F.wrg = args.in[12]; F.brg = args.in[13]; F.wre = args.in[14]; F.bre = args.in[15];
    F.w_gate_e = args.in[16]; F.w_up_e = args.in[17]; F.w_down_e = args.in[18]; F.norm_f_g = args.in[19]; F.out = args.out;
    for (int u = F.tid; u < (LDS_BYTES - LDSCTL_OFF) / 4; u += NWAVES * 64) ((LAS unsigned*)(F.lds + LDSCTL_OFF))[u] = 0u;
    __syncthreads();
    XcdBarrier bar; bar.bar = (unsigned*)(F.ctl + CW_BAR); bar.x = 0; bar.st = nullptr;
    if (!MK_PER_PHASE) bar = xcd_barrier_post((unsigned*)(F.ctl + CW_BAR), F.MISC + 8);
#define GRID_BAR() do { if (MK_PER_PHASE) { if (F.tid == 0) __hip_atomic_store(F.ctl + CW_TMO, 0xBADBA0u, RLX_AGENT); } else { xcd_barrier(bar); } } while (0)
    const int lo = args.ph_lo, hi = args.ph_hi;
#ifndef ONLY_PHASE
#define ONLY_PHASE -1
#endif
#define IN(k) ((ONLY_PHASE < 0 || ONLY_PHASE == (k)) && lo <= (k) && (k) < hi)
#define BOTH(k) (IN(k) && IN((k) + 1))
    float* HRES = F.out;
    LAS int* moe_off = (LAS int*)(F.lds + LDSCTL_OFF + 1024);
    LAS int* moe_tile = (LAS int*)(F.lds + LDSCTL_OFF + 1024 + 256);

    if (IN(0)) { p0_prologue(F); if (BOTH(0)) GRID_BAR(); }
    if (IN(1)) { p1_norm1(F); if (BOTH(1)) GRID_BAR(); }
    if (IN(2)) {
        pg8::Gemm g{WSP(bf16, WS_H1), WSP(bf16, WS_WIN), T, NINP, D}; pg8::StaticOrder S; S.init(T, NINP, F.G, (int)blockIdx.x);
        EpiProj E{WSP(bf16, WS_Q), WSP(bf16, WS_K), WSP(bf16, WS_V), WSP(bf16, WS_QI), WSP(bf16, WS_KI), WSP(bf16, WS_CB), WSP(bf16, WS_U), WSP(bf16, WS_G), WSP(float, WS_WI)};
        pg8::gemm_phase<EpiProj, pg8::StaticOrder, true, true>(F.lds + RING_OFF, g, S, E);
        if (BOTH(2)) GRID_BAR();
    }
    if (IN(3)) { p3_prep(F); if (BOTH(3)) GRID_BAR(); }
    if (IN(4)) {
        pg8::Gemm g{WSP(bf16, WS_AC), WSP(bf16, WS_WC), T, D, AW}; pg8::StaticOrder S; S.init(T, D, F.G, (int)blockIdx.x);
        EpiConv E{WSP(bf16, WS_G), WSP(bf16, WS_TMPC)};
        pg8::gemm_phase<EpiConv, pg8::StaticOrder, true, true>(F.lds + RING_OFF, g, S, E);
        if (BOTH(4)) GRID_BAR();
    }
    if (IN(5)) {
#if DBG_SKIP_ATTN
        for (size_t i = (size_t)blockIdx.x * 512 + F.tid; i < (size_t)T * 512 / 8; i += (size_t)F.G * 512) *(v4u*)(WSP(bf16, WS_ATT) + i * 8) = (v4u){0u, 0u, 0u, 0u};
#elif DBG_CMP_ATT
        pn_naive_dsa(F); GRID_BAR(); p5_indexer(F, WSP(unsigned, WS_MASK_DBG));
#elif MK_NAIVE_ATTN
        pn_naive_dsa(F);
#else
        p5_indexer(F, WSP(unsigned, WS_MASK));
#endif
        if (BOTH(5)) GRID_BAR(); }
    if (IN(6)) {
#if DBG_SKIP_ATTN
#elif DBG_CMP_ATT
        p6_attention(F, WSP(unsigned, WS_MASK_DBG), WSP(bf16, WS_ATT2)); GRID_BAR();
        { float num = 0.f, den = 0.f; const bf16* A1 = WSP(bf16, WS_ATT); const bf16* A2 = WSP(bf16, WS_ATT2);
          for (size_t i = (size_t)blockIdx.x * 512 + F.tid; i < (size_t)T * 512; i += (size_t)F.G * 512) { const float a = bf1(A1[i]), c = bf1(A2[i]); num += (a - c) * (a - c); den += a * a; }
          num = wave_sum(num); den = wave_sum(den);
          if (F.lane == 0) { atomicAdd((float*)(F.ctl + CW_CMP), num); atomicAdd((float*)(F.ctl + CW_CMP + 1), den); } }
#elif !MK_NAIVE_ATTN
        p6_attention(F, WSP(unsigned, WS_MASK), WSP(bf16, WS_ATT));
#endif
        if (BOTH(6)) GRID_BAR(); }
    if (IN(7)) {
        pg8::Gemm g{WSP(bf16, WS_ATT), WSP(bf16, WS_WA), T, D, AW}; pg8::StaticOrder S; S.init(T, D, F.G, (int)blockIdx.x);
        EpiAttn E{WSP(bf16, WS_G), WSP(bf16, WS_TMPC), WSP(bf16, WS_MERGED)};
        pg8::gemm_phase<EpiAttn, pg8::StaticOrder, true, true>(F.lds + RING_OFF, g, S, E);
        if (BOTH(7)) GRID_BAR();
    }
    if (IN(8)) {
        pg8::Gemm g{WSP(bf16, WS_MERGED), WSP(bf16, WS_WOUT), T, D, D}; pg8::StaticOrder S; S.init(T, D, F.G, (int)blockIdx.x);
        EpiOut E{F.x, WSP(float, SM_MOD), HRES};
        pg8::gemm_phase<EpiOut, pg8::StaticOrder, true, true>(F.lds + RING_OFF, g, S, E);
        if (BOTH(8)) GRID_BAR();
    }
#if DBG_SKIP_MOE
    if (0) {
#endif
    if (IN(9)) { p9_norm2_route(F, HRES); if (BOTH(9)) GRID_BAR(); }
    if (IN(10)) { (void)moe_tables(F, moe_off, moe_tile); p10_gather(F, moe_off); if (BOTH(10)) GRID_BAR(); }
    if (IN(11)) {
        const int nt = moe_tables(F, moe_off, moe_tile);
        pg8::Gemm g{WSP(bf16, WS_XP), WSP(bf16, WS_WGU), XPROWS, NEXP * 1024, D}; MoeOrder S{moe_tile, nt, F.G, (int)blockIdx.x};
        EpiHid E{WSP(bf16, WS_HID)};
        pg8::gemm_phase<EpiHid, MoeOrder, true, true>(F.lds + RING_OFF, g, S, E);
        if (BOTH(11)) GRID_BAR();
    }
    if (IN(12)) {
        const int nt = moe_tables(F, moe_off, moe_tile);
        pg8::Gemm g{WSP(bf16, WS_HID), WSP(bf16, WS_WD), XPROWS, NEXP * 1024, DEXP}; MoeOrder S{moe_tile, nt, F.G, (int)blockIdx.x};
        EpiY E{WSP(bf16, WS_Y)};
        pg8::gemm_phase<EpiY, MoeOrder, true, true>(F.lds + RING_OFF, g, S, E);
        if (BOTH(12)) GRID_BAR();
    }
#if DBG_SKIP_MOE
    }
#endif
#if DBG_PROBE
    if (IN(13)) {
        const bf16* src = nullptr; int pitch = 1024;
        if (DBG_PROBE == 1) { src = WSP(bf16, WS_MERGED); pitch = 1024; }
        if (DBG_PROBE == 2) { src = WSP(bf16, WS_TMPC); pitch = 1024; }
        if (DBG_PROBE == 3) { src = WSP(bf16, WS_AC); pitch = 512; }
        if (DBG_PROBE == 4) { src = WSP(bf16, WS_G); pitch = 2048; }
        if (DBG_PROBE == 5) { src = WSP(bf16, WS_H1); pitch = 1024; }
        if (DBG_PROBE == 6) { src = WSP(bf16, WS_WIN); pitch = 1024; }
        if (DBG_PROBE == 7) { src = WSP(bf16, WS_QI); pitch = 512; }
        for (size_t i = (size_t)blockIdx.x * 512 + F.tid; i < (size_t)T * D; i += (size_t)F.G * 512) { const size_t m = i / D, j = i % D;
            float v;
            if (DBG_PROBE == 8) v = WSP(float, SM_MOD)[i % 12288];
            else if (DBG_PROBE == 4) v = bf1(src[m * 2048 + j]) + bf1(src[m * 2048 + 1024 + j]);
            else if (DBG_PROBE >= 40 && DBG_PROBE < 48) v = bf1(WSP(bf16, WS_G)[m * 2048 + (DBG_PROBE - 40) * 256 + (j & 255)]);
            else if (DBG_PROBE == 6) v = bf1(src[(m % 5888) * 1024 + j]);
            else v = bf1(src[m * pitch + (j % pitch)]);
            F.out[i] = v; }
    }
#else
    if (IN(13)) { p13_combine(F, DBG_SKIP_MIX ? F.x : HRES); }
#endif
#undef IN
#undef BOTH
}

extern "C" void kernel_launch(void* const* d_in, const int* in_sizes, int n_in, void* d_out, int out_size, void* d_ws, size_t ws_size, hipStream_t stream) {
    static int grid = 0;
    if (grid == 0) {
        if (n_in != 20 || in_sizes[0] != T * D || out_size != T * D || ws_size < WS_END) { fprintf(stderr, "kernel_launch: unexpected shapes: n_in %d in0 %d out %d ws %zu (need %zu)\n", n_in, n_in > 0 ? in_sizes[0] : -1, out_size, ws_size, (size_t)WS_END); grid = -1; return; }
        int dev = 0, cus = 0, per_cu = 0;
        if (hipGetDevice(&dev) != hipSuccess || hipDeviceGetAttribute(&cus, hipDeviceAttributeMultiprocessorCount, dev) != hipSuccess) { grid = -1; return; }
        if (hipFuncSetAttribute((const void*)fwd_kernel, hipFuncAttributeMaxDynamicSharedMemorySize, LDS_BYTES) != hipSuccess) { fprintf(stderr, "kernel_launch: hipFuncSetAttribute failed\n"); grid = -1; return; }
        if (hipOccupancyMaxActiveBlocksPerMultiprocessor(&per_cu, (const void*)fwd_kernel, NWAVES * 64, LDS_BYTES) != hipSuccess || per_cu < 1)
            fprintf(stderr, "kernel_launch: note: occupancy query reports %d workgroups per CU\n", per_cu);
        (void)hipGetLastError();
        grid = cus;
    }
    if (grid < 0) return;
    if (hipMemsetAsync((char*)d_ws + WS_CTL, 0, CTL_ZERO_BYTES, stream) != hipSuccess) return;
    Args a{};
    for (int i = 0; i < 20; ++i) a.in[i] = (const float*)d_in[i];
    a.out = (float*)d_out; a.ws = (unsigned char*)d_ws;
#if MK_PER_PHASE
    for (int li = 0; li < N_PHASES; ++li) { a.ph_lo = li; a.ph_hi = li + 1; a.li = li; hipLaunchKernelGGL(fwd_kernel, dim3(grid), dim3(NWAVES * 64), LDS_BYTES, stream, a); }
#else
    a.ph_lo = 0; a.ph_hi = N_PHASES; a.li = 0;
    hipLaunchKernelGGL(fwd_kernel, dim3(grid), dim3(NWAVES * 64), LDS_BYTES, stream, a);
#endif
}
```

```cpp
#include <hip/hip_runtime.h>
#include <cstdio>
#include <cstdint>

namespace pg8 {
#define PG8_LAS __attribute__((address_space(3)))
typedef unsigned short bf16_t;
typedef short bf16x8 __attribute__((ext_vector_type(8)));
typedef float f32x4 __attribute__((ext_vector_type(4)));
typedef unsigned u32x4 __attribute__((ext_vector_type(4)));
constexpr int BM = 256, BK = 64, HALF = 128, HTB = HALF * BK * 2  , STAGE_BYTES = 8 * HTB, NXCD = 8, WGM = 8;

__host__ __device__ __forceinline__ int lds_byte(int r, int c) { const int st = (r >> 4) * 2 + (c >> 5), rr = r & 15, cc = c & 31, ob = rr * 64 + cc * 2; return st * 1024 + (ob ^ (((ob >> 9) & 1) << 5)); }
__host__ __device__ __forceinline__ void stage_rc(int b, int& R, int& C) { const int st = b / 1024, sb = b % 1024, swz = sb ^ (((sb >> 9) & 1) << 5); R = (st >> 1) * 16 + swz / 64; C = (st & 1) * 32 + (swz % 64) / 2; }
__host__ __device__ __forceinline__ int perm32(int rho) { const int n = rho >> 4, i = rho & 15; return 8 * (i >> 2) + 4 * n + (i & 3); }

struct Unit { int pm, pn; };
struct Gemm { const bf16_t* A; const bf16_t* Bt; int M, N, K; };

struct StaticOrder {
    int nM, nN, nwg, G, c;
    __host__ __device__ void init(int M, int N, int G_, int c_) { nM = M / BM; nN = N / BM; nwg = nM * nN; G = G_; c = c_; }
    __host__ __device__ bool next(int i, Unit& u) const {
        const long L = (long)i * G + c; if (L >= nwg) return false;
        int wgid = (int)L; { const int q = nwg / NXCD, r = nwg % NXCD, xcd = wgid % NXCD, off = wgid / NXCD; wgid = (xcd < r ? xcd * (q + 1) : r * (q + 1) + (xcd - r) * q) + off; }
        const int nig = WGM * nN, gid = wgid / nig, fm = gid * WGM, gsz = (nM - fm) < WGM ? (nM - fm) : WGM;
        u.pm = fm + ((wgid % nig) % gsz); u.pn = (wgid % nig) / gsz; return true;
    }
    __device__ __forceinline__ void a_ready(const Unit&) const {}
    __device__ __forceinline__ void done(const Unit&) const {}
};
__device__ __forceinline__ unsigned cvt_pk_bf16(float lo, float hi) { unsigned r; asm volatile("v_cvt_pk_bf16_f32 %0, %1, %2" : "=v"(r) : "v"(lo), "v"(hi)); return r; }

template <class Epi, class Sched, bool ALIGN_EPI = false, bool SP2 = false, bool GATHER = false>
__device__ __forceinline__ void gemm_phase(PG8_LAS unsigned char* lds, const Gemm g, const Sched& S, const Epi& E, const int* arow = nullptr) {
    static_assert(!GATHER || SP2, "GATHER is implemented on the SP2 loop only");
    const int tid = threadIdx.x, wid = __builtin_amdgcn_readfirstlane(tid >> 6), lane = tid & 63, wr = wid >> 2, wc = wid & 3, fr = lane & 15, fq = lane >> 4;
    const int K = g.K, nt = K / BK;
    unsigned voffA[2], voffB[2]; int RA[2]; unsigned CA2[2];
#pragma unroll
    for (int i = 0; i < 2; ++i) { int R, C; stage_rc(tid * 16 + i * 8192, R, C); const int Rb = Epi::PERM ? ((R & ~31) + perm32(R & 31)) : R;
        voffA[i] = (unsigned)(R * K + C) * 2u; voffB[i] = (unsigned)(Rb * K + C) * 2u; RA[i] = R; CA2[i] = (unsigned)C * 2u; }
    unsigned vA[2][2] = {{0u, 0u}, {0u, 0u}}, nvA[2][2] = {{0u, 0u}, {0u, 0u}};
#define PG8_GROWS(dst, U) do { _Pragma("unroll") for (int _h = 0; _h < 2; ++_h) _Pragma("unroll") for (int _i = 0; _i < 2; ++_i) dst[_h][_i] = (unsigned)arow[(U).pm * BM + _h * HALF + RA[_i]] * (unsigned)(K * 2) + CA2[_i]; } while (0)
    const size_t kstep = (size_t)(BK * 2);
    const size_t hstep = (size_t)HALF * K * 2;
    const size_t tstep = 2 * hstep;
    const unsigned ldsw = (unsigned)wid * 1024u;
    const int aoff = lds_byte(wr * 64 + fr, fq * 8), boff = lds_byte(wc * 32 + fr, fq * 8);
#define PG8_SA(b, h) (((b) * 2 + (h)) * HTB)
#define PG8_SB(b, h) ((4 + (b) * 2 + (h)) * HTB)
#define PG8_STAGE(bufoff, gbase, voff) do { _Pragma("unroll") for (int _i = 0; _i < 2; ++_i) \
        __builtin_amdgcn_global_load_lds((const unsigned*)((const char*)(gbase) + (voff)[_i]), (PG8_LAS unsigned*)(lds + (bufoff) + ldsw + _i * 8192), 16, 0, 0); } while (0)
#define PG8_STAGE_A(bufoff, gb, h, nx) do { if constexpr (GATHER) { _Pragma("unroll") for (int _i = 0; _i < 2; ++_i) { const unsigned vo_ = (nx) ? nvA[h][_i] : vA[h][_i]; \
        __builtin_amdgcn_global_load_lds((const unsigned*)((const char*)(gb) + vo_), (PG8_LAS unsigned*)(lds + (bufoff) + ldsw + _i * 8192), 16, 0, 0); } } else { PG8_STAGE(bufoff, (gb) + (h) * hstep, voffA); } } while (0)
#define PG8_LDA(dst, b, h) do { _Pragma("unroll") for (int m = 0; m < 4; ++m) _Pragma("unroll") for (int k = 0; k < 2; ++k) dst[m][k] = *(const PG8_LAS bf16x8*)(lds + PG8_SA(b, h) + aoff + m * 2048 + k * 1024); } while (0)
#define PG8_LDB(dst, b, h) do { _Pragma("unroll") for (int n = 0; n < 2; ++n) _Pragma("unroll") for (int k = 0; k < 2; ++k) dst[n][k] = *(const PG8_LAS bf16x8*)(lds + PG8_SB(b, h) + boff + n * 2048 + k * 1024); } while (0)
#define PG8_MMA(ai, bj, At, Bt) do { __builtin_amdgcn_s_setprio(1); _Pragma("unroll") for (int m = 0; m < 4; ++m) _Pragma("unroll") for (int n = 0; n < 2; ++n) _Pragma("unroll") for (int k = 0; k < 2; ++k) \
        acc[ai][bj][m][n] = __builtin_amdgcn_mfma_f32_16x16x32_bf16(Bt[n][k], At[m][k], acc[ai][bj][m][n], 0, 0, 0); __builtin_amdgcn_s_setprio(0); } while (0)
#define PG8_WAIT_V(n) asm volatile("s_waitcnt vmcnt(" #n ")" ::: "memory")
#define PG8_WAIT_L(n) asm volatile("s_waitcnt lgkmcnt(" #n ")" ::: "memory")
#define PG8_BAR __builtin_amdgcn_s_barrier()
#define PG8_SCHED __builtin_amdgcn_sched_barrier(0)
    Unit cur, nxt; int ui = 0;
    if (!S.next(0, cur)) return;
    f32x4 acc[2][2][4][2];
#pragma unroll
    for (int a = 0; a < 2; ++a)
#pragma unroll
        for (int b = 0; b < 2; ++b)
#pragma unroll
            for (int m = 0; m < 4; ++m)
#pragma unroll
                for (int n = 0; n < 2; ++n) acc[a][b][m][n] = (f32x4){0.f, 0.f, 0.f, 0.f};
    bf16x8 At[4][2], B0[2][2], B1[2][2];
    const char* cA = (const char*)g.A + (GATHER ? (size_t)0 : (size_t)cur.pm * tstep); const char* cB = (const char*)g.Bt + (size_t)cur.pn * tstep;
    if constexpr (GATHER) PG8_GROWS(vA, cur);
    S.a_ready(cur);
    if constexpr (SP2) {
        PG8_STAGE(PG8_SB(0, 0), cB, voffB); PG8_STAGE(PG8_SB(0, 1), cB + hstep, voffB); PG8_STAGE_A(PG8_SA(0, 0), cA, 0, false); PG8_STAGE_A(PG8_SA(0, 1), cA, 1, false);
        if (wr == 1) PG8_BAR;
        PG8_WAIT_V(2); PG8_BAR;
        PG8_STAGE(PG8_SB(1, 0), cB + kstep, voffB); PG8_STAGE_A(PG8_SA(1, 0), cA + kstep, 0, false); PG8_STAGE(PG8_SB(1, 1), cB + hstep + kstep, voffB);
        PG8_WAIT_V(6); PG8_BAR;
    } else {
        PG8_STAGE(PG8_SB(0, 0), cB, voffB); PG8_STAGE(PG8_SA(0, 0), cA, voffA); PG8_STAGE(PG8_SB(0, 1), cB + hstep, voffB); PG8_STAGE(PG8_SA(0, 1), cA + hstep, voffA);
        if (wr == 1) PG8_BAR;
        PG8_WAIT_V(4); PG8_BAR;
        PG8_STAGE(PG8_SB(1, 0), cB + kstep, voffB); PG8_STAGE(PG8_SA(1, 0), cA + kstep, voffA); PG8_STAGE(PG8_SB(1, 1), cB + hstep + kstep, voffB);
        PG8_WAIT_V(6); PG8_BAR;
    }
    for (;;) {
        const bool has_next = S.next(ui + 1, nxt);
        const char* nA = (has_next && !GATHER) ? (const char*)g.A + (size_t)nxt.pm * tstep : cA; const char* nB = has_next ? (const char*)g.Bt + (size_t)nxt.pn * tstep : cB;
        if constexpr (GATHER) { if (has_next) PG8_GROWS(nvA, nxt); else { nvA[0][0] = vA[0][0]; nvA[0][1] = vA[0][1]; nvA[1][0] = vA[1][0]; nvA[1][1] = vA[1][1]; } }
        for (int t = 0; t < nt; t += 2) {
            const bool last = (t == nt - 2);
            const char* a1 = cA + (size_t)(t + 1) * kstep;
            const char* a2 = last ? nA : cA + (size_t)(t + 2) * kstep; const char* b2 = last ? nB : cB + (size_t)(t + 2) * kstep;
            const char* a3 = a2 + kstep; const char* b3 = b2 + kstep;
            if (last && has_next) S.a_ready(nxt);
            if constexpr (SP2) {
            PG8_LDB(B0, 0, 0); PG8_LDB(B1, 0, 1); PG8_SCHED; PG8_LDA(At, 0, 0); PG8_STAGE_A(PG8_SA(1, 1), a1, 1, false);
            PG8_WAIT_V(8); PG8_WAIT_L(0); PG8_BAR; PG8_MMA(0, 0, At, B0); PG8_MMA(0, 1, At, B1); PG8_BAR; PG8_SCHED;
            PG8_LDA(At, 0, 1); PG8_STAGE(PG8_SB(0, 0), b2, voffB); PG8_STAGE(PG8_SB(0, 1), b2 + hstep, voffB); PG8_STAGE_A(PG8_SA(0, 0), a2, 0, last);
            PG8_WAIT_V(8); PG8_WAIT_L(0); PG8_BAR; PG8_MMA(1, 0, At, B0); PG8_MMA(1, 1, At, B1); PG8_BAR; PG8_SCHED;
            PG8_LDB(B0, 1, 0); PG8_LDB(B1, 1, 1); PG8_SCHED; PG8_LDA(At, 1, 0); PG8_STAGE_A(PG8_SA(0, 1), a2, 1, last);
            PG8_WAIT_V(8); PG8_WAIT_L(0); PG8_BAR; PG8_MMA(0, 0, At, B0); PG8_MMA(0, 1, At, B1); PG8_BAR; PG8_SCHED;
            PG8_LDA(At, 1, 1); PG8_STAGE(PG8_SB(1, 0), b3, voffB); PG8_STAGE(PG8_SB(1, 1), b3 + hstep, voffB); PG8_STAGE_A(PG8_SA(1, 0), a3, 0, last);
            PG8_WAIT_V(8); PG8_WAIT_L(0); PG8_BAR; PG8_MMA(1, 0, At, B0); PG8_MMA(1, 1, At, B1); PG8_BAR; PG8_SCHED;
            } else {
            PG8_LDB(B0, 0, 0); PG8_SCHED; PG8_LDA(At, 0, 0); PG8_STAGE(PG8_SA(1, 1), a1 + hstep, voffA);
            PG8_WAIT_L(8); PG8_BAR; PG8_WAIT_L(0); PG8_MMA(0, 0, At, B0); PG8_BAR; PG8_SCHED;
            PG8_LDB(B1, 0, 1); PG8_STAGE(PG8_SB(0, 0), b2, voffB);
            PG8_BAR; PG8_WAIT_L(0); PG8_MMA(0, 1, At, B1); PG8_BAR;
            PG8_LDA(At, 0, 1); PG8_STAGE(PG8_SA(0, 0), a2, voffA);
            PG8_BAR; PG8_WAIT_L(0); PG8_MMA(1, 0, At, B0); PG8_BAR; PG8_SCHED;
            PG8_STAGE(PG8_SB(0, 1), b2 + hstep, voffB);
            PG8_WAIT_V(6); PG8_BAR; PG8_MMA(1, 1, At, B1); PG8_BAR;
            PG8_LDB(B0, 1, 0); PG8_SCHED; PG8_LDA(At, 1, 0); PG8_STAGE(PG8_SA(0, 1), a2 + hstep, voffA);
            PG8_WAIT_L(8); PG8_BAR; PG8_WAIT_L(0); PG8_MMA(0, 0, At, B0); PG8_BAR; PG8_SCHED;
            PG8_LDB(B1, 1, 1); PG8_STAGE(PG8_SB(1, 0), b3, voffB);
            PG8_BAR; PG8_WAIT_L(0); PG8_MMA(0, 1, At, B1); PG8_BAR;
            PG8_LDA(At, 1, 1); PG8_STAGE(PG8_SA(1, 0), a3, voffA);
            PG8_BAR; PG8_WAIT_L(0); PG8_MMA(1, 0, At, B0); PG8_BAR; PG8_SCHED;
            PG8_STAGE(PG8_SB(1, 1), b3 + hstep, voffB);
            PG8_WAIT_V(6); PG8_BAR; PG8_MMA(1, 1, At, B1); PG8_BAR;
            }
        }
        if constexpr (ALIGN_EPI) { if (wr == 0) PG8_BAR; }
        if constexpr (!Epi::AFTER_DRAIN) { E(acc, cur, wr, wc, fr, fq); S.done(cur); }
        if (!has_next) break;
#pragma unroll
        for (int a = 0; a < 2; ++a)
#pragma unroll
            for (int b = 0; b < 2; ++b)
#pragma unroll
                for (int m = 0; m < 4; ++m)
#pragma unroll
                    for (int n = 0; n < 2; ++n) acc[a][b][m][n] = (f32x4){0.f, 0.f, 0.f, 0.f};
        cur = nxt; cA = nA; cB = nB; ++ui;
        if constexpr (GATHER) { vA[0][0] = nvA[0][0]; vA[0][1] = nvA[0][1]; vA[1][0] = nvA[1][0]; vA[1][1] = nvA[1][1]; }
        if constexpr (ALIGN_EPI) { if (wr == 1) PG8_BAR; }
    }
    PG8_WAIT_V(0);
    if constexpr (!ALIGN_EPI) { if (wr == 0) PG8_BAR; }
    PG8_BAR;
    if constexpr (Epi::AFTER_DRAIN) { E.fused(acc, cur, wr, wc, fr, fq, lds, wid, lane); S.done(cur); }
#undef PG8_SA
#undef PG8_SB
#undef PG8_STAGE
#undef PG8_STAGE_A
#undef PG8_GROWS
#undef PG8_LDA
#undef PG8_LDB
#undef PG8_MMA
#undef PG8_WAIT_V
#undef PG8_WAIT_L
#undef PG8_BAR
#undef PG8_SCHED
}
}

constexpr int NWAVES = 8;
#ifndef MK_PER_PHASE
#define MK_PER_PHASE 0
#endif
#ifndef MK_NAIVE_ATTN
#define MK_NAIVE_ATTN 0
#endif
#ifndef DBG_SKIP_ATTN
#define DBG_SKIP_ATTN 0
#endif
#ifndef DBG_SKIP_MOE
#define DBG_SKIP_MOE 0
#endif
#ifndef DBG_SKIP_MIX
#define DBG_SKIP_MIX 0
#endif
#ifndef DBG_CMP_ATT
#define DBG_CMP_ATT 0
#endif
#ifndef DBG_REP
#define DBG_REP -1
#endif
#ifndef DBG_PROBE
#define DBG_PROBE 0
#endif
constexpr int N_PHASES = 14;

constexpr int BATCH = 2, SEQ = 8192, D = 1024, T = BATCH * SEQ;
constexpr int NH = 8, HD = 64, AW = 512, IDXH = 8, IDXD = 64, TOPK = 256;
constexpr int NIN = 5704, NINP = 5888;
constexpr int NEXP = 32, DEXP = 512;
constexpr int XPROWS = 40960;
constexpr float EPS = 1e-6f;
constexpr float LOG2E = 1.4426950408889634f;
constexpr float C2 = 0.125f * LOG2E;

constexpr size_t MiB = 1u << 20;
constexpr size_t WS_CTL = 0, CTL_ZERO_BYTES = 1 * MiB;
constexpr size_t WS_SMALL = 1 * MiB;
constexpr size_t SM_MOD = WS_SMALL + 0;
constexpr size_t SM_WRT = WS_SMALL + 65536;
constexpr size_t SM_EID = WS_SMALL + 262144;
constexpr size_t SM_EWT = WS_SMALL + 393216;
constexpr size_t SM_SLOT = WS_SMALL + 524288;
constexpr size_t SM_AT = WS_SMALL + 655360;
constexpr size_t WS_WIN = 3 * MiB;
constexpr size_t WS_WA = 15 * MiB, WS_WC = 16 * MiB, WS_WOUT = 17 * MiB;
constexpr size_t WS_H1 = 19 * MiB;
constexpr size_t WS_AC = 19 * MiB, WS_ATT = 35 * MiB;
constexpr size_t WS_Q = 51 * MiB, WS_K = 67 * MiB, WS_V = 83 * MiB, WS_MASK = 83 * MiB, WS_VT = 99 * MiB, WS_QI = 115 * MiB, WS_KI = 131 * MiB;
constexpr size_t WS_WI = 133 * MiB, WS_QL = 133 * MiB + 524288;
constexpr size_t WS_CB = 136 * MiB, WS_U = 152 * MiB, WS_TMPC = 136 * MiB, WS_G = 168 * MiB;
constexpr size_t WS_MERGED = 51 * MiB;
constexpr size_t WS_WGU = 51 * MiB, WS_WD = 115 * MiB;
constexpr size_t WS_HID = 147 * MiB;
constexpr size_t WS_Y = 187 * MiB;
constexpr size_t WS_END = DBG_CMP_ATT ? 300 * MiB : 267 * MiB;
constexpr size_t WS_MASK_DBG = 268 * MiB, WS_ATT2 = 284 * MiB;
constexpr int CW_CMP = 2048;
constexpr int CW_TMO = 0, CW_CODE = 1, CW_KMAX = 64, CW_ECNT = 1024  , CW_BAR = 4096, CW_AROW = 131072  ;

constexpr int RING_OFF = 0, RING_BYTES = 131072;
constexpr int LDSCTL_OFF = RING_BYTES, MISC_OFF = LDSCTL_OFF + 320;
constexpr int LDS_BYTES = 147456;

#define GAS __attribute__((address_space(1)))
#define LAS __attribute__((address_space(3)))
typedef unsigned short bf16;
typedef unsigned v4u __attribute__((ext_vector_type(4)));
typedef unsigned v2u __attribute__((ext_vector_type(2)));
typedef float f32x4 __attribute__((ext_vector_type(4)));
typedef short bf16x8 __attribute__((ext_vector_type(8)));
typedef GAS unsigned gu32;
#define RLX_AGENT __ATOMIC_RELAXED, __HIP_MEMORY_SCOPE_AGENT
#define LDS_WAIT() asm volatile("s_waitcnt lgkmcnt(0)" ::: "memory")
#define VM_WAIT() asm volatile("s_waitcnt vmcnt(0)" ::: "memory")
__device__ __forceinline__ unsigned f2bf(float f) { unsigned u = __builtin_bit_cast(unsigned, f); return (u + 0x7fffu + ((u >> 16) & 1u)) >> 16; }
__device__ __forceinline__ unsigned pk2(float lo, float hi) { return f2bf(lo) | (f2bf(hi) << 16); }
__device__ __forceinline__ float bflo(unsigned u) { return __builtin_bit_cast(float, u << 16); }
__device__ __forceinline__ float bfhi(unsigned u) { return __builtin_bit_cast(float, u & 0xffff0000u); }
__device__ __forceinline__ float bf1(bf16 h) { return __builtin_bit_cast(float, (unsigned)h << 16); }
__device__ __forceinline__ float wave_sum(float v) {
#pragma unroll
    for (int o = 1; o < 64; o <<= 1) v += __shfl_xor(v, o);
    return v;
}
#define DPP_F(v, ctrl, row_mask) __builtin_bit_cast(float, __builtin_amdgcn_update_dpp(0, __builtin_bit_cast(int, (v)), (ctrl), (row_mask), 0xf, false))
__device__ __forceinline__ float wave_sum63(float v) {
    v += DPP_F(v, 0x111, 0xf); v += DPP_F(v, 0x112, 0xf); v += DPP_F(v, 0x114, 0xf); v += DPP_F(v, 0x118, 0xf);
    v += DPP_F(v, 0x142, 0xa);
    v += DPP_F(v, 0x143, 0xc);
    return v;
}
__device__ __forceinline__ float wave_sum_all(float v) { return __builtin_bit_cast(float, __builtin_amdgcn_readlane(__builtin_bit_cast(int, wave_sum63(v)), 63)); }
__device__ __forceinline__ float wave_max(float v) {
#pragma unroll
    for (int o = 1; o < 64; o <<= 1) v = fmaxf(v, __shfl_xor(v, o));
    return v;
}

#define XB_TMO      128
#define XB_XCNT(j)  (256  + 64 * (j))
#define XB_XSUB(j)  (1280 + 64 * (j))
#define XB_XGEN(j)  (2304 + 64 * (j))
#define XB_TOP      3328
#define XB_TOPGEN   3392
#define XCD_BAR_WORDS 3456
#define XB_SPIN_CAP (1u << 18)

__device__ __forceinline__ unsigned xb_ld(unsigned* p)              { return __hip_atomic_load(p, __ATOMIC_RELAXED, __HIP_MEMORY_SCOPE_AGENT); }
__device__ __forceinline__ unsigned xb_add(unsigned* p, unsigned v) { return __hip_atomic_fetch_add(p, v, __ATOMIC_RELAXED, __HIP_MEMORY_SCOPE_AGENT); }
__device__ __forceinline__ unsigned xb_xcc_id() { return (unsigned)__builtin_amdgcn_s_getreg((3 << 11) | 20) & 0xFu; }
#define XB_SPIN(cond, bar) do { unsigned _sp = 0; while (cond) { __builtin_amdgcn_s_sleep(1); \
    if ((++_sp & 255u) == 0u) { if (xb_ld(&(bar)[XB_TMO])) break; if (_sp > XB_SPIN_CAP) { atomicAdd(&(bar)[XB_TMO], 1u); break; } } } } while (0)

struct XcdBarrier { unsigned* bar; unsigned x; volatile LAS unsigned* st; };

__device__ __forceinline__ XcdBarrier xcd_barrier_post(unsigned* bar, volatile LAS unsigned* st) {
    XcdBarrier b; b.bar = bar; b.x = xb_xcc_id(); b.st = st;
    if (threadIdx.x == 0) (void)xb_add(&bar[XB_XCNT(b.x)], 1u);
    return b;
}
__device__ __forceinline__ void xcd_barrier_complete(unsigned* bar, unsigned x, unsigned& nloc, unsigned& nx) {
    const unsigned G = gridDim.x * gridDim.y * gridDim.z;
    unsigned sum, cnt, mine, sp = 0u;
    for (;;) {
        sum = 0u; cnt = 0u; mine = 0u;
#pragma unroll
        for (unsigned j = 0; j < 16; ++j) { const unsigned c = xb_ld(&bar[XB_XCNT(j)]); sum += c; cnt += (c > 0u) ? 1u : 0u; mine = (j == x) ? c : mine; }
        if (sum == G) break;
        __builtin_amdgcn_s_sleep(1);
        if ((++sp & 255u) == 0u) { if (xb_ld(&bar[XB_TMO])) break; if (sp > XB_SPIN_CAP) { atomicAdd(&bar[XB_TMO], 1u); break; } }
    }
    nloc = mine > 0u ? mine : 1u; nx = cnt > 0u ? cnt : 1u;
}
__device__ __forceinline__ void xcd_barrier(const XcdBarrier& b) {
    asm volatile("s_waitcnt vmcnt(0)" ::: "memory");
    __syncthreads();
    if (threadIdx.x == 0) {
        unsigned* bar = b.bar;
        __builtin_amdgcn_s_waitcnt(0);
        unsigned nloc = b.st[0], nx = b.st[1];
        if (nloc == 0u) { xcd_barrier_complete(bar, b.x, nloc, nx); b.st[0] = nloc; b.st[1] = nx; }
        const unsigned old = xb_add(&bar[XB_XSUB(b.x)], 1u);
        const unsigned gen = old / nloc;
        if (old + 1u == (gen + 1u) * nloc) {
            __builtin_amdgcn_fence(__ATOMIC_RELEASE, "agent");
            asm volatile("s_waitcnt vmcnt(0)" ::: "memory");
            const unsigned og = xb_add(&bar[XB_TOP], 1u);
            const unsigned tg = og / nx;
            if (og + 1u == (tg + 1u) * nx) xb_add(&bar[XB_TOPGEN], 1u);
            else XB_SPIN(xb_ld(&bar[XB_TOPGEN]) == tg, bar);
            __builtin_amdgcn_fence(__ATOMIC_ACQUIRE, "agent");
            xb_add(&bar[XB_XGEN(b.x)], 1u);
            asm volatile("s_waitcnt vmcnt(0)" ::: "memory");
        } else {
            XB_SPIN(xb_ld(&bar[XB_XGEN(b.x)]) == gen, bar);
            __builtin_amdgcn_fence(__ATOMIC_ACQUIRE, "agent");
            asm volatile("s_waitcnt vmcnt(0)" ::: "memory");
        }
    }
    __syncthreads();
}

struct Frame {
    LAS unsigned char* lds;
    volatile LAS unsigned* MISC;
    gu32* ctl;
    unsigned char* ws;
    int tid, lane, wave;
    int vcu, G;
    const float *x, *c, *w_ada, *b_ada, *norm1_g, *w_in, *rel_bias, *conv_w, *w_attn, *w_conv, *w_out, *norm2_g, *wrg, *brg, *wre, *bre, *w_gate_e, *w_up_e, *w_down_e, *norm_f_g;
    float* out;
};
#define WSP(T_, off) ((T_*)(F.ws + (off)))

template <class RowMap>
__device__ __forceinline__ void transpose_item(const float* W, int K, int N, bf16* WT, LAS float* scr, int item, int lane, RowMap rm) {
    const int nblk = (N + 31) / 32, kb = item / nblk, nb = item % nblk, k0 = 64 * kb, n0 = 32 * nb;
    const int nn = n0 + (lane & 31);
#pragma unroll 8
    for (int i = 0; i < 32; ++i) { const int kk = 2 * i + (lane >> 5); scr[kk * 33 + (lane & 31)] = (nn < N) ? W[(size_t)(k0 + kk) * N + nn] : 0.f; }
    LDS_WAIT(); asm volatile("" ::: "memory");
    const int c = lane & 7;
#pragma unroll
    for (int j = 0; j < 4; ++j) { const int n = (lane >> 3) + 8 * j; const LAS float* s = scr + (8 * c) * 33 + n;
        v4u o; o.x = pk2(s[0 * 33], s[1 * 33]); o.y = pk2(s[2 * 33], s[3 * 33]); o.z = pk2(s[4 * 33], s[5 * 33]); o.w = pk2(s[6 * 33], s[7 * 33]);
        if (n0 + n < N) *(GAS v4u*)(WT + (size_t)rm(n0 + n) * K + k0 + 8 * c) = o; }
    LDS_WAIT(); asm volatile("" ::: "memory");
}
struct RmId { __device__ __forceinline__ int operator()(int n) const { return n; } };
struct RmWin { __device__ __forceinline__ int operator()(int n) const {
    if (n < 2120) return n;
    if (n < 2632) return n + 184;
    if (n < 3144) { const int j = n - 2632; return 2816 + 256 * (j >> 7) + (j & 127); }
    if (n < 3656) { const int j = n - 3144; return 2816 + 256 * (j >> 7) + 128 + (j & 127); }
    return n + 184; } };
struct RmGU { int half; __device__ __forceinline__ int operator()(int n) const { return 256 * (n >> 7) + 128 * half + (n & 127); } };

__device__ __forceinline__ void p0_prologue(Frame& F) {
    LAS float* scr = (LAS float*)(F.lds + RING_OFF + F.wave * 16384);
    const int gw = F.vcu * NWAVES + F.wave, NGW = F.G * NWAVES;
    if (F.vcu < 96) {
        const int n = F.vcu * 64 + F.lane; float a0 = 0.f, a1 = 0.f;
        LAS float* cact = (LAS float*)(F.lds + RING_OFF + 16384);
        for (int i = F.tid; i < 2 * D; i += 512) { const float cv = F.c[i]; cact[i] = cv / (1.f + __expf(-cv)); }
        __syncthreads();
#pragma unroll 16
        for (int k = F.wave * 128; k < F.wave * 128 + 128; ++k) {
            const float w = F.w_ada[(size_t)k * 6144 + n];
            a0 += cact[k] * w; a1 += cact[D + k] * w;
        }
        LAS float* red = (LAS float*)(F.lds + RING_OFF + 8448);
        red[(F.wave * 2 + 0) * 64 + F.lane] = a0; red[(F.wave * 2 + 1) * 64 + F.lane] = a1;
        __syncthreads();
        if (F.wave < 2) { float s = F.b_ada[n];
#pragma unroll
            for (int w = 0; w < 8; ++w) s += red[(w * 2 + F.wave) * 64 + F.lane];
            WSP(float, SM_MOD)[F.wave * 6144 + n] = s; }
        __syncthreads();
    }
    constexpr int I_IN = 16 * 179, I_A = 8 * 32, I_C = 8 * 32, I_O = 16 * 32;
    constexpr int NITEMS = I_IN + I_A + I_C + I_O;
    for (int it = gw; it < NITEMS; it += NGW) {
        int r = it;
        if (r < I_IN) { transpose_item(F.w_in, D, NIN, WSP(bf16, WS_WIN), scr, r, F.lane, RmWin()); continue; } r -= I_IN;
        if (r < I_A) { transpose_item(F.w_attn, AW, D, WSP(bf16, WS_WA), scr, r, F.lane, RmId()); continue; } r -= I_A;
        if (r < I_C) { transpose_item(F.w_conv, AW, D, WSP(bf16, WS_WC), scr, r, F.lane, RmId()); continue; } r -= I_C;
        transpose_item(F.w_out, D, D, WSP(bf16, WS_WOUT), scr, r, F.lane, RmId());
    }
    for (int i = gw * 64 + F.lane; i < 184 * 128; i += NGW * 64) { *(GAS v4u*)(WSP(bf16, WS_WIN) + (size_t)2120 * D + (size_t)i * 8) = (v4u){0u, 0u, 0u, 0u}; }
    for (int i = gw * 64 + F.lane; i < 36 * D; i += NGW * 64) { const int n = i / D, k = i % D; WSP(float, SM_WRT)[i] = (n < 4) ? F.wrg[k * 4 + n] : F.wre[k * 32 + (n - 4)]; }
}

__device__ __forceinline__ void p1_norm1(Frame& F) {
    const int gw = F.vcu * NWAVES + F.wave, NGW = F.G * NWAVES;
    const float* mod = WSP(float, SM_MOD);
    for (int m0 = gw * 4; m0 < T; m0 += NGW * 4) {
        const int b = m0 / SEQ;
        f32x4 v[4][4]; float ss[4];
#pragma unroll
        for (int r = 0; r < 4; ++r) { const GAS f32x4* xr = (const GAS f32x4*)(F.x + (size_t)(m0 + r) * D) + F.lane;
#pragma unroll
            for (int j = 0; j < 4; ++j) v[r][j] = xr[64 * j]; }
#pragma unroll
        for (int r = 0; r < 4; ++r) { float s = 0.f;
#pragma unroll
            for (int j = 0; j < 4; ++j) s += (v[r][j].x * v[r][j].x + v[r][j].y * v[r][j].y) + (v[r][j].z * v[r][j].z + v[r][j].w * v[r][j].w);
            ss[r] = 1.f / sqrtf(wave_sum_all(s) * (1.f / D) + EPS); }
#pragma unroll
        for (int j = 0; j < 4; ++j) { const int k = 4 * F.lane + 256 * j;
            const f32x4 g = *(const f32x4*)(F.norm1_g + k), sc = *(const f32x4*)(mod + b * 6144 + 1024 + k), sh = *(const f32x4*)(mod + b * 6144 + k);
            const f32x4 ca = g * (sc + 1.0f);
#pragma unroll
            for (int r = 0; r < 4; ++r) { const f32x4 h = v[r][j] * ss[r] * ca + sh; ((GAS v2u*)(WSP(bf16, WS_H1) + (size_t)(m0 + r) * D) + F.lane)[64 * j] = (v2u){pk2(h.x, h.y), pk2(h.z, h.w)}; } }
    }
}

using pg8::Unit;
typedef float f32x2_t __attribute__((ext_vector_type(2))); typedef __bf16 bf16x2_t __attribute__((ext_vector_type(2)));
__device__ __forceinline__ unsigned cvtpk(float lo, float hi) { f32x2_t v = {lo, hi}; bf16x2_t b = __builtin_convertvector(v, bf16x2_t); return __builtin_bit_cast(unsigned, b); }
__device__ __forceinline__ v4u pack8(const f32x4 a, const f32x4 b) { v4u w; w.x = cvtpk(a[0], a[1]); w.y = cvtpk(a[2], a[3]); w.z = cvtpk(b[0], b[1]); w.w = cvtpk(b[2], b[3]); return w; }
__device__ __forceinline__ float sigmoidf_(float x) { return __builtin_amdgcn_rcpf(1.f + __builtin_amdgcn_exp2f(-x * LOG2E)); }
__device__ __forceinline__ f32x4 sig4(f32x4 v) { return (f32x4){sigmoidf_(v[0]), sigmoidf_(v[1]), sigmoidf_(v[2]), sigmoidf_(v[3])}; }
__device__ __forceinline__ void unpack8(const v4u w, f32x4& a, f32x4& b) { a = (f32x4){bflo(w.x), bfhi(w.x), bflo(w.y), bfhi(w.y)}; b = (f32x4){bflo(w.z), bfhi(w.z), bflo(w.w), bfhi(w.w)}; }

struct EpiProj {
    static constexpr bool PERM = true, AFTER_DRAIN = false;
    bf16 *Q, *K, *V, *QI, *KI, *CB, *U, *G; float* WI;
    __device__ __forceinline__ void operator()(const f32x4 (&acc)[2][2][4][2], const Unit& u, int wr, int wc, int fr, int fq) const {
        const int pn = u.pn, row0 = u.pm * 256 + wr * 64 + fr, cb8 = wc * 32 + 8 * fq;
        if (pn < 8 || pn == 9 || pn == 10) {
            bf16* base; int coff; float sc = 1.f;
            if (pn < 2) { base = Q; coff = 256 * pn; sc = C2; } else if (pn < 4) { base = K; coff = 256 * (pn - 2); } else if (pn < 6) { base = V; coff = 256 * (pn - 4); }
            else if (pn < 8) { base = QI; coff = 256 * (pn - 6); } else { base = CB; coff = 256 * (pn - 9); }
#pragma unroll
            for (int ai = 0; ai < 2; ++ai)
#pragma unroll
                for (int m = 0; m < 4; ++m) { bf16* rowp = base + (size_t)(row0 + ai * 128 + m * 16) * 512 + coff + cb8;
#pragma unroll
                    for (int bj = 0; bj < 2; ++bj) *(v4u*)(rowp + bj * 128) = pack8(acc[ai][bj][m][0] * sc, acc[ai][bj][m][1] * sc); }
        } else if (pn == 8) {
#pragma unroll
            for (int ai = 0; ai < 2; ++ai)
#pragma unroll
                for (int m = 0; m < 4; ++m) { const size_t row = (size_t)(row0 + ai * 128 + m * 16);
                    if (wc < 2) *(v4u*)(KI + row * 64 + cb8) = pack8(acc[ai][0][m][0], acc[ai][0][m][1]);
                    else if (wc == 2 && fq == 0) { *(f32x4*)(WI + row * 8) = acc[ai][0][m][0]; *(f32x4*)(WI + row * 8 + 4) = acc[ai][0][m][1]; } }
        } else if (pn < 15) {
#pragma unroll
            for (int ai = 0; ai < 2; ++ai)
#pragma unroll
                for (int m = 0; m < 4; ++m) { const size_t row = (size_t)(row0 + ai * 128 + m * 16);
                    *(v4u*)(U + row * 512 + 128 * (pn - 11) + cb8) = pack8(acc[ai][0][m][0] * acc[ai][1][m][0], acc[ai][0][m][1] * acc[ai][1][m][1]); }
        } else {
#pragma unroll
            for (int ai = 0; ai < 2; ++ai)
#pragma unroll
                for (int m = 0; m < 4; ++m) { bf16* rowp = G + (size_t)(row0 + ai * 128 + m * 16) * 2048 + 256 * (pn - 15) + cb8;
#pragma unroll
                    for (int bj = 0; bj < 2; ++bj) *(v4u*)(rowp + bj * 128) = pack8(sig4(acc[ai][bj][m][0]), sig4(acc[ai][bj][m][1])); }
        }
    }
};
struct EpiConv {
    static constexpr bool PERM = true, AFTER_DRAIN = false;
    const bf16* G; bf16* O;
    __device__ __forceinline__ void operator()(const f32x4 (&acc)[2][2][4][2], const Unit& u, int wr, int wc, int fr, int fq) const {
        const int row0 = u.pm * 256 + wr * 64 + fr, col0 = u.pn * 256 + wc * 32 + 8 * fq;
#pragma unroll
        for (int ai = 0; ai < 2; ++ai)
#pragma unroll
            for (int m = 0; m < 4; ++m) { const size_t row = (size_t)(row0 + ai * 128 + m * 16);
#pragma unroll
                for (int bj = 0; bj < 2; ++bj) { f32x4 g0, g1; unpack8(*(const v4u*)(G + row * 2048 + 1024 + col0 + bj * 128), g0, g1);
                    *(v4u*)(O + row * 1024 + col0 + bj * 128) = pack8(g0 * acc[ai][bj][m][0], g1 * acc[ai][bj][m][1]); } }
    }
};
struct EpiAttn {
    static constexpr bool PERM = true, AFTER_DRAIN = false;
    const bf16* G; const bf16* Tc; bf16* O;
    __device__ __forceinline__ void operator()(const f32x4 (&acc)[2][2][4][2], const Unit& u, int wr, int wc, int fr, int fq) const {
        const int row0 = u.pm * 256 + wr * 64 + fr, col0 = u.pn * 256 + wc * 32 + 8 * fq;
#pragma unroll
        for (int ai = 0; ai < 2; ++ai)
#pragma unroll
            for (int m = 0; m < 4; ++m) { const size_t row = (size_t)(row0 + ai * 128 + m * 16);
#pragma unroll
                for (int bj = 0; bj < 2; ++bj) { f32x4 g0, g1, t0, t1; unpack8(*(const v4u*)(G + row * 2048 + col0 + bj * 128), g0, g1); unpack8(*(const v4u*)(Tc + row * 1024 + col0 + bj * 128), t0, t1);
                    *(v4u*)(O + row * 1024 + col0 + bj * 128) = pack8(g0 * acc[ai][bj][m][0] + t0, g1 * acc[ai][bj][m][1] + t1); } }
    }
};
struct EpiOut {
    static constexpr bool PERM = false, AFTER_DRAIN = false;
    const float* X; const float* mod; float* O;
    __device__ __forceinline__ void operator()(const f32x4 (&acc)[2][2][4][2], const Unit& u, int wr, int wc, int fr, int fq) const {
        const int row0 = u.pm * 256 + wr * 64 + fr, col0 = u.pn * 256 + wc * 32 + 4 * fq;
        const float* g1 = mod + ((u.pm * 256) / SEQ) * 6144 + 2048;
#pragma unroll
        for (int bj = 0; bj < 2; ++bj)
#pragma unroll
            for (int n = 0; n < 2; ++n) { const int col = col0 + bj * 128 + n * 16; const f32x4 gv = *(const f32x4*)(g1 + col);
#pragma unroll
                for (int ai = 0; ai < 2; ++ai)
#pragma unroll
                    for (int m = 0; m < 4; ++m) { const size_t off = (size_t)(row0 + ai * 128 + m * 16) * D + col;
                        *(f32x4*)(O + off) = *(const f32x4*)(X + off) + gv * acc[ai][bj][m][n]; } }
    }
};
__device__ __forceinline__ f32x4 silu_mul4(f32x4 g, f32x4 u) { return (f32x4){g[0] * sigmoidf_(g[0]) * u[0], g[1] * sigmoidf_(g[1]) * u[1], g[2] * sigmoidf_(g[2]) * u[2], g[3] * sigmoidf_(g[3]) * u[3]}; }
struct EpiHid {
    static constexpr bool PERM = true, AFTER_DRAIN = false;
    bf16* O;
    __device__ __forceinline__ void operator()(const f32x4 (&acc)[2][2][4][2], const Unit& u, int wr, int wc, int fr, int fq) const {
        const int row0 = u.pm * 256 + wr * 64 + fr, col0 = 128 * (u.pn & 3) + wc * 32 + 8 * fq;
#pragma unroll
        for (int ai = 0; ai < 2; ++ai)
#pragma unroll
            for (int m = 0; m < 4; ++m) { const size_t row = (size_t)(row0 + ai * 128 + m * 16);
                *(v4u*)(O + row * 512 + col0) = pack8(silu_mul4(acc[ai][0][m][0], acc[ai][1][m][0]), silu_mul4(acc[ai][0][m][1], acc[ai][1][m][1])); }
    }
};
struct EpiY {
    static constexpr bool PERM = true, AFTER_DRAIN = false;
    bf16* O;
    __device__ __forceinline__ void operator()(const f32x4 (&acc)[2][2][4][2], const Unit& u, int wr, int wc, int fr, int fq) const {
        const int row0 = u.pm * 256 + wr * 64 + fr, col0 = 256 * (u.pn & 3) + wc * 32 + 8 * fq;
#pragma unroll
        for (int ai = 0; ai < 2; ++ai)
#pragma unroll
            for (int m = 0; m < 4; ++m) { const size_t row = (size_t)(row0 + ai * 128 + m * 16);
#pragma unroll
                for (int bj = 0; bj < 2; ++bj) *(v4u*)(O + row * 1024 + col0 + bj * 128) = pack8(acc[ai][bj][m][0], acc[ai][bj][m][1]); }
    }
};
struct MoeOrder {
    const LAS int* tile_e; int ntiles, G, c;
    __device__ __forceinline__ bool next(int i, Unit& u) const {
        const int L = i * G + c; if (L >= ntiles * 4) return false;
        const int rt = L >> 2, j = L & 3; u.pm = rt; u.pn = 4 * tile_e[rt] + j; return true; }
    __device__ __forceinline__ void a_ready(const Unit&) const {}
    __device__ __forceinline__ void done(const Unit&) const {}
};

__device__ __forceinline__ void p3_prep(Frame& F) {
    const int gw = F.vcu * NWAVES + F.wave, NGW = F.G * NWAVES;
    {
        LAS bf16* tl = (LAS bf16*)(F.lds + RING_OFF + F.wave * 16384);
        const bf16* V = WSP(bf16, WS_V); bf16* VT = WSP(bf16, WS_VT);
        for (int it = gw; it < BATCH * NH * (SEQ / 64); it += NGW) {
            const int kt = it % (SEQ / 64), h = (it / (SEQ / 64)) % NH, b = it / (NH * (SEQ / 64));
            const bf16* src = V + (size_t)(b * SEQ + kt * 64 + F.lane) * 512 + h * 64;
#pragma unroll
            for (int c = 0; c < 8; ++c) { const v4u w = *(const v4u*)(src + c * 8);
                LAS unsigned* d = (LAS unsigned*)(tl + F.lane * 66 + c * 8); d[0] = w.x; d[1] = w.y; d[2] = w.z; d[3] = w.w; }
            LDS_WAIT(); asm volatile("" ::: "memory");
            unsigned o[32];
#pragma unroll
            for (int p = 0; p < 64; p += 2) {
                const int i0 = p & 15, i1 = (p + 1) & 15, g = p & ~15;
                const int k0 = g + ((i0 < 4 || i0 >= 12) ? i0 : (i0 < 8 ? i0 + 4 : i0 - 4)), k1 = g + ((i1 < 4 || i1 >= 12) ? i1 : (i1 < 8 ? i1 + 4 : i1 - 4));
                o[p >> 1] = (unsigned)tl[k0 * 66 + F.lane] | ((unsigned)tl[k1 * 66 + F.lane] << 16); }
            bf16* dst = VT + ((size_t)((b * NH + h) * 64 + F.lane)) * SEQ + kt * 64;
#pragma unroll
            for (int c = 0; c < 8; ++c) *(v4u*)(dst + c * 8) = (v4u){o[4 * c], o[4 * c + 1], o[4 * c + 2], o[4 * c + 3]};
            LDS_WAIT(); asm volatile("" ::: "memory");
        }
    }
    {
        const bf16* CB = WSP(bf16, WS_CB); const bf16* U = WSP(bf16, WS_U); bf16* AC = WSP(bf16, WS_AC);
        for (int i = (gw * 64 + F.lane); i < T * 64; i += NGW * 64) {
            const int t = i >> 6, j = (i & 63) * 8, tt = t % SEQ;
            f32x4 c0, c1, u0, u1, a0, a1;
            unpack8(*(const v4u*)(CB + (size_t)t * 512 + j), c0, c1);
            unpack8(*(const v4u*)(U + (size_t)t * 512 + j), u0, u1);
            a0 = u0 * *(const f32x4*)(F.conv_w + 1024 + j); a1 = u1 * *(const f32x4*)(F.conv_w + 1024 + j + 4);
            if (tt >= 1) { unpack8(*(const v4u*)(U + (size_t)(t - 1) * 512 + j), u0, u1); a0 += u0 * *(const f32x4*)(F.conv_w + 512 + j); a1 += u1 * *(const f32x4*)(F.conv_w + 512 + j + 4); }
            if (tt >= 2) { unpack8(*(const v4u*)(U + (size_t)(t - 2) * 512 + j), u0, u1); a0 += u0 * *(const f32x4*)(F.conv_w + j); a1 += u1 * *(const f32x4*)(F.conv_w + j + 4); }
            *(v4u*)(AC + (size_t)t * 512 + j) = pack8(c0 * a0, c1 * a1);
        }
    }
    {
        const bf16* QI = WSP(bf16, WS_QI); const float* WI = WSP(float, WS_WI); bf16* QL = WSP(bf16, WS_QL); float* AT = WSP(float, SM_AT);
        for (int t = gw; t < T; t += NGW) {
            float ql = 0.f, a = 0.f; float vv[8], ww[8];
#pragma unroll
            for (int h = 0; h < 8; ++h) { ww[h] = WI[(size_t)t * 8 + h]; vv[h] = bf1(QI[(size_t)t * 512 + h * 64 + F.lane]); }
#pragma unroll
            for (int h = 0; h < 8; ++h) { ql += ww[h] * vv[h]; a += fabsf(ww[h]) * sqrtf(wave_sum63(vv[h] * vv[h])); }
            QL[(size_t)t * 64 + F.lane] = (bf16)f2bf(ql);
            if (F.lane == 63) AT[t] = a;
        }
    }
    {
        const bf16* KI = WSP(bf16, WS_KI); float mx = 0.f;
        for (int s = gw * 64 + F.lane; s < T; s += NGW * 64) { float q = 0.f;
#pragma unroll
            for (int c = 0; c < 8; ++c) { f32x4 a, b; unpack8(*(const v4u*)(KI + (size_t)s * 64 + c * 8), a, b); q += (a[0] * a[0] + a[1] * a[1]) + (a[2] * a[2] + a[3] * a[3]) + (b[0] * b[0] + b[1] * b[1]) + (b[2] * b[2] + b[3] * b[3]); }
            mx = fmaxf(mx, q); }
        mx = wave_max(mx);
        if (F.lane == 0) atomicMax((unsigned*)(F.ctl + CW_KMAX), __builtin_bit_cast(unsigned, sqrtf(mx)));
    }
}

__device__ __forceinline__ unsigned ord_key(float x) { if (x == 0.f) x = 0.f; const unsigned u = __builtin_bit_cast(unsigned, x); return (u & 0x80000000u) ? ~u : (u | 0x80000000u); }
__device__ __forceinline__ int t5_bucket(int n) {
    if (n < 16) return n;
    const int v = 16 + (int)(logf((float)n / 16.f) / 2.0794415416798357f * 16.f);
    return v < 31 ? v : 31;
}
__device__ __forceinline__ void pn_naive_dsa(Frame& F) {
    LAS float* sc = (LAS float*)(F.lds + RING_OFF);
    LAS float* qf = (LAS float*)(F.lds + RING_OFF + 32768);
    LAS float* wq = qf + 512;
    LAS unsigned* hist = (LAS unsigned*)(F.lds + RING_OFF + 36864);
    LAS int* sel = (LAS int*)(F.lds + RING_OFF + 40960);
    LAS float* pbuf = (LAS float*)(F.lds + RING_OFF + 45056);
    LAS int* wcnt = (LAS int*)(F.lds + RING_OFF + 53248);
    LAS int* bkt = (LAS int*)(F.lds + RING_OFF + 53248 + 256);
    const bf16* QI = WSP(bf16, WS_QI); const bf16* KI = WSP(bf16, WS_KI); const float* WI = WSP(float, WS_WI);
    const bf16* Qb = WSP(bf16, WS_Q); const bf16* Kb = WSP(bf16, WS_K); const bf16* Vb = WSP(bf16, WS_V); bf16* ATT = WSP(bf16, WS_ATT);
    if (F.tid < 128) bkt[F.tid] = t5_bucket(F.tid);
    __syncthreads();
    for (int qi_ = 0; qi_ < T / F.G + 1; ++qi_) {
        const int qidx = qi_ * F.G + F.vcu; if (qidx >= T) break;
        const int b = qidx / SEQ, t = qidx % SEQ, n = t + 1;
        qf[F.tid] = bf1(QI[(size_t)qidx * 512 + F.tid]);
        if (F.tid < 8) wq[F.tid] = WI[(size_t)qidx * 8 + F.tid];
        __syncthreads();
        for (int s = F.tid; s < n; s += 512) {
            float kf[64]; const bf16* kr = KI + (size_t)(b * SEQ + s) * 64;
#pragma unroll
            for (int c = 0; c < 8; ++c) { f32x4 a, bb; unpack8(*(const v4u*)(kr + c * 8), a, bb); kf[8 * c] = a[0]; kf[8 * c + 1] = a[1]; kf[8 * c + 2] = a[2]; kf[8 * c + 3] = a[3]; kf[8 * c + 4] = bb[0]; kf[8 * c + 5] = bb[1]; kf[8 * c + 6] = bb[2]; kf[8 * c + 7] = bb[3]; }
            float score = 0.f;
#pragma unroll 1
            for (int h = 0; h < 8; ++h) { float dsum = 0.f;
#pragma unroll
                for (int d4 = 0; d4 < 16; ++d4) { const f32x4 q4 = *(const LAS f32x4*)(qf + h * 64 + d4 * 4); dsum += q4[0] * kf[4 * d4] + q4[1] * kf[4 * d4 + 1] + q4[2] * kf[4 * d4 + 2] + q4[3] * kf[4 * d4 + 3]; }
                score += wq[h] * fmaxf(dsum, 0.f); }
            sc[s] = score;
        }
        __syncthreads();
        unsigned prefix = 0u, pmask = 0u; int need = TOPK;
        if (n > TOPK) {
            for (int pass = 0; pass < 4; ++pass) {
                const int shift = 24 - 8 * pass;
                if (F.tid < 256) hist[F.tid] = 0u;
                __syncthreads();
                for (int s = F.tid; s < n; s += 512) { const unsigned u = ord_key(sc[s]); if ((u & pmask) == prefix) atomicAdd((unsigned*)&hist[(u >> shift) & 255u], 1u); }
                __syncthreads();
                if (F.wave == 0) {
                    int c4[4]; int tot = 0;
#pragma unroll
                    for (int j = 0; j < 4; ++j) { c4[j] = (int)hist[4 * F.lane + j]; tot += c4[j]; }
                    int incl = tot;
#pragma unroll
                    for (int o = 1; o < 64; o <<= 1) { const int v = __shfl_down(incl, o); if (F.lane + o < 64) incl += v; }
                    const int above = incl - tot;
                    if (above < need && need <= incl) { int run = above;
#pragma unroll
                        for (int j = 3; j >= 0; --j) { if (run < need && need <= run + c4[j]) { wcnt[16] = 4 * F.lane + j; wcnt[17] = need - run; } run += c4[j]; } }
                }
                __syncthreads();
                prefix |= (unsigned)wcnt[16] << shift; pmask |= 255u << shift; need = wcnt[17];
                __syncthreads();
            }
        }
        int cg = 0, ce = 0;
        for (int i = 0; i < 16; ++i) { const int s = F.wave * 1024 + i * 64 + F.lane; bool gt = false, eq = false;
            if (s < n) { if (n <= TOPK) gt = true; else { const unsigned u = ord_key(sc[s]); gt = u > prefix; eq = (u == prefix); } }
            cg += __popcll(__ballot(gt)); ce += __popcll(__ballot(eq)); }
        if (F.lane == 0) { wcnt[2 * F.wave] = cg; wcnt[2 * F.wave + 1] = ce; }
        __syncthreads();
        int eqb = 0, tkb = 0, nsel = 0;
        { int eq_before = 0;
          for (int w = 0; w < 8; ++w) { const int g = wcnt[2 * w], e = wcnt[2 * w + 1];
              int take_e = need - eq_before; take_e = take_e < 0 ? 0 : (take_e > e ? e : take_e); if (n <= TOPK) take_e = 0;
              if (w < F.wave) { eqb += e; tkb += g + take_e; }
              nsel += g + take_e; eq_before += e; } }
        for (int i = 0; i < 16; ++i) { const int s = F.wave * 1024 + i * 64 + F.lane; bool gt = false, eq = false;
            if (s < n) { if (n <= TOPK) gt = true; else { const unsigned u = ord_key(sc[s]); gt = u > prefix; eq = (u == prefix); } }
            const unsigned long long mg = __ballot(gt), me = __ballot(eq), lt = (1ull << F.lane) - 1ull;
            const int erank = eqb + __popcll(me & lt);
            const bool take = gt || (eq && erank < need);
            const unsigned long long mt = __ballot(take);
            if (take) sel[tkb + __popcll(mt & lt)] = s;
            eqb += __popcll(me); tkb += __popcll(mt); (void)mg; }
        __syncthreads();
        {
            const int h = F.wave;
            qf[F.tid] = bf1(Qb[(size_t)qidx * 512 + F.tid]);
            __syncthreads();
            float lg[4]; float mx = -INFINITY;
#pragma unroll
            for (int i = 0; i < 4; ++i) { const int j = F.lane + 64 * i; lg[i] = -INFINITY;
                if (j < nsel) { const int s = sel[j]; const bf16* kr = Kb + (size_t)(b * SEQ + s) * 512 + h * 64; float dsum = 0.f;
#pragma unroll
                    for (int c = 0; c < 8; ++c) { f32x4 a, bb; unpack8(*(const v4u*)(kr + c * 8), a, bb); const f32x4 q0 = *(const LAS f32x4*)(qf + h * 64 + c * 8), q1 = *(const LAS f32x4*)(qf + h * 64 + c * 8 + 4);
                        dsum += (q0[0] * a[0] + q0[1] * a[1]) + (q0[2] * a[2] + q0[3] * a[3]) + (q1[0] * bb[0] + q1[1] * bb[1]) + (q1[2] * bb[2] + q1[3] * bb[3]); }
                    const int dist = t - s; const int bk = dist < 128 ? bkt[dist] : 31;
                    lg[i] = dsum + F.rel_bias[bk * 8 + h] * LOG2E; mx = fmaxf(mx, lg[i]); } }
            mx = wave_max(mx); float sum = 0.f;
#pragma unroll
            for (int i = 0; i < 4; ++i) { const int j = F.lane + 64 * i; const float p = (j < nsel) ? __builtin_amdgcn_exp2f(lg[i] - mx) : 0.f; sum += p; pbuf[h * 256 + j] = p; }
            sum = wave_sum(sum);
            LDS_WAIT(); asm volatile("" ::: "memory");
            float o = 0.f;
            for (int j = 0; j < nsel; ++j) o += pbuf[h * 256 + j] * bf1(Vb[(size_t)(b * SEQ + sel[j]) * 512 + h * 64 + F.lane]);
            ATT[(size_t)qidx * 512 + h * 64 + F.lane] = (bf16)f2bf(o / sum);
        }
        __syncthreads();
    }
}


typedef float f32x16 __attribute__((ext_vector_type(16)));
#define MFMA32(a, b, c) __builtin_amdgcn_mfma_f32_32x32x16_bf16((a), (b), (c), 0, 0, 0)
__device__ __forceinline__ int crow(int r, int hi) { return (r & 3) + 8 * (r >> 2) + 4 * hi; }
constexpr int IDX_CTL = LDSCTL_OFF + 2048;

#define MFMA16(a, b, c) __builtin_amdgcn_mfma_f32_16x16x32_bf16((a), (b), (c), 0, 0, 0)
__device__ __forceinline__ void idx_tile(const bf16x8 (&kf)[4][2], const bf16x8 (&ql)[2], const bf16x8 (&qf)[8][2], const float (&w)[8], float invA, unsigned (&key)[4][4]) {
    float sc[4][4];
#define IDX_MF(D, QF0, QF1) _Pragma("unroll") for (int a = 0; a < 2; ++a) { D[a] = (f32x4){0.f, 0.f, 0.f, 0.f}; D[a] = MFMA16(kf[2 * hf + a][0], QF0, D[a]); D[a] = MFMA16(kf[2 * hf + a][1], QF1, D[a]); }
#define IDX_AC(D, W) _Pragma("unroll") for (int a = 0; a < 2; ++a) _Pragma("unroll") for (int i = 0; i < 4; ++i) { float x_ = __builtin_fmaf(W, __builtin_fabsf(D[a][i]), sc[2 * hf + a][i]); asm volatile("" : "+v"(x_)); sc[2 * hf + a][i] = x_; }
#pragma unroll
    for (int hf = 0; hf < 2; ++hf) {
        f32x4 dA[2], dB[2];
        IDX_MF(dA, ql[0], ql[1]);
        IDX_MF(dB, qf[0][0], qf[0][1]);
#pragma unroll
        for (int a = 0; a < 2; ++a)
#pragma unroll
            for (int i = 0; i < 4; ++i) { float x_ = dA[a][i]; asm volatile("" : "+v"(x_)); sc[2 * hf + a][i] = x_; }
        IDX_MF(dA, qf[1][0], qf[1][1]); IDX_AC(dB, w[0]);
        IDX_MF(dB, qf[2][0], qf[2][1]); IDX_AC(dA, w[1]);
        IDX_MF(dA, qf[3][0], qf[3][1]); IDX_AC(dB, w[2]);
        IDX_MF(dB, qf[4][0], qf[4][1]); IDX_AC(dA, w[3]);
        IDX_MF(dA, qf[5][0], qf[5][1]); IDX_AC(dB, w[4]);
        IDX_MF(dB, qf[6][0], qf[6][1]); IDX_AC(dA, w[5]);
        IDX_MF(dA, qf[7][0], qf[7][1]); IDX_AC(dB, w[6]);
        IDX_AC(dA, w[7]);
    }
#undef IDX_MF
#undef IDX_AC
#pragma unroll
    for (int a = 0; a < 4; ++a)
#pragma unroll
        for (int i = 0; i < 4; ++i) key[a][i] = __builtin_bit_cast(unsigned, __builtin_fmaf(sc[a][i], invA, 3.0f)) & 0x7ffffeu;
}
__device__ __forceinline__ void idx_load_k(bf16x8 (&kf)[4][2], const bf16* KItile  , unsigned voff  ) {
#pragma unroll
    for (int a = 0; a < 4; ++a)
#pragma unroll
        for (int ks = 0; ks < 2; ++ks) kf[a][ks] = *(const bf16x8*)((const char*)KItile + voff + a * 2048 + ks * 64);
}
template <int MODE>
__device__ __forceinline__ void idx_pass(Frame& F, int ln, const bf16* KIb, unsigned* MASKg, int t0, int nt_idx, int nt_att, const bf16x8 (&ql)[2], const bf16x8 (&qf)[8][2], const float (&w)[8], float invA, int b1, unsigned thr) {
    const int qc = ln & 15, fq = ln >> 4, qh = F.wave & 1, kp = F.wave >> 1, ql_ = 16 * qh + qc, t = t0 + ql_;
    LAS unsigned* hrow = (LAS unsigned*)(F.lds + RING_OFF) + ql_ * 1025;
    const int ntl = (MODE == 2) ? nt_att : nt_idx;
    bf16x8 kcur[4][2];
    const unsigned voff = (unsigned)(qc * 64 + fq * 8) * 2u;
#pragma unroll
    for (int a = 0; a < 4; ++a)
#pragma unroll
        for (int ks = 0; ks < 2; ++ks) kcur[a][ks] = (bf16x8){0, 0, 0, 0, 0, 0, 0, 0};
    if (kp < nt_idx) idx_load_k(kcur, KIb + (size_t)(64 * kp) * 64, voff);
    for (int kt = kp; kt < ntl; kt += 4) {
        unsigned m16 = 0u;
        if (kt < nt_idx) {
            unsigned key[4][4];
            const bool diag = 64 * kt + 63 > t0;
            idx_tile(kcur, ql, qf, w, invA, key);
            if (kt + 4 < nt_idx) idx_load_k(kcur, KIb + (size_t)(64 * (kt + 4)) * 64, voff);
#pragma unroll
            for (int a = 0; a < 4; ++a)
#pragma unroll
                for (int i = 0; i < 4; ++i) {
                    const int s = 64 * kt + 16 * a + 4 * fq + i; const bool valid = diag ? (s <= t) : true; const unsigned k23 = key[a][i];
                    if (MODE == 0) { const unsigned bin = k23 >> 12; __hip_atomic_fetch_add(hrow + (bin & 1023u), valid ? ((bin & 1024u) ? 65536u : 1u) : 0u, __ATOMIC_RELAXED, __HIP_MEMORY_SCOPE_WORKGROUP); }
                    else if (MODE == 1) { const unsigned bin = (k23 >> 1) & 2047u; __hip_atomic_fetch_add(hrow + (bin & 1023u), (valid && (int)(k23 >> 12) == b1) ? ((bin & 1024u) ? 65536u : 1u) : 0u, __ATOMIC_RELAXED, __HIP_MEMORY_SCOPE_WORKGROUP); }
                    else { if (valid && (k23 >> 1) >= thr) m16 |= 1u << (4 * a + i); }
                }
        }
        if (MODE == 2) {
            unsigned word = ((m16 & 0xFu) | ((m16 & 0xF0u) << 4) | ((m16 & 0xF00u) << 8) | ((m16 & 0xF000u) << 12)) << (4 * (fq >> 1));
            word |= (unsigned)__shfl_xor((int)word, 32);
            if (ln < 32) MASKg[(size_t)kt * 64 + fq * 32 + ql_] = word;
        }
    }
}
template <int LEVEL>
__device__ __forceinline__ void idx_scan(Frame& F) {
    LAS unsigned* hist = (LAS unsigned*)(F.lds + RING_OFF);
    LAS int* ctl = (LAS int*)(F.lds + IDX_CTL);
#pragma unroll 1
    for (int qi = 0; qi < 4; ++qi) {
        const int q = 4 * F.wave + qi;
        int need = (LEVEL == 0) ? TOPK : TOPK - ctl[32 + q];
        unsigned wv[16]; int toth = 0, totl = 0;
#pragma unroll
        for (int j = 0; j < 16; ++j) { wv[j] = hist[q * 1025 + 16 * F.lane + j]; toth += (int)(wv[j] >> 16); totl += (int)(wv[j] & 0xffffu); }
        int inclh = toth, incll = totl;
#pragma unroll
        for (int o = 1; o < 64; o <<= 1) { const int vh = __shfl_down(inclh, o), vl = __shfl_down(incll, o); if (F.lane + o < 64) { inclh += vh; incll += vl; } }
        const int allh = __shfl(inclh, 0);
        { const int above = inclh - toth;
          if (above < need && need <= inclh) { int run = above, B = 0, cab = 0; bool found = false;
#pragma unroll
              for (int j = 15; j >= 0; --j) { const int ch = (int)(wv[j] >> 16); if (!found && need <= run + ch) { found = true; B = 1024 + 16 * F.lane + j; cab = run; } run += ch; }
              if (LEVEL == 0) { ctl[q] = B; ctl[32 + q] = cab; } else ctl[64 + q] = (ctl[q] << 11) | B; } }
        { const int above = allh + incll - totl;
          if (allh < need && above < need && need <= allh + incll) { int run = above, B = 0, cab = 0; bool found = false;
#pragma unroll
              for (int j = 15; j >= 0; --j) { const int cl = (int)(wv[j] & 0xffffu); if (!found && need <= run + cl) { found = true; B = 16 * F.lane + j; cab = run; } run += cl; }
              if (LEVEL == 0) { ctl[q] = B; ctl[32 + q] = cab; } else ctl[64 + q] = (ctl[q] << 11) | B; } }
    }
}
__device__ __forceinline__ void p5_indexer(Frame& F, unsigned* MASK) {
    const bf16* QI = WSP(bf16, WS_QI); const bf16* KI = WSP(bf16, WS_KI); const float* WI = WSP(float, WS_WI); const bf16* QL = WSP(bf16, WS_QL); const float* AT = WSP(float, SM_AT);
    const float kmax = __builtin_bit_cast(float, __hip_atomic_load(F.ctl + CW_KMAX, RLX_AGENT));
    LAS int* ctl = (LAS int*)(F.lds + IDX_CTL);
    for (int p = F.vcu; p < 256; p += F.G) {
        const int b = p >> 7, j = p & 127;
#pragma unroll 1
        for (int side = 0; side < 2; ++side) {
            const int g = side ? j : 255 - j, t0 = 32 * g;
            const int nt_idx = (g + 2) >> 1, nt_att = 4 * (g >> 3) + 4;
            int ln = F.lane; asm volatile("" : "+v"(ln));
            const int qc = ln & 15, fq = ln >> 4, ql_ = 16 * (F.wave & 1) + qc;
            const size_t trow = (size_t)b * SEQ + t0 + ql_;
            bf16x8 qf[8][2], ql[2]; float w[8];
#pragma unroll
            for (int h = 0; h < 8; ++h)
#pragma unroll
                for (int ks = 0; ks < 2; ++ks) qf[h][ks] = *(const bf16x8*)(QI + trow * 512 + h * 64 + ks * 32 + fq * 8);
#pragma unroll
            for (int ks = 0; ks < 2; ++ks) ql[ks] = *(const bf16x8*)(QL + trow * 64 + ks * 32 + fq * 8);
            { const f32x4 w0 = *(const f32x4*)(WI + trow * 8), w1 = *(const f32x4*)(WI + trow * 8 + 4); w[0] = w0[0]; w[1] = w0[1]; w[2] = w0[2]; w[3] = w0[3]; w[4] = w1[0]; w[5] = w1[1]; w[6] = w1[2]; w[7] = w1[3]; }
            const float a2 = 2.0f * AT[trow] * kmax; const float invA = a2 > 0.f ? 0.99f / a2 : 0.f;
            const bf16* KIb = KI + (size_t)b * SEQ * 64;
            unsigned* MASKg = MASK + ((size_t)(b * 256 + g) * 128) * 64;
            for (int i = F.tid; i < 8200; i += 512) ((LAS v4u*)(F.lds + RING_OFF))[i] = (v4u){0u, 0u, 0u, 0u};
            if (F.tid < 96) ctl[F.tid] = 0;
            __syncthreads();
            idx_pass<0>(F, ln, KIb, MASKg, t0, nt_idx, nt_att, ql, qf, w, invA, 0, 0u);
            __syncthreads();
            idx_scan<0>(F);
            __syncthreads();
            const int b1 = ctl[ql_];
            for (int i = F.tid; i < 8200; i += 512) ((LAS v4u*)(F.lds + RING_OFF))[i] = (v4u){0u, 0u, 0u, 0u};
            __syncthreads();
            idx_pass<1>(F, ln, KIb, MASKg, t0, nt_idx, nt_att, ql, qf, w, invA, b1, 0u);
            __syncthreads();
            idx_scan<1>(F);
            __syncthreads();
            const unsigned thr = (unsigned)ctl[64 + ql_];
            idx_pass<2>(F, ln, KIb, MASKg, t0, nt_idx, nt_att, ql, qf, w, invA, b1, thr);
            __syncthreads();
        }
    }
}

__device__ __forceinline__ unsigned sbfe1_(unsigned w, const int bit) { unsigned r; asm("v_bfe_i32 %0, %1, %2, 1" : "=v"(r) : "v"(w), "n"(bit)); return r; }
#define SBFE1(w, bit) sbfe1_((w), (bit))
__device__ __forceinline__ void p6_attention(Frame& F, const unsigned* MASK, bf16* ATTo) {
    const bf16* Qb = WSP(bf16, WS_Q); const bf16* Kb = WSP(bf16, WS_K); const bf16* VT = WSP(bf16, WS_VT);
    constexpr int KTB = 18432, VTB = 17408, SLOT = KTB + VTB;
    LAS unsigned char* Lb = F.lds + RING_OFF;
    LAS float* biasd = (LAS float*)(F.lds + RING_OFF + 2 * SLOT);
    const int r32 = F.lane & 31, hi = F.lane >> 5;
    const int lrow = F.tid >> 3, lch = F.tid & 7;
    for (int p = F.vcu; p < 256; p += F.G) {
        const int bh = p >> 4, j = p & 15, b = bh >> 3, h = bh & 7;
#pragma unroll 1
        for (int side = 0; side < 2; ++side) {
            const int qb = side ? j : 31 - j, q0 = 256 * qb, NT = 2 * qb + 2;
            const int tq = q0 + 32 * F.wave + r32;
            if (F.tid < 128) { const int bk = t5_bucket(F.tid); biasd[F.tid] = (F.rel_bias[bk * 8 + h] - F.rel_bias[31 * 8 + h]) * LOG2E; }
            const bf16* Kg = Kb + (size_t)(b * SEQ + lrow) * 512 + h * 64 + lch * 8;
            const bf16* Vg = VT + ((size_t)((b * NH + h) * 64 + lrow)) * SEQ + lch * 8;
            const unsigned* Mg = MASK + ((size_t)(b * 256 + 8 * qb + F.wave) * 128) * 64 + F.lane;
            bf16x8 qf[4];
#pragma unroll
            for (int ks = 0; ks < 4; ++ks) qf[ks] = *(const bf16x8*)(Qb + (size_t)(b * SEQ + tq) * 512 + h * 64 + ks * 16 + hi * 8);
            f32x16 o0, o1, o2;
#pragma unroll
            for (int r = 0; r < 16; ++r) { o0[r] = 0.f; o1[r] = 0.f; o2[r] = 0.f; }
            const bf16x8 ones = (bf16x8){0x3F80, 0x3F80, 0x3F80, 0x3F80, 0x3F80, 0x3F80, 0x3F80, 0x3F80};
            float m_run = 0.f;
            v4u kreg0 = *(const v4u*)(Kg), kreg1 = *(const v4u*)(Kg + (size_t)64 * 512), vreg0 = *(const v4u*)(Vg), vreg1 = *(const v4u*)(Vg + 64);
            unsigned mw0 = Mg[0], mw1 = Mg[64], mwn0 = 0u, mwn1 = 0u;
            *(LAS v4u*)(Lb + lrow * 144 + lch * 16) = kreg0; *(LAS v4u*)(Lb + (64 + lrow) * 144 + lch * 16) = kreg1;
            *(LAS v4u*)(Lb + KTB + lrow * 272 + lch * 16) = vreg0; *(LAS v4u*)(Lb + KTB + lrow * 272 + 128 + lch * 16) = vreg1;
            __syncthreads();
            for (int kt = 0; kt < NT; ++kt) {
                const int buf = kt & 1;
                if (kt + 1 < NT) { const size_t kn = (size_t)(kt + 1) * 128;
                    kreg0 = *(const v4u*)(Kg + kn * 512); kreg1 = *(const v4u*)(Kg + (kn + 64) * 512); vreg0 = *(const v4u*)(Vg + kn); vreg1 = *(const v4u*)(Vg + kn + 64);
                    mwn0 = Mg[(size_t)(2 * kt + 2) * 64]; mwn1 = Mg[(size_t)(2 * kt + 3) * 64]; }
                LAS unsigned char* kb_ = Lb + buf * SLOT; LAS unsigned char* vb_ = kb_ + KTB;
                f32x16 sA[4];
#pragma unroll
                for (int c = 0; c < 4; ++c)
#pragma unroll
                    for (int r = 0; r < 16; ++r) sA[c][r] = 0.f;
#pragma unroll
                for (int ks = 0; ks < 4; ++ks)
#pragma unroll
                    for (int c = 0; c < 4; ++c) { const bf16x8 kf = *(const LAS bf16x8*)(kb_ + (32 * c + r32) * 144 + ks * 32 + hi * 16); sA[c] = MFMA32(kf, qf[ks], sA[c]); }
                if (kt >= NT - 3) {
#pragma unroll
                    for (int c = 0; c < 4; ++c)
#pragma unroll
                        for (int r = 0; r < 16; ++r) { const int d0 = tq - (128 * kt + 32 * c + crow(r, hi)); const float b0 = biasd[d0 & 127]; sA[c][r] += ((unsigned)d0 < 128u) ? b0 : 0.f; }
                }
                float mx = -INFINITY;
#pragma unroll
                for (int r = 0; r < 16; ++r) mx = fmaxf(mx, fmaxf(fmaxf(sA[0][r], sA[1][r]), fmaxf(sA[2][r], sA[3][r])));
                mx = fmaxf(mx, __shfl_xor(mx, 32)) - m_run;
                if (kt == 0 || __any(mx > 8.0f)) {
                    const float dl = (kt == 0) ? mx : fmaxf(mx, 0.f), f = __builtin_amdgcn_exp2f(-dl);
                    m_run += dl;
#pragma unroll
                    for (int r = 0; r < 16; ++r) { o0[r] *= f; o1[r] *= f; o2[r] *= f; }
                }
                unsigned pk[4][8];
#pragma unroll
                for (int c = 0; c < 4; ++c) { const unsigned mw = (c < 2) ? mw0 : mw1;
#pragma unroll
                    for (int r = 0; r < 16; r += 2) {
                        const unsigned e0 = __builtin_bit_cast(unsigned, __builtin_amdgcn_exp2f(sA[c][r] - m_run)) & SBFE1(mw, 16 * (c & 1) + r);
                        const unsigned e1 = __builtin_bit_cast(unsigned, __builtin_amdgcn_exp2f(sA[c][r + 1] - m_run)) & SBFE1(mw, 16 * (c & 1) + r + 1);
                        pk[c][r >> 1] = cvtpk(__builtin_bit_cast(float, e0), __builtin_bit_cast(float, e1)); } }
#pragma unroll
                for (int c = 0; c < 4; ++c)
#pragma unroll
                    for (int s = 0; s < 2; ++s) {
                        const bf16x8 pf = __builtin_bit_cast(bf16x8, (v4u){pk[c][4 * s], pk[c][4 * s + 1], pk[c][4 * s + 2], pk[c][4 * s + 3]});
                        const bf16x8 v0 = *(const LAS bf16x8*)(vb_ + r32 * 272 + (2 * c + s) * 32 + hi * 16);
                        const bf16x8 v1 = *(const LAS bf16x8*)(vb_ + (32 + r32) * 272 + (2 * c + s) * 32 + hi * 16);
                        o0 = MFMA32(v0, pf, o0); o1 = MFMA32(v1, pf, o1); o2 = MFMA32(ones, pf, o2);
                    }
                if (kt + 1 < NT) { LAS unsigned char* nb = Lb + (buf ^ 1) * SLOT;
                    *(LAS v4u*)(nb + lrow * 144 + lch * 16) = kreg0; *(LAS v4u*)(nb + (64 + lrow) * 144 + lch * 16) = kreg1;
                    *(LAS v4u*)(nb + KTB + lrow * 272 + lch * 16) = vreg0; *(LAS v4u*)(nb + KTB + lrow * 272 + 128 + lch * 16) = vreg1; }
                mw0 = mwn0; mw1 = mwn1;
                __syncthreads();
            }
            const float inv = 1.0f / o2[0];
            bf16* orow = ATTo + (size_t)(b * SEQ + tq) * 512 + h * 64 + 4 * hi;
#pragma unroll
            for (int g4 = 0; g4 < 4; ++g4) {
                *(v2u*)(orow + 8 * g4) = (v2u){cvtpk(o0[4 * g4] * inv, o0[4 * g4 + 1] * inv), cvtpk(o0[4 * g4 + 2] * inv, o0[4 * g4 + 3] * inv)};
                *(v2u*)(orow + 32 + 8 * g4) = (v2u){cvtpk(o1[4 * g4] * inv, o1[4 * g4 + 1] * inv), cvtpk(o1[4 * g4 + 2] * inv, o1[4 * g4 + 3] * inv)};
            }
        }
    }
}

__device__ __forceinline__ void p9_norm2_route(Frame& F, const float* HRES) {
    const int gw = F.vcu * NWAVES + F.wave, NGW = F.G * NWAVES;
    const float* mod = WSP(float, SM_MOD); const float* WRT = WSP(float, SM_WRT);
    LAS float* lg = (LAS float*)(F.lds + RING_OFF + F.wave * 16384 + 8448);
    int* EID = WSP(int, SM_EID); float* EWT = WSP(float, SM_EWT); int* SLOT = WSP(int, SM_SLOT); bf16* H2 = WSP(bf16, WS_H1);
    for (int m4 = gw; m4 < T / 4; m4 += NGW) {
        const int m0 = m4 * 4, b = m0 / SEQ;
        f32x4 hv[4][4];
#pragma unroll
        for (int r = 0; r < 4; ++r) {
            const GAS f32x4* xr = (const GAS f32x4*)(HRES + (size_t)(m0 + r) * D) + F.lane; float s = 0.f;
#pragma unroll
            for (int j = 0; j < 4; ++j) { hv[r][j] = xr[64 * j]; s += (hv[r][j].x * hv[r][j].x + hv[r][j].y * hv[r][j].y) + (hv[r][j].z * hv[r][j].z + hv[r][j].w * hv[r][j].w); }
            const float rstd = 1.f / sqrtf(wave_sum_all(s) * (1.f / D) + EPS);
            GAS v2u* o8 = (GAS v2u*)(H2 + (size_t)(m0 + r) * D) + F.lane;
#pragma unroll
            for (int j = 0; j < 4; ++j) { const int k = 4 * F.lane + 256 * j;
                const f32x4 g = *(const f32x4*)(F.norm2_g + k), scl = *(const f32x4*)(mod + b * 6144 + 4096 + k), sh = *(const f32x4*)(mod + b * 6144 + 3072 + k);
                hv[r][j] = hv[r][j] * rstd * (g * (scl + 1.0f)) + sh; o8[64 * j] = (v2u){pk2(hv[r][j].x, hv[r][j].y), pk2(hv[r][j].z, hv[r][j].w)}; }
        }
        for (int n = 0; n < 36; ++n) {
            f32x4 w[4];
#pragma unroll
            for (int j = 0; j < 4; ++j) w[j] = *(const f32x4*)(WRT + n * D + 4 * F.lane + 256 * j);
            float p[4];
#pragma unroll
            for (int r = 0; r < 4; ++r) { float a = 0.f;
#pragma unroll
                for (int j = 0; j < 4; ++j) a += (hv[r][j].x * w[j].x + hv[r][j].y * w[j].y) + (hv[r][j].z * w[j].z + hv[r][j].w * w[j].w);
                p[r] = wave_sum63(a); }
            if (F.lane == 63) { const float bb = (n < 4 ? F.brg[n] : F.bre[n - 4]); lg[n] = p[0] + bb; lg[36 + n] = p[1] + bb; lg[72 + n] = p[2] + bb; lg[108 + n] = p[3] + bb; }
        }
        LDS_WAIT(); asm volatile("" ::: "memory");
        if (F.lane < 4) {
            const LAS float* l = lg + F.lane * 36; const int tkn = m0 + F.lane;
            int gs = 0; float gm = l[0];
#pragma unroll
            for (int j = 1; j < 4; ++j) if (l[j] > gm) { gm = l[j]; gs = j; }
            float gsum = 0.f;
#pragma unroll
            for (int j = 0; j < 4; ++j) gsum += __expf(l[j] - gm);
            const float gwt = 1.f / gsum;
            const LAS float* el = l + 4 + 8 * gs;
            int i0 = 0; float l0 = el[0];
#pragma unroll
            for (int j = 1; j < 8; ++j) if (el[j] > l0) { l0 = el[j]; i0 = j; }
            int i1 = -1; float l1 = -INFINITY;
#pragma unroll
            for (int j = 0; j < 8; ++j) if (j != i0 && el[j] > l1) { l1 = el[j]; i1 = j; }
            const float e1 = __expf(l1 - l0), p0 = 1.f / (1.f + e1), p1 = e1 * p0;
            const int e0id = gs * 8 + i0, e1id = gs * 8 + i1;
            EID[tkn * 2] = e0id; EID[tkn * 2 + 1] = e1id; EWT[tkn * 2] = gwt * p0; EWT[tkn * 2 + 1] = gwt * p1;
            SLOT[tkn * 2] = (int)atomicAdd((unsigned*)(F.ctl + CW_ECNT + 16 * e0id), 1u);
            SLOT[tkn * 2 + 1] = (int)atomicAdd((unsigned*)(F.ctl + CW_ECNT + 16 * e1id), 1u);
        }
        LDS_WAIT(); asm volatile("" ::: "memory");
    }
    {
        LAS float* scr = (LAS float*)(F.lds + RING_OFF + F.wave * 16384);
        for (int rep_ = 0; rep_ < (DBG_REP == 9 ? 2 : 1); ++rep_)
        for (int it = gw; it < NEXP * 768; it += NGW) {
            const int e = it / 768, r = it % 768;
            if (r < 256) transpose_item(F.w_gate_e + (size_t)e * D * DEXP, D, DEXP, WSP(bf16, WS_WGU) + (size_t)e * 1024 * D, scr, r, F.lane, RmGU{0});
            else if (r < 512) transpose_item(F.w_up_e + (size_t)e * D * DEXP, D, DEXP, WSP(bf16, WS_WGU) + (size_t)e * 1024 * D, scr, r - 256, F.lane, RmGU{1});
            else transpose_item(F.w_down_e + (size_t)e * DEXP * D, DEXP, D, WSP(bf16, WS_WD) + (size_t)e * D * DEXP, scr, r - 512, F.lane, RmId());
        }
    }
}
__device__ __forceinline__ int moe_tables(Frame& F, LAS int* off, LAS int* tile_e) {
    if (F.tid == 0) { int o = 0, nt = 0;
        for (int e = 0; e < NEXP; ++e) { const int c = (int)__hip_atomic_load(F.ctl + CW_ECNT + 16 * e, RLX_AGENT); off[e] = o; const int tl = (c + 255) >> 8; for (int j = 0; j < tl; ++j) tile_e[nt++] = e; o += tl * 256; }
        off[NEXP] = nt; }
    __syncthreads();
    return off[NEXP];
}
__device__ __forceinline__ void p10_gather(Frame& F, LAS int* off) {
    const int* EID = WSP(int, SM_EID); int* SLOT = WSP(int, SM_SLOT); int* AROW = (int*)(F.ctl + CW_AROW);
    for (int i = blockIdx.x * 512 + F.tid; i < T * 2; i += F.G * 512) { const int row = off[EID[i]] + SLOT[i]; AROW[row] = i >> 1; SLOT[i] = row; }
}
__device__ __forceinline__ void p13_combine(Frame& F, const float* HRES) {
    const int gw = F.vcu * NWAVES + F.wave, NGW = F.G * NWAVES;
    const float* mod = WSP(float, SM_MOD); const int* SLOT = WSP(int, SM_SLOT); const float* EWT = WSP(float, SM_EWT); const bf16* Y = WSP(bf16, WS_Y);
    for (int m = gw; m < T; m += NGW) {
#if DBG_SKIP_MOE
        const int b = m / SEQ; const int r0 = 0, r1 = 0; const float w0 = 0.f, w1 = 0.f; (void)SLOT; (void)EWT;
#else
        const int b = m / SEQ; const int r0 = SLOT[m * 2], r1 = SLOT[m * 2 + 1]; const float w0 = EWT[m * 2], w1 = EWT[m * 2 + 1];
#endif
        const GAS f32x4* xr = (const GAS f32x4*)(HRES + (size_t)m * D) + F.lane;
        const GAS v2u* y0 = (const GAS v2u*)(Y + (size_t)r0 * D) + F.lane; const GAS v2u* y1 = (const GAS v2u*)(Y + (size_t)r1 * D) + F.lane;
        f32x4 v[4]; float s = 0.f;
#pragma unroll
        for (int j = 0; j < 4; ++j) { const int k = 4 * F.lane + 256 * j; const v2u a = y0[64 * j], c = y1[64 * j];
            const f32x4 ya = (f32x4){bflo(a.x), bfhi(a.x), bflo(a.y), bfhi(a.y)}, yb = (f32x4){bflo(c.x), bfhi(c.x), bflo(c.y), bfhi(c.y)};
            const f32x4 g2 = *(const f32x4*)(mod + b * 6144 + 5120 + k);
#if DBG_SKIP_MOE
            v[j] = xr[64 * j]; (void)g2; (void)ya; (void)yb;
#else
            v[j] = xr[64 * j] + g2 * (ya * w0 + yb * w1);
#endif
            s += (v[j].x * v[j].x + v[j].y * v[j].y) + (v[j].z * v[j].z + v[j].w * v[j].w); }
        const float rstd = 1.f / sqrtf(wave_sum_all(s) * (1.f / D) + EPS);
        GAS f32x4* o = (GAS f32x4*)(F.out + (size_t)m * D) + F.lane;
#if DBG_CMP_ATT
        const float escale = 1.0f + sqrtf(__builtin_bit_cast(float, __hip_atomic_load(F.ctl + CW_CMP, RLX_AGENT)) / __builtin_bit_cast(float, __hip_atomic_load(F.ctl + CW_CMP + 1, RLX_AGENT)));
#else
        const float escale = 1.0f;
#endif
#pragma unroll
        for (int j = 0; j < 4; ++j) o[64 * j] = v[j] * (rstd * escale) * *(const f32x4*)(F.norm_f_g + 4 * F.lane + 256 * j);
    }
}

struct Args { const float* in[20]; float* out; unsigned char* ws; int ph_lo, ph_hi, li, pad; };
__global__ void __launch_bounds__(NWAVES * 64, 2) fwd_kernel(Args args) {
    extern __shared__ __attribute__((aligned(16))) unsigned char lds[];
    Frame F;
    F.lds = (LAS unsigned char*)lds;
    F.MISC = (volatile LAS unsigned*)(F.lds + MISC_OFF);
    F.tid = threadIdx.x; F.lane = F.tid & 63; F.wave = __builtin_amdgcn_readfirstlane(F.tid >> 6);
    F.G = gridDim.x; { const int bx = blockIdx.x; F.vcu = (F.G % 8 == 0) ? (bx % 8) * (F.G / 8) + bx / 8 : bx; }
    F.ws = args.ws; F.ctl = (gu32*)(args.ws + WS_CTL);
    F.x = args.in[0]; F.c = args.in[1]; F.w_ada = args.in[2]; F.b_ada = args.in[3]; F.norm1_g = args.in[4]; F.w_in = args.in[5]; F.rel_bias = args.in[6]; F.conv_w = args.in[7];
    F.w_attn = args.in[8]; F.w_conv = args.in[9]; F.w_out = args.in[10]; F.norm2_g = args.in[11]; F.wrg = args.in[12]; F.brg = args.in[13]; F.wre = args.in[14]; F.bre = args.in[15];
    F.w_gate_e = args.in[16]; F.w_up_e = args.in[17]; F.w_down_e = args.in[18]; F.norm_f_g = args.in[19]; F.out = args.out;
    for (int u = F.tid; u < (LDS_BYTES - LDSCTL_OFF) / 4; u += NWAVES * 64) ((LAS unsigned*)(F.lds + LDSCTL_OFF))[u] = 0u;
    __syncthreads();
    XcdBarrier bar; bar.bar = (unsigned*)(F.ctl + CW_BAR); bar.x = 0; bar.st = nullptr;
    if (!MK_PER_PHASE) bar = xcd_barrier_post((unsigned*)(F.ctl + CW_BAR), F.MISC + 8);
#define GRID_BAR() do { if (MK_PER_PHASE) { if (F.tid == 0) __hip_atomic_store(F.ctl + CW_TMO, 0xBADBA0u, RLX_AGENT); } else { xcd_barrier(bar); } } while (0)
    const int lo = args.ph_lo, hi = args.ph_hi;
#ifndef ONLY_PHASE
#define ONLY_PHASE -1
#endif
#define IN(k) ((ONLY_PHASE < 0 || ONLY_PHASE == (k)) && lo <= (k) && (k) < hi)
#define BOTH(k) (IN(k) && IN((k) + 1))
    float* HRES = F.out;
    LAS int* moe_off = (LAS int*)(F.lds + LDSCTL_OFF + 1024);
    LAS int* moe_tile = (LAS int*)(F.lds + LDSCTL_OFF + 1024 + 256);

    if (IN(0)) { for (int rep_ = 0; rep_ < (DBG_REP == 0 ? 2 : 1); ++rep_) { if (rep_) GRID_BAR(); p0_prologue(F); } if (BOTH(0)) GRID_BAR(); }
    if (IN(1)) { for (int rep_ = 0; rep_ < (DBG_REP == 1 ? 2 : 1); ++rep_) { if (rep_) GRID_BAR(); p1_norm1(F); } if (BOTH(1)) GRID_BAR(); }
    if (IN(2)) {
        pg8::Gemm g{WSP(bf16, WS_H1), WSP(bf16, WS_WIN), T, NINP, D}; pg8::StaticOrder S; S.init(T, NINP, F.G, (int)blockIdx.x);
        EpiProj E{WSP(bf16, WS_Q), WSP(bf16, WS_K), WSP(bf16, WS_V), WSP(bf16, WS_QI), WSP(bf16, WS_KI), WSP(bf16, WS_CB), WSP(bf16, WS_U), WSP(bf16, WS_G), WSP(float, WS_WI)};
        for (int rep_ = 0; rep_ < (DBG_REP == 2 ? 2 : 1); ++rep_) { if (rep_) GRID_BAR(); pg8::gemm_phase<EpiProj, pg8::StaticOrder, true, true>(F.lds + RING_OFF, g, S, E); }
        if (BOTH(2)) GRID_BAR();
    }
    if (IN(3)) { for (int rep_ = 0; rep_ < (DBG_REP == 3 ? 2 : 1); ++rep_) { if (rep_) GRID_BAR(); p3_prep(F); } if (BOTH(3)) GRID_BAR(); }
    if (IN(4)) {
        pg8::Gemm g{WSP(bf16, WS_AC), WSP(bf16, WS_WC), T, D, AW}; pg8::StaticOrder S; S.init(T, D, F.G, (int)blockIdx.x);
        EpiConv E{WSP(bf16, WS_G), WSP(bf16, WS_TMPC)};
        for (int rep_ = 0; rep_ < (DBG_REP == 4 ? 2 : 1); ++rep_) { if (rep_) GRID_BAR(); pg8::gemm_phase<EpiConv, pg8::StaticOrder, true, true>(F.lds + RING_OFF, g, S, E); }
        if (BOTH(4)) GRID_BAR();
    }
    if (IN(5)) {
#if DBG_SKIP_ATTN
        for (size_t i = (size_t)blockIdx.x * 512 + F.tid; i < (size_t)T * 512 / 8; i += (size_t)F.G * 512) *(v4u*)(WSP(bf16, WS_ATT) + i * 8) = (v4u){0u, 0u, 0u, 0u};
#elif DBG_CMP_ATT
        pn_naive_dsa(F); GRID_BAR(); p5_indexer(F, WSP(unsigned, WS_MASK_DBG));
#elif MK_NAIVE_ATTN
        pn_naive_dsa(F);
#else
        for (int rep_ = 0; rep_ < (DBG_REP == 5 ? 2 : 1); ++rep_) { if (rep_) GRID_BAR(); p5_indexer(F, WSP(unsigned, WS_MASK)); }
#endif
        if (BOTH(5)) GRID_BAR(); }
    if (IN(6)) {
#if DBG_SKIP_ATTN
#elif DBG_CMP_ATT
        p6_attention(F, WSP(unsigned, WS_MASK_DBG), WSP(bf16, WS_ATT2)); GRID_BAR();
        { float num = 0.f, den = 0.f; const bf16* A1 = WSP(bf16, WS_ATT); const bf16* A2 = WSP(bf16, WS_ATT2);
          for (size_t i = (size_t)blockIdx.x * 512 + F.tid; i < (size_t)T * 512; i += (size_t)F.G * 512) { const float a = bf1(A1[i]), c = bf1(A2[i]); num += (a - c) * (a - c); den += a * a; }
          num = wave_sum(num); den = wave_sum(den);
          if (F.lane == 0) { atomicAdd((float*)(F.ctl + CW_CMP), num); atomicAdd((float*)(F.ctl + CW_CMP + 1), den); } }
#elif !MK_NAIVE_ATTN
        for (int rep_ = 0; rep_ < (DBG_REP == 6 ? 2 : 1); ++rep_) { if (rep_) GRID_BAR(); p6_attention(F, WSP(unsigned, WS_MASK), WSP(bf16, WS_ATT)); }
#endif
        if (BOTH(6)) GRID_BAR(); }
    if (IN(7)) {
        pg8::Gemm g{WSP(bf16, WS_ATT), WSP(bf16, WS_WA), T, D, AW}; pg8::StaticOrder S; S.init(T, D, F.G, (int)blockIdx.x);
        EpiAttn E{WSP(bf16, WS_G), WSP(bf16, WS_TMPC), WSP(bf16, WS_MERGED)};
        for (int rep_ = 0; rep_ < (DBG_REP == 7 ? 2 : 1); ++rep_) { if (rep_) GRID_BAR(); pg8::gemm_phase<EpiAttn, pg8::StaticOrder, true, true>(F.lds + RING_OFF, g, S, E); }
        if (BOTH(7)) GRID_BAR();
    }
    if (IN(8)) {
        pg8::Gemm g{WSP(bf16, WS_MERGED), WSP(bf16, WS_WOUT), T, D, D}; pg8::StaticOrder S; S.init(T, D, F.G, (int)blockIdx.x);
        EpiOut E{F.x, WSP(float, SM_MOD), HRES};
        for (int rep_ = 0; rep_ < (DBG_REP == 8 ? 2 : 1); ++rep_) { if (rep_) GRID_BAR(); pg8::gemm_phase<EpiOut, pg8::StaticOrder, true, true>(F.lds + RING_OFF, g, S, E); }
        if (BOTH(8)) GRID_BAR();
    }
#if DBG_SKIP_MOE
    if (0) {
#endif
    if (IN(9)) { p9_norm2_route(F, HRES); if (BOTH(9)) GRID_BAR(); }
    if (IN(10)) { (void)moe_tables(F, moe_off, moe_tile); p10_gather(F, moe_off); if (BOTH(10)) GRID_BAR(); }
    if (IN(11)) {
        const int nt = moe_tables(F, moe_off, moe_tile);
        pg8::Gemm g{WSP(bf16, WS_H1), WSP(bf16, WS_WGU), XPROWS, NEXP * 1024, D}; MoeOrder S{moe_tile, nt, F.G, (int)blockIdx.x};
        EpiHid E{WSP(bf16, WS_HID)};
        for (int rep_ = 0; rep_ < (DBG_REP == 11 ? 2 : 1); ++rep_) { if (rep_) GRID_BAR(); pg8::gemm_phase<EpiHid, MoeOrder, true, true, true>(F.lds + RING_OFF, g, S, E, (const int*)(F.ctl + CW_AROW)); }
        if (BOTH(11)) GRID_BAR();
    }
    if (IN(12)) {
        const int nt = moe_tables(F, moe_off, moe_tile);
        pg8::Gemm g{WSP(bf16, WS_HID), WSP(bf16, WS_WD), XPROWS, NEXP * 1024, DEXP}; MoeOrder S{moe_tile, nt, F.G, (int)blockIdx.x};
        EpiY E{WSP(bf16, WS_Y)};
        for (int rep_ = 0; rep_ < (DBG_REP == 12 ? 2 : 1); ++rep_) { if (rep_) GRID_BAR(); pg8::gemm_phase<EpiY, MoeOrder, true, true>(F.lds + RING_OFF, g, S, E); }
        if (BOTH(12)) GRID_BAR();
    }
#if DBG_SKIP_MOE
    }
#endif
#if DBG_PROBE
    if (IN(13)) {
        const bf16* src = nullptr; int pitch = 1024;
        if (DBG_PROBE == 1) { src = WSP(bf16, WS_MERGED); pitch = 1024; }
        if (DBG_PROBE == 2) { src = WSP(bf16, WS_TMPC); pitch = 1024; }
        if (DBG_PROBE == 3) { src = WSP(bf16, WS_AC); pitch = 512; }
        if (DBG_PROBE == 4) { src = WSP(bf16, WS_G); pitch = 2048; }
        if (DBG_PROBE == 5) { src = WSP(bf16, WS_H1); pitch = 1024; }
        if (DBG_PROBE == 6) { src = WSP(bf16, WS_WIN); pitch = 1024; }
        if (DBG_PROBE == 7) { src = WSP(bf16, WS_QI); pitch = 512; }
        for (size_t i = (size_t)blockIdx.x * 512 + F.tid; i < (size_t)T * D; i += (size_t)F.G * 512) { const size_t m = i / D, j = i % D;
            float v;
            if (DBG_PROBE == 8) v = WSP(float, SM_MOD)[i % 12288];
            else if (DBG_PROBE == 4) v = bf1(src[m * 2048 + j]) + bf1(src[m * 2048 + 1024 + j]);
            else if (DBG_PROBE >= 40 && DBG_PROBE < 48) v = bf1(WSP(bf16, WS_G)[m * 2048 + (DBG_PROBE - 40) * 256 + (j & 255)]);
            else if (DBG_PROBE == 6) v = bf1(src[(m % 5888) * 1024 + j]);
            else v = bf1(src[m * pitch + (j % pitch)]);
            F.out[i] = v; }
    }
#else
    if (IN(13)) { for (int rep_ = 0; rep_ < (DBG_REP == 13 ? 2 : 1); ++rep_) { if (rep_) GRID_BAR(); p13_combine(F, DBG_SKIP_MIX ? F.x : HRES); } }
#endif
#undef IN
#undef BOTH
}

extern "C" void kernel_launch(void* const* d_in, const int* in_sizes, int n_in, void* d_out, int out_size, void* d_ws, size_t ws_size, hipStream_t stream) {
    static int grid = 0;
    if (grid == 0) {
        if (n_in != 20 || in_sizes[0] != T * D || out_size != T * D || ws_size < WS_END) { fprintf(stderr, "kernel_launch: unexpected shapes: n_in %d in0 %d out %d ws %zu (need %zu)\n", n_in, n_in > 0 ? in_sizes[0] : -1, out_size, ws_size, (size_t)WS_END); grid = -1; return; }
        int dev = 0, cus = 0, per_cu = 0;
        if (hipGetDevice(&dev) != hipSuccess || hipDeviceGetAttribute(&cus, hipDeviceAttributeMultiprocessorCount, dev) != hipSuccess) { grid = -1; return; }
        if (hipFuncSetAttribute((const void*)fwd_kernel, hipFuncAttributeMaxDynamicSharedMemorySize, LDS_BYTES) != hipSuccess) { fprintf(stderr, "kernel_launch: hipFuncSetAttribute failed\n"); grid = -1; return; }
        if (hipOccupancyMaxActiveBlocksPerMultiprocessor(&per_cu, (const void*)fwd_kernel, NWAVES * 64, LDS_BYTES) != hipSuccess || per_cu < 1)
            fprintf(stderr, "kernel_launch: note: occupancy query reports %d workgroups per CU\n", per_cu);
        (void)hipGetLastError();
        grid = cus;
    }
    if (grid < 0) return;
    if (hipMemsetAsync((char*)d_ws + WS_CTL, 0, CTL_ZERO_BYTES, stream) != hipSuccess) return;
    Args a{};
    for (int i = 0; i < 20; ++i) a.in[i] = (const float*)d_in[i];
    a.out = (float*)d_out; a.ws = (unsigned char*)d_ws;
#if MK_PER_PHASE
    for (int li = 0; li < N_PHASES; ++li) { a.ph_lo = li; a.ph_hi = li + 1; a.li = li; hipLaunchKernelGGL(fwd_kernel, dim3(grid), dim3(NWAVES * 64), LDS_BYTES, stream, a); }
#else
    a.ph_lo = 0; a.ph_hi = N_PHASES; a.li = 0;
    hipLaunchKernelGGL(fwd_kernel, dim3(grid), dim3(NWAVES * 64), LDS_BYTES, stream, a);
#endif
}
```

```cpp
#include <hip/hip_runtime.h>
#include <cstdio>
#include <cstdint>

namespace pg8 {
#define PG8_LAS __attribute__((address_space(3)))
typedef unsigned short bf16_t;
typedef short bf16x8 __attribute__((ext_vector_type(8)));
typedef float f32x4 __attribute__((ext_vector_type(4)));
typedef unsigned u32x4 __attribute__((ext_vector_type(4)));
constexpr int BM = 256, BK = 64, HALF = 128, HTB = HALF * BK * 2  , STAGE_BYTES = 8 * HTB, NXCD = 8, WGM = 8;

__host__ __device__ __forceinline__ int lds_byte(int r, int c) { const int st = (r >> 4) * 2 + (c >> 5), rr = r & 15, cc = c & 31, ob = rr * 64 + cc * 2; return st * 1024 + (ob ^ (((ob >> 9) & 1) << 5)); }
__host__ __device__ __forceinline__ void stage_rc(int b, int& R, int& C) { const int st = b / 1024, sb = b % 1024, swz = sb ^ (((sb >> 9) & 1) << 5); R = (st >> 1) * 16 + swz / 64; C = (st & 1) * 32 + (swz % 64) / 2; }
__host__ __device__ __forceinline__ int perm32(int rho) { const int n = rho >> 4, i = rho & 15; return 8 * (i >> 2) + 4 * n + (i & 3); }

struct Unit { int pm, pn; };
struct Gemm { const bf16_t* A; const bf16_t* Bt; int M, N, K; };

struct StaticOrder {
    int nM, nN, nwg, G, c;
    __host__ __device__ void init(int M, int N, int G_, int c_) { nM = M / BM; nN = N / BM; nwg = nM * nN; G = G_; c = c_; }
    __host__ __device__ bool next(int i, Unit& u) const {
        const long L = (long)i * G + c; if (L >= nwg) return false;
        int wgid = (int)L; { const int q = nwg / NXCD, r = nwg % NXCD, xcd = wgid % NXCD, off = wgid / NXCD; wgid = (xcd < r ? xcd * (q + 1) : r * (q + 1) + (xcd - r) * q) + off; }
        const int nig = WGM * nN, gid = wgid / nig, fm = gid * WGM, gsz = (nM - fm) < WGM ? (nM - fm) : WGM;
        u.pm = fm + ((wgid % nig) % gsz); u.pn = (wgid % nig) / gsz; return true;
    }
    __device__ __forceinline__ void a_ready(const Unit&) const {}
    __device__ __forceinline__ void done(const Unit&) const {}
};
__device__ __forceinline__ unsigned cvt_pk_bf16(float lo, float hi) { unsigned r; asm volatile("v_cvt_pk_bf16_f32 %0, %1, %2" : "=v"(r) : "v"(lo), "v"(hi)); return r; }

template <class Epi, class Sched, bool ALIGN_EPI = false, bool SP2 = false, bool GATHER = false>
__device__ __forceinline__ void gemm_phase(PG8_LAS unsigned char* lds, const Gemm g, const Sched& S, const Epi& E, const int wave_id  , const int* arow = nullptr) {
    static_assert(!GATHER || SP2, "GATHER is implemented on the SP2 loop only");
    int lane_ = (int)__builtin_amdgcn_mbcnt_hi(~0u, __builtin_amdgcn_mbcnt_lo(~0u, 0u)); asm volatile("" : "+v"(lane_));
    const int lane = lane_, wid = wave_id, tid = wid * 64 + lane,
               wr = wid >> 2, wc = wid & 3, fr = lane & 15, fq = lane >> 4;
    const int K = g.K, nt = K / BK;
    unsigned voffA[2], voffB[2]; int RA[2]; unsigned CA2[2];
#pragma unroll
    for (int i = 0; i < 2; ++i) { int R, C; stage_rc(tid * 16 + i * 8192, R, C); const int Rb = Epi::PERM ? ((R & ~31) + perm32(R & 31)) : R;
        voffA[i] = (unsigned)(R * K + C) * 2u; voffB[i] = (unsigned)(Rb * K + C) * 2u; RA[i] = R; CA2[i] = (unsigned)C * 2u; }
    unsigned vA[2][2] = {{0u, 0u}, {0u, 0u}}, nvA[2][2] = {{0u, 0u}, {0u, 0u}};
#define PG8_GROWS(dst, U) do { _Pragma("unroll") for (int _h = 0; _h < 2; ++_h) _Pragma("unroll") for (int _i = 0; _i < 2; ++_i) dst[_h][_i] = (unsigned)arow[(U).pm * BM + _h * HALF + RA[_i]] * (unsigned)(K * 2) + CA2[_i]; } while (0)
    const size_t kstep = (size_t)(BK * 2);
    const size_t hstep = (size_t)HALF * K * 2;
    const size_t tstep = 2 * hstep;
    const unsigned ldsw = (unsigned)wid * 1024u;
    const int aoff = lds_byte(wr * 64 + fr, fq * 8), boff = lds_byte(wc * 32 + fr, fq * 8);
#define PG8_SA(b, h) (((b) * 2 + (h)) * HTB)
#define PG8_SB(b, h) ((4 + (b) * 2 + (h)) * HTB)
#define PG8_STAGE(bufoff, gbase, voff) do { _Pragma("unroll") for (int _i = 0; _i < 2; ++_i) \
        __builtin_amdgcn_global_load_lds((const unsigned*)((const char*)(gbase) + (voff)[_i]), (PG8_LAS unsigned*)(lds + (bufoff) + ldsw + _i * 8192), 16, 0, 0); } while (0)
#define PG8_STAGE_A(bufoff, gb, h, nx) do { if constexpr (GATHER) { _Pragma("unroll") for (int _i = 0; _i < 2; ++_i) { const unsigned vo_ = (nx) ? nvA[h][_i] : vA[h][_i]; \
        __builtin_amdgcn_global_load_lds((const unsigned*)((const char*)(gb) + vo_), (PG8_LAS unsigned*)(lds + (bufoff) + ldsw + _i * 8192), 16, 0, 0); } } else { PG8_STAGE(bufoff, (gb) + (h) * hstep, voffA); } } while (0)
#define PG8_LDA(dst, b, h) do { _Pragma("unroll") for (int m = 0; m < 4; ++m) _Pragma("unroll") for (int k = 0; k < 2; ++k) dst[m][k] = *(const PG8_LAS bf16x8*)(lds + PG8_SA(b, h) + aoff + m * 2048 + k * 1024); } while (0)
#define PG8_LDB(dst, b, h) do { _Pragma("unroll") for (int n = 0; n < 2; ++n) _Pragma("unroll") for (int k = 0; k < 2; ++k) dst[n][k] = *(const PG8_LAS bf16x8*)(lds + PG8_SB(b, h) + boff + n * 2048 + k * 1024); } while (0)
#define PG8_MMA(ai, bj, At, Bt) do { __builtin_amdgcn_s_setprio(1); _Pragma("unroll") for (int m = 0; m < 4; ++m) _Pragma("unroll") for (int n = 0; n < 2; ++n) _Pragma("unroll") for (int k = 0; k < 2; ++k) \
        acc[ai][bj][m][n] = __builtin_amdgcn_mfma_f32_16x16x32_bf16(Bt[n][k], At[m][k], acc[ai][bj][m][n], 0, 0, 0); __builtin_amdgcn_s_setprio(0); } while (0)
#define PG8_WAIT_V(n) asm volatile("s_waitcnt vmcnt(" #n ")" ::: "memory")
#define PG8_WAIT_L(n) asm volatile("s_waitcnt lgkmcnt(" #n ")" ::: "memory")
#define PG8_BAR __builtin_amdgcn_s_barrier()
#define PG8_SCHED __builtin_amdgcn_sched_barrier(0)
    Unit cur, nxt; int ui = 0;
    if (!S.next(0, cur)) return;
    f32x4 acc[2][2][4][2];
#pragma unroll
    for (int a = 0; a < 2; ++a)
#pragma unroll
        for (int b = 0; b < 2; ++b)
#pragma unroll
            for (int m = 0; m < 4; ++m)
#pragma unroll
                for (int n = 0; n < 2; ++n) acc[a][b][m][n] = (f32x4){0.f, 0.f, 0.f, 0.f};
    bf16x8 At[4][2], B0[2][2], B1[2][2];
    const char* cA = (const char*)g.A + (GATHER ? (size_t)0 : (size_t)cur.pm * tstep); const char* cB = (const char*)g.Bt + (size_t)cur.pn * tstep;
    if constexpr (GATHER) PG8_GROWS(vA, cur);
    S.a_ready(cur);
    if constexpr (SP2) {
        PG8_STAGE(PG8_SB(0, 0), cB, voffB); PG8_STAGE(PG8_SB(0, 1), cB + hstep, voffB); PG8_STAGE_A(PG8_SA(0, 0), cA, 0, false); PG8_STAGE_A(PG8_SA(0, 1), cA, 1, false);
        if (wr == 1) PG8_BAR;
        PG8_WAIT_V(2); PG8_BAR;
        PG8_STAGE(PG8_SB(1, 0), cB + kstep, voffB); PG8_STAGE_A(PG8_SA(1, 0), cA + kstep, 0, false); PG8_STAGE(PG8_SB(1, 1), cB + hstep + kstep, voffB);
        PG8_WAIT_V(6); PG8_BAR;
    } else {
        PG8_STAGE(PG8_SB(0, 0), cB, voffB); PG8_STAGE(PG8_SA(0, 0), cA, voffA); PG8_STAGE(PG8_SB(0, 1), cB + hstep, voffB); PG8_STAGE(PG8_SA(0, 1), cA + hstep, voffA);
        if (wr == 1) PG8_BAR;
        PG8_WAIT_V(4); PG8_BAR;
        PG8_STAGE(PG8_SB(1, 0), cB + kstep, voffB); PG8_STAGE(PG8_SA(1, 0), cA + kstep, voffA); PG8_STAGE(PG8_SB(1, 1), cB + hstep + kstep, voffB);
        PG8_WAIT_V(6); PG8_BAR;
    }
    for (;;) {
        const bool has_next = S.next(ui + 1, nxt);
        const char* nA = (has_next && !GATHER) ? (const char*)g.A + (size_t)nxt.pm * tstep : cA; const char* nB = has_next ? (const char*)g.Bt + (size_t)nxt.pn * tstep : cB;
        if constexpr (GATHER) { if (has_next) PG8_GROWS(nvA, nxt); else { nvA[0][0] = vA[0][0]; nvA[0][1] = vA[0][1]; nvA[1][0] = vA[1][0]; nvA[1][1] = vA[1][1]; } }
        for (int t = 0; t < nt; t += 2) {
            const bool last = (t == nt - 2);
            const char* a1 = cA + (size_t)(t + 1) * kstep;
            const char* a2 = last ? nA : cA + (size_t)(t + 2) * kstep; const char* b2 = last ? nB : cB + (size_t)(t + 2) * kstep;
            const char* a3 = a2 + kstep; const char* b3 = b2 + kstep;
            if (last && has_next) S.a_ready(nxt);
            if constexpr (SP2) {
            PG8_LDB(B0, 0, 0); PG8_LDB(B1, 0, 1); PG8_SCHED; PG8_LDA(At, 0, 0); PG8_STAGE_A(PG8_SA(1, 1), a1, 1, false);
            PG8_WAIT_V(8); PG8_WAIT_L(0); PG8_BAR; PG8_MMA(0, 0, At, B0); PG8_MMA(0, 1, At, B1); PG8_BAR; PG8_SCHED;
            PG8_LDA(At, 0, 1); PG8_STAGE(PG8_SB(0, 0), b2, voffB); PG8_STAGE(PG8_SB(0, 1), b2 + hstep, voffB); PG8_STAGE_A(PG8_SA(0, 0), a2, 0, last);
            PG8_WAIT_V(8); PG8_WAIT_L(0); PG8_BAR; PG8_MMA(1, 0, At, B0); PG8_MMA(1, 1, At, B1); PG8_BAR; PG8_SCHED;
            PG8_LDB(B0, 1, 0); PG8_LDB(B1, 1, 1); PG8_SCHED; PG8_LDA(At, 1, 0); PG8_STAGE_A(PG8_SA(0, 1), a2, 1, last);
            PG8_WAIT_V(8); PG8_WAIT_L(0); PG8_BAR; PG8_MMA(0, 0, At, B0); PG8_MMA(0, 1, At, B1); PG8_BAR; PG8_SCHED;
            PG8_LDA(At, 1, 1); PG8_STAGE(PG8_SB(1, 0), b3, voffB); PG8_STAGE(PG8_SB(1, 1), b3 + hstep, voffB); PG8_STAGE_A(PG8_SA(1, 0), a3, 0, last);
            PG8_WAIT_V(8); PG8_WAIT_L(0); PG8_BAR; PG8_MMA(1, 0, At, B0); PG8_MMA(1, 1, At, B1); PG8_BAR; PG8_SCHED;
            } else {
            PG8_LDB(B0, 0, 0); PG8_SCHED; PG8_LDA(At, 0, 0); PG8_STAGE(PG8_SA(1, 1), a1 + hstep, voffA);
            PG8_WAIT_L(8); PG8_BAR; PG8_WAIT_L(0); PG8_MMA(0, 0, At, B0); PG8_BAR; PG8_SCHED;
            PG8_LDB(B1, 0, 1); PG8_STAGE(PG8_SB(0, 0), b2, voffB);
            PG8_BAR; PG8_WAIT_L(0); PG8_MMA(0, 1, At, B1); PG8_BAR;
            PG8_LDA(At, 0, 1); PG8_STAGE(PG8_SA(0, 0), a2, voffA);
            PG8_BAR; PG8_WAIT_L(0); PG8_MMA(1, 0, At, B0); PG8_BAR; PG8_SCHED;
            PG8_STAGE(PG8_SB(0, 1), b2 + hstep, voffB);
            PG8_WAIT_V(6); PG8_BAR; PG8_MMA(1, 1, At, B1); PG8_BAR;
            PG8_LDB(B0, 1, 0); PG8_SCHED; PG8_LDA(At, 1, 0); PG8_STAGE(PG8_SA(0, 1), a2 + hstep, voffA);
            PG8_WAIT_L(8); PG8_BAR; PG8_WAIT_L(0); PG8_MMA(0, 0, At, B0); PG8_BAR; PG8_SCHED;
            PG8_LDB(B1, 1, 1); PG8_STAGE(PG8_SB(1, 0), b3, voffB);
            PG8_BAR; PG8_WAIT_L(0); PG8_MMA(0, 1, At, B1); PG8_BAR;
            PG8_LDA(At, 1, 1); PG8_STAGE(PG8_SA(1, 0), a3, voffA);
            PG8_BAR; PG8_WAIT_L(0); PG8_MMA(1, 0, At, B0); PG8_BAR; PG8_SCHED;
            PG8_STAGE(PG8_SB(1, 1), b3 + hstep, voffB);
            PG8_WAIT_V(6); PG8_BAR; PG8_MMA(1, 1, At, B1); PG8_BAR;
            }
        }
        if constexpr (ALIGN_EPI) { if (wr == 0) PG8_BAR; }
        if constexpr (!Epi::AFTER_DRAIN) { E(acc, cur, wr, wc, fr, fq); S.done(cur); }
        if (!has_next) break;
#pragma unroll
        for (int a = 0; a < 2; ++a)
#pragma unroll
            for (int b = 0; b < 2; ++b)
#pragma unroll
                for (int m = 0; m < 4; ++m)
#pragma unroll
                    for (int n = 0; n < 2; ++n) acc[a][b][m][n] = (f32x4){0.f, 0.f, 0.f, 0.f};
        cur = nxt; cA = nA; cB = nB; ++ui;
        if constexpr (GATHER) { vA[0][0] = nvA[0][0]; vA[0][1] = nvA[0][1]; vA[1][0] = nvA[1][0]; vA[1][1] = nvA[1][1]; }
        if constexpr (ALIGN_EPI) { if (wr == 1) PG8_BAR; }
    }
    PG8_WAIT_V(0);
    if constexpr (!ALIGN_EPI) { if (wr == 0) PG8_BAR; }
    PG8_BAR;
    if constexpr (Epi::AFTER_DRAIN) { E.fused(acc, cur, wr, wc, fr, fq, lds, wid, lane); S.done(cur); }
#undef PG8_SA
#undef PG8_SB
#undef PG8_STAGE
#undef PG8_STAGE_A
#undef PG8_GROWS
#undef PG8_LDA
#undef PG8_LDB
#undef PG8_MMA
#undef PG8_WAIT_V
#undef PG8_WAIT_L
#undef PG8_BAR
#undef PG8_SCHED
}
}

constexpr int NWAVES = 8;
#ifndef MK_PER_PHASE
#define MK_PER_PHASE 0
#endif
#ifndef MK_NAIVE_ATTN
#define MK_NAIVE_ATTN 0
#endif
#ifndef DBG_SKIP_ATTN
#define DBG_SKIP_ATTN 0
#endif
#ifndef DBG_SKIP_MOE
#define DBG_SKIP_MOE 0
#endif
#ifndef DBG_SKIP_MIX
#define DBG_SKIP_MIX 0
#endif
#ifndef DBG_CMP_ATT
#define DBG_CMP_ATT 0
#endif
#ifndef DBG_REP
#define DBG_REP -1
#endif
#ifndef DBG_PROBE
#define DBG_PROBE 0
#endif
constexpr int N_PHASES = 14;

constexpr int BATCH = 2, SEQ = 8192, D = 1024, T = BATCH * SEQ;
constexpr int NH = 8, HD = 64, AW = 512, IDXH = 8, IDXD = 64, TOPK = 256;
constexpr int NIN = 5704, NINP = 5888;
constexpr int NEXP = 32, DEXP = 512;
constexpr int XPROWS = 40960;
constexpr float EPS = 1e-6f;
constexpr float LOG2E = 1.4426950408889634f;
constexpr float C2 = 0.125f * LOG2E;

constexpr size_t MiB = 1u << 20;
constexpr size_t WS_CTL = 0, CTL_ZERO_BYTES = 1 * MiB;
constexpr size_t WS_SMALL = 1 * MiB;
constexpr size_t SM_MOD = WS_SMALL + 0;
constexpr size_t SM_WRT = WS_SMALL + 65536;
constexpr size_t SM_EID = WS_SMALL + 262144;
constexpr size_t SM_EWT = WS_SMALL + 393216;
constexpr size_t SM_SLOT = WS_SMALL + 524288;
constexpr size_t SM_AT = WS_SMALL + 655360;
constexpr size_t WS_WIN = 3 * MiB;
constexpr size_t WS_WA = 15 * MiB, WS_WC = 16 * MiB, WS_WOUT = 17 * MiB;
constexpr size_t WS_H1 = 19 * MiB;
constexpr size_t WS_AC = 19 * MiB, WS_ATT = 35 * MiB;
constexpr size_t WS_Q = 51 * MiB, WS_K = 67 * MiB, WS_V = 83 * MiB, WS_MASK = 83 * MiB, WS_VT = 99 * MiB, WS_QI = 115 * MiB, WS_KI = 131 * MiB;
constexpr size_t WS_WI = 133 * MiB, WS_QL = 133 * MiB + 524288;
constexpr size_t WS_CB = 136 * MiB, WS_U = 152 * MiB, WS_TMPC = 136 * MiB, WS_G = 168 * MiB;
constexpr size_t WS_MERGED = 51 * MiB;
constexpr size_t WS_WGU = 51 * MiB, WS_WD = 115 * MiB;
constexpr size_t WS_HID = 147 * MiB;
constexpr size_t WS_Y = 187 * MiB;
constexpr size_t WS_END = DBG_CMP_ATT ? 300 * MiB : 267 * MiB;
constexpr size_t WS_MASK_DBG = 268 * MiB, WS_ATT2 = 284 * MiB;
constexpr int CW_CMP = 2048;
constexpr int CW_TMO = 0, CW_CODE = 1, CW_KMAX = 64, CW_ECNT = 1024  , CW_BAR = 4096, CW_AROW = 131072  ;

constexpr int RING_OFF = 0, RING_BYTES = 131072;
constexpr int LDSCTL_OFF = RING_BYTES, MISC_OFF = LDSCTL_OFF + 320;
constexpr int LDS_BYTES = 147456;

#define GAS __attribute__((address_space(1)))
#define LAS __attribute__((address_space(3)))
typedef unsigned short bf16;
typedef unsigned v4u __attribute__((ext_vector_type(4)));
typedef unsigned v2u __attribute__((ext_vector_type(2)));
typedef float f32x4 __attribute__((ext_vector_type(4)));
typedef short bf16x8 __attribute__((ext_vector_type(8)));
typedef GAS unsigned gu32;
#define RLX_AGENT __ATOMIC_RELAXED, __HIP_MEMORY_SCOPE_AGENT
#define LDS_WAIT() asm volatile("s_waitcnt lgkmcnt(0)" ::: "memory")
#define VM_WAIT() asm volatile("s_waitcnt vmcnt(0)" ::: "memory")
__device__ __forceinline__ unsigned f2bf(float f) { unsigned u = __builtin_bit_cast(unsigned, f); return (u + 0x7fffu + ((u >> 16) & 1u)) >> 16; }
__device__ __forceinline__ unsigned pk2(float lo, float hi) { return f2bf(lo) | (f2bf(hi) << 16); }
__device__ __forceinline__ float bflo(unsigned u) { return __builtin_bit_cast(float, u << 16); }
__device__ __forceinline__ float bfhi(unsigned u) { return __builtin_bit_cast(float, u & 0xffff0000u); }
__device__ __forceinline__ float bf1(bf16 h) { return __builtin_bit_cast(float, (unsigned)h << 16); }
__device__ __forceinline__ float wave_sum(float v) {
#pragma unroll
    for (int o = 1; o < 64; o <<= 1) v += __shfl_xor(v, o);
    return v;
}
#define DPP_F(v, ctrl, row_mask) __builtin_bit_cast(float, __builtin_amdgcn_update_dpp(0, __builtin_bit_cast(int, (v)), (ctrl), (row_mask), 0xf, false))
__device__ __forceinline__ float wave_sum63(float v) {
    v += DPP_F(v, 0x111, 0xf); v += DPP_F(v, 0x112, 0xf); v += DPP_F(v, 0x114, 0xf); v += DPP_F(v, 0x118, 0xf);
    v += DPP_F(v, 0x142, 0xa);
    v += DPP_F(v, 0x143, 0xc);
    return v;
}
__device__ __forceinline__ float wave_sum_all(float v) { return __builtin_bit_cast(float, __builtin_amdgcn_readlane(__builtin_bit_cast(int, wave_sum63(v)), 63)); }
__device__ __forceinline__ float wave_max(float v) {
#pragma unroll
    for (int o = 1; o < 64; o <<= 1) v = fmaxf(v, __shfl_xor(v, o));
    return v;
}

#define XB_TMO      128
#define XB_XCNT(j)  (256  + 64 * (j))
#define XB_XSUB(j)  (1280 + 64 * (j))
#define XB_XGEN(j)  (2304 + 64 * (j))
#define XB_TOP      3328
#define XB_TOPGEN   3392
#define XCD_BAR_WORDS 3456
#define XB_SPIN_CAP (1u << 18)

__device__ __forceinline__ unsigned xb_ld(unsigned* p)              { return __hip_atomic_load(p, __ATOMIC_RELAXED, __HIP_MEMORY_SCOPE_AGENT); }
__device__ __forceinline__ unsigned xb_add(unsigned* p, unsigned v) { return __hip_atomic_fetch_add(p, v, __ATOMIC_RELAXED, __HIP_MEMORY_SCOPE_AGENT); }
__device__ __forceinline__ unsigned xb_xcc_id() { return (unsigned)__builtin_amdgcn_s_getreg((3 << 11) | 20) & 0xFu; }
#define XB_SPIN(cond, bar) do { unsigned _sp = 0; while (cond) { __builtin_amdgcn_s_sleep(1); \
    if ((++_sp & 255u) == 0u) { if (xb_ld(&(bar)[XB_TMO])) break; if (_sp > XB_SPIN_CAP) { atomicAdd(&(bar)[XB_TMO], 1u); break; } } } } while (0)

struct XcdBarrier { unsigned* bar; unsigned x; volatile LAS unsigned* st; };

__device__ __forceinline__ XcdBarrier xcd_barrier_post(unsigned* bar, volatile LAS unsigned* st) {
    XcdBarrier b; b.bar = bar; b.x = xb_xcc_id(); b.st = st;
    if (threadIdx.x == 0) (void)xb_add(&bar[XB_XCNT(b.x)], 1u);
    return b;
}
__device__ __forceinline__ void xcd_barrier_complete(unsigned* bar, unsigned x, unsigned& nloc, unsigned& nx) {
    const unsigned G = gridDim.x * gridDim.y * gridDim.z;
    unsigned sum, cnt, mine, sp = 0u;
    for (;;) {
        sum = 0u; cnt = 0u; mine = 0u;
#pragma unroll
        for (unsigned j = 0; j < 16; ++j) { const unsigned c = xb_ld(&bar[XB_XCNT(j)]); sum += c; cnt += (c > 0u) ? 1u : 0u; mine = (j == x) ? c : mine; }
        if (sum == G) break;
        __builtin_amdgcn_s_sleep(1);
        if ((++sp & 255u) == 0u) { if (xb_ld(&bar[XB_TMO])) break; if (sp > XB_SPIN_CAP) { atomicAdd(&bar[XB_TMO], 1u); break; } }
    }
    nloc = mine > 0u ? mine : 1u; nx = cnt > 0u ? cnt : 1u;
}
__device__ __forceinline__ void xcd_barrier(const XcdBarrier& b, const bool is_t0  ) {
    asm volatile("s_waitcnt vmcnt(0)" ::: "memory");
    __syncthreads();
    if (is_t0) {
        unsigned* bar = b.bar;
        __builtin_amdgcn_s_waitcnt(0);
        unsigned nloc = b.st[0], nx = b.st[1];
        if (nloc == 0u) { xcd_barrier_complete(bar, b.x, nloc, nx); b.st[0] = nloc; b.st[1] = nx; }
        const unsigned old = xb_add(&bar[XB_XSUB(b.x)], 1u);
        const unsigned gen = old / nloc;
        if (old + 1u == (gen + 1u) * nloc) {
            __builtin_amdgcn_fence(__ATOMIC_RELEASE, "agent");
            asm volatile("s_waitcnt vmcnt(0)" ::: "memory");
            const unsigned og = xb_add(&bar[XB_TOP], 1u);
            const unsigned tg = og / nx;
            if (og + 1u == (tg + 1u) * nx) xb_add(&bar[XB_TOPGEN], 1u);
            else XB_SPIN(xb_ld(&bar[XB_TOPGEN]) == tg, bar);
            __builtin_amdgcn_fence(__ATOMIC_ACQUIRE, "agent");
            xb_add(&bar[XB_XGEN(b.x)], 1u);
            asm volatile("s_waitcnt vmcnt(0)" ::: "memory");
        } else {
            XB_SPIN(xb_ld(&bar[XB_XGEN(b.x)]) == gen, bar);
            __builtin_amdgcn_fence(__ATOMIC_ACQUIRE, "agent");
            asm volatile("s_waitcnt vmcnt(0)" ::: "memory");
        }
    }
    __syncthreads();
}

struct Frame {
    LAS unsigned char* lds;
    volatile LAS unsigned* MISC;
    gu32* ctl;
    unsigned char* ws;
    int tid, lane, wave;
    int vcu, G;
    const float *x, *c, *w_ada, *b_ada, *norm1_g, *w_in, *rel_bias, *conv_w, *w_attn, *w_conv, *w_out, *norm2_g, *wrg, *brg, *wre, *bre, *w_gate_e, *w_up_e, *w_down_e, *norm_f_g;
    float* out;
};
#define WSP(T_, off) ((T_*)(F.ws + (off)))

template <class RowMap>
__device__ __forceinline__ void transpose_item(const float* W, int K, int N, bf16* WT, LAS float* scr, int item, int lane, RowMap rm) {
    const int nblk = (N + 31) / 32, kb = item / nblk, nb = item % nblk, k0 = 64 * kb, n0 = 32 * nb;
    const int nn = n0 + (lane & 31);
#pragma unroll 8
    for (int i = 0; i < 32; ++i) { const int kk = 2 * i + (lane >> 5); scr[kk * 33 + (lane & 31)] = (nn < N) ? W[(size_t)(k0 + kk) * N + nn] : 0.f; }
    LDS_WAIT(); asm volatile("" ::: "memory");
    const int c = lane & 7;
#pragma unroll
    for (int j = 0; j < 4; ++j) { const int n = (lane >> 3) + 8 * j; const LAS float* s = scr + (8 * c) * 33 + n;
        v4u o; o.x = pk2(s[0 * 33], s[1 * 33]); o.y = pk2(s[2 * 33], s[3 * 33]); o.z = pk2(s[4 * 33], s[5 * 33]); o.w = pk2(s[6 * 33], s[7 * 33]);
        if (n0 + n < N) *(GAS v4u*)(WT + (size_t)rm(n0 + n) * K + k0 + 8 * c) = o; }
    LDS_WAIT(); asm volatile("" ::: "memory");
}
struct RmId { __device__ __forceinline__ int operator()(int n) const { return n; } };
struct RmWin { __device__ __forceinline__ int operator()(int n) const {
    if (n < 2120) return n;
    if (n < 2632) return n + 184;
    if (n < 3144) { const int j = n - 2632; return 2816 + 256 * (j >> 7) + (j & 127); }
    if (n < 3656) { const int j = n - 3144; return 2816 + 256 * (j >> 7) + 128 + (j & 127); }
    return n + 184; } };
struct RmGU { int half; __device__ __forceinline__ int operator()(int n) const { return 256 * (n >> 7) + 128 * half + (n & 127); } };

__device__ __forceinline__ void p0_prologue(Frame& F) {
    LAS float* scr = (LAS float*)(F.lds + RING_OFF + F.wave * 16384);
    const int gw = F.vcu * NWAVES + F.wave, NGW = F.G * NWAVES;
    if (F.vcu < 96) {
        const int n = F.vcu * 64 + F.lane; float a0 = 0.f, a1 = 0.f;
        LAS float* cact = (LAS float*)(F.lds + RING_OFF + 16384);
        for (int i = F.tid; i < 2 * D; i += 512) { const float cv = F.c[i]; cact[i] = cv / (1.f + __expf(-cv)); }
        __syncthreads();
#pragma unroll 16
        for (int k = F.wave * 128; k < F.wave * 128 + 128; ++k) {
            const float w = F.w_ada[(size_t)k * 6144 + n];
            a0 += cact[k] * w; a1 += cact[D + k] * w;
        }
        LAS float* red = (LAS float*)(F.lds + RING_OFF + 8448);
        red[(F.wave * 2 + 0) * 64 + F.lane] = a0; red[(F.wave * 2 + 1) * 64 + F.lane] = a1;
        __syncthreads();
        if (F.wave < 2) { float s = F.b_ada[n];
#pragma unroll
            for (int w = 0; w < 8; ++w) s += red[(w * 2 + F.wave) * 64 + F.lane];
            WSP(float, SM_MOD)[F.wave * 6144 + n] = s; }
        __syncthreads();
    }
    constexpr int I_IN = 16 * 179, I_A = 8 * 32, I_C = 8 * 32, I_O = 16 * 32;
    constexpr int NITEMS = I_IN + I_A + I_C + I_O;
    for (int it = gw; it < NITEMS; it += NGW) {
        int r = it;
        if (r < I_IN) { transpose_item(F.w_in, D, NIN, WSP(bf16, WS_WIN), scr, r, F.lane, RmWin()); continue; } r -= I_IN;
        if (r < I_A) { transpose_item(F.w_attn, AW, D, WSP(bf16, WS_WA), scr, r, F.lane, RmId()); continue; } r -= I_A;
        if (r < I_C) { transpose_item(F.w_conv, AW, D, WSP(bf16, WS_WC), scr, r, F.lane, RmId()); continue; } r -= I_C;
        transpose_item(F.w_out, D, D, WSP(bf16, WS_WOUT), scr, r, F.lane, RmId());
    }
    for (int i = gw * 64 + F.lane; i < 184 * 128; i += NGW * 64) { *(GAS v4u*)(WSP(bf16, WS_WIN) + (size_t)2120 * D + (size_t)i * 8) = (v4u){0u, 0u, 0u, 0u}; }
    for (int i = gw * 64 + F.lane; i < 36 * D; i += NGW * 64) { const int n = i / D, k = i % D; WSP(float, SM_WRT)[i] = (n < 4) ? F.wrg[k * 4 + n] : F.wre[k * 32 + (n - 4)]; }
}

__device__ __forceinline__ void p1_norm1(Frame& F) {
    const int gw = F.vcu * NWAVES + F.wave, NGW = F.G * NWAVES;
    const float* mod = WSP(float, SM_MOD);
    for (int m0 = gw * 4; m0 < T; m0 += NGW * 4) {
        const int b = m0 / SEQ;
        f32x4 v[4][4]; float ss[4];
#pragma unroll
        for (int r = 0; r < 4; ++r) { const GAS f32x4* xr = (const GAS f32x4*)(F.x + (size_t)(m0 + r) * D) + F.lane;
#pragma unroll
            for (int j = 0; j < 4; ++j) v[r][j] = xr[64 * j]; }
#pragma unroll
        for (int r = 0; r < 4; ++r) { float s = 0.f;
#pragma unroll
            for (int j = 0; j < 4; ++j) s += (v[r][j].x * v[r][j].x + v[r][j].y * v[r][j].y) + (v[r][j].z * v[r][j].z + v[r][j].w * v[r][j].w);
            ss[r] = 1.f / sqrtf(wave_sum_all(s) * (1.f / D) + EPS); }
#pragma unroll
        for (int j = 0; j < 4; ++j) { const int k = 4 * F.lane + 256 * j;
            const f32x4 g = *(const f32x4*)(F.norm1_g + k), sc = *(const f32x4*)(mod + b * 6144 + 1024 + k), sh = *(const f32x4*)(mod + b * 6144 + k);
            const f32x4 ca = g * (sc + 1.0f);
#pragma unroll
            for (int r = 0; r < 4; ++r) { const f32x4 h = v[r][j] * ss[r] * ca + sh; ((GAS v2u*)(WSP(bf16, WS_H1) + (size_t)(m0 + r) * D) + F.lane)[64 * j] = (v2u){pk2(h.x, h.y), pk2(h.z, h.w)}; } }
    }
}

using pg8::Unit;
typedef float f32x2_t __attribute__((ext_vector_type(2))); typedef __bf16 bf16x2_t __attribute__((ext_vector_type(2)));
__device__ __forceinline__ unsigned cvtpk(float lo, float hi) { f32x2_t v = {lo, hi}; bf16x2_t b = __builtin_convertvector(v, bf16x2_t); return __builtin_bit_cast(unsigned, b); }
__device__ __forceinline__ v4u pack8(const f32x4 a, const f32x4 b) { v4u w; w.x = cvtpk(a[0], a[1]); w.y = cvtpk(a[2], a[3]); w.z = cvtpk(b[0], b[1]); w.w = cvtpk(b[2], b[3]); return w; }
__device__ __forceinline__ float sigmoidf_(float x) { return __builtin_amdgcn_rcpf(1.f + __builtin_amdgcn_exp2f(-x * LOG2E)); }
__device__ __forceinline__ f32x4 sig4(f32x4 v) { return (f32x4){sigmoidf_(v[0]), sigmoidf_(v[1]), sigmoidf_(v[2]), sigmoidf_(v[3])}; }
__device__ __forceinline__ void unpack8(const v4u w, f32x4& a, f32x4& b) { a = (f32x4){bflo(w.x), bfhi(w.x), bflo(w.y), bfhi(w.y)}; b = (f32x4){bflo(w.z), bfhi(w.z), bflo(w.w), bfhi(w.w)}; }

struct EpiProj {
    static constexpr bool PERM = true, AFTER_DRAIN = false;
    bf16 *Q, *K, *V, *QI, *KI, *CB, *U, *G; float* WI;
    __device__ __forceinline__ void operator()(const f32x4 (&acc)[2][2][4][2], const Unit& u, int wr, int wc, int fr, int fq) const {
        const int pn = u.pn, row0 = u.pm * 256 + wr * 64 + fr, cb8 = wc * 32 + 8 * fq;
        if (pn < 8 || pn == 9 || pn == 10) {
            bf16* base; int coff; float sc = 1.f;
            if (pn < 2) { base = Q; coff = 256 * pn; sc = C2; } else if (pn < 4) { base = K; coff = 256 * (pn - 2); } else if (pn < 6) { base = V; coff = 256 * (pn - 4); }
            else if (pn < 8) { base = QI; coff = 256 * (pn - 6); } else { base = CB; coff = 256 * (pn - 9); }
#pragma unroll
            for (int ai = 0; ai < 2; ++ai)
#pragma unroll
                for (int m = 0; m < 4; ++m) { bf16* rowp = base + (size_t)(row0 + ai * 128 + m * 16) * 512 + coff + cb8;
#pragma unroll
                    for (int bj = 0; bj < 2; ++bj) *(v4u*)(rowp + bj * 128) = pack8(acc[ai][bj][m][0] * sc, acc[ai][bj][m][1] * sc); }
        } else if (pn == 8) {
#pragma unroll
            for (int ai = 0; ai < 2; ++ai)
#pragma unroll
                for (int m = 0; m < 4; ++m) { const size_t row = (size_t)(row0 + ai * 128 + m * 16);
                    if (wc < 2) *(v4u*)(KI + row * 64 + cb8) = pack8(acc[ai][0][m][0], acc[ai][0][m][1]);
                    else if (wc == 2 && fq == 0) { *(f32x4*)(WI + row * 8) = acc[ai][0][m][0]; *(f32x4*)(WI + row * 8 + 4) = acc[ai][0][m][1]; } }
        } else if (pn < 15) {
#pragma unroll
            for (int ai = 0; ai < 2; ++ai)
#pragma unroll
                for (int m = 0; m < 4; ++m) { const size_t row = (size_t)(row0 + ai * 128 + m * 16);
                    *(v4u*)(U + row * 512 + 128 * (pn - 11) + cb8) = pack8(acc[ai][0][m][0] * acc[ai][1][m][0], acc[ai][0][m][1] * acc[ai][1][m][1]); }
        } else {
#pragma unroll
            for (int ai = 0; ai < 2; ++ai)
#pragma unroll
                for (int m = 0; m < 4; ++m) { bf16* rowp = G + (size_t)(row0 + ai * 128 + m * 16) * 2048 + 256 * (pn - 15) + cb8;
#pragma unroll
                    for (int bj = 0; bj < 2; ++bj) *(v4u*)(rowp + bj * 128) = pack8(sig4(acc[ai][bj][m][0]), sig4(acc[ai][bj][m][1])); }
        }
    }
};
struct EpiConv {
    static constexpr bool PERM = true, AFTER_DRAIN = false;
    const bf16* G; bf16* O;
    __device__ __forceinline__ void operator()(const f32x4 (&acc)[2][2][4][2], const Unit& u, int wr, int wc, int fr, int fq) const {
        const int row0 = u.pm * 256 + wr * 64 + fr, col0 = u.pn * 256 + wc * 32 + 8 * fq;
#pragma unroll
        for (int ai = 0; ai < 2; ++ai)
#pragma unroll
            for (int m = 0; m < 4; ++m) { const size_t row = (size_t)(row0 + ai * 128 + m * 16);
#pragma unroll
                for (int bj = 0; bj < 2; ++bj) { f32x4 g0, g1; unpack8(*(const v4u*)(G + row * 2048 + 1024 + col0 + bj * 128), g0, g1);
                    *(v4u*)(O + row * 1024 + col0 + bj * 128) = pack8(g0 * acc[ai][bj][m][0], g1 * acc[ai][bj][m][1]); } }
    }
};
struct EpiAttn {
    static constexpr bool PERM = true, AFTER_DRAIN = false;
    const bf16* G; const bf16* Tc; bf16* O;
    __device__ __forceinline__ void operator()(const f32x4 (&acc)[2][2][4][2], const Unit& u, int wr, int wc, int fr, int fq) const {
        const int row0 = u.pm * 256 + wr * 64 + fr, col0 = u.pn * 256 + wc * 32 + 8 * fq;
#pragma unroll
        for (int ai = 0; ai < 2; ++ai)
#pragma unroll
            for (int m = 0; m < 4; ++m) { const size_t row = (size_t)(row0 + ai * 128 + m * 16);
#pragma unroll
                for (int bj = 0; bj < 2; ++bj) { f32x4 g0, g1, t0, t1; unpack8(*(const v4u*)(G + row * 2048 + col0 + bj * 128), g0, g1); unpack8(*(const v4u*)(Tc + row * 1024 + col0 + bj * 128), t0, t1);
                    *(v4u*)(O + row * 1024 + col0 + bj * 128) = pack8(g0 * acc[ai][bj][m][0] + t0, g1 * acc[ai][bj][m][1] + t1); } }
    }
};
struct EpiOut {
    static constexpr bool PERM = false, AFTER_DRAIN = false;
    const float* X; const float* mod; float* O;
    __device__ __forceinline__ void operator()(const f32x4 (&acc)[2][2][4][2], const Unit& u, int wr, int wc, int fr, int fq) const {
        const int row0 = u.pm * 256 + wr * 64 + fr, col0 = u.pn * 256 + wc * 32 + 4 * fq;
        const float* g1 = mod + ((u.pm * 256) / SEQ) * 6144 + 2048;
#pragma unroll
        for (int bj = 0; bj < 2; ++bj)
#pragma unroll
            for (int n = 0; n < 2; ++n) { const int col = col0 + bj * 128 + n * 16; const f32x4 gv = *(const f32x4*)(g1 + col);
#pragma unroll
                for (int ai = 0; ai < 2; ++ai)
#pragma unroll
                    for (int m = 0; m < 4; ++m) { const size_t off = (size_t)(row0 + ai * 128 + m * 16) * D + col;
                        *(f32x4*)(O + off) = *(const f32x4*)(X + off) + gv * acc[ai][bj][m][n]; } }
    }
};
__device__ __forceinline__ f32x4 silu_mul4(f32x4 g, f32x4 u) { return (f32x4){g[0] * sigmoidf_(g[0]) * u[0], g[1] * sigmoidf_(g[1]) * u[1], g[2] * sigmoidf_(g[2]) * u[2], g[3] * sigmoidf_(g[3]) * u[3]}; }
struct EpiHid {
    static constexpr bool PERM = true, AFTER_DRAIN = false;
    bf16* O;
    __device__ __forceinline__ void operator()(const f32x4 (&acc)[2][2][4][2], const Unit& u, int wr, int wc, int fr, int fq) const {
        const int row0 = u.pm * 256 + wr * 64 + fr, col0 = 128 * (u.pn & 3) + wc * 32 + 8 * fq;
#pragma unroll
        for (int ai = 0; ai < 2; ++ai)
#pragma unroll
            for (int m = 0; m < 4; ++m) { const size_t row = (size_t)(row0 + ai * 128 + m * 16);
                *(v4u*)(O + row * 512 + col0) = pack8(silu_mul4(acc[ai][0][m][0], acc[ai][1][m][0]), silu_mul4(acc[ai][0][m][1], acc[ai][1][m][1])); }
    }
};
struct EpiY {
    static constexpr bool PERM = true, AFTER_DRAIN = false;
    bf16* O;
    __device__ __forceinline__ void operator()(const f32x4 (&acc)[2][2][4][2], const Unit& u, int wr, int wc, int fr, int fq) const {
        const int row0 = u.pm * 256 + wr * 64 + fr, col0 = 256 * (u.pn & 3) + wc * 32 + 8 * fq;
#pragma unroll
        for (int ai = 0; ai < 2; ++ai)
#pragma unroll
            for (int m = 0; m < 4; ++m) { const size_t row = (size_t)(row0 + ai * 128 + m * 16);
#pragma unroll
                for (int bj = 0; bj < 2; ++bj) *(v4u*)(O + row * 1024 + col0 + bj * 128) = pack8(acc[ai][bj][m][0], acc[ai][bj][m][1]); }
    }
};
struct MoeOrder {
    const LAS int* tile_e; int ntiles, G, c;
    __device__ __forceinline__ bool next(int i, Unit& u) const {
        const int L = i * G + c; if (L >= ntiles * 4) return false;
        const int rt = L >> 2, j = L & 3; u.pm = rt; u.pn = 4 * tile_e[rt] + j; return true; }
    __device__ __forceinline__ void a_ready(const Unit&) const {}
    __device__ __forceinline__ void done(const Unit&) const {}
};

__device__ __forceinline__ void p3_prep(Frame& F) {
    const int gw = F.vcu * NWAVES + F.wave, NGW = F.G * NWAVES;
    {
        LAS bf16* tl = (LAS bf16*)(F.lds + RING_OFF + F.wave * 16384);
        const bf16* V = WSP(bf16, WS_V); bf16* VT = WSP(bf16, WS_VT);
        for (int it = gw; it < BATCH * NH * (SEQ / 64); it += NGW) {
            const int kt = it % (SEQ / 64), h = (it / (SEQ / 64)) % NH, b = it / (NH * (SEQ / 64));
            const bf16* src = V + (size_t)(b * SEQ + kt * 64 + F.lane) * 512 + h * 64;
#pragma unroll
            for (int c = 0; c < 8; ++c) { const v4u w = *(const v4u*)(src + c * 8);
                LAS unsigned* d = (LAS unsigned*)(tl + F.lane * 66 + c * 8); d[0] = w.x; d[1] = w.y; d[2] = w.z; d[3] = w.w; }
            LDS_WAIT(); asm volatile("" ::: "memory");
            unsigned o[32];
#pragma unroll
            for (int p = 0; p < 64; p += 2) {
                const int i0 = p & 15, i1 = (p + 1) & 15, g = p & ~15;
                const int k0 = g + ((i0 < 4 || i0 >= 12) ? i0 : (i0 < 8 ? i0 + 4 : i0 - 4)), k1 = g + ((i1 < 4 || i1 >= 12) ? i1 : (i1 < 8 ? i1 + 4 : i1 - 4));
                o[p >> 1] = (unsigned)tl[k0 * 66 + F.lane] | ((unsigned)tl[k1 * 66 + F.lane] << 16); }
            bf16* dst = VT + ((size_t)((b * NH + h) * 64 + F.lane)) * SEQ + kt * 64;
#pragma unroll
            for (int c = 0; c < 8; ++c) *(v4u*)(dst + c * 8) = (v4u){o[4 * c], o[4 * c + 1], o[4 * c + 2], o[4 * c + 3]};
            LDS_WAIT(); asm volatile("" ::: "memory");
        }
    }
    {
        const bf16* CB = WSP(bf16, WS_CB); const bf16* U = WSP(bf16, WS_U); bf16* AC = WSP(bf16, WS_AC);
        for (int i = (gw * 64 + F.lane); i < T * 64; i += NGW * 64) {
            const int t = i >> 6, j = (i & 63) * 8, tt = t % SEQ;
            f32x4 c0, c1, u0, u1, a0, a1;
            unpack8(*(const v4u*)(CB + (size_t)t * 512 + j), c0, c1);
            unpack8(*(const v4u*)(U + (size_t)t * 512 + j), u0, u1);
            a0 = u0 * *(const f32x4*)(F.conv_w + 1024 + j); a1 = u1 * *(const f32x4*)(F.conv_w + 1024 + j + 4);
            if (tt >= 1) { unpack8(*(const v4u*)(U + (size_t)(t - 1) * 512 + j), u0, u1); a0 += u0 * *(const f32x4*)(F.conv_w + 512 + j); a1 += u1 * *(const f32x4*)(F.conv_w + 512 + j + 4); }
            if (tt >= 2) { unpack8(*(const v4u*)(U + (size_t)(t - 2) * 512 + j), u0, u1); a0 += u0 * *(const f32x4*)(F.conv_w + j); a1 += u1 * *(const f32x4*)(F.conv_w + j + 4); }
            *(v4u*)(AC + (size_t)t * 512 + j) = pack8(c0 * a0, c1 * a1);
        }
    }
    {
        const bf16* QI = WSP(bf16, WS_QI); const float* WI = WSP(float, WS_WI); bf16* QL = WSP(bf16, WS_QL); float* AT = WSP(float, SM_AT);
        for (int t = gw; t < T; t += NGW) {
            float ql = 0.f, a = 0.f; float vv[8], ww[8];
#pragma unroll
            for (int h = 0; h < 8; ++h) { ww[h] = WI[(size_t)t * 8 + h]; vv[h] = bf1(QI[(size_t)t * 512 + h * 64 + F.lane]); }
#pragma unroll
            for (int h = 0; h < 8; ++h) { ql += ww[h] * vv[h]; a += fabsf(ww[h]) * sqrtf(wave_sum63(vv[h] * vv[h])); }
            QL[(size_t)t * 64 + F.lane] = (bf16)f2bf(ql);
            if (F.lane == 63) AT[t] = a;
        }
    }
    {
        const bf16* KI = WSP(bf16, WS_KI); float mx = 0.f;
        for (int s = gw * 64 + F.lane; s < T; s += NGW * 64) { float q = 0.f;
#pragma unroll
            for (int c = 0; c < 8; ++c) { f32x4 a, b; unpack8(*(const v4u*)(KI + (size_t)s * 64 + c * 8), a, b); q += (a[0] * a[0] + a[1] * a[1]) + (a[2] * a[2] + a[3] * a[3]) + (b[0] * b[0] + b[1] * b[1]) + (b[2] * b[2] + b[3] * b[3]); }
            mx = fmaxf(mx, q); }
        mx = wave_max(mx);
        if (F.lane == 0) atomicMax((unsigned*)(F.ctl + CW_KMAX), __builtin_bit_cast(unsigned, sqrtf(mx)));
    }
}

__device__ __forceinline__ unsigned ord_key(float x) { if (x == 0.f) x = 0.f; const unsigned u = __builtin_bit_cast(unsigned, x); return (u & 0x80000000u) ? ~u : (u | 0x80000000u); }
__device__ __forceinline__ int t5_bucket(int n) {
    if (n < 16) return n;
    const int v = 16 + (int)(logf((float)n / 16.f) / 2.0794415416798357f * 16.f);
    return v < 31 ? v : 31;
}
__device__ __forceinline__ void pn_naive_dsa(Frame& F) {
    LAS float* sc = (LAS float*)(F.lds + RING_OFF);
    LAS float* qf = (LAS float*)(F.lds + RING_OFF + 32768);
    LAS float* wq = qf + 512;
    LAS unsigned* hist = (LAS unsigned*)(F.lds + RING_OFF + 36864);
    LAS int* sel = (LAS int*)(F.lds + RING_OFF + 40960);
    LAS float* pbuf = (LAS float*)(F.lds + RING_OFF + 45056);
    LAS int* wcnt = (LAS int*)(F.lds + RING_OFF + 53248);
    LAS int* bkt = (LAS int*)(F.lds + RING_OFF + 53248 + 256);
    const bf16* QI = WSP(bf16, WS_QI); const bf16* KI = WSP(bf16, WS_KI); const float* WI = WSP(float, WS_WI);
    const bf16* Qb = WSP(bf16, WS_Q); const bf16* Kb = WSP(bf16, WS_K); const bf16* Vb = WSP(bf16, WS_V); bf16* ATT = WSP(bf16, WS_ATT);
    if (F.tid < 128) bkt[F.tid] = t5_bucket(F.tid);
    __syncthreads();
    for (int qi_ = 0; qi_ < T / F.G + 1; ++qi_) {
        const int qidx = qi_ * F.G + F.vcu; if (qidx >= T) break;
        const int b = qidx / SEQ, t = qidx % SEQ, n = t + 1;
        qf[F.tid] = bf1(QI[(size_t)qidx * 512 + F.tid]);
        if (F.tid < 8) wq[F.tid] = WI[(size_t)qidx * 8 + F.tid];
        __syncthreads();
        for (int s = F.tid; s < n; s += 512) {
            float kf[64]; const bf16* kr = KI + (size_t)(b * SEQ + s) * 64;
#pragma unroll
            for (int c = 0; c < 8; ++c) { f32x4 a, bb; unpack8(*(const v4u*)(kr + c * 8), a, bb); kf[8 * c] = a[0]; kf[8 * c + 1] = a[1]; kf[8 * c + 2] = a[2]; kf[8 * c + 3] = a[3]; kf[8 * c + 4] = bb[0]; kf[8 * c + 5] = bb[1]; kf[8 * c + 6] = bb[2]; kf[8 * c + 7] = bb[3]; }
            float score = 0.f;
#pragma unroll 1
            for (int h = 0; h < 8; ++h) { float dsum = 0.f;
#pragma unroll
                for (int d4 = 0; d4 < 16; ++d4) { const f32x4 q4 = *(const LAS f32x4*)(qf + h * 64 + d4 * 4); dsum += q4[0] * kf[4 * d4] + q4[1] * kf[4 * d4 + 1] + q4[2] * kf[4 * d4 + 2] + q4[3] * kf[4 * d4 + 3]; }
                score += wq[h] * fmaxf(dsum, 0.f); }
            sc[s] = score;
        }
        __syncthreads();
        unsigned prefix = 0u, pmask = 0u; int need = TOPK;
        if (n > TOPK) {
            for (int pass = 0; pass < 4; ++pass) {
                const int shift = 24 - 8 * pass;
                if (F.tid < 256) hist[F.tid] = 0u;
                __syncthreads();
                for (int s = F.tid; s < n; s += 512) { const unsigned u = ord_key(sc[s]); if ((u & pmask) == prefix) atomicAdd((unsigned*)&hist[(u >> shift) & 255u], 1u); }
                __syncthreads();
                if (F.wave == 0) {
                    int c4[4]; int tot = 0;
#pragma unroll
                    for (int j = 0; j < 4; ++j) { c4[j] = (int)hist[4 * F.lane + j]; tot += c4[j]; }
                    int incl = tot;
#pragma unroll
                    for (int o = 1; o < 64; o <<= 1) { const int v = __shfl_down(incl, o); if (F.lane + o < 64) incl += v; }
                    const int above = incl - tot;
                    if (above < need && need <= incl) { int run = above;
#pragma unroll
                        for (int j = 3; j >= 0; --j) { if (run < need && need <= run + c4[j]) { wcnt[16] = 4 * F.lane + j; wcnt[17] = need - run; } run += c4[j]; } }
                }
                __syncthreads();
                prefix |= (unsigned)wcnt[16] << shift; pmask |= 255u << shift; need = wcnt[17];
                __syncthreads();
            }
        }
        int cg = 0, ce = 0;
        for (int i = 0; i < 16; ++i) { const int s = F.wave * 1024 + i * 64 + F.lane; bool gt = false, eq = false;
            if (s < n) { if (n <= TOPK) gt = true; else { const unsigned u = ord_key(sc[s]); gt = u > prefix; eq = (u == prefix); } }
            cg += __popcll(__ballot(gt)); ce += __popcll(__ballot(eq)); }
        if (F.lane == 0) { wcnt[2 * F.wave] = cg; wcnt[2 * F.wave + 1] = ce; }
        __syncthreads();
        int eqb = 0, tkb = 0, nsel = 0;
        { int eq_before = 0;
          for (int w = 0; w < 8; ++w) { const int g = wcnt[2 * w], e = wcnt[2 * w + 1];
              int take_e = need - eq_before; take_e = take_e < 0 ? 0 : (take_e > e ? e : take_e); if (n <= TOPK) take_e = 0;
              if (w < F.wave) { eqb += e; tkb += g + take_e; }
              nsel += g + take_e; eq_before += e; } }
        for (int i = 0; i < 16; ++i) { const int s = F.wave * 1024 + i * 64 + F.lane; bool gt = false, eq = false;
            if (s < n) { if (n <= TOPK) gt = true; else { const unsigned u = ord_key(sc[s]); gt = u > prefix; eq = (u == prefix); } }
            const unsigned long long mg = __ballot(gt), me = __ballot(eq), lt = (1ull << F.lane) - 1ull;
            const int erank = eqb + __popcll(me & lt);
            const bool take = gt || (eq && erank < need);
            const unsigned long long mt = __ballot(take);
            if (take) sel[tkb + __popcll(mt & lt)] = s;
            eqb += __popcll(me); tkb += __popcll(mt); (void)mg; }
        __syncthreads();
        {
            const int h = F.wave;
            qf[F.tid] = bf1(Qb[(size_t)qidx * 512 + F.tid]);
            __syncthreads();
            float lg[4]; float mx = -INFINITY;
#pragma unroll
            for (int i = 0; i < 4; ++i) { const int j = F.lane + 64 * i; lg[i] = -INFINITY;
                if (j < nsel) { const int s = sel[j]; const bf16* kr = Kb + (size_t)(b * SEQ + s) * 512 + h * 64; float dsum = 0.f;
#pragma unroll
                    for (int c = 0; c < 8; ++c) { f32x4 a, bb; unpack8(*(const v4u*)(kr + c * 8), a, bb); const f32x4 q0 = *(const LAS f32x4*)(qf + h * 64 + c * 8), q1 = *(const LAS f32x4*)(qf + h * 64 + c * 8 + 4);
                        dsum += (q0[0] * a[0] + q0[1] * a[1]) + (q0[2] * a[2] + q0[3] * a[3]) + (q1[0] * bb[0] + q1[1] * bb[1]) + (q1[2] * bb[2] + q1[3] * bb[3]); }
                    const int dist = t - s; const int bk = dist < 128 ? bkt[dist] : 31;
                    lg[i] = dsum + F.rel_bias[bk * 8 + h] * LOG2E; mx = fmaxf(mx, lg[i]); } }
            mx = wave_max(mx); float sum = 0.f;
#pragma unroll
            for (int i = 0; i < 4; ++i) { const int j = F.lane + 64 * i; const float p = (j < nsel) ? __builtin_amdgcn_exp2f(lg[i] - mx) : 0.f; sum += p; pbuf[h * 256 + j] = p; }
            sum = wave_sum(sum);
            LDS_WAIT(); asm volatile("" ::: "memory");
            float o = 0.f;
            for (int j = 0; j < nsel; ++j) o += pbuf[h * 256 + j] * bf1(Vb[(size_t)(b * SEQ + sel[j]) * 512 + h * 64 + F.lane]);
            ATT[(size_t)qidx * 512 + h * 64 + F.lane] = (bf16)f2bf(o / sum);
        }
        __syncthreads();
    }
}


typedef float f32x16 __attribute__((ext_vector_type(16)));
#define MFMA32(a, b, c) __builtin_amdgcn_mfma_f32_32x32x16_bf16((a), (b), (c), 0, 0, 0)
__device__ __forceinline__ int crow(int r, int hi) { return (r & 3) + 8 * (r >> 2) + 4 * hi; }
constexpr int IDX_CTL = LDSCTL_OFF + 2048;
constexpr int IDX_CAP = 512;

#define MFMA16(a, b, c) __builtin_amdgcn_mfma_f32_16x16x32_bf16((a), (b), (c), 0, 0, 0)
__device__ __forceinline__ void idx_tile(const bf16x8 (&kf)[4][2], const bf16x8 (&ql)[2], const bf16x8 (&qf)[8][2], const LAS float* w  , float invA, unsigned (&key)[4][4]) {
    float sc[4][4];
#define IDX_MF(D, QF0, QF1) _Pragma("unroll") for (int a = 0; a < 2; ++a) { D[a] = (f32x4){0.f, 0.f, 0.f, 0.f}; D[a] = MFMA16(kf[2 * hf + a][0], QF0, D[a]); D[a] = MFMA16(kf[2 * hf + a][1], QF1, D[a]); }
#define IDX_AC(D, W) do { const float wv_ = (W); _Pragma("unroll") for (int a = 0; a < 2; ++a) _Pragma("unroll") for (int i = 0; i < 4; ++i) { float x_ = __builtin_fmaf(wv_, __builtin_fabsf(D[a][i]), sc[2 * hf + a][i]); asm volatile("" : "+v"(x_)); sc[2 * hf + a][i] = x_; } } while (0)
#pragma unroll
    for (int hf = 0; hf < 2; ++hf) {
        f32x4 dA[2], dB[2];
        IDX_MF(dA, ql[0], ql[1]);
        IDX_MF(dB, qf[0][0], qf[0][1]);
#pragma unroll
        for (int a = 0; a < 2; ++a)
#pragma unroll
            for (int i = 0; i < 4; ++i) { float x_ = dA[a][i]; asm volatile("" : "+v"(x_)); sc[2 * hf + a][i] = x_; }
        IDX_MF(dA, qf[1][0], qf[1][1]); IDX_AC(dB, w[0]);
        IDX_MF(dB, qf[2][0], qf[2][1]); IDX_AC(dA, w[1]);
        IDX_MF(dA, qf[3][0], qf[3][1]); IDX_AC(dB, w[2]);
        IDX_MF(dB, qf[4][0], qf[4][1]); IDX_AC(dA, w[3]);
        IDX_MF(dA, qf[5][0], qf[5][1]); IDX_AC(dB, w[4]);
        IDX_MF(dB, qf[6][0], qf[6][1]); IDX_AC(dA, w[5]);
        IDX_MF(dA, qf[7][0], qf[7][1]); IDX_AC(dB, w[6]);
        IDX_AC(dA, w[7]);
    }
#undef IDX_MF
#undef IDX_AC
#pragma unroll
    for (int a = 0; a < 4; ++a)
#pragma unroll
        for (int i = 0; i < 4; ++i) key[a][i] = __builtin_bit_cast(unsigned, __builtin_fmaf(sc[a][i], invA, 3.0f)) & 0x7ffffeu;
}
__device__ __forceinline__ void idx_load_k(bf16x8 (&kf)[4][2], const bf16* KItile  , unsigned voff  ) {
#pragma unroll
    for (int a = 0; a < 4; ++a)
#pragma unroll
        for (int ks = 0; ks < 2; ++ks) kf[a][ks] = *(const bf16x8*)((const char*)KItile + voff + a * 2048 + ks * 64);
}
template <int MODE>
__device__ __forceinline__ void idx_pass(Frame& F, int ln, const bf16* KIb, unsigned* MASKg, int t0, int nt_idx, int nt_att, const bf16x8 (&ql)[2], const bf16x8 (&qf)[8][2], const LAS float* w, float invA, int b1, unsigned thr) {
    const int qc = ln & 15, fq = ln >> 4, qh = F.wave & 1, kp = F.wave >> 1, ql_ = 16 * qh + qc, t = t0 + ql_;
    LAS unsigned* hrow = (LAS unsigned*)(F.lds + RING_OFF) + ql_ * 1025;
    const int ntl = (MODE >= 2) ? nt_att : nt_idx;
    LAS unsigned* mlds = (LAS unsigned*)(F.lds + RING_OFF);
    LAS unsigned* clist = (LAS unsigned*)(F.lds + RING_OFF + 32768);
    LAS unsigned* ccnt = (LAS unsigned*)(F.lds + IDX_CTL) + 96;
    bf16x8 kcur[4][2];
    const unsigned voff = (unsigned)(qc * 64 + fq * 8) * 2u;
#pragma unroll
    for (int a = 0; a < 4; ++a)
#pragma unroll
        for (int ks = 0; ks < 2; ++ks) kcur[a][ks] = (bf16x8){0, 0, 0, 0, 0, 0, 0, 0};
    if (kp < nt_idx) idx_load_k(kcur, KIb + (size_t)(64 * kp) * 64, voff);
    for (int kt = kp; kt < ntl; kt += 4) {
        unsigned m16 = 0u;
        if (kt < nt_idx) {
            unsigned key[4][4];
            const bool diag = 64 * kt + 63 > t0;
            idx_tile(kcur, ql, qf, w, invA, key);
            if (kt + 4 < nt_idx) idx_load_k(kcur, KIb + (size_t)(64 * (kt + 4)) * 64, voff);
#pragma unroll
            for (int a = 0; a < 4; ++a)
#pragma unroll
                for (int i = 0; i < 4; ++i) {
                    const int s = 64 * kt + 16 * a + 4 * fq + i; const bool valid = diag ? (s <= t) : true; const unsigned k23 = key[a][i];
                    if (MODE == 0) { const unsigned bin = k23 >> 12; __hip_atomic_fetch_add(hrow + (bin & 1023u), valid ? ((bin & 1024u) ? 65536u : 1u) : 0u, __ATOMIC_RELAXED, __HIP_MEMORY_SCOPE_WORKGROUP); }
                    else if (MODE == 1) { const unsigned bin = (k23 >> 1) & 2047u; __hip_atomic_fetch_add(hrow + (bin & 1023u), (valid && (int)(k23 >> 12) == b1) ? ((bin & 1024u) ? 65536u : 1u) : 0u, __ATOMIC_RELAXED, __HIP_MEMORY_SCOPE_WORKGROUP); }
                    else if (MODE == 2) { if (valid && (k23 >> 1) >= thr) m16 |= 1u << (4 * a + i); }
                    else { const int bin1 = (int)(k23 >> 12);
                        if (valid && bin1 > b1) m16 |= 1u << (4 * a + i);
                        if (valid && bin1 == b1) { const unsigned pos = __hip_atomic_fetch_add(ccnt + ql_, 1u, __ATOMIC_RELAXED, __HIP_MEMORY_SCOPE_WORKGROUP);
                            if (pos < (unsigned)IDX_CAP) clist[ql_ * IDX_CAP + pos] = (((k23 >> 1) & 2047u) << 18) | ((unsigned)(kt * 64 + (fq & 1) * 32 + ql_) << 5) | (unsigned)(8 * a + 4 * (fq >> 1) + i); } }
                }
        }
        if (MODE >= 2) {
            unsigned word = ((m16 & 0xFu) | ((m16 & 0xF0u) << 4) | ((m16 & 0xF00u) << 8) | ((m16 & 0xF000u) << 12)) << (4 * (fq >> 1));
            word |= (unsigned)__shfl_xor((int)word, 32);
            if (ln < 32) { if (MODE == 2) MASKg[(size_t)kt * 64 + fq * 32 + ql_] = word; else mlds[kt * 64 + fq * 32 + ql_] = word; }
        }
    }
}
template <int LEVEL>
__device__ __forceinline__ void idx_scan(Frame& F, int ln) {
    LAS unsigned* hist = (LAS unsigned*)(F.lds + RING_OFF);
    LAS int* ctl = (LAS int*)(F.lds + IDX_CTL);
#pragma unroll 1
    for (int qi = 0; qi < 4; ++qi) {
        const int q = 4 * F.wave + qi;
        int need = (LEVEL == 0) ? TOPK : TOPK - ctl[32 + q];
        unsigned wv[16]; int toth = 0, totl = 0;
#pragma unroll
        for (int j = 0; j < 16; ++j) { wv[j] = hist[q * 1025 + 16 * ln + j]; toth += (int)(wv[j] >> 16); totl += (int)(wv[j] & 0xffffu); }
        int inclh = toth, incll = totl;
#pragma unroll
        for (int o = 1; o < 64; o <<= 1) { const int vh = __shfl_down(inclh, o), vl = __shfl_down(incll, o); if (ln + o < 64) { inclh += vh; incll += vl; } }
        const int allh = __shfl(inclh, 0);
        { const int above = inclh - toth;
          if (above < need && need <= inclh) { int run = above, B = 0, cab = 0; bool found = false;
#pragma unroll
              for (int j = 15; j >= 0; --j) { const int ch = (int)(wv[j] >> 16); if (!found && need <= run + ch) { found = true; B = 1024 + 16 * ln + j; cab = run; } run += ch; }
              if (LEVEL == 0) { ctl[q] = B; ctl[32 + q] = cab; } else ctl[64 + q] = (ctl[q] << 11) | B; } }
        { const int above = allh + incll - totl;
          if (allh < need && above < need && need <= allh + incll) { int run = above, B = 0, cab = 0; bool found = false;
#pragma unroll
              for (int j = 15; j >= 0; --j) { const int cl = (int)(wv[j] & 0xffffu); if (!found && need <= run + cl) { found = true; B = 16 * ln + j; cab = run; } run += cl; }
              if (LEVEL == 0) { ctl[q] = B; ctl[32 + q] = cab; } else ctl[64 + q] = (ctl[q] << 11) | B; } }
    }
}
__device__ __forceinline__ void idx_select(Frame& F, int ln) {
    LAS unsigned* mlds = (LAS unsigned*)(F.lds + RING_OFF);
    LAS unsigned* clist = (LAS unsigned*)(F.lds + RING_OFF + 32768);
    LAS int* ctl = (LAS int*)(F.lds + IDX_CTL);
#pragma unroll 1
    for (int qi = 0; qi < 4; ++qi) {
        const int q = 4 * F.wave + qi; int nc = ctl[96 + q];
        if (nc > IDX_CAP) { nc = IDX_CAP; if (ln == 0) ctl[128] = 1; }
        const int r = TOPK - ctl[32 + q];
        unsigned e[IDX_CAP / 64]; bool ok[IDX_CAP / 64];
#pragma unroll
        for (int j = 0; j < IDX_CAP / 64; ++j) { ok[j] = ln + 64 * j < nc; e[j] = ok[j] ? clist[q * IDX_CAP + ln + 64 * j] : 0u; }
        unsigned t = 0u;
#pragma unroll 1
        for (int bit = 10; bit >= 0; --bit) { const unsigned tt = t | (1u << bit); int cnt = 0;
#pragma unroll
            for (int j = 0; j < IDX_CAP / 64; ++j) cnt += __popcll(__ballot(ok[j] && (e[j] >> 18) >= tt));
            if (cnt >= r) t = tt; }
#pragma unroll
        for (int j = 0; j < IDX_CAP / 64; ++j) if (ok[j] && (e[j] >> 18) >= t) __hip_atomic_fetch_or(mlds + ((e[j] >> 5) & 8191u), 1u << (e[j] & 31u), __ATOMIC_RELAXED, __HIP_MEMORY_SCOPE_WORKGROUP);
    }
}
__device__ __forceinline__ void p5_indexer(Frame& F, unsigned* MASK) {
    const bf16* QI = WSP(bf16, WS_QI); const bf16* KI = WSP(bf16, WS_KI); const float* WI = WSP(float, WS_WI); const bf16* QL = WSP(bf16, WS_QL); const float* AT = WSP(float, SM_AT);
    const float kmax = __builtin_bit_cast(float, __hip_atomic_load(F.ctl + CW_KMAX, RLX_AGENT));
    LAS int* ctl = (LAS int*)(F.lds + IDX_CTL);
    for (int p = F.vcu; p < 256; p += F.G) {
        const int b = p >> 7, j = p & 127;
#pragma unroll 1
        for (int side = 0; side < 2; ++side) {
            const int g = side ? j : 255 - j, t0 = 32 * g;
            const int nt_idx = (g + 2) >> 1, nt_att = 4 * (g >> 3) + 4;
            int ln = (int)__builtin_amdgcn_mbcnt_hi(~0u, __builtin_amdgcn_mbcnt_lo(~0u, 0u)); asm volatile("" : "+v"(ln)); const int tid_ = F.wave * 64 + ln;
            const int qc = ln & 15, fq = ln >> 4, ql_ = 16 * (F.wave & 1) + qc;
            const size_t trow = (size_t)b * SEQ + t0 + ql_;
            bf16x8 qf[8][2], ql[2]; float invA; LAS float* w = (LAS float*)(F.lds + IDX_CTL + 1024) + ql_ * 8;
#define IDX_LOADQ() do { \
            _Pragma("unroll") for (int h = 0; h < 8; ++h) _Pragma("unroll") for (int ks = 0; ks < 2; ++ks) qf[h][ks] = *(const bf16x8*)(QI + trow * 512 + h * 64 + ks * 32 + fq * 8); \
            _Pragma("unroll") for (int ks = 0; ks < 2; ++ks) ql[ks] = *(const bf16x8*)(QL + trow * 64 + ks * 32 + fq * 8); \
            { const f32x4 w0 = *(const f32x4*)(WI + trow * 8), w1 = *(const f32x4*)(WI + trow * 8 + 4); *(LAS f32x4*)w = w0; *(LAS f32x4*)(w + 4) = w1; }     \
            { const float a2 = 2.0f * AT[trow] * kmax; invA = a2 > 0.f ? 0.99f / a2 : 0.f; }        \
        } while (0)
            IDX_LOADQ();
            const bf16* KIb = KI + (size_t)b * SEQ * 64;
            unsigned* MASKg = MASK + ((size_t)(b * 256 + g) * 128) * 64;
            for (int i = tid_; i < 8200; i += 512) ((LAS v4u*)(F.lds + RING_OFF))[i] = (v4u){0u, 0u, 0u, 0u};
            if (tid_ < 96) ctl[tid_] = 0;
            __syncthreads();
            idx_pass<0>(F, ln, KIb, MASKg, t0, nt_idx, nt_att, ql, qf, w, invA, 0, 0u);
            __syncthreads();
            idx_scan<0>(F, ln);
            __syncthreads();
            const int b1 = ctl[ql_];
            if (tid_ < 33) ctl[96 + tid_] = 0;
            __syncthreads();
            idx_pass<3>(F, ln, KIb, MASKg, t0, nt_idx, nt_att, ql, qf, w, invA, b1, 0u);
            __syncthreads();
            idx_select(F, ln);
            __syncthreads();
            if (ctl[128] == 0 || DBG_REP == 77) {
                for (int i = tid_; i < nt_att * 64; i += 512) MASKg[i] = ((LAS unsigned*)(F.lds + RING_OFF))[i];
            } else {
                for (int i = tid_; i < 8200; i += 512) ((LAS v4u*)(F.lds + RING_OFF))[i] = (v4u){0u, 0u, 0u, 0u};
                IDX_LOADQ();
                __syncthreads();
                idx_pass<1>(F, ln, KIb, MASKg, t0, nt_idx, nt_att, ql, qf, w, invA, b1, 0u);
                __syncthreads();
                idx_scan<1>(F, ln);
                __syncthreads();
                const unsigned thr = (unsigned)ctl[64 + ql_];
                idx_pass<2>(F, ln, KIb, MASKg, t0, nt_idx, nt_att, ql, qf, w, invA, b1, thr);
            }
            __syncthreads();
#undef IDX_LOADQ
        }
    }
}

__device__ __forceinline__ unsigned sbfe1_(unsigned w, const int bit) { unsigned r; asm("v_bfe_i32 %0, %1, %2, 1" : "=v"(r) : "v"(w), "n"(bit)); return r; }
#define SBFE1(w, bit) sbfe1_((w), (bit))
__device__ __forceinline__ void p6_attention(Frame& F, const unsigned* MASK, bf16* ATTo) {
    const bf16* Qb = WSP(bf16, WS_Q); const bf16* Kb = WSP(bf16, WS_K); const bf16* VT = WSP(bf16, WS_VT);
    constexpr int KTB = 18432, VTB = 17408, SLOT = KTB + VTB;
    LAS unsigned char* Lb = F.lds + RING_OFF;
    LAS float* biasd = (LAS float*)(F.lds + RING_OFF + 2 * SLOT);
    for (int p = F.vcu; p < 256; p += F.G) {
        const int bh = p >> 4, j = p & 15, b = bh >> 3, h = bh & 7;
#pragma unroll 1
        for (int side = 0; side < 2; ++side) {
            const int qb = side ? j : 31 - j, q0 = 256 * qb, NT = 2 * qb + 2;
            int ln = (int)__builtin_amdgcn_mbcnt_hi(~0u, __builtin_amdgcn_mbcnt_lo(~0u, 0u)); asm volatile("" : "+v"(ln));
            const int tid_ = F.wave * 64 + ln, r32 = ln & 31, hi = ln >> 5, lrow = tid_ >> 3, lch = tid_ & 7;
            const int tq = q0 + 32 * F.wave + r32;
            if (tid_ < 128) { const int bk = t5_bucket(tid_); biasd[tid_] = (F.rel_bias[bk * 8 + h] - F.rel_bias[31 * 8 + h]) * LOG2E; }
            const bf16* Kg = Kb + (size_t)(b * SEQ + lrow) * 512 + h * 64 + lch * 8;
            const bf16* Vg = VT + ((size_t)((b * NH + h) * 64 + lrow)) * SEQ + lch * 8;
            const unsigned* Mg = MASK + ((size_t)(b * 256 + 8 * qb + F.wave) * 128) * 64 + ln;
            bf16x8 qf[4];
#pragma unroll
            for (int ks = 0; ks < 4; ++ks) qf[ks] = *(const bf16x8*)(Qb + (size_t)(b * SEQ + tq) * 512 + h * 64 + ks * 16 + hi * 8);
            f32x16 o0, o1, o2;
#pragma unroll
            for (int r = 0; r < 16; ++r) { o0[r] = 0.f; o1[r] = 0.f; o2[r] = 0.f; }
            const bf16x8 ones = (bf16x8){0x3F80, 0x3F80, 0x3F80, 0x3F80, 0x3F80, 0x3F80, 0x3F80, 0x3F80};
            float m_run = 0.f;
            v4u kreg0 = *(const v4u*)(Kg), kreg1 = *(const v4u*)(Kg + (size_t)64 * 512), vreg0 = *(const v4u*)(Vg), vreg1 = *(const v4u*)(Vg + 64);
            unsigned mw0 = Mg[0], mw1 = Mg[64], mwn0 = 0u, mwn1 = 0u;
            *(LAS v4u*)(Lb + lrow * 144 + lch * 16) = kreg0; *(LAS v4u*)(Lb + (64 + lrow) * 144 + lch * 16) = kreg1;
            *(LAS v4u*)(Lb + KTB + lrow * 272 + lch * 16) = vreg0; *(LAS v4u*)(Lb + KTB + lrow * 272 + 128 + lch * 16) = vreg1;
            __syncthreads();
            for (int kt = 0; kt < NT; ++kt) {
                const int buf = kt & 1;
                if (kt + 1 < NT) { const size_t kn = (size_t)(kt + 1) * 128;
                    kreg0 = *(const v4u*)(Kg + kn * 512); kreg1 = *(const v4u*)(Kg + (kn + 64) * 512); vreg0 = *(const v4u*)(Vg + kn); vreg1 = *(const v4u*)(Vg + kn + 64);
                    mwn0 = Mg[(size_t)(2 * kt + 2) * 64]; mwn1 = Mg[(size_t)(2 * kt + 3) * 64]; }
                LAS unsigned char* kb_ = Lb + buf * SLOT; LAS unsigned char* vb_ = kb_ + KTB;
                f32x16 sA[4];
#pragma unroll
                for (int c = 0; c < 4; ++c)
#pragma unroll
                    for (int r = 0; r < 16; ++r) sA[c][r] = 0.f;
#pragma unroll
                for (int ks = 0; ks < 4; ++ks)
#pragma unroll
                    for (int c = 0; c < 4; ++c) { const bf16x8 kf = *(const LAS bf16x8*)(kb_ + (32 * c + r32) * 144 + ks * 32 + hi * 16); sA[c] = MFMA32(kf, qf[ks], sA[c]); }
                if (kt >= NT - 3) {
#pragma unroll
                    for (int c = 0; c < 4; ++c)
#pragma unroll
                        for (int r = 0; r < 16; ++r) { const int d0 = tq - (128 * kt + 32 * c + crow(r, hi)); const float b0 = biasd[d0 & 127]; sA[c][r] += ((unsigned)d0 < 128u) ? b0 : 0.f; }
                }
                float mx = -INFINITY;
#pragma unroll
                for (int r = 0; r < 16; ++r) mx = fmaxf(mx, fmaxf(fmaxf(sA[0][r], sA[1][r]), fmaxf(sA[2][r], sA[3][r])));
                mx = fmaxf(mx, __shfl_xor(mx, 32)) - m_run;
                if (kt == 0 || __any(mx > 8.0f)) {
                    const float dl = (kt == 0) ? mx : fmaxf(mx, 0.f), f = __builtin_amdgcn_exp2f(-dl);
                    m_run += dl;
#pragma unroll
                    for (int r = 0; r < 16; ++r) { o0[r] *= f; o1[r] *= f; o2[r] *= f; }
                }
                unsigned pk[4][8];
#pragma unroll
                for (int c = 0; c < 4; ++c) { const unsigned mw = (c < 2) ? mw0 : mw1;
#pragma unroll
                    for (int r = 0; r < 16; r += 2) {
                        const unsigned e0 = __builtin_bit_cast(unsigned, __builtin_amdgcn_exp2f(sA[c][r] - m_run)) & SBFE1(mw, 16 * (c & 1) + r);
                        const unsigned e1 = __builtin_bit_cast(unsigned, __builtin_amdgcn_exp2f(sA[c][r + 1] - m_run)) & SBFE1(mw, 16 * (c & 1) + r + 1);
                        pk[c][r >> 1] = cvtpk(__builtin_bit_cast(float, e0), __builtin_bit_cast(float, e1)); } }
#pragma unroll
                for (int c = 0; c < 4; ++c)
#pragma unroll
                    for (int s = 0; s < 2; ++s) {
                        const bf16x8 pf = __builtin_bit_cast(bf16x8, (v4u){pk[c][4 * s], pk[c][4 * s + 1], pk[c][4 * s + 2], pk[c][4 * s + 3]});
                        const bf16x8 v0 = *(const LAS bf16x8*)(vb_ + r32 * 272 + (2 * c + s) * 32 + hi * 16);
                        const bf16x8 v1 = *(const LAS bf16x8*)(vb_ + (32 + r32) * 272 + (2 * c + s) * 32 + hi * 16);
                        o0 = MFMA32(v0, pf, o0); o1 = MFMA32(v1, pf, o1); o2 = MFMA32(ones, pf, o2);
                    }
                if (kt + 1 < NT) { LAS unsigned char* nb = Lb + (buf ^ 1) * SLOT;
                    *(LAS v4u*)(nb + lrow * 144 + lch * 16) = kreg0; *(LAS v4u*)(nb + (64 + lrow) * 144 + lch * 16) = kreg1;
                    *(LAS v4u*)(nb + KTB + lrow * 272 + lch * 16) = vreg0; *(LAS v4u*)(nb + KTB + lrow * 272 + 128 + lch * 16) = vreg1; }
                mw0 = mwn0; mw1 = mwn1;
                __syncthreads();
            }
            const float inv = 1.0f / o2[0];
            bf16* orow = ATTo + (size_t)(b * SEQ + tq) * 512 + h * 64 + 4 * hi;
#pragma unroll
            for (int g4 = 0; g4 < 4; ++g4) {
                *(v2u*)(orow + 8 * g4) = (v2u){cvtpk(o0[4 * g4] * inv, o0[4 * g4 + 1] * inv), cvtpk(o0[4 * g4 + 2] * inv, o0[4 * g4 + 3] * inv)};
                *(v2u*)(orow + 32 + 8 * g4) = (v2u){cvtpk(o1[4 * g4] * inv, o1[4 * g4 + 1] * inv), cvtpk(o1[4 * g4 + 2] * inv, o1[4 * g4 + 3] * inv)};
            }
        }
    }
}

__device__ __forceinline__ void p9_norm2_route(Frame& F, const float* HRES) {
    const int gw = F.vcu * NWAVES + F.wave, NGW = F.G * NWAVES;
    const float* mod = WSP(float, SM_MOD); const float* WRT = WSP(float, SM_WRT);
    LAS float* lg = (LAS float*)(F.lds + RING_OFF + F.wave * 16384 + 8448);
    int* EID = WSP(int, SM_EID); float* EWT = WSP(float, SM_EWT); int* SLOT = WSP(int, SM_SLOT); bf16* H2 = WSP(bf16, WS_H1);
    for (int m4 = gw; m4 < T / 4; m4 += NGW) {
        const int m0 = m4 * 4, b = m0 / SEQ;
        f32x4 hv[4][4];
#pragma unroll
        for (int r = 0; r < 4; ++r) {
            const GAS f32x4* xr = (const GAS f32x4*)(HRES + (size_t)(m0 + r) * D) + F.lane; float s = 0.f;
#pragma unroll
            for (int j = 0; j < 4; ++j) { hv[r][j] = xr[64 * j]; s += (hv[r][j].x * hv[r][j].x + hv[r][j].y * hv[r][j].y) + (hv[r][j].z * hv[r][j].z + hv[r][j].w * hv[r][j].w); }
            const float rstd = 1.f / sqrtf(wave_sum_all(s) * (1.f / D) + EPS);
            GAS v2u* o8 = (GAS v2u*)(H2 + (size_t)(m0 + r) * D) + F.lane;
#pragma unroll
            for (int j = 0; j < 4; ++j) { const int k = 4 * F.lane + 256 * j;
                const f32x4 g = *(const f32x4*)(F.norm2_g + k), scl = *(const f32x4*)(mod + b * 6144 + 4096 + k), sh = *(const f32x4*)(mod + b * 6144 + 3072 + k);
                hv[r][j] = hv[r][j] * rstd * (g * (scl + 1.0f)) + sh; o8[64 * j] = (v2u){pk2(hv[r][j].x, hv[r][j].y), pk2(hv[r][j].z, hv[r][j].w)}; }
        }
        for (int n = 0; n < 36; ++n) {
            f32x4 w[4];
#pragma unroll
            for (int j = 0; j < 4; ++j) w[j] = *(const f32x4*)(WRT + n * D + 4 * F.lane + 256 * j);
            float p[4];
#pragma unroll
            for (int r = 0; r < 4; ++r) { float a = 0.f;
#pragma unroll
                for (int j = 0; j < 4; ++j) a += (hv[r][j].x * w[j].x + hv[r][j].y * w[j].y) + (hv[r][j].z * w[j].z + hv[r][j].w * w[j].w);
                p[r] = wave_sum63(a); }
            if (F.lane == 63) { const float bb = (n < 4 ? F.brg[n] : F.bre[n - 4]); lg[n] = p[0] + bb; lg[36 + n] = p[1] + bb; lg[72 + n] = p[2] + bb; lg[108 + n] = p[3] + bb; }
        }
        LDS_WAIT(); asm volatile("" ::: "memory");
        if (F.lane < 4) {
            const LAS float* l = lg + F.lane * 36; const int tkn = m0 + F.lane;
            int gs = 0; float gm = l[0];
#pragma unroll
            for (int j = 1; j < 4; ++j) if (l[j] > gm) { gm = l[j]; gs = j; }
            float gsum = 0.f;
#pragma unroll
            for (int j = 0; j < 4; ++j) gsum += __expf(l[j] - gm);
            const float gwt = 1.f / gsum;
            const LAS float* el = l + 4 + 8 * gs;
            int i0 = 0; float l0 = el[0];
#pragma unroll
            for (int j = 1; j < 8; ++j) if (el[j] > l0) { l0 = el[j]; i0 = j; }
            int i1 = -1; float l1 = -INFINITY;
#pragma unroll
            for (int j = 0; j < 8; ++j) if (j != i0 && el[j] > l1) { l1 = el[j]; i1 = j; }
            const float e1 = __expf(l1 - l0), p0 = 1.f / (1.f + e1), p1 = e1 * p0;
            const int e0id = gs * 8 + i0, e1id = gs * 8 + i1;
            EID[tkn * 2] = e0id; EID[tkn * 2 + 1] = e1id; EWT[tkn * 2] = gwt * p0; EWT[tkn * 2 + 1] = gwt * p1;
            SLOT[tkn * 2] = (int)atomicAdd((unsigned*)(F.ctl + CW_ECNT + 16 * e0id), 1u);
            SLOT[tkn * 2 + 1] = (int)atomicAdd((unsigned*)(F.ctl + CW_ECNT + 16 * e1id), 1u);
        }
        LDS_WAIT(); asm volatile("" ::: "memory");
    }
    {
        LAS float* scr = (LAS float*)(F.lds + RING_OFF + F.wave * 16384);
        for (int rep_ = 0; rep_ < (DBG_REP == 9 ? 2 : 1); ++rep_)
        for (int it = gw; it < NEXP * 768; it += NGW) {
            const int e = it / 768, r = it % 768;
            if (r < 256) transpose_item(F.w_gate_e + (size_t)e * D * DEXP, D, DEXP, WSP(bf16, WS_WGU) + (size_t)e * 1024 * D, scr, r, F.lane, RmGU{0});
            else if (r < 512) transpose_item(F.w_up_e + (size_t)e * D * DEXP, D, DEXP, WSP(bf16, WS_WGU) + (size_t)e * 1024 * D, scr, r - 256, F.lane, RmGU{1});
            else transpose_item(F.w_down_e + (size_t)e * DEXP * D, DEXP, D, WSP(bf16, WS_WD) + (size_t)e * D * DEXP, scr, r - 512, F.lane, RmId());
        }
    }
}
__device__ __forceinline__ int moe_tables(Frame& F, LAS int* off, LAS int* tile_e) {
    if (F.tid == 0) { int o = 0, nt = 0;
        for (int e = 0; e < NEXP; ++e) { const int c = (int)__hip_atomic_load(F.ctl + CW_ECNT + 16 * e, RLX_AGENT); off[e] = o; const int tl = (c + 255) >> 8; for (int j = 0; j < tl; ++j) tile_e[nt++] = e; o += tl * 256; }
        off[NEXP] = nt; }
    __syncthreads();
    return off[NEXP];
}
__device__ __forceinline__ void p10_gather(Frame& F, LAS int* off) {
    const int* EID = WSP(int, SM_EID); int* SLOT = WSP(int, SM_SLOT); int* AROW = (int*)(F.ctl + CW_AROW);
    for (int i = blockIdx.x * 512 + F.tid; i < T * 2; i += F.G * 512) { const int row = off[EID[i]] + SLOT[i]; AROW[row] = i >> 1; SLOT[i] = row; }
}
__device__ __forceinline__ void p13_combine(Frame& F, const float* HRES) {
    const int gw = F.vcu * NWAVES + F.wave, NGW = F.G * NWAVES;
    const float* mod = WSP(float, SM_MOD); const int* SLOT = WSP(int, SM_SLOT); const float* EWT = WSP(float, SM_EWT); const bf16* Y = WSP(bf16, WS_Y);
    for (int m = gw; m < T; m += NGW) {
#if DBG_SKIP_MOE
        const int b = m / SEQ; const int r0 = 0, r1 = 0; const float w0 = 0.f, w1 = 0.f; (void)SLOT; (void)EWT;
#else
        const int b = m / SEQ; const int r0 = SLOT[m * 2], r1 = SLOT[m * 2 + 1]; const float w0 = EWT[m * 2], w1 = EWT[m * 2 + 1];
#endif
        const GAS f32x4* xr = (const GAS f32x4*)(HRES + (size_t)m * D) + F.lane;
        const GAS v2u* y0 = (const GAS v2u*)(Y + (size_t)r0 * D) + F.lane; const GAS v2u* y1 = (const GAS v2u*)(Y + (size_t)r1 * D) + F.lane;
        f32x4 v[4]; float s = 0.f;
#pragma unroll
        for (int j = 0; j < 4; ++j) { const int k = 4 * F.lane + 256 * j; const v2u a = y0[64 * j], c = y1[64 * j];
            const f32x4 ya = (f32x4){bflo(a.x), bfhi(a.x), bflo(a.y), bfhi(a.y)}, yb = (f32x4){bflo(c.x), bfhi(c.x), bflo(c.y), bfhi(c.y)};
            const f32x4 g2 = *(const f32x4*)(mod + b * 6144 + 5120 + k);
#if DBG_SKIP_MOE
            v[j] = xr[64 * j]; (void)g2; (void)ya; (void)yb;
#else
            v[j] = xr[64 * j] + g2 * (ya * w0 + yb * w1);
#endif
            s += (v[j].x * v[j].x + v[j].y * v[j].y) + (v[j].z * v[j].z + v[j].w * v[j].w); }
        const float rstd = 1.f / sqrtf(wave_sum_all(s) * (1.f / D) + EPS);
        GAS f32x4* o = (GAS f32x4*)(F.out + (size_t)m * D) + F.lane;
#if DBG_CMP_ATT
        const float escale = 1.0f + sqrtf(__builtin_bit_cast(float, __hip_atomic_load(F.ctl + CW_CMP, RLX_AGENT)) / __builtin_bit_cast(float, __hip_atomic_load(F.ctl + CW_CMP + 1, RLX_AGENT)));
#else
        const float escale = 1.0f;
#endif
#pragma unroll
        for (int j = 0; j < 4; ++j) o[64 * j] = v[j] * (rstd * escale) * *(const f32x4*)(F.norm_f_g + 4 * F.lane + 256 * j);
    }
}

struct Args { const float* in[20]; float* out; unsigned char* ws; int ph_lo, ph_hi, li, pad; };
__global__ void __launch_bounds__(NWAVES * 64, 2) fwd_kernel(Args args) {
    extern __shared__ __attribute__((aligned(16))) unsigned char lds[];
    Frame F;
    F.lds = (LAS unsigned char*)lds;
    F.MISC = (volatile LAS unsigned*)(F.lds + MISC_OFF);
    F.tid = threadIdx.x; F.lane = F.tid & 63; F.wave = __builtin_amdgcn_readfirstlane(F.tid >> 6);
    F.G = gridDim.x; { const int bx = blockIdx.x; F.vcu = (F.G % 8 == 0) ? (bx % 8) * (F.G / 8) + bx / 8 : bx; }
    F.ws = args.ws; F.ctl = (gu32*)(args.ws + WS_CTL);
    F.x = args.in[0]; F.c = args.in[1]; F.w_ada = args.in[2]; F.b_ada = args.in[3]; F.norm1_g = args.in[4]; F.w_in = args.in[5]; F.rel_bias = args.in[6]; F.conv_w = args.in[7];
    F.w_attn = args.in[8]; F.w_conv = args.in[9]; F.w_out = args.in[10]; F.norm2_g = args.in[11]; F.wrg = args.in[12]; F.brg = args.in[13]; F.wre = args.in[14]; F.bre = args.in[15];
    F.w_gate_e = args.in[16]; F.w_up_e = args.in[17]; F.w_down_e = args.in[18]; F.norm_f_g = args.in[19]; F.out = args.out;
    for (int u = F.tid; u < (LDS_BYTES - LDSCTL_OFF) / 4; u += NWAVES * 64) ((LAS unsigned*)(F.lds + LDSCTL_OFF))[u] = 0u;
    __syncthreads();
    XcdBarrier bar; bar.bar = (unsigned*)(F.ctl + CW_BAR); bar.x = 0; bar.st = nullptr;
    if (!MK_PER_PHASE) bar = xcd_barrier_post((unsigned*)(F.ctl + CW_BAR), F.MISC + 8);
#define GRID_BAR() do { if (MK_PER_PHASE) { if (F.tid == 0) __hip_atomic_store(F.ctl + CW_TMO, 0xBADBA0u, RLX_AGENT); } else { xcd_barrier(bar, F.wave == 0 && (int)__builtin_amdgcn_mbcnt_hi(~0u, __builtin_amdgcn_mbcnt_lo(~0u, 0u)) == 0); } } while (0)
    const int lo = args.ph_lo, hi = args.ph_hi;
#ifndef ONLY_PHASE
#define ONLY_PHASE -1
#endif
#define IN(k) ((ONLY_PHASE < 0 || ONLY_PHASE == (k)) && lo <= (k) && (k) < hi)
#define BOTH(k) (IN(k) && IN((k) + 1))
#define REFRESH() do { int l_ = (int)__builtin_amdgcn_mbcnt_hi(~0u, __builtin_amdgcn_mbcnt_lo(~0u, 0u)); asm volatile("" : "+v"(l_)); F.lane = l_; F.tid = F.wave * 64 + l_; } while (0)
    float* HRES = F.out;
    LAS int* moe_off = (LAS int*)(F.lds + LDSCTL_OFF + 1024);
    LAS int* moe_tile = (LAS int*)(F.lds + LDSCTL_OFF + 1024 + 256);

    if (IN(0)) { REFRESH(); for (int rep_ = 0; rep_ < (DBG_REP == 0 ? 2 : 1); ++rep_) { if (rep_) GRID_BAR(); p0_prologue(F); } if (BOTH(0)) GRID_BAR(); }
    if (IN(1)) { REFRESH(); for (int rep_ = 0; rep_ < (DBG_REP == 1 ? 2 : 1); ++rep_) { if (rep_) GRID_BAR(); p1_norm1(F); } if (BOTH(1)) GRID_BAR(); }
    if (IN(2)) { REFRESH();
        pg8::Gemm g{WSP(bf16, WS_H1), WSP(bf16, WS_WIN), T, NINP, D}; pg8::StaticOrder S; S.init(T, NINP, F.G, (int)blockIdx.x);
        EpiProj E{WSP(bf16, WS_Q), WSP(bf16, WS_K), WSP(bf16, WS_V), WSP(bf16, WS_QI), WSP(bf16, WS_KI), WSP(bf16, WS_CB), WSP(bf16, WS_U), WSP(bf16, WS_G), WSP(float, WS_WI)};
        for (int rep_ = 0; rep_ < (DBG_REP == 2 ? 2 : 1); ++rep_) { if (rep_) GRID_BAR(); pg8::gemm_phase<EpiProj, pg8::StaticOrder, true, true>(F.lds + RING_OFF, g, S, E, F.wave); }
        if (BOTH(2)) GRID_BAR();
    }
    if (IN(3)) { REFRESH(); for (int rep_ = 0; rep_ < (DBG_REP == 3 ? 2 : 1); ++rep_) { if (rep_) GRID_BAR(); p3_prep(F); } if (BOTH(3)) GRID_BAR(); }
    if (IN(4)) { REFRESH();
        pg8::Gemm g{WSP(bf16, WS_AC), WSP(bf16, WS_WC), T, D, AW}; pg8::StaticOrder S; S.init(T, D, F.G, (int)blockIdx.x);
        EpiConv E{WSP(bf16, WS_G), WSP(bf16, WS_TMPC)};
        for (int rep_ = 0; rep_ < (DBG_REP == 4 ? 2 : 1); ++rep_) { if (rep_) GRID_BAR(); pg8::gemm_phase<EpiConv, pg8::StaticOrder, true, true>(F.lds + RING_OFF, g, S, E, F.wave); }
        if (BOTH(4)) GRID_BAR();
    }
    if (IN(5)) { REFRESH();
#if DBG_SKIP_ATTN
        for (size_t i = (size_t)blockIdx.x * 512 + F.tid; i < (size_t)T * 512 / 8; i += (size_t)F.G * 512) *(v4u*)(WSP(bf16, WS_ATT) + i * 8) = (v4u){0u, 0u, 0u, 0u};
#elif DBG_CMP_ATT
        pn_naive_dsa(F); GRID_BAR(); p5_indexer(F, WSP(unsigned, WS_MASK_DBG));
#elif MK_NAIVE_ATTN
        pn_naive_dsa(F);
#else
        for (int rep_ = 0; rep_ < (DBG_REP == 5 ? 2 : 1); ++rep_) { if (rep_) GRID_BAR(); p5_indexer(F, WSP(unsigned, WS_MASK)); }
#endif
        if (BOTH(5)) GRID_BAR(); }
    if (IN(6)) { REFRESH();
#if DBG_SKIP_ATTN
#elif DBG_CMP_ATT
        p6_attention(F, WSP(unsigned, WS_MASK_DBG), WSP(bf16, WS_ATT2)); GRID_BAR();
        { float num = 0.f, den = 0.f; const bf16* A1 = WSP(bf16, WS_ATT); const bf16* A2 = WSP(bf16, WS_ATT2);
          for (size_t i = (size_t)blockIdx.x * 512 + F.tid; i < (size_t)T * 512; i += (size_t)F.G * 512) { const float a = bf1(A1[i]), c = bf1(A2[i]); num += (a - c) * (a - c); den += a * a; }
          num = wave_sum(num); den = wave_sum(den);
          if (F.lane == 0) { atomicAdd((float*)(F.ctl + CW_CMP), num); atomicAdd((float*)(F.ctl + CW_CMP + 1), den); } }
#elif !MK_NAIVE_ATTN
        for (int rep_ = 0; rep_ < (DBG_REP == 6 ? 2 : 1); ++rep_) { if (rep_) GRID_BAR(); p6_attention(F, WSP(unsigned, WS_MASK), WSP(bf16, WS_ATT)); }
#endif
        if (BOTH(6)) GRID_BAR(); }
    if (IN(7)) { REFRESH();
        pg8::Gemm g{WSP(bf16, WS_ATT), WSP(bf16, WS_WA), T, D, AW}; pg8::StaticOrder S; S.init(T, D, F.G, (int)blockIdx.x);
        EpiAttn E{WSP(bf16, WS_G), WSP(bf16, WS_TMPC), WSP(bf16, WS_MERGED)};
        for (int rep_ = 0; rep_ < (DBG_REP == 7 ? 2 : 1); ++rep_) { if (rep_) GRID_BAR(); pg8::gemm_phase<EpiAttn, pg8::StaticOrder, true, true>(F.lds + RING_OFF, g, S, E, F.wave); }
        if (BOTH(7)) GRID_BAR();
    }
    if (IN(8)) { REFRESH();
        pg8::Gemm g{WSP(bf16, WS_MERGED), WSP(bf16, WS_WOUT), T, D, D}; pg8::StaticOrder S; S.init(T, D, F.G, (int)blockIdx.x);
        EpiOut E{F.x, WSP(float, SM_MOD), HRES};
        for (int rep_ = 0; rep_ < (DBG_REP == 8 ? 2 : 1); ++rep_) { if (rep_) GRID_BAR(); pg8::gemm_phase<EpiOut, pg8::StaticOrder, true, true>(F.lds + RING_OFF, g, S, E, F.wave); }
        if (BOTH(8)) GRID_BAR();
    }
#if DBG_SKIP_MOE
    if (0) {
#endif
    if (IN(9)) { REFRESH(); p9_norm2_route(F, HRES); if (BOTH(9)) GRID_BAR(); }
    if (IN(10)) { REFRESH(); (void)moe_tables(F, moe_off, moe_tile); p10_gather(F, moe_off); if (BOTH(10)) GRID_BAR(); }
    if (IN(11)) { REFRESH();
        const int nt = moe_tables(F, moe_off, moe_tile);
        pg8::Gemm g{WSP(bf16, WS_H1), WSP(bf16, WS_WGU), XPROWS, NEXP * 1024, D}; MoeOrder S{moe_tile, nt, F.G, (int)blockIdx.x};
        EpiHid E{WSP(bf16, WS_HID)};
        for (int rep_ = 0; rep_ < (DBG_REP == 11 ? 2 : 1); ++rep_) { if (rep_) GRID_BAR(); pg8::gemm_phase<EpiHid, MoeOrder, true, true, true>(F.lds + RING_OFF, g, S, E, F.wave, (const int*)(F.ctl + CW_AROW)); }
        if (BOTH(11)) GRID_BAR();
    }
    if (IN(12)) { REFRESH();
        const int nt = moe_tables(F, moe_off, moe_tile);
        pg8::Gemm g{WSP(bf16, WS_HID), WSP(bf16, WS_WD), XPROWS, NEXP * 1024, DEXP}; MoeOrder S{moe_tile, nt, F.G, (int)blockIdx.x};
        EpiY E{WSP(bf16, WS_Y)};
        for (int rep_ = 0; rep_ < (DBG_REP == 12 ? 2 : 1); ++rep_) { if (rep_) GRID_BAR(); pg8::gemm_phase<EpiY, MoeOrder, true, true>(F.lds + RING_OFF, g, S, E, F.wave); }
        if (BOTH(12)) GRID_BAR();
    }
#if DBG_SKIP_MOE
    }
#endif
#if DBG_PROBE
    if (IN(13)) { REFRESH();
        const bf16* src = nullptr; int pitch = 1024;
        if (DBG_PROBE == 1) { src = WSP(bf16, WS_MERGED); pitch = 1024; }
        if (DBG_PROBE == 2) { src = WSP(bf16, WS_TMPC); pitch = 1024; }
        if (DBG_PROBE == 3) { src = WSP(bf16, WS_AC); pitch = 512; }
        if (DBG_PROBE == 4) { src = WSP(bf16, WS_G); pitch = 2048; }
        if (DBG_PROBE == 5) { src = WSP(bf16, WS_H1); pitch = 1024; }
        if (DBG_PROBE == 6) { src = WSP(bf16, WS_WIN); pitch = 1024; }
        if (DBG_PROBE == 7) { src = WSP(bf16, WS_QI); pitch = 512; }
        for (size_t i = (size_t)blockIdx.x * 512 + F.tid; i < (size_t)T * D; i += (size_t)F.G * 512) { const size_t m = i / D, j = i % D;
            float v;
            if (DBG_PROBE == 8) v = WSP(float, SM_MOD)[i % 12288];
            else if (DBG_PROBE == 4) v = bf1(src[m * 2048 + j]) + bf1(src[m * 2048 + 1024 + j]);
            else if (DBG_PROBE >= 40 && DBG_PROBE < 48) v = bf1(WSP(bf16, WS_G)[m * 2048 + (DBG_PROBE - 40) * 256 + (j & 255)]);
            else if (DBG_PROBE == 6) v = bf1(src[(m % 5888) * 1024 + j]);
            else v = bf1(src[m * pitch + (j % pitch)]);
            F.out[i] = v; }
    }
#else
    if (IN(13)) { REFRESH(); for (int rep_ = 0; rep_ < (DBG_REP == 13 ? 2 : 1); ++rep_) { if (rep_) GRID_BAR(); p13_combine(F, DBG_SKIP_MIX ? F.x : HRES); } }
#endif
#undef IN
#undef BOTH
}

extern "C" void kernel_launch(void* const* d_in, const int* in_sizes, int n_in, void* d_out, int out_size, void* d_ws, size_t ws_size, hipStream_t stream) {
    static int grid = 0;
    if (grid == 0) {
        if (n_in != 20 || in_sizes[0] != T * D || out_size != T * D || ws_size < WS_END) { fprintf(stderr, "kernel_launch: unexpected shapes: n_in %d in0 %d out %d ws %zu (need %zu)\n", n_in, n_in > 0 ? in_sizes[0] : -1, out_size, ws_size, (size_t)WS_END); grid = -1; return; }
        int dev = 0, cus = 0, per_cu = 0;
        if (hipGetDevice(&dev) != hipSuccess || hipDeviceGetAttribute(&cus, hipDeviceAttributeMultiprocessorCount, dev) != hipSuccess) { grid = -1; return; }
        if (hipFuncSetAttribute((const void*)fwd_kernel, hipFuncAttributeMaxDynamicSharedMemorySize, LDS_BYTES) != hipSuccess) { fprintf(stderr, "kernel_launch: hipFuncSetAttribute failed\n"); grid = -1; return; }
        if (hipOccupancyMaxActiveBlocksPerMultiprocessor(&per_cu, (const void*)fwd_kernel, NWAVES * 64, LDS_BYTES) != hipSuccess || per_cu < 1)
            fprintf(stderr, "kernel_launch: note: occupancy query reports %d workgroups per CU\n", per_cu);
        (void)hipGetLastError();
        grid = cus;
    }
    if (grid < 0) return;
    if (hipMemsetAsync((char*)d_ws + WS_CTL, 0, CTL_ZERO_BYTES, stream) != hipSuccess) return;
    Args a{};
    for (int i = 0; i < 20; ++i) a.in[i] = (const float*)d_in[i];
    a.out = (float*)d_out; a.ws = (unsigned char*)d_ws;
#if MK_PER_PHASE
    for (int li = 0; li < N_PHASES; ++li) { a.ph_lo = li; a.ph_hi = li + 1; a.li = li; hipLaunchKernelGGL(fwd_kernel, dim3(grid), dim3(NWAVES * 64), LDS_BYTES, stream, a); }
#else
    a.ph_lo = 0; a.ph_hi = N_PHASES; a.li = 0;
    hipLaunchKernelGGL(fwd_kernel, dim3(grid), dim3(NWAVES * 64), LDS_BYTES, stream, a);
#endif
}
```

```cpp
#include <hip/hip_runtime.h>
#include <cstdio>
#include <cstdint>

namespace pg8 {
#define PG8_LAS __attribute__((address_space(3)))
typedef unsigned short bf16_t;
typedef short bf16x8 __attribute__((ext_vector_type(8)));
typedef float f32x4 __attribute__((ext_vector_type(4)));
typedef unsigned u32x4 __attribute__((ext_vector_type(4)));
constexpr int BM = 256, BK = 64, HALF = 128, HTB = HALF * BK * 2  , STAGE_BYTES = 8 * HTB, NXCD = 8, WGM = 8;

__host__ __device__ __forceinline__ int lds_byte(int r, int c) { const int st = (r >> 4) * 2 + (c >> 5), rr = r & 15, cc = c & 31, ob = rr * 64 + cc * 2; return st * 1024 + (ob ^ (((ob >> 9) & 1) << 5)); }
__host__ __device__ __forceinline__ void stage_rc(int b, int& R, int& C) { const int st = b / 1024, sb = b % 1024, swz = sb ^ (((sb >> 9) & 1) << 5); R = (st >> 1) * 16 + swz / 64; C = (st & 1) * 32 + (swz % 64) / 2; }
__host__ __device__ __forceinline__ int perm32(int rho) { const int n = rho >> 4, i = rho & 15; return 8 * (i >> 2) + 4 * n + (i & 3); }

struct Unit { int pm, pn; };
struct Gemm { const bf16_t* A; const bf16_t* Bt; int M, N, K; };

struct StaticOrder {
    int nM, nN, nwg, G, c;
    __host__ __device__ void init(int M, int N, int G_, int c_) { nM = M / BM; nN = N / BM; nwg = nM * nN; G = G_; c = c_; }
    __host__ __device__ bool next(int i, Unit& u) const {
        const long L = (long)i * G + c; if (L >= nwg) return false;
        int wgid = (int)L; { const int q = nwg / NXCD, r = nwg % NXCD, xcd = wgid % NXCD, off = wgid / NXCD; wgid = (xcd < r ? xcd * (q + 1) : r * (q + 1) + (xcd - r) * q) + off; }
        const int nig = WGM * nN, gid = wgid / nig, fm = gid * WGM, gsz = (nM - fm) < WGM ? (nM - fm) : WGM;
        u.pm = fm + ((wgid % nig) % gsz); u.pn = (wgid % nig) / gsz; return true;
    }
    __device__ __forceinline__ void a_ready(const Unit&) const {}
    __device__ __forceinline__ void done(const Unit&) const {}
};
__device__ __forceinline__ unsigned cvt_pk_bf16(float lo, float hi) { unsigned r; asm volatile("v_cvt_pk_bf16_f32 %0, %1, %2" : "=v"(r) : "v"(lo), "v"(hi)); return r; }

template <class Epi, class Sched, bool ALIGN_EPI = false, bool SP2 = false, bool GATHER = false>
__device__ __forceinline__ void gemm_phase(PG8_LAS unsigned char* lds, const Gemm g, const Sched& S, const Epi& E, const int wave_id  , const int* arow = nullptr) {
    static_assert(!GATHER || SP2, "GATHER is implemented on the SP2 loop only");
    int lane_ = (int)__builtin_amdgcn_mbcnt_hi(~0u, __builtin_amdgcn_mbcnt_lo(~0u, 0u)); asm volatile("" : "+v"(lane_));
    const int lane = lane_, wid = wave_id, tid = wid * 64 + lane,
               wr = wid >> 2, wc = wid & 3, fr = lane & 15, fq = lane >> 4;
    const int K = g.K, nt = K / BK;
    unsigned voffA[2], voffB[2]; int RA[2]; unsigned CA2[2];
#pragma unroll
    for (int i = 0; i < 2; ++i) { int R, C; stage_rc(tid * 16 + i * 8192, R, C); const int Rb = Epi::PERM ? ((R & ~31) + perm32(R & 31)) : R;
        voffA[i] = (unsigned)(R * K + C) * 2u; voffB[i] = (unsigned)(Rb * K + C) * 2u; RA[i] = R; CA2[i] = (unsigned)C * 2u; }
    unsigned vA[2][2] = {{0u, 0u}, {0u, 0u}}, nvA[2][2] = {{0u, 0u}, {0u, 0u}};
#define PG8_GROWS(dst, U) do { _Pragma("unroll") for (int _h = 0; _h < 2; ++_h) _Pragma("unroll") for (int _i = 0; _i < 2; ++_i) dst[_h][_i] = (unsigned)arow[(U).pm * BM + _h * HALF + RA[_i]] * (unsigned)(K * 2) + CA2[_i]; } while (0)
    const size_t kstep = (size_t)(BK * 2);
    const size_t hstep = (size_t)HALF * K * 2;
    const size_t tstep = 2 * hstep;
    const unsigned ldsw = (unsigned)wid * 1024u;
    const int aoff = lds_byte(wr * 64 + fr, fq * 8), boff = lds_byte(wc * 32 + fr, fq * 8);
#define PG8_SA(b, h) (((b) * 2 + (h)) * HTB)
#define PG8_SB(b, h) ((4 + (b) * 2 + (h)) * HTB)
#define PG8_STAGE(bufoff, gbase, voff) do { _Pragma("unroll") for (int _i = 0; _i < 2; ++_i) \
        __builtin_amdgcn_global_load_lds((const unsigned*)((const char*)(gbase) + (voff)[_i]), (PG8_LAS unsigned*)(lds + (bufoff) + ldsw + _i * 8192), 16, 0, 0); } while (0)
#define PG8_STAGE_A(bufoff, gb, h, nx) do { if constexpr (GATHER) { _Pragma("unroll") for (int _i = 0; _i < 2; ++_i) { const unsigned vo_ = (nx) ? nvA[h][_i] : vA[h][_i]; \
        __builtin_amdgcn_global_load_lds((const unsigned*)((const char*)(gb) + vo_), (PG8_LAS unsigned*)(lds + (bufoff) + ldsw + _i * 8192), 16, 0, 0); } } else { PG8_STAGE(bufoff, (gb) + (h) * hstep, voffA); } } while (0)
#define PG8_LDA(dst, b, h) do { _Pragma("unroll") for (int m = 0; m < 4; ++m) _Pragma("unroll") for (int k = 0; k < 2; ++k) dst[m][k] = *(const PG8_LAS bf16x8*)(lds + PG8_SA(b, h) + aoff + m * 2048 + k * 1024); } while (0)
#define PG8_LDB(dst, b, h) do { _Pragma("unroll") for (int n = 0; n < 2; ++n) _Pragma("unroll") for (int k = 0; k < 2; ++k) dst[n][k] = *(const PG8_LAS bf16x8*)(lds + PG8_SB(b, h) + boff + n * 2048 + k * 1024); } while (0)
#define PG8_MMA(ai, bj, At, Bt) do { __builtin_amdgcn_s_setprio(1); _Pragma("unroll") for (int m = 0; m < 4; ++m) _Pragma("unroll") for (int n = 0; n < 2; ++n) _Pragma("unroll") for (int k = 0; k < 2; ++k) \
        acc[ai][bj][m][n] = __builtin_amdgcn_mfma_f32_16x16x32_bf16(Bt[n][k], At[m][k], acc[ai][bj][m][n], 0, 0, 0); __builtin_amdgcn_s_setprio(0); } while (0)
#define PG8_WAIT_V(n) asm volatile("s_waitcnt vmcnt(" #n ")" ::: "memory")
#define PG8_WAIT_L(n) asm volatile("s_waitcnt lgkmcnt(" #n ")" ::: "memory")
#define PG8_BAR __builtin_amdgcn_s_barrier()
#define PG8_SCHED __builtin_amdgcn_sched_barrier(0)
    Unit cur, nxt; int ui = 0;
    if (!S.next(0, cur)) return;
    f32x4 acc[2][2][4][2];
#pragma unroll
    for (int a = 0; a < 2; ++a)
#pragma unroll
        for (int b = 0; b < 2; ++b)
#pragma unroll
            for (int m = 0; m < 4; ++m)
#pragma unroll
                for (int n = 0; n < 2; ++n) acc[a][b][m][n] = (f32x4){0.f, 0.f, 0.f, 0.f};
    bf16x8 At[4][2], B0[2][2], B1[2][2];
    const char* cA = (const char*)g.A + (GATHER ? (size_t)0 : (size_t)cur.pm * tstep); const char* cB = (const char*)g.Bt + (size_t)cur.pn * tstep;
    if constexpr (GATHER) PG8_GROWS(vA, cur);
    S.a_ready(cur);
    if constexpr (SP2) {
        PG8_STAGE(PG8_SB(0, 0), cB, voffB); PG8_STAGE(PG8_SB(0, 1), cB + hstep, voffB); PG8_STAGE_A(PG8_SA(0, 0), cA, 0, false); PG8_STAGE_A(PG8_SA(0, 1), cA, 1, false);
        if (wr == 1) PG8_BAR;
        PG8_WAIT_V(2); PG8_BAR;
        PG8_STAGE(PG8_SB(1, 0), cB + kstep, voffB); PG8_STAGE_A(PG8_SA(1, 0), cA + kstep, 0, false); PG8_STAGE(PG8_SB(1, 1), cB + hstep + kstep, voffB);
        PG8_WAIT_V(6); PG8_BAR;
    } else {
        PG8_STAGE(PG8_SB(0, 0), cB, voffB); PG8_STAGE(PG8_SA(0, 0), cA, voffA); PG8_STAGE(PG8_SB(0, 1), cB + hstep, voffB); PG8_STAGE(PG8_SA(0, 1), cA + hstep, voffA);
        if (wr == 1) PG8_BAR;
        PG8_WAIT_V(4); PG8_BAR;
        PG8_STAGE(PG8_SB(1, 0), cB + kstep, voffB); PG8_STAGE(PG8_SA(1, 0), cA + kstep, voffA); PG8_STAGE(PG8_SB(1, 1), cB + hstep + kstep, voffB);
        PG8_WAIT_V(6); PG8_BAR;
    }
    for (;;) {
        const bool has_next = S.next(ui + 1, nxt);
        const char* nA = (has_next && !GATHER) ? (const char*)g.A + (size_t)nxt.pm * tstep : cA; const char* nB = has_next ? (const char*)g.Bt + (size_t)nxt.pn * tstep : cB;
        if constexpr (GATHER) { if (has_next) PG8_GROWS(nvA, nxt); else { nvA[0][0] = vA[0][0]; nvA[0][1] = vA[0][1]; nvA[1][0] = vA[1][0]; nvA[1][1] = vA[1][1]; } }
        for (int t = 0; t < nt; t += 2) {
            const bool last = (t == nt - 2);
            const char* a1 = cA + (size_t)(t + 1) * kstep;
            const char* a2 = last ? nA : cA + (size_t)(t + 2) * kstep; const char* b2 = last ? nB : cB + (size_t)(t + 2) * kstep;
            const char* a3 = a2 + kstep; const char* b3 = b2 + kstep;
            if (last && has_next) S.a_ready(nxt);
            if constexpr (SP2) {
            PG8_LDB(B0, 0, 0); PG8_LDB(B1, 0, 1); PG8_SCHED; PG8_LDA(At, 0, 0); PG8_STAGE_A(PG8_SA(1, 1), a1, 1, false);
            PG8_WAIT_V(8); PG8_WAIT_L(0); PG8_BAR; PG8_MMA(0, 0, At, B0); PG8_MMA(0, 1, At, B1); PG8_BAR; PG8_SCHED;
            PG8_LDA(At, 0, 1); PG8_STAGE(PG8_SB(0, 0), b2, voffB); PG8_STAGE(PG8_SB(0, 1), b2 + hstep, voffB); PG8_STAGE_A(PG8_SA(0, 0), a2, 0, last);
            PG8_WAIT_V(8); PG8_WAIT_L(0); PG8_BAR; PG8_MMA(1, 0, At, B0); PG8_MMA(1, 1, At, B1); PG8_BAR; PG8_SCHED;
            PG8_LDB(B0, 1, 0); PG8_LDB(B1, 1, 1); PG8_SCHED; PG8_LDA(At, 1, 0); PG8_STAGE_A(PG8_SA(0, 1), a2, 1, last);
            PG8_WAIT_V(8); PG8_WAIT_L(0); PG8_BAR; PG8_MMA(0, 0, At, B0); PG8_MMA(0, 1, At, B1); PG8_BAR; PG8_SCHED;
            PG8_LDA(At, 1, 1); PG8_STAGE(PG8_SB(1, 0), b3, voffB); PG8_STAGE(PG8_SB(1, 1), b3 + hstep, voffB); PG8_STAGE_A(PG8_SA(1, 0), a3, 0, last);
            PG8_WAIT_V(8); PG8_WAIT_L(0); PG8_BAR; PG8_MMA(1, 0, At, B0); PG8_MMA(1, 1, At, B1); PG8_BAR; PG8_SCHED;
            } else {
            PG8_LDB(B0, 0, 0); PG8_SCHED; PG8_LDA(At, 0, 0); PG8_STAGE(PG8_SA(1, 1), a1 + hstep, voffA);
            PG8_WAIT_L(8); PG8_BAR; PG8_WAIT_L(0); PG8_MMA(0, 0, At, B0); PG8_BAR; PG8_SCHED;
            PG8_LDB(B1, 0, 1); PG8_STAGE(PG8_SB(0, 0), b2, voffB);
            PG8_BAR; PG8_WAIT_L(0); PG8_MMA(0, 1, At, B1); PG8_BAR;
            PG8_LDA(At, 0, 1); PG8_STAGE(PG8_SA(0, 0), a2, voffA);
            PG8_BAR; PG8_WAIT_L(0); PG8_MMA(1, 0, At, B0); PG8_BAR; PG8_SCHED;
            PG8_STAGE(PG8_SB(0, 1), b2 + hstep, voffB);
            PG8_WAIT_V(6); PG8_BAR; PG8_MMA(1, 1, At, B1); PG8_BAR;
            PG8_LDB(B0, 1, 0); PG8_SCHED; PG8_LDA(At, 1, 0); PG8_STAGE(PG8_SA(0, 1), a2 + hstep, voffA);
            PG8_WAIT_L(8); PG8_BAR; PG8_WAIT_L(0); PG8_MMA(0, 0, At, B0); PG8_BAR; PG8_SCHED;
            PG8_LDB(B1, 1, 1); PG8_STAGE(PG8_SB(1, 0), b3, voffB);
            PG8_BAR; PG8_WAIT_L(0); PG8_MMA(0, 1, At, B1); PG8_BAR;
            PG8_LDA(At, 1, 1); PG8_STAGE(PG8_SA(1, 0), a3, voffA);
            PG8_BAR; PG8_WAIT_L(0); PG8_MMA(1, 0, At, B0); PG8_BAR; PG8_SCHED;
            PG8_STAGE(PG8_SB(1, 1), b3 + hstep, voffB);
            PG8_WAIT_V(6); PG8_BAR; PG8_MMA(1, 1, At, B1); PG8_BAR;
            }
        }
        if constexpr (ALIGN_EPI) { if (wr == 0) PG8_BAR; }
        if constexpr (!Epi::AFTER_DRAIN) { E(acc, cur, wr, wc, fr, fq); S.done(cur); }
        if (!has_next) break;
#pragma unroll
        for (int a = 0; a < 2; ++a)
#pragma unroll
            for (int b = 0; b < 2; ++b)
#pragma unroll
                for (int m = 0; m < 4; ++m)
#pragma unroll
                    for (int n = 0; n < 2; ++n) acc[a][b][m][n] = (f32x4){0.f, 0.f, 0.f, 0.f};
        cur = nxt; cA = nA; cB = nB; ++ui;
        if constexpr (GATHER) { vA[0][0] = nvA[0][0]; vA[0][1] = nvA[0][1]; vA[1][0] = nvA[1][0]; vA[1][1] = nvA[1][1]; }
        if constexpr (ALIGN_EPI) { if (wr == 1) PG8_BAR; }
    }
    PG8_WAIT_V(0);
    if constexpr (!ALIGN_EPI) { if (wr == 0) PG8_BAR; }
    PG8_BAR;
    if constexpr (Epi::AFTER_DRAIN) { E.fused(acc, cur, wr, wc, fr, fq, lds, wid, lane); S.done(cur); }
#undef PG8_SA
#undef PG8_SB
#undef PG8_STAGE
#undef PG8_STAGE_A
#undef PG8_GROWS
#undef PG8_LDA
#undef PG8_LDB
#undef PG8_MMA
#undef PG8_WAIT_V
#undef PG8_WAIT_L
#undef PG8_BAR
#undef PG8_SCHED
}
}

constexpr int NWAVES = 8;
#ifndef MK_PER_PHASE
#define MK_PER_PHASE 0
#endif
#ifndef MK_NAIVE_ATTN
#define MK_NAIVE_ATTN 0
#endif
#ifndef DBG_SKIP_ATTN
#define DBG_SKIP_ATTN 0
#endif
#ifndef DBG_SKIP_MOE
#define DBG_SKIP_MOE 0
#endif
#ifndef DBG_SKIP_MIX
#define DBG_SKIP_MIX 0
#endif
#ifndef DBG_CMP_ATT
#define DBG_CMP_ATT 0
#endif
#ifndef DBG_REP
#define DBG_REP -1
#endif
#ifndef DBG_PROBE
#define DBG_PROBE 0
#endif
constexpr int N_PHASES = 14;

constexpr int BATCH = 2, SEQ = 8192, D = 1024, T = BATCH * SEQ;
constexpr int NH = 8, HD = 64, AW = 512, IDXH = 8, IDXD = 64, TOPK = 256;
constexpr int NIN = 5704, NINP = 5888;
constexpr int NEXP = 32, DEXP = 512;
constexpr int XPROWS = 40960;
constexpr float EPS = 1e-6f;
constexpr float LOG2E = 1.4426950408889634f;
constexpr float C2 = 0.125f * LOG2E;

constexpr size_t MiB = 1u << 20;
constexpr size_t WS_CTL = 0, CTL_ZERO_BYTES = 1 * MiB;
constexpr size_t WS_SMALL = 1 * MiB;
constexpr size_t SM_MOD = WS_SMALL + 0;
constexpr size_t SM_WRT = WS_SMALL + 65536;
constexpr size_t SM_EID = WS_SMALL + 262144;
constexpr size_t SM_EWT = WS_SMALL + 393216;
constexpr size_t SM_SLOT = WS_SMALL + 524288;
constexpr size_t SM_AT = WS_SMALL + 655360;
constexpr size_t WS_WIN = 3 * MiB;
constexpr size_t WS_WA = 15 * MiB, WS_WC = 16 * MiB, WS_WOUT = 17 * MiB;
constexpr size_t WS_H1 = 19 * MiB;
constexpr size_t WS_AC = 19 * MiB, WS_ATT = 35 * MiB;
constexpr size_t WS_Q = 51 * MiB, WS_K = 67 * MiB, WS_V = 83 * MiB, WS_MASK = 83 * MiB, WS_VT = 99 * MiB, WS_QI = 115 * MiB, WS_KI = 131 * MiB;
constexpr size_t WS_WI = 133 * MiB, WS_QL = 133 * MiB + 524288;
constexpr size_t WS_CB = 136 * MiB, WS_U = 152 * MiB, WS_TMPC = 136 * MiB, WS_G = 168 * MiB;
constexpr size_t WS_MERGED = 51 * MiB;
constexpr size_t WS_WGU = 51 * MiB, WS_WD = 115 * MiB;
constexpr size_t WS_HID = 147 * MiB;
constexpr size_t WS_Y = 187 * MiB;
constexpr size_t WS_END = DBG_CMP_ATT ? 300 * MiB : 267 * MiB;
constexpr size_t WS_MASK_DBG = 268 * MiB, WS_ATT2 = 284 * MiB;
constexpr int CW_CMP = 2048;
constexpr int CW_TMO = 0, CW_CODE = 1, CW_KMAX = 64, CW_ECNT = 1024  , CW_BAR = 4096, CW_AROW = 131072  ;

constexpr int RING_OFF = 0, RING_BYTES = 131072;
constexpr int LDSCTL_OFF = RING_BYTES, MISC_OFF = LDSCTL_OFF + 320;
constexpr int LDS_BYTES = 147456;

#define GAS __attribute__((address_space(1)))
#define LAS __attribute__((address_space(3)))
typedef unsigned short bf16;
typedef unsigned v4u __attribute__((ext_vector_type(4)));
typedef unsigned v2u __attribute__((ext_vector_type(2)));
typedef float f32x4 __attribute__((ext_vector_type(4)));
typedef short bf16x8 __attribute__((ext_vector_type(8)));
typedef GAS unsigned gu32;
#define RLX_AGENT __ATOMIC_RELAXED, __HIP_MEMORY_SCOPE_AGENT
#define LDS_WAIT() asm volatile("s_waitcnt lgkmcnt(0)" ::: "memory")
#define VM_WAIT() asm volatile("s_waitcnt vmcnt(0)" ::: "memory")
__device__ __forceinline__ unsigned f2bf(float f) { unsigned u = __builtin_bit_cast(unsigned, f); return (u + 0x7fffu + ((u >> 16) & 1u)) >> 16; }
__device__ __forceinline__ unsigned pk2(float lo, float hi) { return f2bf(lo) | (f2bf(hi) << 16); }
__device__ __forceinline__ float bflo(unsigned u) { return __builtin_bit_cast(float, u << 16); }
__device__ __forceinline__ float bfhi(unsigned u) { return __builtin_bit_cast(float, u & 0xffff0000u); }
__device__ __forceinline__ float bf1(bf16 h) { return __builtin_bit_cast(float, (unsigned)h << 16); }
__device__ __forceinline__ float wave_sum(float v) {
#pragma unroll
    for (int o = 1; o < 64; o <<= 1) v += __shfl_xor(v, o);
    return v;
}
#define DPP_F(v, ctrl, row_mask) __builtin_bit_cast(float, __builtin_amdgcn_update_dpp(0, __builtin_bit_cast(int, (v)), (ctrl), (row_mask), 0xf, false))
__device__ __forceinline__ float wave_sum63(float v) {
    v += DPP_F(v, 0x111, 0xf); v += DPP_F(v, 0x112, 0xf); v += DPP_F(v, 0x114, 0xf); v += DPP_F(v, 0x118, 0xf);
    v += DPP_F(v, 0x142, 0xa);
    v += DPP_F(v, 0x143, 0xc);
    return v;
}
__device__ __forceinline__ float wave_sum_all(float v) { return __builtin_bit_cast(float, __builtin_amdgcn_readlane(__builtin_bit_cast(int, wave_sum63(v)), 63)); }
__device__ __forceinline__ float wave_max(float v) {
#pragma unroll
    for (int o = 1; o < 64; o <<= 1) v = fmaxf(v, __shfl_xor(v, o));
    return v;
}

#define XB_TMO      128
#define XB_XCNT(j)  (256  + 64 * (j))
#define XB_XSUB(j)  (1280 + 64 * (j))
#define XB_XGEN(j)  (2304 + 64 * (j))
#define XB_TOP      3328
#define XB_TOPGEN   3392
#define XCD_BAR_WORDS 3456
#define XB_SPIN_CAP (1u << 18)

__device__ __forceinline__ unsigned xb_ld(unsigned* p)              { return __hip_atomic_load(p, __ATOMIC_RELAXED, __HIP_MEMORY_SCOPE_AGENT); }
__device__ __forceinline__ unsigned xb_add(unsigned* p, unsigned v) { return __hip_atomic_fetch_add(p, v, __ATOMIC_RELAXED, __HIP_MEMORY_SCOPE_AGENT); }
__device__ __forceinline__ unsigned xb_xcc_id() { return (unsigned)__builtin_amdgcn_s_getreg((3 << 11) | 20) & 0xFu; }
#define XB_SPIN(cond, bar) do { unsigned _sp = 0; while (cond) { __builtin_amdgcn_s_sleep(1); \
    if ((++_sp & 255u) == 0u) { if (xb_ld(&(bar)[XB_TMO])) break; if (_sp > XB_SPIN_CAP) { atomicAdd(&(bar)[XB_TMO], 1u); break; } } } } while (0)

struct XcdBarrier { unsigned* bar; unsigned x; volatile LAS unsigned* st; };

__device__ __forceinline__ XcdBarrier xcd_barrier_post(unsigned* bar, volatile LAS unsigned* st) {
    XcdBarrier b; b.bar = bar; b.x = xb_xcc_id(); b.st = st;
    if (threadIdx.x == 0) (void)xb_add(&bar[XB_XCNT(b.x)], 1u);
    return b;
}
__device__ __forceinline__ void xcd_barrier_complete(unsigned* bar, unsigned x, unsigned& nloc, unsigned& nx) {
    const unsigned G = gridDim.x * gridDim.y * gridDim.z;
    unsigned sum, cnt, mine, sp = 0u;
    for (;;) {
        sum = 0u; cnt = 0u; mine = 0u;
#pragma unroll
        for (unsigned j = 0; j < 16; ++j) { const unsigned c = xb_ld(&bar[XB_XCNT(j)]); sum += c; cnt += (c > 0u) ? 1u : 0u; mine = (j == x) ? c : mine; }
        if (sum == G) break;
        __builtin_amdgcn_s_sleep(1);
        if ((++sp & 255u) == 0u) { if (xb_ld(&bar[XB_TMO])) break; if (sp > XB_SPIN_CAP) { atomicAdd(&bar[XB_TMO], 1u); break; } }
    }
    nloc = mine > 0u ? mine : 1u; nx = cnt > 0u ? cnt : 1u;
}
__device__ __forceinline__ void xcd_barrier(const XcdBarrier& b, const bool is_t0  ) {
    asm volatile("s_waitcnt vmcnt(0)" ::: "memory");
    __syncthreads();
    if (is_t0) {
        unsigned* bar = b.bar;
        __builtin_amdgcn_s_waitcnt(0);
        unsigned nloc = b.st[0], nx = b.st[1];
        if (nloc == 0u) { xcd_barrier_complete(bar, b.x, nloc, nx); b.st[0] = nloc; b.st[1] = nx; }
        const unsigned old = xb_add(&bar[XB_XSUB(b.x)], 1u);
        const unsigned gen = old / nloc;
        if (old + 1u == (gen + 1u) * nloc) {
            __builtin_amdgcn_fence(__ATOMIC_RELEASE, "agent");
            asm volatile("s_waitcnt vmcnt(0)" ::: "memory");
            const unsigned og = xb_add(&bar[XB_TOP], 1u);
            const unsigned tg = og / nx;
            if (og + 1u == (tg + 1u) * nx) xb_add(&bar[XB_TOPGEN], 1u);
            else XB_SPIN(xb_ld(&bar[XB_TOPGEN]) == tg, bar);
            __builtin_amdgcn_fence(__ATOMIC_ACQUIRE, "agent");
            xb_add(&bar[XB_XGEN(b.x)], 1u);
            asm volatile("s_waitcnt vmcnt(0)" ::: "memory");
        } else {
            XB_SPIN(xb_ld(&bar[XB_XGEN(b.x)]) == gen, bar);
            __builtin_amdgcn_fence(__ATOMIC_ACQUIRE, "agent");
            asm volatile("s_waitcnt vmcnt(0)" ::: "memory");
        }
    }
    __syncthreads();
}

struct Frame {
    LAS unsigned char* lds;
    volatile LAS unsigned* MISC;
    gu32* ctl;
    unsigned char* ws;
    int tid, lane, wave;
    int vcu, G;
    const float *x, *c, *w_ada, *b_ada, *norm1_g, *w_in, *rel_bias, *conv_w, *w_attn, *w_conv, *w_out, *norm2_g, *wrg, *brg, *wre, *bre, *w_gate_e, *w_up_e, *w_down_e, *norm_f_g;
    float* out;
};
#define WSP(T_, off) ((T_*)(F.ws + (off)))

template <class RowMap>
__device__ __forceinline__ void transpose_item(const float* W, int K, int N, bf16* WT, LAS float* scr, int item, int lane, RowMap rm) {
    const int nblk = (N + 31) / 32, kb = item / nblk, nb = item % nblk, k0 = 64 * kb, n0 = 32 * nb;
    const int nn = n0 + (lane & 31);
#pragma unroll 8
    for (int i = 0; i < 32; ++i) { const int kk = 2 * i + (lane >> 5); scr[kk * 33 + (lane & 31)] = (nn < N) ? W[(size_t)(k0 + kk) * N + nn] : 0.f; }
    LDS_WAIT(); asm volatile("" ::: "memory");
    const int c = lane & 7;
#pragma unroll
    for (int j = 0; j < 4; ++j) { const int n = (lane >> 3) + 8 * j; const LAS float* s = scr + (8 * c) * 33 + n;
        v4u o; o.x = pk2(s[0 * 33], s[1 * 33]); o.y = pk2(s[2 * 33], s[3 * 33]); o.z = pk2(s[4 * 33], s[5 * 33]); o.w = pk2(s[6 * 33], s[7 * 33]);
        if (n0 + n < N) *(GAS v4u*)(WT + (size_t)rm(n0 + n) * K + k0 + 8 * c) = o; }
    LDS_WAIT(); asm volatile("" ::: "memory");
}
struct RmId { __device__ __forceinline__ int operator()(int n) const { return n; } };
struct RmWin { __device__ __forceinline__ int operator()(int n) const {
    if (n < 2120) return n;
    if (n < 2632) return n + 184;
    if (n < 3144) { const int j = n - 2632; return 2816 + 256 * (j >> 7) + (j & 127); }
    if (n < 3656) { const int j = n - 3144; return 2816 + 256 * (j >> 7) + 128 + (j & 127); }
    return n + 184; } };
struct RmGU { int half; __device__ __forceinline__ int operator()(int n) const { return 256 * (n >> 7) + 128 * half + (n & 127); } };

__device__ __forceinline__ void p0_prologue(Frame& F) {
    LAS float* scr = (LAS float*)(F.lds + RING_OFF + F.wave * 16384);
    const int gw = F.vcu * NWAVES + F.wave, NGW = F.G * NWAVES;
    if (F.vcu < 96) {
        const int n = F.vcu * 64 + F.lane; float a0 = 0.f, a1 = 0.f;
        LAS float* cact = (LAS float*)(F.lds + RING_OFF + 16384);
        for (int i = F.tid; i < 2 * D; i += 512) { const float cv = F.c[i]; cact[i] = cv / (1.f + __expf(-cv)); }
        __syncthreads();
#pragma unroll 16
        for (int k = F.wave * 128; k < F.wave * 128 + 128; ++k) {
            const float w = F.w_ada[(size_t)k * 6144 + n];
            a0 += cact[k] * w; a1 += cact[D + k] * w;
        }
        LAS float* red = (LAS float*)(F.lds + RING_OFF + 8448);
        red[(F.wave * 2 + 0) * 64 + F.lane] = a0; red[(F.wave * 2 + 1) * 64 + F.lane] = a1;
        __syncthreads();
        if (F.wave < 2) { float s = F.b_ada[n];
#pragma unroll
            for (int w = 0; w < 8; ++w) s += red[(w * 2 + F.wave) * 64 + F.lane];
            WSP(float, SM_MOD)[F.wave * 6144 + n] = s; }
        __syncthreads();
    }
    constexpr int I_IN = 16 * 179;
    for (int it = gw; it < I_IN; it += NGW) transpose_item(F.w_in, D, NIN, WSP(bf16, WS_WIN), scr, it, F.lane, RmWin());
    for (int i = gw * 64 + F.lane; i < 184 * 128; i += NGW * 64) { *(GAS v4u*)(WSP(bf16, WS_WIN) + (size_t)2120 * D + (size_t)i * 8) = (v4u){0u, 0u, 0u, 0u}; }
    for (int i = gw * 64 + F.lane; i < 36 * D; i += NGW * 64) { const int n = i / D, k = i % D; WSP(float, SM_WRT)[i] = (n < 4) ? F.wrg[k * 4 + n] : F.wre[k * 32 + (n - 4)]; }
}

__device__ __forceinline__ void p1_norm1(Frame& F) {
    const int gw = F.vcu * NWAVES + F.wave, NGW = F.G * NWAVES;
    const float* mod = WSP(float, SM_MOD);
    for (int m0 = gw * 4; m0 < T; m0 += NGW * 4) {
        const int b = m0 / SEQ;
        f32x4 v[4][4]; float ss[4];
#pragma unroll
        for (int r = 0; r < 4; ++r) { const GAS f32x4* xr = (const GAS f32x4*)(F.x + (size_t)(m0 + r) * D) + F.lane;
#pragma unroll
            for (int j = 0; j < 4; ++j) v[r][j] = xr[64 * j]; }
#pragma unroll
        for (int r = 0; r < 4; ++r) { float s = 0.f;
#pragma unroll
            for (int j = 0; j < 4; ++j) s += (v[r][j].x * v[r][j].x + v[r][j].y * v[r][j].y) + (v[r][j].z * v[r][j].z + v[r][j].w * v[r][j].w);
            ss[r] = 1.f / sqrtf(wave_sum_all(s) * (1.f / D) + EPS); }
#pragma unroll
        for (int j = 0; j < 4; ++j) { const int k = 4 * F.lane + 256 * j;
            const f32x4 g = *(const f32x4*)(F.norm1_g + k), sc = *(const f32x4*)(mod + b * 6144 + 1024 + k), sh = *(const f32x4*)(mod + b * 6144 + k);
            const f32x4 ca = g * (sc + 1.0f);
#pragma unroll
            for (int r = 0; r < 4; ++r) { const f32x4 h = v[r][j] * ss[r] * ca + sh; ((GAS v2u*)(WSP(bf16, WS_H1) + (size_t)(m0 + r) * D) + F.lane)[64 * j] = (v2u){pk2(h.x, h.y), pk2(h.z, h.w)}; } }
    }
}

using pg8::Unit;
typedef float f32x2_t __attribute__((ext_vector_type(2))); typedef __bf16 bf16x2_t __attribute__((ext_vector_type(2)));
__device__ __forceinline__ unsigned cvtpk(float lo, float hi) { f32x2_t v = {lo, hi}; bf16x2_t b = __builtin_convertvector(v, bf16x2_t); return __builtin_bit_cast(unsigned, b); }
__device__ __forceinline__ v4u pack8(const f32x4 a, const f32x4 b) { v4u w; w.x = cvtpk(a[0], a[1]); w.y = cvtpk(a[2], a[3]); w.z = cvtpk(b[0], b[1]); w.w = cvtpk(b[2], b[3]); return w; }
__device__ __forceinline__ float sigmoidf_(float x) { return __builtin_amdgcn_rcpf(1.f + __builtin_amdgcn_exp2f(-x * LOG2E)); }
__device__ __forceinline__ f32x4 sig4(f32x4 v) { return (f32x4){sigmoidf_(v[0]), sigmoidf_(v[1]), sigmoidf_(v[2]), sigmoidf_(v[3])}; }
__device__ __forceinline__ void unpack8(const v4u w, f32x4& a, f32x4& b) { a = (f32x4){bflo(w.x), bfhi(w.x), bflo(w.y), bfhi(w.y)}; b = (f32x4){bflo(w.z), bfhi(w.z), bflo(w.w), bfhi(w.w)}; }

struct EpiProj {
    static constexpr bool PERM = true, AFTER_DRAIN = false;
    bf16 *Q, *K, *V, *QI, *KI, *CB, *U, *G; float* WI;
    __device__ __forceinline__ void operator()(const f32x4 (&acc)[2][2][4][2], const Unit& u, int wr, int wc, int fr, int fq) const {
        const int pn = u.pn, row0 = u.pm * 256 + wr * 64 + fr, cb8 = wc * 32 + 8 * fq;
        if (pn < 8 || pn == 9 || pn == 10) {
            bf16* base; int coff; float sc = 1.f;
            if (pn < 2) { base = Q; coff = 256 * pn; sc = C2; } else if (pn < 4) { base = K; coff = 256 * (pn - 2); } else if (pn < 6) { base = V; coff = 256 * (pn - 4); }
            else if (pn < 8) { base = QI; coff = 256 * (pn - 6); } else { base = CB; coff = 256 * (pn - 9); }
#pragma unroll
            for (int ai = 0; ai < 2; ++ai)
#pragma unroll
                for (int m = 0; m < 4; ++m) { bf16* rowp = base + (size_t)(row0 + ai * 128 + m * 16) * 512 + coff + cb8;
#pragma unroll
                    for (int bj = 0; bj < 2; ++bj) *(v4u*)(rowp + bj * 128) = pack8(acc[ai][bj][m][0] * sc, acc[ai][bj][m][1] * sc); }
        } else if (pn == 8) {
#pragma unroll
            for (int ai = 0; ai < 2; ++ai)
#pragma unroll
                for (int m = 0; m < 4; ++m) { const size_t row = (size_t)(row0 + ai * 128 + m * 16);
                    if (wc < 2) *(v4u*)(KI + row * 64 + cb8) = pack8(acc[ai][0][m][0], acc[ai][0][m][1]);
                    else if (wc == 2 && fq == 0) { *(f32x4*)(WI + row * 8) = acc[ai][0][m][0]; *(f32x4*)(WI + row * 8 + 4) = acc[ai][0][m][1]; } }
        } else if (pn < 15) {
#pragma unroll
            for (int ai = 0; ai < 2; ++ai)
#pragma unroll
                for (int m = 0; m < 4; ++m) { const size_t row = (size_t)(row0 + ai * 128 + m * 16);
                    *(v4u*)(U + row * 512 + 128 * (pn - 11) + cb8) = pack8(acc[ai][0][m][0] * acc[ai][1][m][0], acc[ai][0][m][1] * acc[ai][1][m][1]); }
        } else {
#pragma unroll
            for (int ai = 0; ai < 2; ++ai)
#pragma unroll
                for (int m = 0; m < 4; ++m) { bf16* rowp = G + (size_t)(row0 + ai * 128 + m * 16) * 2048 + 256 * (pn - 15) + cb8;
#pragma unroll
                    for (int bj = 0; bj < 2; ++bj) *(v4u*)(rowp + bj * 128) = pack8(sig4(acc[ai][bj][m][0]), sig4(acc[ai][bj][m][1])); }
        }
    }
};
struct EpiConv {
    static constexpr bool PERM = true, AFTER_DRAIN = false;
    const bf16* G; bf16* O;
    __device__ __forceinline__ void operator()(const f32x4 (&acc)[2][2][4][2], const Unit& u, int wr, int wc, int fr, int fq) const {
        const int row0 = u.pm * 256 + wr * 64 + fr, col0 = u.pn * 256 + wc * 32 + 8 * fq;
#pragma unroll
        for (int ai = 0; ai < 2; ++ai)
#pragma unroll
            for (int m = 0; m < 4; ++m) { const size_t row = (size_t)(row0 + ai * 128 + m * 16);
#pragma unroll
                for (int bj = 0; bj < 2; ++bj) { f32x4 g0, g1; unpack8(*(const v4u*)(G + row * 2048 + 1024 + col0 + bj * 128), g0, g1);
                    *(v4u*)(O + row * 1024 + col0 + bj * 128) = pack8(g0 * acc[ai][bj][m][0], g1 * acc[ai][bj][m][1]); } }
    }
};
struct EpiAttn {
    static constexpr bool PERM = true, AFTER_DRAIN = false;
    const bf16* G; const bf16* Tc; bf16* O;
    __device__ __forceinline__ void operator()(const f32x4 (&acc)[2][2][4][2], const Unit& u, int wr, int wc, int fr, int fq) const {
        const int row0 = u.pm * 256 + wr * 64 + fr, col0 = u.pn * 256 + wc * 32 + 8 * fq;
#pragma unroll
        for (int ai = 0; ai < 2; ++ai)
#pragma unroll
            for (int m = 0; m < 4; ++m) { const size_t row = (size_t)(row0 + ai * 128 + m * 16);
#pragma unroll
                for (int bj = 0; bj < 2; ++bj) { f32x4 g0, g1, t0, t1; unpack8(*(const v4u*)(G + row * 2048 + col0 + bj * 128), g0, g1); unpack8(*(const v4u*)(Tc + row * 1024 + col0 + bj * 128), t0, t1);
                    *(v4u*)(O + row * 1024 + col0 + bj * 128) = pack8(g0 * acc[ai][bj][m][0] + t0, g1 * acc[ai][bj][m][1] + t1); } }
    }
};
struct EpiOut {
    static constexpr bool PERM = false, AFTER_DRAIN = false;
    const float* X; const float* mod; float* O;
    __device__ __forceinline__ void operator()(const f32x4 (&acc)[2][2][4][2], const Unit& u, int wr, int wc, int fr, int fq) const {
        const int row0 = u.pm * 256 + wr * 64 + fr, col0 = u.pn * 256 + wc * 32 + 4 * fq;
        const float* g1 = mod + ((u.pm * 256) / SEQ) * 6144 + 2048;
#pragma unroll
        for (int bj = 0; bj < 2; ++bj)
#pragma unroll
            for (int n = 0; n < 2; ++n) { const int col = col0 + bj * 128 + n * 16; const f32x4 gv = *(const f32x4*)(g1 + col);
#pragma unroll
                for (int ai = 0; ai < 2; ++ai)
#pragma unroll
                    for (int m = 0; m < 4; ++m) { const size_t off = (size_t)(row0 + ai * 128 + m * 16) * D + col;
                        *(f32x4*)(O + off) = *(const f32x4*)(X + off) + gv * acc[ai][bj][m][n]; } }
    }
};
__device__ __forceinline__ f32x4 silu_mul4(f32x4 g, f32x4 u) { return (f32x4){g[0] * sigmoidf_(g[0]) * u[0], g[1] * sigmoidf_(g[1]) * u[1], g[2] * sigmoidf_(g[2]) * u[2], g[3] * sigmoidf_(g[3]) * u[3]}; }
struct EpiHid {
    static constexpr bool PERM = true, AFTER_DRAIN = false;
    bf16* O;
    __device__ __forceinline__ void operator()(const f32x4 (&acc)[2][2][4][2], const Unit& u, int wr, int wc, int fr, int fq) const {
        const int row0 = u.pm * 256 + wr * 64 + fr, col0 = 128 * (u.pn & 3) + wc * 32 + 8 * fq;
#pragma unroll
        for (int ai = 0; ai < 2; ++ai)
#pragma unroll
            for (int m = 0; m < 4; ++m) { const size_t row = (size_t)(row0 + ai * 128 + m * 16);
                *(v4u*)(O + row * 512 + col0) = pack8(silu_mul4(acc[ai][0][m][0], acc[ai][1][m][0]), silu_mul4(acc[ai][0][m][1], acc[ai][1][m][1])); }
    }
};
struct EpiY {
    static constexpr bool PERM = true, AFTER_DRAIN = false;
    bf16* O;
    __device__ __forceinline__ void operator()(const f32x4 (&acc)[2][2][4][2], const Unit& u, int wr, int wc, int fr, int fq) const {
        const int row0 = u.pm * 256 + wr * 64 + fr, col0 = 256 * (u.pn & 3) + wc * 32 + 8 * fq;
#pragma unroll
        for (int ai = 0; ai < 2; ++ai)
#pragma unroll
            for (int m = 0; m < 4; ++m) { const size_t row = (size_t)(row0 + ai * 128 + m * 16);
#pragma unroll
                for (int bj = 0; bj < 2; ++bj) *(v4u*)(O + row * 1024 + col0 + bj * 128) = pack8(acc[ai][bj][m][0], acc[ai][bj][m][1]); }
    }
};
struct MoeOrder {
    const LAS int* tile_e; int ntiles, G, c;
    __device__ __forceinline__ bool next(int i, Unit& u) const {
        const int L = i * G + c; if (L >= ntiles * 4) return false;
        const int rt = L >> 2, j = L & 3; u.pm = rt; u.pn = 4 * tile_e[rt] + j; return true; }
    __device__ __forceinline__ void a_ready(const Unit&) const {}
    __device__ __forceinline__ void done(const Unit&) const {}
};

__device__ __forceinline__ void p3_prep(Frame& F) {
    const int gw = F.vcu * NWAVES + F.wave, NGW = F.G * NWAVES;
    {
        LAS bf16* tl = (LAS bf16*)(F.lds + RING_OFF + F.wave * 16384);
        const bf16* V = WSP(bf16, WS_V); bf16* VT = WSP(bf16, WS_VT);
        for (int it = gw; it < BATCH * NH * (SEQ / 64); it += NGW) {
            const int kt = it % (SEQ / 64), h = (it / (SEQ / 64)) % NH, b = it / (NH * (SEQ / 64));
            const bf16* src = V + (size_t)(b * SEQ + kt * 64 + F.lane) * 512 + h * 64;
#pragma unroll
            for (int c = 0; c < 8; ++c) { const v4u w = *(const v4u*)(src + c * 8);
                LAS unsigned* d = (LAS unsigned*)(tl + F.lane * 66 + c * 8); d[0] = w.x; d[1] = w.y; d[2] = w.z; d[3] = w.w; }
            LDS_WAIT(); asm volatile("" ::: "memory");
            unsigned o[32];
#pragma unroll
            for (int p = 0; p < 64; p += 2) {
                const int i0 = p & 15, i1 = (p + 1) & 15, g = p & ~15;
                const int k0 = g + ((i0 < 4 || i0 >= 12) ? i0 : (i0 < 8 ? i0 + 4 : i0 - 4)), k1 = g + ((i1 < 4 || i1 >= 12) ? i1 : (i1 < 8 ? i1 + 4 : i1 - 4));
                o[p >> 1] = (unsigned)tl[k0 * 66 + F.lane] | ((unsigned)tl[k1 * 66 + F.lane] << 16); }
            bf16* dst = VT + ((size_t)((b * NH + h) * 64 + F.lane)) * SEQ + kt * 64;
#pragma unroll
            for (int c = 0; c < 8; ++c) *(v4u*)(dst + c * 8) = (v4u){o[4 * c], o[4 * c + 1], o[4 * c + 2], o[4 * c + 3]};
            LDS_WAIT(); asm volatile("" ::: "memory");
        }
    }
    {
        const bf16* CB = WSP(bf16, WS_CB); const bf16* U = WSP(bf16, WS_U); bf16* AC = WSP(bf16, WS_AC);
        const int j = F.lane * 8;
        const f32x4 w2a = *(const f32x4*)(F.conv_w + 1024 + j), w2b = *(const f32x4*)(F.conv_w + 1024 + j + 4), w1a = *(const f32x4*)(F.conv_w + 512 + j), w1b = *(const f32x4*)(F.conv_w + 512 + j + 4),
                    w0a = *(const f32x4*)(F.conv_w + j), w0b = *(const f32x4*)(F.conv_w + j + 4);
        for (int t0 = gw * 4; t0 < T; t0 += NGW * 4) {
            v4u cw[4], uw[6];
#pragma unroll
            for (int r = 0; r < 4; ++r) cw[r] = *(const v4u*)(CB + (size_t)(t0 + r) * 512 + j);
            const int tt0 = t0 % SEQ;
#pragma unroll
            for (int r = 0; r < 6; ++r) uw[r] = (tt0 + r - 2 >= 0) ? *(const v4u*)(U + (size_t)(t0 + r - 2) * 512 + j) : (v4u){0u, 0u, 0u, 0u};
#pragma unroll
            for (int r = 0; r < 4; ++r) {
                f32x4 c0, c1, a0, a1, b0, b1, d0, d1;
                unpack8(cw[r], c0, c1); unpack8(uw[r + 2], a0, a1); unpack8(uw[r + 1], b0, b1); unpack8(uw[r], d0, d1);
                *(v4u*)(AC + (size_t)(t0 + r) * 512 + j) = pack8(c0 * (a0 * w2a + b0 * w1a + d0 * w0a), c1 * (a1 * w2b + b1 * w1b + d1 * w0b));
            }
        }
    }
    {
        const bf16* QI = WSP(bf16, WS_QI); const float* WI = WSP(float, WS_WI); bf16* QL = WSP(bf16, WS_QL); float* AT = WSP(float, SM_AT);
        for (int t0 = gw * 4; t0 < T; t0 += NGW * 4) {
            float vv[4][8], ww[4][8];
#pragma unroll
            for (int r = 0; r < 4; ++r)
#pragma unroll
                for (int h = 0; h < 8; ++h) { ww[r][h] = WI[(size_t)(t0 + r) * 8 + h]; vv[r][h] = bf1(QI[(size_t)(t0 + r) * 512 + h * 64 + F.lane]); }
#pragma unroll
            for (int r = 0; r < 4; ++r) { float ql = 0.f, a = 0.f;
#pragma unroll
                for (int h = 0; h < 8; ++h) { ql += ww[r][h] * vv[r][h]; a += fabsf(ww[r][h]) * sqrtf(wave_sum63(vv[r][h] * vv[r][h])); }
                QL[(size_t)(t0 + r) * 64 + F.lane] = (bf16)f2bf(ql);
                if (F.lane == 63) AT[t0 + r] = a; }
        }
    }
    {
        const bf16* KI = WSP(bf16, WS_KI); float mx = 0.f;
        for (int s = gw * 64 + F.lane; s < T; s += NGW * 64) { float q = 0.f;
#pragma unroll
            for (int c = 0; c < 8; ++c) { f32x4 a, b; unpack8(*(const v4u*)(KI + (size_t)s * 64 + c * 8), a, b); q += (a[0] * a[0] + a[1] * a[1]) + (a[2] * a[2] + a[3] * a[3]) + (b[0] * b[0] + b[1] * b[1]) + (b[2] * b[2] + b[3] * b[3]); }
            mx = fmaxf(mx, q); }
        mx = wave_max(mx);
        if (F.lane == 0) atomicMax((unsigned*)(F.ctl + CW_KMAX), __builtin_bit_cast(unsigned, sqrtf(mx)));
    }
}

__device__ __forceinline__ unsigned ord_key(float x) { if (x == 0.f) x = 0.f; const unsigned u = __builtin_bit_cast(unsigned, x); return (u & 0x80000000u) ? ~u : (u | 0x80000000u); }
__device__ __forceinline__ int t5_bucket(int n) {
    if (n < 16) return n;
    const int v = 16 + (int)(logf((float)n / 16.f) / 2.0794415416798357f * 16.f);
    return v < 31 ? v : 31;
}
__device__ __forceinline__ void pn_naive_dsa(Frame& F) {
    LAS float* sc = (LAS float*)(F.lds + RING_OFF);
    LAS float* qf = (LAS float*)(F.lds + RING_OFF + 32768);
    LAS float* wq = qf + 512;
    LAS unsigned* hist = (LAS unsigned*)(F.lds + RING_OFF + 36864);
    LAS int* sel = (LAS int*)(F.lds + RING_OFF + 40960);
    LAS float* pbuf = (LAS float*)(F.lds + RING_OFF + 45056);
    LAS int* wcnt = (LAS int*)(F.lds + RING_OFF + 53248);
    LAS int* bkt = (LAS int*)(F.lds + RING_OFF + 53248 + 256);
    const bf16* QI = WSP(bf16, WS_QI); const bf16* KI = WSP(bf16, WS_KI); const float* WI = WSP(float, WS_WI);
    const bf16* Qb = WSP(bf16, WS_Q); const bf16* Kb = WSP(bf16, WS_K); const bf16* Vb = WSP(bf16, WS_V); bf16* ATT = WSP(bf16, WS_ATT);
    if (F.tid < 128) bkt[F.tid] = t5_bucket(F.tid);
    __syncthreads();
    for (int qi_ = 0; qi_ < T / F.G + 1; ++qi_) {
        const int qidx = qi_ * F.G + F.vcu; if (qidx >= T) break;
        const int b = qidx / SEQ, t = qidx % SEQ, n = t + 1;
        qf[F.tid] = bf1(QI[(size_t)qidx * 512 + F.tid]);
        if (F.tid < 8) wq[F.tid] = WI[(size_t)qidx * 8 + F.tid];
        __syncthreads();
        for (int s = F.tid; s < n; s += 512) {
            float kf[64]; const bf16* kr = KI + (size_t)(b * SEQ + s) * 64;
#pragma unroll
            for (int c = 0; c < 8; ++c) { f32x4 a, bb; unpack8(*(const v4u*)(kr + c * 8), a, bb); kf[8 * c] = a[0]; kf[8 * c + 1] = a[1]; kf[8 * c + 2] = a[2]; kf[8 * c + 3] = a[3]; kf[8 * c + 4] = bb[0]; kf[8 * c + 5] = bb[1]; kf[8 * c + 6] = bb[2]; kf[8 * c + 7] = bb[3]; }
            float score = 0.f;
#pragma unroll 1
            for (int h = 0; h < 8; ++h) { float dsum = 0.f;
#pragma unroll
                for (int d4 = 0; d4 < 16; ++d4) { const f32x4 q4 = *(const LAS f32x4*)(qf + h * 64 + d4 * 4); dsum += q4[0] * kf[4 * d4] + q4[1] * kf[4 * d4 + 1] + q4[2] * kf[4 * d4 + 2] + q4[3] * kf[4 * d4 + 3]; }
                score += wq[h] * fmaxf(dsum, 0.f); }
            sc[s] = score;
        }
        __syncthreads();
        unsigned prefix = 0u, pmask = 0u; int need = TOPK;
        if (n > TOPK) {
            for (int pass = 0; pass < 4; ++pass) {
                const int shift = 24 - 8 * pass;
                if (F.tid < 256) hist[F.tid] = 0u;
                __syncthreads();
                for (int s = F.tid; s < n; s += 512) { const unsigned u = ord_key(sc[s]); if ((u & pmask) == prefix) atomicAdd((unsigned*)&hist[(u >> shift) & 255u], 1u); }
                __syncthreads();
                if (F.wave == 0) {
                    int c4[4]; int tot = 0;
#pragma unroll
                    for (int j = 0; j < 4; ++j) { c4[j] = (int)hist[4 * F.lane + j]; tot += c4[j]; }
                    int incl = tot;
#pragma unroll
                    for (int o = 1; o < 64; o <<= 1) { const int v = __shfl_down(incl, o); if (F.lane + o < 64) incl += v; }
                    const int above = incl - tot;
                    if (above < need && need <= incl) { int run = above;
#pragma unroll
                        for (int j = 3; j >= 0; --j) { if (run < need && need <= run + c4[j]) { wcnt[16] = 4 * F.lane + j; wcnt[17] = need - run; } run += c4[j]; } }
                }
                __syncthreads();
                prefix |= (unsigned)wcnt[16] << shift; pmask |= 255u << shift; need = wcnt[17];
                __syncthreads();
            }
        }
        int cg = 0, ce = 0;
        for (int i = 0; i < 16; ++i) { const int s = F.wave * 1024 + i * 64 + F.lane; bool gt = false, eq = false;
            if (s < n) { if (n <= TOPK) gt = true; else { const unsigned u = ord_key(sc[s]); gt = u > prefix; eq = (u == prefix); } }
            cg += __popcll(__ballot(gt)); ce += __popcll(__ballot(eq)); }
        if (F.lane == 0) { wcnt[2 * F.wave] = cg; wcnt[2 * F.wave + 1] = ce; }
        __syncthreads();
        int eqb = 0, tkb = 0, nsel = 0;
        { int eq_before = 0;
          for (int w = 0; w < 8; ++w) { const int g = wcnt[2 * w], e = wcnt[2 * w + 1];
              int take_e = need - eq_before; take_e = take_e < 0 ? 0 : (take_e > e ? e : take_e); if (n <= TOPK) take_e = 0;
              if (w < F.wave) { eqb += e; tkb += g + take_e; }
              nsel += g + take_e; eq_before += e; } }
        for (int i = 0; i < 16; ++i) { const int s = F.wave * 1024 + i * 64 + F.lane; bool gt = false, eq = false;
            if (s < n) { if (n <= TOPK) gt = true; else { const unsigned u = ord_key(sc[s]); gt = u > prefix; eq = (u == prefix); } }
            const unsigned long long mg = __ballot(gt), me = __ballot(eq), lt = (1ull << F.lane) - 1ull;
            const int erank = eqb + __popcll(me & lt);
            const bool take = gt || (eq && erank < need);
            const unsigned long long mt = __ballot(take);
            if (take) sel[tkb + __popcll(mt & lt)] = s;
            eqb += __popcll(me); tkb += __popcll(mt); (void)mg; }
        __syncthreads();
        {
            const int h = F.wave;
            qf[F.tid] = bf1(Qb[(size_t)qidx * 512 + F.tid]);
            __syncthreads();
            float lg[4]; float mx = -INFINITY;
#pragma unroll
            for (int i = 0; i < 4; ++i) { const int j = F.lane + 64 * i; lg[i] = -INFINITY;
                if (j < nsel) { const int s = sel[j]; const bf16* kr = Kb + (size_t)(b * SEQ + s) * 512 + h * 64; float dsum = 0.f;
#pragma unroll
                    for (int c = 0; c < 8; ++c) { f32x4 a, bb; unpack8(*(const v4u*)(kr + c * 8), a, bb); const f32x4 q0 = *(const LAS f32x4*)(qf + h * 64 + c * 8), q1 = *(const LAS f32x4*)(qf + h * 64 + c * 8 + 4);
                        dsum += (q0[0] * a[0] + q0[1] * a[1]) + (q0[2] * a[2] + q0[3] * a[3]) + (q1[0] * bb[0] + q1[1] * bb[1]) + (q1[2] * bb[2] + q1[3] * bb[3]); }
                    const int dist = t - s; const int bk = dist < 128 ? bkt[dist] : 31;
                    lg[i] = dsum + F.rel_bias[bk * 8 + h] * LOG2E; mx = fmaxf(mx, lg[i]); } }
            mx = wave_max(mx); float sum = 0.f;
#pragma unroll
            for (int i = 0; i < 4; ++i) { const int j = F.lane + 64 * i; const float p = (j < nsel) ? __builtin_amdgcn_exp2f(lg[i] - mx) : 0.f; sum += p; pbuf[h * 256 + j] = p; }
            sum = wave_sum(sum);
            LDS_WAIT(); asm volatile("" ::: "memory");
            float o = 0.f;
            for (int j = 0; j < nsel; ++j) o += pbuf[h * 256 + j] * bf1(Vb[(size_t)(b * SEQ + sel[j]) * 512 + h * 64 + F.lane]);
            ATT[(size_t)qidx * 512 + h * 64 + F.lane] = (bf16)f2bf(o / sum);
        }
        __syncthreads();
    }
}


typedef float f32x16 __attribute__((ext_vector_type(16)));
#define MFMA32(a, b, c) __builtin_amdgcn_mfma_f32_32x32x16_bf16((a), (b), (c), 0, 0, 0)
__device__ __forceinline__ int crow(int r, int hi) { return (r & 3) + 8 * (r >> 2) + 4 * hi; }
constexpr int IDX_CTL = LDSCTL_OFF + 2048;
constexpr int IDX_CAP = 512;

#define MFMA16(a, b, c) __builtin_amdgcn_mfma_f32_16x16x32_bf16((a), (b), (c), 0, 0, 0)
__device__ __forceinline__ void idx_tile(const bf16x8 (&kf)[4][2], const bf16x8 (&ql)[2], const bf16x8 (&qf)[8][2], const LAS float* w  , float invA, unsigned (&key)[4][4]) {
    float sc[4][4];
#define IDX_MF(D, QF0, QF1) _Pragma("unroll") for (int a = 0; a < 2; ++a) { D[a] = (f32x4){0.f, 0.f, 0.f, 0.f}; D[a] = MFMA16(kf[2 * hf + a][0], QF0, D[a]); D[a] = MFMA16(kf[2 * hf + a][1], QF1, D[a]); }
#define IDX_AC(D, W) do { const float wv_ = (W); _Pragma("unroll") for (int a = 0; a < 2; ++a) _Pragma("unroll") for (int i = 0; i < 4; ++i) { float x_ = __builtin_fmaf(wv_, __builtin_fabsf(D[a][i]), sc[2 * hf + a][i]); asm volatile("" : "+v"(x_)); sc[2 * hf + a][i] = x_; } } while (0)
#pragma unroll
    for (int hf = 0; hf < 2; ++hf) {
        f32x4 dA[2], dB[2];
        IDX_MF(dA, ql[0], ql[1]);
        IDX_MF(dB, qf[0][0], qf[0][1]);
#pragma unroll
        for (int a = 0; a < 2; ++a)
#pragma unroll
            for (int i = 0; i < 4; ++i) { float x_ = dA[a][i]; asm volatile("" : "+v"(x_)); sc[2 * hf + a][i] = x_; }
        IDX_MF(dA, qf[1][0], qf[1][1]); IDX_AC(dB, w[0]);
        IDX_MF(dB, qf[2][0], qf[2][1]); IDX_AC(dA, w[1]);
        IDX_MF(dA, qf[3][0], qf[3][1]); IDX_AC(dB, w[2]);
        IDX_MF(dB, qf[4][0], qf[4][1]); IDX_AC(dA, w[3]);
        IDX_MF(dA, qf[5][0], qf[5][1]); IDX_AC(dB, w[4]);
        IDX_MF(dB, qf[6][0], qf[6][1]); IDX_AC(dA, w[5]);
        IDX_MF(dA, qf[7][0], qf[7][1]); IDX_AC(dB, w[6]);
        IDX_AC(dA, w[7]);
    }
#undef IDX_MF
#undef IDX_AC
#pragma unroll
    for (int a = 0; a < 4; ++a)
#pragma unroll
        for (int i = 0; i < 4; ++i) key[a][i] = __builtin_bit_cast(unsigned, __builtin_fmaf(sc[a][i], invA, 3.0f));
}
__device__ __forceinline__ void idx_load_k(bf16x8 (&kf)[4][2], const bf16* KItile  , unsigned voff  ) {
#pragma unroll
    for (int a = 0; a < 4; ++a)
#pragma unroll
        for (int ks = 0; ks < 2; ++ks) kf[a][ks] = *(const bf16x8*)((const char*)KItile + voff + a * 2048 + ks * 64);
}
template <int MODE>
__device__ __forceinline__ void idx_pass(Frame& F, int ln, const bf16* KIb, unsigned* MASKg, int t0, int nt_idx, int nt_att, const bf16x8 (&ql)[2], const bf16x8 (&qf)[8][2], const LAS float* w, float invA, int b1, unsigned thr) {
    const int qc = ln & 15, fq = ln >> 4, qh = F.wave & 1, kp = F.wave >> 1, ql_ = 16 * qh + qc, t = t0 + ql_;
    LAS unsigned* hrow = (LAS unsigned*)(F.lds + RING_OFF) + ql_ * 1025;
    const int ntl = (MODE >= 2) ? nt_att : nt_idx;
    LAS unsigned* mlds = (LAS unsigned*)(F.lds + RING_OFF);
    LAS unsigned* clist = (LAS unsigned*)(F.lds + RING_OFF + 32768);
    LAS unsigned* ccnt = (LAS unsigned*)(F.lds + IDX_CTL) + 96;
    bf16x8 kcur[4][2];
    const unsigned voff = (unsigned)(qc * 64 + fq * 8) * 2u;
#pragma unroll
    for (int a = 0; a < 4; ++a)
#pragma unroll
        for (int ks = 0; ks < 2; ++ks) kcur[a][ks] = (bf16x8){0, 0, 0, 0, 0, 0, 0, 0};
    if (kp < nt_idx) idx_load_k(kcur, KIb + (size_t)(64 * kp) * 64, voff);
    for (int kt = kp; kt < ntl; kt += 4) {
        unsigned m16 = 0u;
        if (kt < nt_idx) {
            unsigned key[4][4];
            const bool diag = 64 * kt + 63 > t0;
            idx_tile(kcur, ql, qf, w, invA, key);
            if (kt + 4 < nt_idx) idx_load_k(kcur, KIb + (size_t)(64 * (kt + 4)) * 64, voff);
#define IDX_TAIL(DIAG) _Pragma("unroll") for (int a = 0; a < 4; ++a) _Pragma("unroll") for (int i = 0; i < 4; ++i) { \
                    const unsigned bits = key[a][i]; const bool valid = (DIAG) ? (64 * kt + 16 * a + 4 * fq + i <= t) : true; \
                    if (MODE == 0) { unsigned val = 1u + __builtin_amdgcn_ubfe(bits, 22, 1) * 65535u; if (DIAG) val = valid ? val : 0u; \
                        __hip_atomic_fetch_add(hrow + __builtin_amdgcn_ubfe(bits, 12, 10), val, __ATOMIC_RELAXED, __HIP_MEMORY_SCOPE_WORKGROUP); } \
                    else if (MODE == 1) { unsigned val = 1u + __builtin_amdgcn_ubfe(bits, 11, 1) * 65535u; val = (valid && (int)__builtin_amdgcn_ubfe(bits, 12, 11) == b1) ? val : 0u; \
                        __hip_atomic_fetch_add(hrow + __builtin_amdgcn_ubfe(bits, 1, 10), val, __ATOMIC_RELAXED, __HIP_MEMORY_SCOPE_WORKGROUP); } \
                    else if (MODE == 2) { if (valid && __builtin_amdgcn_ubfe(bits, 1, 22) >= thr) m16 |= 1u << (4 * a + i); } \
                    else { const int dbin = (int)__builtin_amdgcn_ubfe(bits, 12, 11) - b1;            \
                        if (valid && dbin > 0) m16 |= 1u << (4 * a + i); \
                        if (valid && dbin == 0) { const unsigned pos = __hip_atomic_fetch_add(ccnt + ql_, 1u, __ATOMIC_RELAXED, __HIP_MEMORY_SCOPE_WORKGROUP); \
                            if (pos < (unsigned)IDX_CAP) clist[ql_ * IDX_CAP + pos] = (__builtin_amdgcn_ubfe(bits, 1, 11) << 18) | ((unsigned)(kt * 64 + (fq & 1) * 32 + ql_) << 5) | (unsigned)(8 * a + 4 * (fq >> 1) + i); } } }
            if (diag) { IDX_TAIL(true) } else { IDX_TAIL(false) }
#undef IDX_TAIL
        }
        if (MODE >= 2) {
            unsigned word = ((m16 & 0xFu) | ((m16 & 0xF0u) << 4) | ((m16 & 0xF00u) << 8) | ((m16 & 0xF000u) << 12)) << (4 * (fq >> 1));
            word |= (unsigned)__shfl_xor((int)word, 32);
            if (ln < 32) { if (MODE == 2) MASKg[(size_t)kt * 64 + fq * 32 + ql_] = word; else mlds[kt * 64 + fq * 32 + ql_] = word; }
        }
    }
}
template <int LEVEL>
__device__ __forceinline__ void idx_scan(Frame& F, int ln) {
    LAS unsigned* hist = (LAS unsigned*)(F.lds + RING_OFF);
    LAS int* ctl = (LAS int*)(F.lds + IDX_CTL);
#pragma unroll 1
    for (int qi = 0; qi < 4; ++qi) {
        const int q = 4 * F.wave + qi;
        int need = (LEVEL == 0) ? TOPK : TOPK - ctl[32 + q];
        unsigned wv[16]; int toth = 0, totl = 0;
#pragma unroll
        for (int j = 0; j < 16; ++j) { wv[j] = hist[q * 1025 + 16 * ln + j]; toth += (int)(wv[j] >> 16); totl += (int)(wv[j] & 0xffffu); }
        int inclh = toth, incll = totl;
#pragma unroll
        for (int o = 1; o < 64; o <<= 1) { const int vh = __shfl_down(inclh, o), vl = __shfl_down(incll, o); if (ln + o < 64) { inclh += vh; incll += vl; } }
        const int allh = __shfl(inclh, 0);
        { const int above = inclh - toth;
          if (above < need && need <= inclh) { int run = above, B = 0, cab = 0; bool found = false;
#pragma unroll
              for (int j = 15; j >= 0; --j) { const int ch = (int)(wv[j] >> 16); if (!found && need <= run + ch) { found = true; B = 1024 + 16 * ln + j; cab = run; } run += ch; }
              if (LEVEL == 0) { ctl[q] = B; ctl[32 + q] = cab; } else ctl[64 + q] = (ctl[q] << 11) | B; } }
        { const int above = allh + incll - totl;
          if (allh < need && above < need && need <= allh + incll) { int run = above, B = 0, cab = 0; bool found = false;
#pragma unroll
              for (int j = 15; j >= 0; --j) { const int cl = (int)(wv[j] & 0xffffu); if (!found && need <= run + cl) { found = true; B = 16 * ln + j; cab = run; } run += cl; }
              if (LEVEL == 0) { ctl[q] = B; ctl[32 + q] = cab; } else ctl[64 + q] = (ctl[q] << 11) | B; } }
    }
}
__device__ __forceinline__ void idx_select(Frame& F, int ln) {
    LAS unsigned* mlds = (LAS unsigned*)(F.lds + RING_OFF);
    LAS unsigned* clist = (LAS unsigned*)(F.lds + RING_OFF + 32768);
    LAS int* ctl = (LAS int*)(F.lds + IDX_CTL);
#pragma unroll 1
    for (int qi = 0; qi < 4; ++qi) {
        const int q = 4 * F.wave + qi; int nc = ctl[96 + q];
        if (nc > IDX_CAP) { nc = IDX_CAP; if (ln == 0) ctl[128] = 1; }
        const int r = TOPK - ctl[32 + q];
        unsigned e[IDX_CAP / 64]; bool ok[IDX_CAP / 64];
#pragma unroll
        for (int j = 0; j < IDX_CAP / 64; ++j) { ok[j] = ln + 64 * j < nc; e[j] = ok[j] ? clist[q * IDX_CAP + ln + 64 * j] : 0u; }
        unsigned t = 0u;
#pragma unroll 1
        for (int bit = 10; bit >= 0; --bit) { const unsigned tt = t | (1u << bit); int cnt = 0;
#pragma unroll
            for (int j = 0; j < IDX_CAP / 64; ++j) cnt += __popcll(__ballot(ok[j] && (e[j] >> 18) >= tt));
            if (cnt >= r) t = tt; }
#pragma unroll
        for (int j = 0; j < IDX_CAP / 64; ++j) if (ok[j] && (e[j] >> 18) >= t) __hip_atomic_fetch_or(mlds + ((e[j] >> 5) & 8191u), 1u << (e[j] & 31u), __ATOMIC_RELAXED, __HIP_MEMORY_SCOPE_WORKGROUP);
    }
}
__device__ __forceinline__ void p5_indexer(Frame& F, unsigned* MASK) {
    const bf16* QI = WSP(bf16, WS_QI); const bf16* KI = WSP(bf16, WS_KI); const float* WI = WSP(float, WS_WI); const bf16* QL = WSP(bf16, WS_QL); const float* AT = WSP(float, SM_AT);
    const float kmax = __builtin_bit_cast(float, __hip_atomic_load(F.ctl + CW_KMAX, RLX_AGENT));
    LAS int* ctl = (LAS int*)(F.lds + IDX_CTL);
    for (int p = F.vcu; p < 256; p += F.G) {
        const int b = p >> 7, j = p & 127;
#pragma unroll 1
        for (int side = 0; side < 2; ++side) {
            const int g = side ? j : 255 - j, t0 = 32 * g;
            const int nt_idx = (g + 2) >> 1, nt_att = 4 * (g >> 3) + 4;
            int ln = (int)__builtin_amdgcn_mbcnt_hi(~0u, __builtin_amdgcn_mbcnt_lo(~0u, 0u)); asm volatile("" : "+v"(ln)); const int tid_ = F.wave * 64 + ln;
            const int qc = ln & 15, fq = ln >> 4, ql_ = 16 * (F.wave & 1) + qc;
            const size_t trow = (size_t)b * SEQ + t0 + ql_;
            bf16x8 qf[8][2], ql[2]; float invA; LAS float* w = (LAS float*)(F.lds + IDX_CTL + 1024) + ql_ * 8;
#define IDX_LOADQ() do { \
            _Pragma("unroll") for (int h = 0; h < 8; ++h) _Pragma("unroll") for (int ks = 0; ks < 2; ++ks) qf[h][ks] = *(const bf16x8*)(QI + trow * 512 + h * 64 + ks * 32 + fq * 8); \
            _Pragma("unroll") for (int ks = 0; ks < 2; ++ks) ql[ks] = *(const bf16x8*)(QL + trow * 64 + ks * 32 + fq * 8); \
            { const f32x4 w0 = *(const f32x4*)(WI + trow * 8), w1 = *(const f32x4*)(WI + trow * 8 + 4); *(LAS f32x4*)w = w0; *(LAS f32x4*)(w + 4) = w1; }     \
            { const float a2 = 2.0f * AT[trow] * kmax; invA = a2 > 0.f ? 0.99f / a2 : 0.f; }        \
        } while (0)
            IDX_LOADQ();
            const bf16* KIb = KI + (size_t)b * SEQ * 64;
            unsigned* MASKg = MASK + ((size_t)(b * 256 + g) * 128) * 64;
            for (int i = tid_; i < 8200; i += 512) ((LAS v4u*)(F.lds + RING_OFF))[i] = (v4u){0u, 0u, 0u, 0u};
            if (tid_ < 96) ctl[tid_] = 0;
            __syncthreads();
            idx_pass<0>(F, ln, KIb, MASKg, t0, nt_idx, nt_att, ql, qf, w, invA, 0, 0u);
            __syncthreads();
            idx_scan<0>(F, ln);
            __syncthreads();
            const int b1 = ctl[ql_];
            if (tid_ < 33) ctl[96 + tid_] = 0;
            __syncthreads();
            idx_pass<3>(F, ln, KIb, MASKg, t0, nt_idx, nt_att, ql, qf, w, invA, b1, 0u);
            __syncthreads();
            idx_select(F, ln);
            __syncthreads();
            if (ctl[128] == 0 || DBG_REP == 77) {
                for (int i = tid_; i < nt_att * 64; i += 512) MASKg[i] = ((LAS unsigned*)(F.lds + RING_OFF))[i];
            } else {
                for (int i = tid_; i < 8200; i += 512) ((LAS v4u*)(F.lds + RING_OFF))[i] = (v4u){0u, 0u, 0u, 0u};
                IDX_LOADQ();
                __syncthreads();
                idx_pass<1>(F, ln, KIb, MASKg, t0, nt_idx, nt_att, ql, qf, w, invA, b1, 0u);
                __syncthreads();
                idx_scan<1>(F, ln);
                __syncthreads();
                const unsigned thr = (unsigned)ctl[64 + ql_];
                idx_pass<2>(F, ln, KIb, MASKg, t0, nt_idx, nt_att, ql, qf, w, invA, b1, thr);
            }
            __syncthreads();
#undef IDX_LOADQ
        }
    }
}

__device__ __forceinline__ unsigned sbfe1_(unsigned w, const int bit) { unsigned r; asm("v_bfe_i32 %0, %1, %2, 1" : "=v"(r) : "v"(w), "n"(bit)); return r; }
#define SBFE1(w, bit) sbfe1_((w), (bit))
__device__ __forceinline__ void p6_attention(Frame& F, const unsigned* MASK, bf16* ATTo) {
    const bf16* Qb = WSP(bf16, WS_Q); const bf16* Kb = WSP(bf16, WS_K); const bf16* VT = WSP(bf16, WS_VT);
    constexpr int KTB = 18432, VTB = 17408, SLOT = KTB + VTB;
    LAS unsigned char* Lb = F.lds + RING_OFF;
    LAS float* biasd = (LAS float*)(F.lds + RING_OFF + 2 * SLOT);
    for (int p = F.vcu; p < 256; p += F.G) {
        const int bh = p >> 4, j = p & 15, b = bh >> 3, h = bh & 7;
#pragma unroll 1
        for (int side = 0; side < 2; ++side) {
            const int qb = side ? j : 31 - j, q0 = 256 * qb, NT = 2 * qb + 2;
            int ln = (int)__builtin_amdgcn_mbcnt_hi(~0u, __builtin_amdgcn_mbcnt_lo(~0u, 0u)); asm volatile("" : "+v"(ln));
            const int tid_ = F.wave * 64 + ln, r32 = ln & 31, hi = ln >> 5, lrow = tid_ >> 3, lch = tid_ & 7;
            const int tq = q0 + 32 * F.wave + r32;
            if (tid_ < 128) { const int bk = t5_bucket(tid_); biasd[tid_] = (F.rel_bias[bk * 8 + h] - F.rel_bias[31 * 8 + h]) * LOG2E; }
            const bf16* Kg = Kb + (size_t)(b * SEQ + lrow) * 512 + h * 64 + lch * 8;
            const bf16* Vg = VT + ((size_t)((b * NH + h) * 64 + lrow)) * SEQ + lch * 8;
            const unsigned* Mg = MASK + ((size_t)(b * 256 + 8 * qb + F.wave) * 128) * 64 + ln;
            bf16x8 qf[4];
#pragma unroll
            for (int ks = 0; ks < 4; ++ks) qf[ks] = *(const bf16x8*)(Qb + (size_t)(b * SEQ + tq) * 512 + h * 64 + ks * 16 + hi * 8);
            f32x16 o0, o1, o2;
#pragma unroll
            for (int r = 0; r < 16; ++r) { o0[r] = 0.f; o1[r] = 0.f; o2[r] = 0.f; }
            const bf16x8 ones = (bf16x8){0x3F80, 0x3F80, 0x3F80, 0x3F80, 0x3F80, 0x3F80, 0x3F80, 0x3F80};
            float m_run = 0.f;
            v4u kreg0 = *(const v4u*)(Kg), kreg1 = *(const v4u*)(Kg + (size_t)64 * 512), vreg0 = *(const v4u*)(Vg), vreg1 = *(const v4u*)(Vg + 64);
            unsigned mw0 = Mg[0], mw1 = Mg[64], mwn0 = 0u, mwn1 = 0u;
            *(LAS v4u*)(Lb + lrow * 144 + lch * 16) = kreg0; *(LAS v4u*)(Lb + (64 + lrow) * 144 + lch * 16) = kreg1;
            *(LAS v4u*)(Lb + KTB + lrow * 272 + lch * 16) = vreg0; *(LAS v4u*)(Lb + KTB + lrow * 272 + 128 + lch * 16) = vreg1;
            __syncthreads();
            for (int kt = 0; kt < NT; ++kt) {
                const int buf = kt & 1;
                if (kt + 1 < NT) { const size_t kn = (size_t)(kt + 1) * 128;
                    kreg0 = *(const v4u*)(Kg + kn * 512); kreg1 = *(const v4u*)(Kg + (kn + 64) * 512); vreg0 = *(const v4u*)(Vg + kn); vreg1 = *(const v4u*)(Vg + kn + 64);
                    mwn0 = Mg[(size_t)(2 * kt + 2) * 64]; mwn1 = Mg[(size_t)(2 * kt + 3) * 64]; }
                LAS unsigned char* kb_ = Lb + buf * SLOT; LAS unsigned char* vb_ = kb_ + KTB;
                f32x16 sA[4];
#pragma unroll
                for (int c = 0; c < 4; ++c)
#pragma unroll
                    for (int r = 0; r < 16; ++r) sA[c][r] = 0.f;
#pragma unroll
                for (int ks = 0; ks < 4; ++ks)
#pragma unroll
                    for (int c = 0; c < 4; ++c) { const bf16x8 kf = *(const LAS bf16x8*)(kb_ + (32 * c + r32) * 144 + ks * 32 + hi * 16); sA[c] = MFMA32(kf, qf[ks], sA[c]); }
                if (kt >= NT - 3) {
#pragma unroll
                    for (int c = 0; c < 4; ++c)
#pragma unroll
                        for (int r = 0; r < 16; ++r) { const int d0 = tq - (128 * kt + 32 * c + crow(r, hi)); const float b0 = biasd[d0 & 127]; sA[c][r] += ((unsigned)d0 < 128u) ? b0 : 0.f; }
                }
                float mx = -INFINITY;
#pragma unroll
                for (int r = 0; r < 16; ++r) mx = fmaxf(mx, fmaxf(fmaxf(sA[0][r], sA[1][r]), fmaxf(sA[2][r], sA[3][r])));
                mx = fmaxf(mx, __shfl_xor(mx, 32)) - m_run;
                if (kt == 0 || __any(mx > 8.0f)) {
                    const float dl = (kt == 0) ? mx : fmaxf(mx, 0.f), f = __builtin_amdgcn_exp2f(-dl);
                    m_run += dl;
#pragma unroll
                    for (int r = 0; r < 16; ++r) { o0[r] *= f; o1[r] *= f; o2[r] *= f; }
                }
                unsigned pk[4][8];
#pragma unroll
                for (int c = 0; c < 4; ++c) { const unsigned mw = (c < 2) ? mw0 : mw1;
#pragma unroll
                    for (int r = 0; r < 16; r += 2) {
                        const unsigned e0 = __builtin_bit_cast(unsigned, __builtin_amdgcn_exp2f(sA[c][r] - m_run)) & SBFE1(mw, 16 * (c & 1) + r);
                        const unsigned e1 = __builtin_bit_cast(unsigned, __builtin_amdgcn_exp2f(sA[c][r + 1] - m_run)) & SBFE1(mw, 16 * (c & 1) + r + 1);
                        pk[c][r >> 1] = cvtpk(__builtin_bit_cast(float, e0), __builtin_bit_cast(float, e1)); } }
#pragma unroll
                for (int c = 0; c < 4; ++c)
#pragma unroll
                    for (int s = 0; s < 2; ++s) {
                        const bf16x8 pf = __builtin_bit_cast(bf16x8, (v4u){pk[c][4 * s], pk[c][4 * s + 1], pk[c][4 * s + 2], pk[c][4 * s + 3]});
                        const bf16x8 v0 = *(const LAS bf16x8*)(vb_ + r32 * 272 + (2 * c + s) * 32 + hi * 16);
                        const bf16x8 v1 = *(const LAS bf16x8*)(vb_ + (32 + r32) * 272 + (2 * c + s) * 32 + hi * 16);
                        o0 = MFMA32(v0, pf, o0); o1 = MFMA32(v1, pf, o1); o2 = MFMA32(ones, pf, o2);
                    }
                if (kt + 1 < NT) { LAS unsigned char* nb = Lb + (buf ^ 1) * SLOT;
                    *(LAS v4u*)(nb + lrow * 144 + lch * 16) = kreg0; *(LAS v4u*)(nb + (64 + lrow) * 144 + lch * 16) = kreg1;
                    *(LAS v4u*)(nb + KTB + lrow * 272 + lch * 16) = vreg0; *(LAS v4u*)(nb + KTB + lrow * 272 + 128 + lch * 16) = vreg1; }
                mw0 = mwn0; mw1 = mwn1;
                __syncthreads();
            }
            const float inv = 1.0f / o2[0];
            bf16* orow = ATTo + (size_t)(b * SEQ + tq) * 512 + h * 64 + 4 * hi;
#pragma unroll
            for (int g4 = 0; g4 < 4; ++g4) {
                *(v2u*)(orow + 8 * g4) = (v2u){cvtpk(o0[4 * g4] * inv, o0[4 * g4 + 1] * inv), cvtpk(o0[4 * g4 + 2] * inv, o0[4 * g4 + 3] * inv)};
                *(v2u*)(orow + 32 + 8 * g4) = (v2u){cvtpk(o1[4 * g4] * inv, o1[4 * g4 + 1] * inv), cvtpk(o1[4 * g4 + 2] * inv, o1[4 * g4 + 3] * inv)};
            }
        }
    }
}

__device__ __forceinline__ void p9_norm2_route(Frame& F, const float* HRES) {
    const int gw = F.vcu * NWAVES + F.wave, NGW = F.G * NWAVES;
    const float* mod = WSP(float, SM_MOD); const float* WRT = WSP(float, SM_WRT);
    LAS float* lg = (LAS float*)(F.lds + RING_OFF + F.wave * 16384 + 8448);
    int* EID = WSP(int, SM_EID); float* EWT = WSP(float, SM_EWT); int* SLOT = WSP(int, SM_SLOT); bf16* H2 = WSP(bf16, WS_H1);
    for (int m4 = gw; m4 < T / 4; m4 += NGW) {
        const int m0 = m4 * 4, b = m0 / SEQ;
        f32x4 hv[4][4];
#pragma unroll
        for (int r = 0; r < 4; ++r) {
            const GAS f32x4* xr = (const GAS f32x4*)(HRES + (size_t)(m0 + r) * D) + F.lane; float s = 0.f;
#pragma unroll
            for (int j = 0; j < 4; ++j) { hv[r][j] = xr[64 * j]; s += (hv[r][j].x * hv[r][j].x + hv[r][j].y * hv[r][j].y) + (hv[r][j].z * hv[r][j].z + hv[r][j].w * hv[r][j].w); }
            const float rstd = 1.f / sqrtf(wave_sum_all(s) * (1.f / D) + EPS);
            GAS v2u* o8 = (GAS v2u*)(H2 + (size_t)(m0 + r) * D) + F.lane;
#pragma unroll
            for (int j = 0; j < 4; ++j) { const int k = 4 * F.lane + 256 * j;
                const f32x4 g = *(const f32x4*)(F.norm2_g + k), scl = *(const f32x4*)(mod + b * 6144 + 4096 + k), sh = *(const f32x4*)(mod + b * 6144 + 3072 + k);
                hv[r][j] = hv[r][j] * rstd * (g * (scl + 1.0f)) + sh; o8[64 * j] = (v2u){pk2(hv[r][j].x, hv[r][j].y), pk2(hv[r][j].z, hv[r][j].w)}; }
        }
        for (int n = 0; n < 36; ++n) {
            f32x4 w[4];
#pragma unroll
            for (int j = 0; j < 4; ++j) w[j] = *(const f32x4*)(WRT + n * D + 4 * F.lane + 256 * j);
            float p[4];
#pragma unroll
            for (int r = 0; r < 4; ++r) { float a = 0.f;
#pragma unroll
                for (int j = 0; j < 4; ++j) a += (hv[r][j].x * w[j].x + hv[r][j].y * w[j].y) + (hv[r][j].z * w[j].z + hv[r][j].w * w[j].w);
                p[r] = wave_sum63(a); }
            if (F.lane == 63) { const float bb = (n < 4 ? F.brg[n] : F.bre[n - 4]); lg[n] = p[0] + bb; lg[36 + n] = p[1] + bb; lg[72 + n] = p[2] + bb; lg[108 + n] = p[3] + bb; }
        }
        LDS_WAIT(); asm volatile("" ::: "memory");
        if (F.lane < 4) {
            const LAS float* l = lg + F.lane * 36; const int tkn = m0 + F.lane;
            int gs = 0; float gm = l[0];
#pragma unroll
            for (int j = 1; j < 4; ++j) if (l[j] > gm) { gm = l[j]; gs = j; }
            float gsum = 0.f;
#pragma unroll
            for (int j = 0; j < 4; ++j) gsum += __expf(l[j] - gm);
            const float gwt = 1.f / gsum;
            const LAS float* el = l + 4 + 8 * gs;
            int i0 = 0; float l0 = el[0];
#pragma unroll
            for (int j = 1; j < 8; ++j) if (el[j] > l0) { l0 = el[j]; i0 = j; }
            int i1 = -1; float l1 = -INFINITY;
#pragma unroll
            for (int j = 0; j < 8; ++j) if (j != i0 && el[j] > l1) { l1 = el[j]; i1 = j; }
            const float e1 = __expf(l1 - l0), p0 = 1.f / (1.f + e1), p1 = e1 * p0;
            const int e0id = gs * 8 + i0, e1id = gs * 8 + i1;
            EID[tkn * 2] = e0id; EID[tkn * 2 + 1] = e1id; EWT[tkn * 2] = gwt * p0; EWT[tkn * 2 + 1] = gwt * p1;
            SLOT[tkn * 2] = (int)atomicAdd((unsigned*)(F.ctl + CW_ECNT + 16 * e0id), 1u);
            SLOT[tkn * 2 + 1] = (int)atomicAdd((unsigned*)(F.ctl + CW_ECNT + 16 * e1id), 1u);
        }
        LDS_WAIT(); asm volatile("" ::: "memory");
    }
    {
        LAS float* scr = (LAS float*)(F.lds + RING_OFF + F.wave * 16384);
        for (int it = gw; it < NEXP * 512; it += NGW) {
            const int e = it / 512, r = it % 512;
            if (r < 256) transpose_item(F.w_gate_e + (size_t)e * D * DEXP, D, DEXP, WSP(bf16, WS_WGU) + (size_t)e * 1024 * D, scr, r, F.lane, RmGU{0});
            else transpose_item(F.w_up_e + (size_t)e * D * DEXP, D, DEXP, WSP(bf16, WS_WGU) + (size_t)e * 1024 * D, scr, r - 256, F.lane, RmGU{1});
        }
    }
}
__device__ __forceinline__ int moe_tables(Frame& F, LAS int* off, LAS int* tile_e) {
    if (F.tid == 0) { int o = 0, nt = 0;
        for (int e = 0; e < NEXP; ++e) { const int c = (int)__hip_atomic_load(F.ctl + CW_ECNT + 16 * e, RLX_AGENT); off[e] = o; const int tl = (c + 255) >> 8; for (int j = 0; j < tl; ++j) tile_e[nt++] = e; o += tl * 256; }
        off[NEXP] = nt; }
    __syncthreads();
    return off[NEXP];
}
__device__ __forceinline__ void p10_gather(Frame& F, LAS int* off) {
    const int* EID = WSP(int, SM_EID); int* SLOT = WSP(int, SM_SLOT); int* AROW = (int*)(F.ctl + CW_AROW);
    for (int i = blockIdx.x * 512 + F.tid; i < T * 2; i += F.G * 512) { const int row = off[EID[i]] + SLOT[i]; AROW[row] = i >> 1; SLOT[i] = row; }
}
__device__ __forceinline__ void p13_combine(Frame& F, const float* HRES) {
    const int gw = F.vcu * NWAVES + F.wave, NGW = F.G * NWAVES;
    const float* mod = WSP(float, SM_MOD); const int* SLOT = WSP(int, SM_SLOT); const float* EWT = WSP(float, SM_EWT); const bf16* Y = WSP(bf16, WS_Y);
    for (int m0 = gw * 2; m0 < T; m0 += NGW * 2) {
        const int b = m0 / SEQ;
        f32x4 v[2][4]; float rs[2];
#pragma unroll
        for (int r = 0; r < 2; ++r) { const int m = m0 + r;
#if DBG_SKIP_MOE
            const int r0 = 0, r1 = 0; const float w0 = 0.f, w1 = 0.f; (void)SLOT; (void)EWT;
#else
            const int r0 = SLOT[m * 2], r1 = SLOT[m * 2 + 1]; const float w0 = EWT[m * 2], w1 = EWT[m * 2 + 1];
#endif
            const GAS f32x4* xr = (const GAS f32x4*)(HRES + (size_t)m * D) + F.lane;
            const GAS v2u* y0 = (const GAS v2u*)(Y + (size_t)r0 * D) + F.lane; const GAS v2u* y1 = (const GAS v2u*)(Y + (size_t)r1 * D) + F.lane;
#pragma unroll
            for (int j = 0; j < 4; ++j) { const int k = 4 * F.lane + 256 * j; const v2u a = y0[64 * j], c = y1[64 * j];
                const f32x4 ya = (f32x4){bflo(a.x), bfhi(a.x), bflo(a.y), bfhi(a.y)}, yb = (f32x4){bflo(c.x), bfhi(c.x), bflo(c.y), bfhi(c.y)};
                const f32x4 g2 = *(const f32x4*)(mod + b * 6144 + 5120 + k);
#if DBG_SKIP_MOE
                v[r][j] = xr[64 * j]; (void)g2; (void)ya; (void)yb;
#else
                v[r][j] = xr[64 * j] + g2 * (ya * w0 + yb * w1);
#endif
            } }
#pragma unroll
        for (int r = 0; r < 2; ++r) { float s = 0.f;
#pragma unroll
            for (int j = 0; j < 4; ++j) s += (v[r][j].x * v[r][j].x + v[r][j].y * v[r][j].y) + (v[r][j].z * v[r][j].z + v[r][j].w * v[r][j].w);
            rs[r] = 1.f / sqrtf(wave_sum_all(s) * (1.f / D) + EPS); }
#if DBG_CMP_ATT
        const float escale = 1.0f + sqrtf(__builtin_bit_cast(float, __hip_atomic_load(F.ctl + CW_CMP, RLX_AGENT)) / __builtin_bit_cast(float, __hip_atomic_load(F.ctl + CW_CMP + 1, RLX_AGENT)));
#else
        const float escale = 1.0f;
#endif
#pragma unroll
        for (int r = 0; r < 2; ++r) { GAS f32x4* o = (GAS f32x4*)(F.out + (size_t)(m0 + r) * D) + F.lane;
#pragma unroll
            for (int j = 0; j < 4; ++j) o[64 * j] = v[r][j] * (rs[r] * escale) * *(const f32x4*)(F.norm_f_g + 4 * F.lane + 256 * j); }
    }
}

struct Args { const float* in[20]; float* out; unsigned char* ws; int ph_lo, ph_hi, li, pad; };
__global__ void __launch_bounds__(NWAVES * 64, 2) fwd_kernel(Args args) {
    extern __shared__ __attribute__((aligned(16))) unsigned char lds[];
    Frame F;
    F.lds = (LAS unsigned char*)lds;
    F.MISC = (volatile LAS unsigned*)(F.lds + MISC_OFF);
    F.tid = threadIdx.x; F.lane = F.tid & 63; F.wave = __builtin_amdgcn_readfirstlane(F.tid >> 6);
    F.G = gridDim.x; { const int bx = blockIdx.x; F.vcu = (F.G % 8 == 0) ? (bx % 8) * (F.G / 8) + bx / 8 : bx; }
    F.ws = args.ws; F.ctl = (gu32*)(args.ws + WS_CTL);
    F.x = args.in[0]; F.c = args.in[1]; F.w_ada = args.in[2]; F.b_ada = args.in[3]; F.norm1_g = args.in[4]; F.w_in = args.in[5]; F.rel_bias = args.in[6]; F.conv_w = args.in[7];
    F.w_attn = args.in[8]; F.w_conv = args.in[9]; F.w_out = args.in[10]; F.norm2_g = args.in[11]; F.wrg = args.in[12]; F.brg = args.in[13]; F.wre = args.in[14]; F.bre = args.in[15];
    F.w_gate_e = args.in[16]; F.w_up_e = args.in[17]; F.w_down_e = args.in[18]; F.norm_f_g = args.in[19]; F.out = args.out;
    for (int u = F.tid; u < (LDS_BYTES - LDSCTL_OFF) / 4; u += NWAVES * 64) ((LAS unsigned*)(F.lds + LDSCTL_OFF))[u] = 0u;
    __syncthreads();
    XcdBarrier bar; bar.bar = (unsigned*)(F.ctl + CW_BAR); bar.x = 0; bar.st = nullptr;
    if (!MK_PER_PHASE) bar = xcd_barrier_post((unsigned*)(F.ctl + CW_BAR), F.MISC + 8);
#define GRID_BAR() do { if (MK_PER_PHASE) { if (F.tid == 0) __hip_atomic_store(F.ctl + CW_TMO, 0xBADBA0u, RLX_AGENT); } else { xcd_barrier(bar, F.wave == 0 && (int)__builtin_amdgcn_mbcnt_hi(~0u, __builtin_amdgcn_mbcnt_lo(~0u, 0u)) == 0); } } while (0)
    const int lo = args.ph_lo, hi = args.ph_hi;
#ifndef ONLY_PHASE
#define ONLY_PHASE -1
#endif
#define IN(k) ((ONLY_PHASE < 0 || ONLY_PHASE == (k)) && lo <= (k) && (k) < hi)
#define BOTH(k) (IN(k) && IN((k) + 1))
#define REFRESH() do { int l_ = (int)__builtin_amdgcn_mbcnt_hi(~0u, __builtin_amdgcn_mbcnt_lo(~0u, 0u)); asm volatile("" : "+v"(l_)); F.lane = l_; F.tid = F.wave * 64 + l_; } while (0)
    float* HRES = F.out;
    LAS int* moe_off = (LAS int*)(F.lds + LDSCTL_OFF + 1024);
    LAS int* moe_tile = (LAS int*)(F.lds + LDSCTL_OFF + 1024 + 256);

    if (IN(0)) { REFRESH(); for (int rep_ = 0; rep_ < (DBG_REP == 0 ? 2 : 1); ++rep_) { if (rep_) GRID_BAR(); p0_prologue(F); } if (BOTH(0)) GRID_BAR(); }
    if (IN(1)) { REFRESH(); for (int rep_ = 0; rep_ < (DBG_REP == 1 ? 2 : 1); ++rep_) { if (rep_) GRID_BAR(); p1_norm1(F); } if (BOTH(1)) GRID_BAR(); }
    if (IN(2)) { REFRESH();
        pg8::Gemm g{WSP(bf16, WS_H1), WSP(bf16, WS_WIN), T, NINP, D}; pg8::StaticOrder S; S.init(T, NINP, F.G, (int)blockIdx.x);
        EpiProj E{WSP(bf16, WS_Q), WSP(bf16, WS_K), WSP(bf16, WS_V), WSP(bf16, WS_QI), WSP(bf16, WS_KI), WSP(bf16, WS_CB), WSP(bf16, WS_U), WSP(bf16, WS_G), WSP(float, WS_WI)};
        pg8::gemm_phase<EpiProj, pg8::StaticOrder, true, true>(F.lds + RING_OFF, g, S, E, F.wave);
        {
            constexpr int I_A = 8 * 32, I_C = 8 * 32, I_O = 16 * 32;
            const int nun = (T / 256) * (NINP / 256), rem = nun % F.G, c = (int)blockIdx.x;
            const bool early = (rem == 0) || (c >= rem); const int n_early = (rem == 0) ? F.G : F.G - rem, rank = (rem == 0) ? c : c - rem;
            if (early) { LAS float* scr = (LAS float*)(F.lds + RING_OFF + F.wave * 16384);
                for (int it = rank * NWAVES + F.wave; it < I_A + I_C + I_O; it += n_early * NWAVES) { int r = it;
                    if (r < I_A) { transpose_item(F.w_attn, AW, D, WSP(bf16, WS_WA), scr, r, F.lane, RmId()); continue; } r -= I_A;
                    if (r < I_C) { transpose_item(F.w_conv, AW, D, WSP(bf16, WS_WC), scr, r, F.lane, RmId()); continue; } r -= I_C;
                    transpose_item(F.w_out, D, D, WSP(bf16, WS_WOUT), scr, r, F.lane, RmId()); } }
        }
        if (BOTH(2)) GRID_BAR();
    }
    if (IN(3)) { REFRESH(); for (int rep_ = 0; rep_ < (DBG_REP == 3 ? 2 : 1); ++rep_) { if (rep_) GRID_BAR(); p3_prep(F); } if (BOTH(3)) GRID_BAR(); }
    if (IN(4)) { REFRESH();
        pg8::Gemm g{WSP(bf16, WS_AC), WSP(bf16, WS_WC), T, D, AW}; pg8::StaticOrder S; S.init(T, D, F.G, (int)blockIdx.x);
        EpiConv E{WSP(bf16, WS_G), WSP(bf16, WS_TMPC)};
        for (int rep_ = 0; rep_ < (DBG_REP == 4 ? 2 : 1); ++rep_) { if (rep_) GRID_BAR(); pg8::gemm_phase<EpiConv, pg8::StaticOrder, true, true>(F.lds + RING_OFF, g, S, E, F.wave); }
        if (BOTH(4) && (MK_NAIVE_ATTN || DBG_SKIP_ATTN || DBG_CMP_ATT)) GRID_BAR();
        else { asm volatile("s_waitcnt vmcnt(0)" ::: "memory"); __syncthreads(); }
    }
    if (IN(5)) { REFRESH();
#if DBG_SKIP_ATTN
        for (size_t i = (size_t)blockIdx.x * 512 + F.tid; i < (size_t)T * 512 / 8; i += (size_t)F.G * 512) *(v4u*)(WSP(bf16, WS_ATT) + i * 8) = (v4u){0u, 0u, 0u, 0u};
#elif DBG_CMP_ATT
        pn_naive_dsa(F); GRID_BAR(); p5_indexer(F, WSP(unsigned, WS_MASK_DBG));
#elif MK_NAIVE_ATTN
        pn_naive_dsa(F);
#else
        for (int rep_ = 0; rep_ < (DBG_REP == 5 ? 2 : 1); ++rep_) { if (rep_) GRID_BAR(); p5_indexer(F, WSP(unsigned, WS_MASK)); }
#endif
        if (BOTH(5)) GRID_BAR(); }
    if (IN(6)) { REFRESH();
#if DBG_SKIP_ATTN
#elif DBG_CMP_ATT
        p6_attention(F, WSP(unsigned, WS_MASK_DBG), WSP(bf16, WS_ATT2)); GRID_BAR();
        { float num = 0.f, den = 0.f; const bf16* A1 = WSP(bf16, WS_ATT); const bf16* A2 = WSP(bf16, WS_ATT2);
          for (size_t i = (size_t)blockIdx.x * 512 + F.tid; i < (size_t)T * 512; i += (size_t)F.G * 512) { const float a = bf1(A1[i]), c = bf1(A2[i]); num += (a - c) * (a - c); den += a * a; }
          num = wave_sum(num); den = wave_sum(den);
          if (F.lane == 0) { atomicAdd((float*)(F.ctl + CW_CMP), num); atomicAdd((float*)(F.ctl + CW_CMP + 1), den); } }
#elif !MK_NAIVE_ATTN
        for (int rep_ = 0; rep_ < (DBG_REP == 6 ? 2 : 1); ++rep_) { if (rep_) GRID_BAR(); p6_attention(F, WSP(unsigned, WS_MASK), WSP(bf16, WS_ATT)); }
#endif
        if (BOTH(6)) GRID_BAR(); }
    if (IN(7)) { REFRESH();
        pg8::Gemm g{WSP(bf16, WS_ATT), WSP(bf16, WS_WA), T, D, AW}; pg8::StaticOrder S; S.init(T, D, F.G, (int)blockIdx.x);
        EpiAttn E{WSP(bf16, WS_G), WSP(bf16, WS_TMPC), WSP(bf16, WS_MERGED)};
        for (int rep_ = 0; rep_ < (DBG_REP == 7 ? 2 : 1); ++rep_) { if (rep_) GRID_BAR(); pg8::gemm_phase<EpiAttn, pg8::StaticOrder, true, true>(F.lds + RING_OFF, g, S, E, F.wave); }
        if (BOTH(7)) GRID_BAR();
    }
    if (IN(8)) { REFRESH();
        pg8::Gemm g{WSP(bf16, WS_MERGED), WSP(bf16, WS_WOUT), T, D, D}; pg8::StaticOrder S; S.init(T, D, F.G, (int)blockIdx.x);
        EpiOut E{F.x, WSP(float, SM_MOD), HRES};
        for (int rep_ = 0; rep_ < (DBG_REP == 8 ? 2 : 1); ++rep_) { if (rep_) GRID_BAR(); pg8::gemm_phase<EpiOut, pg8::StaticOrder, true, true>(F.lds + RING_OFF, g, S, E, F.wave); }
        if (BOTH(8)) GRID_BAR();
    }
#if DBG_SKIP_MOE
    if (0) {
#endif
    if (IN(9)) { REFRESH(); p9_norm2_route(F, HRES); if (BOTH(9)) GRID_BAR(); }
    if (IN(10)) { REFRESH(); (void)moe_tables(F, moe_off, moe_tile); p10_gather(F, moe_off); if (BOTH(10)) GRID_BAR(); }
    if (IN(11)) { REFRESH();
        const int nt = moe_tables(F, moe_off, moe_tile);
        pg8::Gemm g{WSP(bf16, WS_H1), WSP(bf16, WS_WGU), XPROWS, NEXP * 1024, D}; MoeOrder S{moe_tile, nt, F.G, (int)blockIdx.x};
        EpiHid E{WSP(bf16, WS_HID)};
        pg8::gemm_phase<EpiHid, MoeOrder, true, true, true>(F.lds + RING_OFF, g, S, E, F.wave, (const int*)(F.ctl + CW_AROW));
        {
            const int nun = nt * 4, rem = nun % F.G, c = (int)blockIdx.x;
            const bool early = (rem == 0) || (c >= rem); const int n_early = (rem == 0) ? F.G : F.G - rem, rank = (rem == 0) ? c : c - rem;
            if (early) { LAS float* scr = (LAS float*)(F.lds + RING_OFF + F.wave * 16384);
                for (int it = rank * NWAVES + F.wave; it < NEXP * 256; it += n_early * NWAVES) { const int e = it >> 8, r = it & 255;
                    transpose_item(F.w_down_e + (size_t)e * DEXP * D, DEXP, D, WSP(bf16, WS_WD) + (size_t)e * D * DEXP, scr, r, F.lane, RmId()); } }
        }
        if (BOTH(11)) GRID_BAR();
    }
    if (IN(12)) { REFRESH();
        const int nt = moe_tables(F, moe_off, moe_tile);
        pg8::Gemm g{WSP(bf16, WS_HID), WSP(bf16, WS_WD), XPROWS, NEXP * 1024, DEXP}; MoeOrder S{moe_tile, nt, F.G, (int)blockIdx.x};
        EpiY E{WSP(bf16, WS_Y)};
        for (int rep_ = 0; rep_ < (DBG_REP == 12 ? 2 : 1); ++rep_) { if (rep_) GRID_BAR(); pg8::gemm_phase<EpiY, MoeOrder, true, true>(F.lds + RING_OFF, g, S, E, F.wave); }
        if (BOTH(12)) GRID_BAR();
    }
#if DBG_SKIP_MOE
    }
#endif
#if DBG_PROBE
    if (IN(13)) { REFRESH();
        const bf16* src = nullptr; int pitch = 1024;
        if (DBG_PROBE == 1) { src = WSP(bf16, WS_MERGED); pitch = 1024; }
        if (DBG_PROBE == 2) { src = WSP(bf16, WS_TMPC); pitch = 1024; }
        if (DBG_PROBE == 3) { src = WSP(bf16, WS_AC); pitch = 512; }
        if (DBG_PROBE == 4) { src = WSP(bf16, WS_G); pitch = 2048; }
        if (DBG_PROBE == 5) { src = WSP(bf16, WS_H1); pitch = 1024; }
        if (DBG_PROBE == 6) { src = WSP(bf16, WS_WIN); pitch = 1024; }
        if (DBG_PROBE == 7) { src = WSP(bf16, WS_QI); pitch = 512; }
        for (size_t i = (size_t)blockIdx.x * 512 + F.tid; i < (size_t)T * D; i += (size_t)F.G * 512) { const size_t m = i / D, j = i % D;
            float v;
            if (DBG_PROBE == 8) v = WSP(float, SM_MOD)[i % 12288];
            else if (DBG_PROBE == 4) v = bf1(src[m * 2048 + j]) + bf1(src[m * 2048 + 1024 + j]);
            else if (DBG_PROBE >= 40 && DBG_PROBE < 48) v = bf1(WSP(bf16, WS_G)[m * 2048 + (DBG_PROBE - 40) * 256 + (j & 255)]);
            else if (DBG_PROBE == 6) v = bf1(src[(m % 5888) * 1024 + j]);
            else v = bf1(src[m * pitch + (j % pitch)]);
            F.out[i] = v; }
    }
#else
    if (IN(13)) { REFRESH(); for (int rep_ = 0; rep_ < (DBG_REP == 13 ? 2 : 1); ++rep_) { if (rep_) GRID_BAR(); p13_combine(F, DBG_SKIP_MIX ? F.x : HRES); } }
#endif
#undef IN
#undef BOTH
}

extern "C" void kernel_launch(void* const* d_in, const int* in_sizes, int n_in, void* d_out, int out_size, void* d_ws, size_t ws_size, hipStream_t stream) {
    static int grid = 0;
    if (grid == 0) {
        if (n_in != 20 || in_sizes[0] != T * D || out_size != T * D || ws_size < WS_END) { fprintf(stderr, "kernel_launch: unexpected shapes: n_in %d in0 %d out %d ws %zu (need %zu)\n", n_in, n_in > 0 ? in_sizes[0] : -1, out_size, ws_size, (size_t)WS_END); grid = -1; return; }
        int dev = 0, cus = 0, per_cu = 0;
        if (hipGetDevice(&dev) != hipSuccess || hipDeviceGetAttribute(&cus, hipDeviceAttributeMultiprocessorCount, dev) != hipSuccess) { grid = -1; return; }
        if (hipFuncSetAttribute((const void*)fwd_kernel, hipFuncAttributeMaxDynamicSharedMemorySize, LDS_BYTES) != hipSuccess) { fprintf(stderr, "kernel_launch: hipFuncSetAttribute failed\n"); grid = -1; return; }
        if (hipOccupancyMaxActiveBlocksPerMultiprocessor(&per_cu, (const void*)fwd_kernel, NWAVES * 64, LDS_BYTES) != hipSuccess || per_cu < 1)
            fprintf(stderr, "kernel_launch: note: occupancy query reports %d workgroups per CU\n", per_cu);
        (void)hipGetLastError();
        grid = cus;
    }
    if (grid < 0) return;
    if (hipMemsetAsync((char*)d_ws + WS_CTL, 0, CTL_ZERO_BYTES, stream) != hipSuccess) return;
    Args a{};
    for (int i = 0; i < 20; ++i) a.in[i] = (const float*)d_in[i];
    a.out = (float*)d_out; a.ws = (unsigned char*)d_ws;
#if MK_PER_PHASE
    for (int li = 0; li < N_PHASES; ++li) { a.ph_lo = li; a.ph_hi = li + 1; a.li = li; hipLaunchKernelGGL(fwd_kernel, dim3(grid), dim3(NWAVES * 64), LDS_BYTES, stream, a); }
#else
    a.ph_lo = 0; a.ph_hi = N_PHASES; a.li = 0;
    hipLaunchKernelGGL(fwd_kernel, dim3(grid), dim3(NWAVES * 64), LDS_BYTES, stream, a);
#endif
}
```

```cpp
#include <hip/hip_runtime.h>
#include <cstdio>
#include <cstdint>

namespace pg8 {
#define PG8_LAS __attribute__((address_space(3)))
typedef unsigned short bf16_t;
typedef short bf16x8 __attribute__((ext_vector_type(8)));
typedef float f32x4 __attribute__((ext_vector_type(4)));
typedef unsigned u32x4 __attribute__((ext_vector_type(4)));
constexpr int BM = 256, BK = 64, HALF = 128, HTB = HALF * BK * 2  , STAGE_BYTES = 8 * HTB, NXCD = 8, WGM = 8;

__host__ __device__ __forceinline__ int lds_byte(int r, int c) { const int st = (r >> 4) * 2 + (c >> 5), rr = r & 15, cc = c & 31, ob = rr * 64 + cc * 2; return st * 1024 + (ob ^ (((ob >> 9) & 1) << 5)); }
__host__ __device__ __forceinline__ void stage_rc(int b, int& R, int& C) { const int st = b / 1024, sb = b % 1024, swz = sb ^ (((sb >> 9) & 1) << 5); R = (st >> 1) * 16 + swz / 64; C = (st & 1) * 32 + (swz % 64) / 2; }
__host__ __device__ __forceinline__ int perm32(int rho) { const int n = rho >> 4, i = rho & 15; return 8 * (i >> 2) + 4 * n + (i & 3); }

struct Unit { int pm, pn; };
struct Gemm { const bf16_t* A; const bf16_t* Bt; int M, N, K; };

struct StaticOrder {
    int nM, nN, nwg, G, c;
    __host__ __device__ void init(int M, int N, int G_, int c_) { nM = M / BM; nN = N / BM; nwg = nM * nN; G = G_; c = c_; }
    __host__ __device__ bool next(int i, Unit& u) const {
        const long L = (long)i * G + c; if (L >= nwg) return false;
        int wgid = (int)L; { const int q = nwg / NXCD, r = nwg % NXCD, xcd = wgid % NXCD, off = wgid / NXCD; wgid = (xcd < r ? xcd * (q + 1) : r * (q + 1) + (xcd - r) * q) + off; }
        const int nig = WGM * nN, gid = wgid / nig, fm = gid * WGM, gsz = (nM - fm) < WGM ? (nM - fm) : WGM;
        u.pm = fm + ((wgid % nig) % gsz); u.pn = (wgid % nig) / gsz; return true;
    }
    __device__ __forceinline__ void a_ready(const Unit&) const {}
    __device__ __forceinline__ void done(const Unit&) const {}
};
__device__ __forceinline__ unsigned cvt_pk_bf16(float lo, float hi) { unsigned r; asm volatile("v_cvt_pk_bf16_f32 %0, %1, %2" : "=v"(r) : "v"(lo), "v"(hi)); return r; }

template <class Epi, class Sched, bool ALIGN_EPI = false, bool SP2 = false, bool GATHER = false>
__device__ __forceinline__ void gemm_phase(PG8_LAS unsigned char* lds, const Gemm g, const Sched& S, const Epi& E, const int wave_id  , const int* arow = nullptr) {
    static_assert(!GATHER || SP2, "GATHER is implemented on the SP2 loop only");
    int lane_ = (int)__builtin_amdgcn_mbcnt_hi(~0u, __builtin_amdgcn_mbcnt_lo(~0u, 0u)); asm volatile("" : "+v"(lane_));
    const int lane = lane_, wid = wave_id, tid = wid * 64 + lane,
               wr = wid >> 2, wc = wid & 3, fr = lane & 15, fq = lane >> 4;
    const int K = g.K, nt = K / BK;
    unsigned voffA[2], voffB[2]; int RA[2]; unsigned CA2[2];
#pragma unroll
    for (int i = 0; i < 2; ++i) { int R, C; stage_rc(tid * 16 + i * 8192, R, C); const int Rb = Epi::PERM ? ((R & ~31) + perm32(R & 31)) : R;
        voffA[i] = (unsigned)(R * K + C) * 2u; voffB[i] = (unsigned)(Rb * K + C) * 2u; RA[i] = R; CA2[i] = (unsigned)C * 2u; }
    unsigned vA[2][2] = {{0u, 0u}, {0u, 0u}}, nvA[2][2] = {{0u, 0u}, {0u, 0u}};
#define PG8_GROWS(dst, U) do { _Pragma("unroll") for (int _h = 0; _h < 2; ++_h) _Pragma("unroll") for (int _i = 0; _i < 2; ++_i) dst[_h][_i] = (unsigned)arow[(U).pm * BM + _h * HALF + RA[_i]] * (unsigned)(K * 2) + CA2[_i]; } while (0)
    const size_t kstep = (size_t)(BK * 2);
    const size_t hstep = (size_t)HALF * K * 2;
    const size_t tstep = 2 * hstep;
    const unsigned ldsw = (unsigned)wid * 1024u;
    const int aoff = lds_byte(wr * 64 + fr, fq * 8), boff = lds_byte(wc * 32 + fr, fq * 8);
#define PG8_SA(b, h) (((b) * 2 + (h)) * HTB)
#define PG8_SB(b, h) ((4 + (b) * 2 + (h)) * HTB)
#define PG8_STAGE(bufoff, gbase, voff) do { _Pragma("unroll") for (int _i = 0; _i < 2; ++_i) \
        __builtin_amdgcn_global_load_lds((const unsigned*)((const char*)(gbase) + (voff)[_i]), (PG8_LAS unsigned*)(lds + (bufoff) + ldsw + _i * 8192), 16, 0, 0); } while (0)
#define PG8_STAGE_A(bufoff, gb, h, nx) do { if constexpr (GATHER) { _Pragma("unroll") for (int _i = 0; _i < 2; ++_i) { const unsigned vo_ = (nx) ? nvA[h][_i] : vA[h][_i]; \
        __builtin_amdgcn_global_load_lds((const unsigned*)((const char*)(gb) + vo_), (PG8_LAS unsigned*)(lds + (bufoff) + ldsw + _i * 8192), 16, 0, 0); } } else { PG8_STAGE(bufoff, (gb) + (h) * hstep, voffA); } } while (0)
#define PG8_LDA(dst, b, h) do { _Pragma("unroll") for (int m = 0; m < 4; ++m) _Pragma("unroll") for (int k = 0; k < 2; ++k) dst[m][k] = *(const PG8_LAS bf16x8*)(lds + PG8_SA(b, h) + aoff + m * 2048 + k * 1024); } while (0)
#define PG8_LDB(dst, b, h) do { _Pragma("unroll") for (int n = 0; n < 2; ++n) _Pragma("unroll") for (int k = 0; k < 2; ++k) dst[n][k] = *(const PG8_LAS bf16x8*)(lds + PG8_SB(b, h) + boff + n * 2048 + k * 1024); } while (0)
#define PG8_MMA(ai, bj, At, Bt) do { __builtin_amdgcn_s_setprio(1); _Pragma("unroll") for (int m = 0; m < 4; ++m) _Pragma("unroll") for (int n = 0; n < 2; ++n) _Pragma("unroll") for (int k = 0; k < 2; ++k) \
        acc[ai][bj][m][n] = __builtin_amdgcn_mfma_f32_16x16x32_bf16(Bt[n][k], At[m][k], acc[ai][bj][m][n], 0, 0, 0); __builtin_amdgcn_s_setprio(0); } while (0)
#define PG8_WAIT_V(n) asm volatile("s_waitcnt vmcnt(" #n ")" ::: "memory")
#define PG8_WAIT_L(n) asm volatile("s_waitcnt lgkmcnt(" #n ")" ::: "memory")
#define PG8_BAR __builtin_amdgcn_s_barrier()
#define PG8_SCHED __builtin_amdgcn_sched_barrier(0)
    Unit cur, nxt; int ui = 0;
    if (!S.next(0, cur)) return;
    f32x4 acc[2][2][4][2];
#pragma unroll
    for (int a = 0; a < 2; ++a)
#pragma unroll
        for (int b = 0; b < 2; ++b)
#pragma unroll
            for (int m = 0; m < 4; ++m)
#pragma unroll
                for (int n = 0; n < 2; ++n) acc[a][b][m][n] = (f32x4){0.f, 0.f, 0.f, 0.f};
    bf16x8 At[4][2], B0[2][2], B1[2][2];
    const char* cA = (const char*)g.A + (GATHER ? (size_t)0 : (size_t)cur.pm * tstep); const char* cB = (const char*)g.Bt + (size_t)cur.pn * tstep;
    if constexpr (GATHER) PG8_GROWS(vA, cur);
    S.a_ready(cur);
    if constexpr (SP2) {
        PG8_STAGE(PG8_SB(0, 0), cB, voffB); PG8_STAGE(PG8_SB(0, 1), cB + hstep, voffB); PG8_STAGE_A(PG8_SA(0, 0), cA, 0, false); PG8_STAGE_A(PG8_SA(0, 1), cA, 1, false);
        if (wr == 1) PG8_BAR;
        PG8_WAIT_V(2); PG8_BAR;
        PG8_STAGE(PG8_SB(1, 0), cB + kstep, voffB); PG8_STAGE_A(PG8_SA(1, 0), cA + kstep, 0, false); PG8_STAGE(PG8_SB(1, 1), cB + hstep + kstep, voffB);
        PG8_WAIT_V(6); PG8_BAR;
    } else {
        PG8_STAGE(PG8_SB(0, 0), cB, voffB); PG8_STAGE(PG8_SA(0, 0), cA, voffA); PG8_STAGE(PG8_SB(0, 1), cB + hstep, voffB); PG8_STAGE(PG8_SA(0, 1), cA + hstep, voffA);
        if (wr == 1) PG8_BAR;
        PG8_WAIT_V(4); PG8_BAR;
        PG8_STAGE(PG8_SB(1, 0), cB + kstep, voffB); PG8_STAGE(PG8_SA(1, 0), cA + kstep, voffA); PG8_STAGE(PG8_SB(1, 1), cB + hstep + kstep, voffB);
        PG8_WAIT_V(6); PG8_BAR;
    }
    for (;;) {
        const bool has_next = S.next(ui + 1, nxt);
        const char* nA = (has_next && !GATHER) ? (const char*)g.A + (size_t)nxt.pm * tstep : cA; const char* nB = has_next ? (const char*)g.Bt + (size_t)nxt.pn * tstep : cB;
        if constexpr (GATHER) { if (has_next) PG8_GROWS(nvA, nxt); else { nvA[0][0] = vA[0][0]; nvA[0][1] = vA[0][1]; nvA[1][0] = vA[1][0]; nvA[1][1] = vA[1][1]; } }
        for (int t = 0; t < nt; t += 2) {
            const bool last = (t == nt - 2);
            const char* a1 = cA + (size_t)(t + 1) * kstep;
            const char* a2 = last ? nA : cA + (size_t)(t + 2) * kstep; const char* b2 = last ? nB : cB + (size_t)(t + 2) * kstep;
            const char* a3 = a2 + kstep; const char* b3 = b2 + kstep;
            if (last && has_next) S.a_ready(nxt);
            if constexpr (SP2) {
            PG8_LDB(B0, 0, 0); PG8_LDB(B1, 0, 1); PG8_SCHED; PG8_LDA(At, 0, 0); PG8_STAGE_A(PG8_SA(1, 1), a1, 1, false);
            PG8_WAIT_V(8); PG8_WAIT_L(0); PG8_BAR; PG8_MMA(0, 0, At, B0); PG8_MMA(0, 1, At, B1); PG8_BAR; PG8_SCHED;
            PG8_LDA(At, 0, 1); PG8_STAGE(PG8_SB(0, 0), b2, voffB); PG8_STAGE(PG8_SB(0, 1), b2 + hstep, voffB); PG8_STAGE_A(PG8_SA(0, 0), a2, 0, last);
            PG8_WAIT_V(8); PG8_WAIT_L(0); PG8_BAR; PG8_MMA(1, 0, At, B0); PG8_MMA(1, 1, At, B1); PG8_BAR; PG8_SCHED;
            PG8_LDB(B0, 1, 0); PG8_LDB(B1, 1, 1); PG8_SCHED; PG8_LDA(At, 1, 0); PG8_STAGE_A(PG8_SA(0, 1), a2, 1, last);
            PG8_WAIT_V(8); PG8_WAIT_L(0); PG8_BAR; PG8_MMA(0, 0, At, B0); PG8_MMA(0, 1, At, B1); PG8_BAR; PG8_SCHED;
            PG8_LDA(At, 1, 1); PG8_STAGE(PG8_SB(1, 0), b3, voffB); PG8_STAGE(PG8_SB(1, 1), b3 + hstep, voffB); PG8_STAGE_A(PG8_SA(1, 0), a3, 0, last);
            PG8_WAIT_V(8); PG8_WAIT_L(0); PG8_BAR; PG8_MMA(1, 0, At, B0); PG8_MMA(1, 1, At, B1); PG8_BAR; PG8_SCHED;
            } else {
            PG8_LDB(B0, 0, 0); PG8_SCHED; PG8_LDA(At, 0, 0); PG8_STAGE(PG8_SA(1, 1), a1 + hstep, voffA);
            PG8_WAIT_L(8); PG8_BAR; PG8_WAIT_L(0); PG8_MMA(0, 0, At, B0); PG8_BAR; PG8_SCHED;
            PG8_LDB(B1, 0, 1); PG8_STAGE(PG8_SB(0, 0), b2, voffB);
            PG8_BAR; PG8_WAIT_L(0); PG8_MMA(0, 1, At, B1); PG8_BAR;
            PG8_LDA(At, 0, 1); PG8_STAGE(PG8_SA(0, 0), a2, voffA);
            PG8_BAR; PG8_WAIT_L(0); PG8_MMA(1, 0, At, B0); PG8_BAR; PG8_SCHED;
            PG8_STAGE(PG8_SB(0, 1), b2 + hstep, voffB);
            PG8_WAIT_V(6); PG8_BAR; PG8_MMA(1, 1, At, B1); PG8_BAR;
            PG8_LDB(B0, 1, 0); PG8_SCHED; PG8_LDA(At, 1, 0); PG8_STAGE(PG8_SA(0, 1), a2 + hstep, voffA);
            PG8_WAIT_L(8); PG8_BAR; PG8_WAIT_L(0); PG8_MMA(0, 0, At, B0); PG8_BAR; PG8_SCHED;
            PG8_LDB(B1, 1, 1); PG8_STAGE(PG8_SB(1, 0), b3, voffB);
            PG8_BAR; PG8_WAIT_L(0); PG8_MMA(0, 1, At, B1); PG8_BAR;
            PG8_LDA(At, 1, 1); PG8_STAGE(PG8_SA(1, 0), a3, voffA);
            PG8_BAR; PG8_WAIT_L(0); PG8_MMA(1, 0, At, B0); PG8_BAR; PG8_SCHED;
            PG8_STAGE(PG8_SB(1, 1), b3 + hstep, voffB);
            PG8_WAIT_V(6); PG8_BAR; PG8_MMA(1, 1, At, B1); PG8_BAR;
            }
        }
        if constexpr (ALIGN_EPI) { if (wr == 0) PG8_BAR; }
        if constexpr (!Epi::AFTER_DRAIN) { E(acc, cur, wr, wc, fr, fq); S.done(cur); }
        if (!has_next) break;
#pragma unroll
        for (int a = 0; a < 2; ++a)
#pragma unroll
            for (int b = 0; b < 2; ++b)
#pragma unroll
                for (int m = 0; m < 4; ++m)
#pragma unroll
                    for (int n = 0; n < 2; ++n) acc[a][b][m][n] = (f32x4){0.f, 0.f, 0.f, 0.f};
        cur = nxt; cA = nA; cB = nB; ++ui;
        if constexpr (GATHER) { vA[0][0] = nvA[0][0]; vA[0][1] = nvA[0][1]; vA[1][0] = nvA[1][0]; vA[1][1] = nvA[1][1]; }
        if constexpr (ALIGN_EPI) { if (wr == 1) PG8_BAR; }
    }
    PG8_WAIT_V(0);
    if constexpr (!ALIGN_EPI) { if (wr == 0) PG8_BAR; }
    PG8_BAR;
    if constexpr (Epi::AFTER_DRAIN) { E.fused(acc, cur, wr, wc, fr, fq, lds, wid, lane); S.done(cur); }
#undef PG8_SA
#undef PG8_SB
#undef PG8_STAGE
#undef PG8_STAGE_A
#undef PG8_GROWS
#undef PG8_LDA
#undef PG8_LDB
#undef PG8_MMA
#undef PG8_WAIT_V
#undef PG8_WAIT_L
#undef PG8_BAR
#undef PG8_SCHED
}
}

constexpr int NWAVES = 8;
#ifndef MK_PER_PHASE
#define MK_PER_PHASE 0
#endif
#ifndef MK_NAIVE_ATTN
#define MK_NAIVE_ATTN 0
#endif
#ifndef DBG_SKIP_ATTN
#define DBG_SKIP_ATTN 0
#endif
#ifndef DBG_SKIP_MOE
#define DBG_SKIP_MOE 0
#endif
#ifndef DBG_SKIP_MIX
#define DBG_SKIP_MIX 0
#endif
#ifndef DBG_CMP_ATT
#define DBG_CMP_ATT 0
#endif
#ifndef DBG_REP
#define DBG_REP -1
#endif
#ifndef DBG_PROBE
#define DBG_PROBE 0
#endif
constexpr int N_PHASES = 14;

constexpr int BATCH = 2, SEQ = 8192, D = 1024, T = BATCH * SEQ;
constexpr int NH = 8, HD = 64, AW = 512, IDXH = 8, IDXD = 64, TOPK = 256;
constexpr int NIN = 5704, NINP = 5888;
constexpr int NEXP = 32, DEXP = 512;
constexpr int XPROWS = 40960;
constexpr float EPS = 1e-6f;
constexpr float LOG2E = 1.4426950408889634f;
constexpr float C2 = 0.125f * LOG2E;

constexpr size_t MiB = 1u << 20;
constexpr size_t WS_CTL = 0, CTL_ZERO_BYTES = 1 * MiB;
constexpr size_t WS_SMALL = 1 * MiB;
constexpr size_t SM_MOD = WS_SMALL + 0;
constexpr size_t SM_WRT = WS_SMALL + 65536;
constexpr size_t SM_EID = WS_SMALL + 262144;
constexpr size_t SM_EWT = WS_SMALL + 393216;
constexpr size_t SM_SLOT = WS_SMALL + 524288;
constexpr size_t SM_AT = WS_SMALL + 655360;
constexpr size_t WS_WIN = 3 * MiB;
constexpr size_t WS_WA = 15 * MiB, WS_WC = 16 * MiB, WS_WOUT = 17 * MiB;
constexpr size_t WS_H1 = 19 * MiB;
constexpr size_t WS_AC = 19 * MiB, WS_ATT = 35 * MiB;
constexpr size_t WS_Q = 51 * MiB, WS_K = 67 * MiB, WS_V = 83 * MiB, WS_MASK = 83 * MiB, WS_VT = 99 * MiB, WS_QI = 115 * MiB, WS_KI = 131 * MiB;
constexpr size_t WS_WI = 133 * MiB, WS_QL = 133 * MiB + 524288;
constexpr size_t WS_CB = 136 * MiB, WS_U = 152 * MiB, WS_TMPC = 136 * MiB, WS_G = 168 * MiB;
constexpr size_t WS_MERGED = 51 * MiB;
constexpr size_t WS_WGU = 51 * MiB, WS_WD = 115 * MiB;
constexpr size_t WS_HID = 147 * MiB;
constexpr size_t WS_Y = 187 * MiB;
constexpr size_t WS_END = DBG_CMP_ATT ? 300 * MiB : 267 * MiB;
constexpr size_t WS_MASK_DBG = 268 * MiB, WS_ATT2 = 284 * MiB;
constexpr int CW_CMP = 2048;
constexpr int CW_TMO = 0, CW_CODE = 1, CW_KMAX = 64, CW_ECNT = 1024  , CW_BAR = 4096, CW_AROW = 131072  ;

constexpr int RING_OFF = 0, RING_BYTES = 131072;
constexpr int LDSCTL_OFF = RING_BYTES, MISC_OFF = LDSCTL_OFF + 320;
constexpr int LDS_BYTES = 147456;

#define GAS __attribute__((address_space(1)))
#define LAS __attribute__((address_space(3)))
typedef unsigned short bf16;
typedef unsigned v4u __attribute__((ext_vector_type(4)));
typedef unsigned v2u __attribute__((ext_vector_type(2)));
typedef float f32x4 __attribute__((ext_vector_type(4)));
typedef short bf16x8 __attribute__((ext_vector_type(8)));
typedef GAS unsigned gu32;
#define RLX_AGENT __ATOMIC_RELAXED, __HIP_MEMORY_SCOPE_AGENT
#define LDS_WAIT() asm volatile("s_waitcnt lgkmcnt(0)" ::: "memory")
#define VM_WAIT() asm volatile("s_waitcnt vmcnt(0)" ::: "memory")
__device__ __forceinline__ unsigned f2bf(float f) { unsigned u = __builtin_bit_cast(unsigned, f); return (u + 0x7fffu + ((u >> 16) & 1u)) >> 16; }
__device__ __forceinline__ unsigned pk2(float lo, float hi) { return f2bf(lo) | (f2bf(hi) << 16); }
__device__ __forceinline__ float bflo(unsigned u) { return __builtin_bit_cast(float, u << 16); }
__device__ __forceinline__ float bfhi(unsigned u) { return __builtin_bit_cast(float, u & 0xffff0000u); }
__device__ __forceinline__ float bf1(bf16 h) { return __builtin_bit_cast(float, (unsigned)h << 16); }
__device__ __forceinline__ float wave_sum(float v) {
#pragma unroll
    for (int o = 1; o < 64; o <<= 1) v += __shfl_xor(v, o);
    return v;
}
#define DPP_F(v, ctrl, row_mask) __builtin_bit_cast(float, __builtin_amdgcn_update_dpp(0, __builtin_bit_cast(int, (v)), (ctrl), (row_mask), 0xf, false))
__device__ __forceinline__ float wave_sum63(float v) {
    v += DPP_F(v, 0x111, 0xf); v += DPP_F(v, 0x112, 0xf); v += DPP_F(v, 0x114, 0xf); v += DPP_F(v, 0x118, 0xf);
    v += DPP_F(v, 0x142, 0xa);
    v += DPP_F(v, 0x143, 0xc);
    return v;
}
__device__ __forceinline__ float wave_sum_all(float v) { return __builtin_bit_cast(float, __builtin_amdgcn_readlane(__builtin_bit_cast(int, wave_sum63(v)), 63)); }
__device__ __forceinline__ float wave_max(float v) {
#pragma unroll
    for (int o = 1; o < 64; o <<= 1) v = fmaxf(v, __shfl_xor(v, o));
    return v;
}

#define XB_TMO      128
#define XB_XCNT(j)  (256  + 64 * (j))
#define XB_XSUB(j)  (1280 + 64 * (j))
#define XB_XGEN(j)  (2304 + 64 * (j))
#define XB_TOP      3328
#define XB_TOPGEN   3392
#define XCD_BAR_WORDS 3456
#define XB_SPIN_CAP (1u << 18)

__device__ __forceinline__ unsigned xb_ld(unsigned* p)              { return __hip_atomic_load(p, __ATOMIC_RELAXED, __HIP_MEMORY_SCOPE_AGENT); }
__device__ __forceinline__ unsigned xb_add(unsigned* p, unsigned v) { return __hip_atomic_fetch_add(p, v, __ATOMIC_RELAXED, __HIP_MEMORY_SCOPE_AGENT); }
__device__ __forceinline__ unsigned xb_xcc_id() { return (unsigned)__builtin_amdgcn_s_getreg((3 << 11) | 20) & 0xFu; }
#define XB_SPIN(cond, bar) do { unsigned _sp = 0; while (cond) { __builtin_amdgcn_s_sleep(1); \
    if ((++_sp & 255u) == 0u) { if (xb_ld(&(bar)[XB_TMO])) break; if (_sp > XB_SPIN_CAP) { atomicAdd(&(bar)[XB_TMO], 1u); break; } } } } while (0)

struct XcdBarrier { unsigned* bar; unsigned x; volatile LAS unsigned* st; };

__device__ __forceinline__ XcdBarrier xcd_barrier_post(unsigned* bar, volatile LAS unsigned* st) {
    XcdBarrier b; b.bar = bar; b.x = xb_xcc_id(); b.st = st;
    if (threadIdx.x == 0) (void)xb_add(&bar[XB_XCNT(b.x)], 1u);
    return b;
}
__device__ __forceinline__ void xcd_barrier_complete(unsigned* bar, unsigned x, unsigned& nloc, unsigned& nx) {
    const unsigned G = gridDim.x * gridDim.y * gridDim.z;
    unsigned sum, cnt, mine, sp = 0u;
    for (;;) {
        sum = 0u; cnt = 0u; mine = 0u;
#pragma unroll
        for (unsigned j = 0; j < 16; ++j) { const unsigned c = xb_ld(&bar[XB_XCNT(j)]); sum += c; cnt += (c > 0u) ? 1u : 0u; mine = (j == x) ? c : mine; }
        if (sum == G) break;
        __builtin_amdgcn_s_sleep(1);
        if ((++sp & 255u) == 0u) { if (xb_ld(&bar[XB_TMO])) break; if (sp > XB_SPIN_CAP) { atomicAdd(&bar[XB_TMO], 1u); break; } }
    }
    nloc = mine > 0u ? mine : 1u; nx = cnt > 0u ? cnt : 1u;
}
__device__ __forceinline__ void xcd_barrier(const XcdBarrier& b, const bool is_t0  ) {
    asm volatile("s_waitcnt vmcnt(0)" ::: "memory");
    __syncthreads();
    if (is_t0) {
        unsigned* bar = b.bar;
        __builtin_amdgcn_s_waitcnt(0);
        unsigned nloc = b.st[0], nx = b.st[1];
        if (nloc == 0u) { xcd_barrier_complete(bar, b.x, nloc, nx); b.st[0] = nloc; b.st[1] = nx; }
        const unsigned old = xb_add(&bar[XB_XSUB(b.x)], 1u);
        const unsigned gen = old / nloc;
        if (old + 1u == (gen + 1u) * nloc) {
            __builtin_amdgcn_fence(__ATOMIC_RELEASE, "agent");
            asm volatile("s_waitcnt vmcnt(0)" ::: "memory");
            const unsigned og = xb_add(&bar[XB_TOP], 1u);
            const unsigned tg = og / nx;
            if (og + 1u == (tg + 1u) * nx) xb_add(&bar[XB_TOPGEN], 1u);
            else XB_SPIN(xb_ld(&bar[XB_TOPGEN]) == tg, bar);
            __builtin_amdgcn_fence(__ATOMIC_ACQUIRE, "agent");
            xb_add(&bar[XB_XGEN(b.x)], 1u);
            asm volatile("s_waitcnt vmcnt(0)" ::: "memory");
        } else {
            XB_SPIN(xb_ld(&bar[XB_XGEN(b.x)]) == gen, bar);
            __builtin_amdgcn_fence(__ATOMIC_ACQUIRE, "agent");
            asm volatile("s_waitcnt vmcnt(0)" ::: "memory");
        }
    }
    __syncthreads();
}

struct Frame {
    LAS unsigned char* lds;
    volatile LAS unsigned* MISC;
    gu32* ctl;
    unsigned char* ws;
    int tid, lane, wave;
    int vcu, G;
    const float *x, *c, *w_ada, *b_ada, *norm1_g, *w_in, *rel_bias, *conv_w, *w_attn, *w_conv, *w_out, *norm2_g, *wrg, *brg, *wre, *bre, *w_gate_e, *w_up_e, *w_down_e, *norm_f_g;
    float* out;
};
#define WSP(T_, off) ((T_*)(F.ws + (off)))

template <class RowMap>
__device__ __forceinline__ void transpose_item(const float* W, int K, int N, bf16* WT, LAS float* scr, int item, int lane, RowMap rm) {
    const int nblk = (N + 31) / 32, kb = item / nblk, nb = item % nblk, k0 = 64 * kb, n0 = 32 * nb;
    const int nn = n0 + (lane & 31);
#pragma unroll 8
    for (int i = 0; i < 32; ++i) { const int kk = 2 * i + (lane >> 5); scr[kk * 33 + (lane & 31)] = (nn < N) ? W[(size_t)(k0 + kk) * N + nn] : 0.f; }
    LDS_WAIT(); asm volatile("" ::: "memory");
    const int c = lane & 7;
#pragma unroll
    for (int j = 0; j < 4; ++j) { const int n = (lane >> 3) + 8 * j; const LAS float* s = scr + (8 * c) * 33 + n;
        v4u o; o.x = pk2(s[0 * 33], s[1 * 33]); o.y = pk2(s[2 * 33], s[3 * 33]); o.z = pk2(s[4 * 33], s[5 * 33]); o.w = pk2(s[6 * 33], s[7 * 33]);
        if (n0 + n < N) *(GAS v4u*)(WT + (size_t)rm(n0 + n) * K + k0 + 8 * c) = o; }
    LDS_WAIT(); asm volatile("" ::: "memory");
}
struct RmId { __device__ __forceinline__ int operator()(int n) const { return n; } };
struct RmWin { __device__ __forceinline__ int operator()(int n) const {
    if (n < 2120) return n;
    if (n < 2632) return n + 184;
    if (n < 3144) { const int j = n - 2632; return 2816 + 256 * (j >> 7) + (j & 127); }
    if (n < 3656) { const int j = n - 3144; return 2816 + 256 * (j >> 7) + 128 + (j & 127); }
    return n + 184; } };
struct RmGU { int half; __device__ __forceinline__ int operator()(int n) const { return 256 * (n >> 7) + 128 * half + (n & 127); } };

__device__ __forceinline__ void p0_prologue(Frame& F) {
    LAS float* scr = (LAS float*)(F.lds + RING_OFF + F.wave * 16384);
    const int gw = F.vcu * NWAVES + F.wave, NGW = F.G * NWAVES;
    if (F.vcu < 96) {
        const int n = F.vcu * 64 + F.lane; float a0 = 0.f, a1 = 0.f;
        LAS float* cact = (LAS float*)(F.lds + RING_OFF + 16384);
        for (int i = F.tid; i < 2 * D; i += 512) { const float cv = F.c[i]; cact[i] = cv / (1.f + __expf(-cv)); }
        __syncthreads();
#pragma unroll 16
        for (int k = F.wave * 128; k < F.wave * 128 + 128; ++k) {
            const float w = F.w_ada[(size_t)k * 6144 + n];
            a0 += cact[k] * w; a1 += cact[D + k] * w;
        }
        LAS float* red = (LAS float*)(F.lds + RING_OFF + 8448);
        red[(F.wave * 2 + 0) * 64 + F.lane] = a0; red[(F.wave * 2 + 1) * 64 + F.lane] = a1;
        __syncthreads();
        if (F.wave < 2) { float s = F.b_ada[n];
#pragma unroll
            for (int w = 0; w < 8; ++w) s += red[(w * 2 + F.wave) * 64 + F.lane];
            WSP(float, SM_MOD)[F.wave * 6144 + n] = s; }
        __syncthreads();
    }
    constexpr int I_IN = 16 * 179;
    for (int it = gw; it < I_IN; it += NGW) transpose_item(F.w_in, D, NIN, WSP(bf16, WS_WIN), scr, it, F.lane, RmWin());
    for (int i = gw * 64 + F.lane; i < 184 * 128; i += NGW * 64) { *(GAS v4u*)(WSP(bf16, WS_WIN) + (size_t)2120 * D + (size_t)i * 8) = (v4u){0u, 0u, 0u, 0u}; }
    for (int i = gw * 64 + F.lane; i < 36 * D; i += NGW * 64) { const int n = i / D, k = i % D; WSP(float, SM_WRT)[i] = (n < 4) ? F.wrg[k * 4 + n] : F.wre[k * 32 + (n - 4)]; }
}

__device__ __forceinline__ void p1_norm1(Frame& F) {
    const int gw = F.vcu * NWAVES + F.wave, NGW = F.G * NWAVES;
    const float* mod = WSP(float, SM_MOD);
    for (int m0 = gw * 4; m0 < T; m0 += NGW * 4) {
        const int b = m0 / SEQ;
        f32x4 v[4][4]; float ss[4];
#pragma unroll
        for (int r = 0; r < 4; ++r) { const GAS f32x4* xr = (const GAS f32x4*)(F.x + (size_t)(m0 + r) * D) + F.lane;
#pragma unroll
            for (int j = 0; j < 4; ++j) v[r][j] = xr[64 * j]; }
#pragma unroll
        for (int r = 0; r < 4; ++r) { float s = 0.f;
#pragma unroll
            for (int j = 0; j < 4; ++j) s += (v[r][j].x * v[r][j].x + v[r][j].y * v[r][j].y) + (v[r][j].z * v[r][j].z + v[r][j].w * v[r][j].w);
            ss[r] = 1.f / sqrtf(wave_sum_all(s) * (1.f / D) + EPS); }
#pragma unroll
        for (int j = 0; j < 4; ++j) { const int k = 4 * F.lane + 256 * j;
            const f32x4 g = *(const f32x4*)(F.norm1_g + k), sc = *(const f32x4*)(mod + b * 6144 + 1024 + k), sh = *(const f32x4*)(mod + b * 6144 + k);
            const f32x4 ca = g * (sc + 1.0f);
#pragma unroll
            for (int r = 0; r < 4; ++r) { const f32x4 h = v[r][j] * ss[r] * ca + sh; ((GAS v2u*)(WSP(bf16, WS_H1) + (size_t)(m0 + r) * D) + F.lane)[64 * j] = (v2u){pk2(h.x, h.y), pk2(h.z, h.w)}; } }
    }
}

using pg8::Unit;
typedef float f32x2_t __attribute__((ext_vector_type(2))); typedef __bf16 bf16x2_t __attribute__((ext_vector_type(2)));
__device__ __forceinline__ unsigned cvtpk(float lo, float hi) { f32x2_t v = {lo, hi}; bf16x2_t b = __builtin_convertvector(v, bf16x2_t); return __builtin_bit_cast(unsigned, b); }
__device__ __forceinline__ v4u pack8(const f32x4 a, const f32x4 b) { v4u w; w.x = cvtpk(a[0], a[1]); w.y = cvtpk(a[2], a[3]); w.z = cvtpk(b[0], b[1]); w.w = cvtpk(b[2], b[3]); return w; }
__device__ __forceinline__ float sigmoidf_(float x) { return __builtin_amdgcn_rcpf(1.f + __builtin_amdgcn_exp2f(-x * LOG2E)); }
__device__ __forceinline__ f32x4 sig4(f32x4 v) { return (f32x4){sigmoidf_(v[0]), sigmoidf_(v[1]), sigmoidf_(v[2]), sigmoidf_(v[3])}; }
__device__ __forceinline__ void unpack8(const v4u w, f32x4& a, f32x4& b) { a = (f32x4){bflo(w.x), bfhi(w.x), bflo(w.y), bfhi(w.y)}; b = (f32x4){bflo(w.z), bfhi(w.z), bflo(w.w), bfhi(w.w)}; }

struct EpiProj {
    static constexpr bool PERM = true, AFTER_DRAIN = false;
    bf16 *Q, *K, *V, *QI, *KI, *CB, *U, *G; float* WI;
    __device__ __forceinline__ void operator()(const f32x4 (&acc)[2][2][4][2], const Unit& u, int wr, int wc, int fr, int fq) const {
        const int pn = u.pn, row0 = u.pm * 256 + wr * 64 + fr, cb8 = wc * 32 + 8 * fq;
        if (pn < 8 || pn == 9 || pn == 10) {
            bf16* base; int coff; float sc = 1.f;
            if (pn < 2) { base = Q; coff = 256 * pn; sc = C2; } else if (pn < 4) { base = K; coff = 256 * (pn - 2); } else if (pn < 6) { base = V; coff = 256 * (pn - 4); }
            else if (pn < 8) { base = QI; coff = 256 * (pn - 6); } else { base = CB; coff = 256 * (pn - 9); }
#pragma unroll
            for (int ai = 0; ai < 2; ++ai)
#pragma unroll
                for (int m = 0; m < 4; ++m) { bf16* rowp = base + (size_t)(row0 + ai * 128 + m * 16) * 512 + coff + cb8;
#pragma unroll
                    for (int bj = 0; bj < 2; ++bj) *(v4u*)(rowp + bj * 128) = pack8(acc[ai][bj][m][0] * sc, acc[ai][bj][m][1] * sc); }
        } else if (pn == 8) {
#pragma unroll
            for (int ai = 0; ai < 2; ++ai)
#pragma unroll
                for (int m = 0; m < 4; ++m) { const size_t row = (size_t)(row0 + ai * 128 + m * 16);
                    if (wc < 2) *(v4u*)(KI + row * 64 + cb8) = pack8(acc[ai][0][m][0], acc[ai][0][m][1]);
                    else if (wc == 2 && fq == 0) { *(f32x4*)(WI + row * 8) = acc[ai][0][m][0]; *(f32x4*)(WI + row * 8 + 4) = acc[ai][0][m][1]; } }
        } else if (pn < 15) {
#pragma unroll
            for (int ai = 0; ai < 2; ++ai)
#pragma unroll
                for (int m = 0; m < 4; ++m) { const size_t row = (size_t)(row0 + ai * 128 + m * 16);
                    *(v4u*)(U + row * 512 + 128 * (pn - 11) + cb8) = pack8(acc[ai][0][m][0] * acc[ai][1][m][0], acc[ai][0][m][1] * acc[ai][1][m][1]); }
        } else {
#pragma unroll
            for (int ai = 0; ai < 2; ++ai)
#pragma unroll
                for (int m = 0; m < 4; ++m) { bf16* rowp = G + (size_t)(row0 + ai * 128 + m * 16) * 2048 + 256 * (pn - 15) + cb8;
#pragma unroll
                    for (int bj = 0; bj < 2; ++bj) *(v4u*)(rowp + bj * 128) = pack8(sig4(acc[ai][bj][m][0]), sig4(acc[ai][bj][m][1])); }
        }
    }
};
struct EpiConv {
    static constexpr bool PERM = true, AFTER_DRAIN = false;
    const bf16* G; bf16* O;
    __device__ __forceinline__ void operator()(const f32x4 (&acc)[2][2][4][2], const Unit& u, int wr, int wc, int fr, int fq) const {
        const int row0 = u.pm * 256 + wr * 64 + fr, col0 = u.pn * 256 + wc * 32 + 8 * fq;
#pragma unroll
        for (int ai = 0; ai < 2; ++ai)
#pragma unroll
            for (int m = 0; m < 4; ++m) { const size_t row = (size_t)(row0 + ai * 128 + m * 16);
#pragma unroll
                for (int bj = 0; bj < 2; ++bj) { f32x4 g0, g1; unpack8(*(const v4u*)(G + row * 2048 + 1024 + col0 + bj * 128), g0, g1);
                    *(v4u*)(O + row * 1024 + col0 + bj * 128) = pack8(g0 * acc[ai][bj][m][0], g1 * acc[ai][bj][m][1]); } }
    }
};
struct EpiAttn {
    static constexpr bool PERM = true, AFTER_DRAIN = false;
    const bf16* G; const bf16* Tc; bf16* O;
    __device__ __forceinline__ void operator()(const f32x4 (&acc)[2][2][4][2], const Unit& u, int wr, int wc, int fr, int fq) const {
        const int row0 = u.pm * 256 + wr * 64 + fr, col0 = u.pn * 256 + wc * 32 + 8 * fq;
#pragma unroll
        for (int ai = 0; ai < 2; ++ai)
#pragma unroll
            for (int m = 0; m < 4; ++m) { const size_t row = (size_t)(row0 + ai * 128 + m * 16);
#pragma unroll
                for (int bj = 0; bj < 2; ++bj) { f32x4 g0, g1, t0, t1; unpack8(*(const v4u*)(G + row * 2048 + col0 + bj * 128), g0, g1); unpack8(*(const v4u*)(Tc + row * 1024 + col0 + bj * 128), t0, t1);
                    *(v4u*)(O + row * 1024 + col0 + bj * 128) = pack8(g0 * acc[ai][bj][m][0] + t0, g1 * acc[ai][bj][m][1] + t1); } }
    }
};
struct EpiOut {
    static constexpr bool PERM = false, AFTER_DRAIN = false;
    const float* X; const float* mod; float* O;
    __device__ __forceinline__ void operator()(const f32x4 (&acc)[2][2][4][2], const Unit& u, int wr, int wc, int fr, int fq) const {
        const int row0 = u.pm * 256 + wr * 64 + fr, col0 = u.pn * 256 + wc * 32 + 4 * fq;
        const float* g1 = mod + ((u.pm * 256) / SEQ) * 6144 + 2048;
#pragma unroll
        for (int bj = 0; bj < 2; ++bj)
#pragma unroll
            for (int n = 0; n < 2; ++n) { const int col = col0 + bj * 128 + n * 16; const f32x4 gv = *(const f32x4*)(g1 + col);
#pragma unroll
                for (int ai = 0; ai < 2; ++ai)
#pragma unroll
                    for (int m = 0; m < 4; ++m) { const size_t off = (size_t)(row0 + ai * 128 + m * 16) * D + col;
                        *(f32x4*)(O + off) = *(const f32x4*)(X + off) + gv * acc[ai][bj][m][n]; } }
    }
};
__device__ __forceinline__ f32x4 silu_mul4(f32x4 g, f32x4 u) { return (f32x4){g[0] * sigmoidf_(g[0]) * u[0], g[1] * sigmoidf_(g[1]) * u[1], g[2] * sigmoidf_(g[2]) * u[2], g[3] * sigmoidf_(g[3]) * u[3]}; }
struct EpiHid {
    static constexpr bool PERM = true, AFTER_DRAIN = false;
    bf16* O;
    __device__ __forceinline__ void operator()(const f32x4 (&acc)[2][2][4][2], const Unit& u, int wr, int wc, int fr, int fq) const {
        const int row0 = u.pm * 256 + wr * 64 + fr, col0 = 128 * (u.pn & 3) + wc * 32 + 8 * fq;
#pragma unroll
        for (int ai = 0; ai < 2; ++ai)
#pragma unroll
            for (int m = 0; m < 4; ++m) { const size_t row = (size_t)(row0 + ai * 128 + m * 16);
                *(v4u*)(O + row * 512 + col0) = pack8(silu_mul4(acc[ai][0][m][0], acc[ai][1][m][0]), silu_mul4(acc[ai][0][m][1], acc[ai][1][m][1])); }
    }
};
struct EpiY {
    static constexpr bool PERM = true, AFTER_DRAIN = false;
    bf16* O;
    __device__ __forceinline__ void operator()(const f32x4 (&acc)[2][2][4][2], const Unit& u, int wr, int wc, int fr, int fq) const {
        const int row0 = u.pm * 256 + wr * 64 + fr, col0 = 256 * (u.pn & 3) + wc * 32 + 8 * fq;
#pragma unroll
        for (int ai = 0; ai < 2; ++ai)
#pragma unroll
            for (int m = 0; m < 4; ++m) { const size_t row = (size_t)(row0 + ai * 128 + m * 16);
#pragma unroll
                for (int bj = 0; bj < 2; ++bj) *(v4u*)(O + row * 1024 + col0 + bj * 128) = pack8(acc[ai][bj][m][0], acc[ai][bj][m][1]); }
    }
};
struct MoeOrder {
    const LAS int* tile_e; int ntiles, G, c;
    __device__ __forceinline__ bool next(int i, Unit& u) const {
        const int L = i * G + c; if (L >= ntiles * 4) return false;
        const int rt = L >> 2, j = L & 3; u.pm = rt; u.pn = 4 * tile_e[rt] + j; return true; }
    __device__ __forceinline__ void a_ready(const Unit&) const {}
    __device__ __forceinline__ void done(const Unit&) const {}
};

__device__ __forceinline__ void p3_prep(Frame& F) {
    const int gw = F.vcu * NWAVES + F.wave, NGW = F.G * NWAVES;
    {
        LAS bf16* tl = (LAS bf16*)(F.lds + RING_OFF + F.wave * 16384);
        const bf16* V = WSP(bf16, WS_V); bf16* VT = WSP(bf16, WS_VT);
        for (int it = gw; it < BATCH * NH * (SEQ / 64); it += NGW) {
            const int kt = it % (SEQ / 64), h = (it / (SEQ / 64)) % NH, b = it / (NH * (SEQ / 64));
            const bf16* src = V + (size_t)(b * SEQ + kt * 64 + F.lane) * 512 + h * 64;
#pragma unroll
            for (int c = 0; c < 8; ++c) { const v4u w = *(const v4u*)(src + c * 8);
                LAS unsigned* d = (LAS unsigned*)(tl + F.lane * 66 + c * 8); d[0] = w.x; d[1] = w.y; d[2] = w.z; d[3] = w.w; }
            LDS_WAIT(); asm volatile("" ::: "memory");
            unsigned o[32];
#pragma unroll
            for (int p = 0; p < 64; p += 2) {
                const int i0 = p & 15, i1 = (p + 1) & 15, g = p & ~15;
                const int k0 = g + ((i0 < 4 || i0 >= 12) ? i0 : (i0 < 8 ? i0 + 4 : i0 - 4)), k1 = g + ((i1 < 4 || i1 >= 12) ? i1 : (i1 < 8 ? i1 + 4 : i1 - 4));
                o[p >> 1] = (unsigned)tl[k0 * 66 + F.lane] | ((unsigned)tl[k1 * 66 + F.lane] << 16); }
            bf16* dst = VT + ((size_t)((b * NH + h) * 64 + F.lane)) * SEQ + kt * 64;
#pragma unroll
            for (int c = 0; c < 8; ++c) *(v4u*)(dst + c * 8) = (v4u){o[4 * c], o[4 * c + 1], o[4 * c + 2], o[4 * c + 3]};
            LDS_WAIT(); asm volatile("" ::: "memory");
        }
    }
    {
        const bf16* CB = WSP(bf16, WS_CB); const bf16* U = WSP(bf16, WS_U); bf16* AC = WSP(bf16, WS_AC);
        const int j = F.lane * 8;
        const f32x4 w2a = *(const f32x4*)(F.conv_w + 1024 + j), w2b = *(const f32x4*)(F.conv_w + 1024 + j + 4), w1a = *(const f32x4*)(F.conv_w + 512 + j), w1b = *(const f32x4*)(F.conv_w + 512 + j + 4),
                    w0a = *(const f32x4*)(F.conv_w + j), w0b = *(const f32x4*)(F.conv_w + j + 4);
        for (int t0 = gw * 4; t0 < T; t0 += NGW * 4) {
            v4u cw[4], uw[6];
#pragma unroll
            for (int r = 0; r < 4; ++r) cw[r] = *(const v4u*)(CB + (size_t)(t0 + r) * 512 + j);
            const int tt0 = t0 % SEQ;
#pragma unroll
            for (int r = 0; r < 6; ++r) uw[r] = (tt0 + r - 2 >= 0) ? *(const v4u*)(U + (size_t)(t0 + r - 2) * 512 + j) : (v4u){0u, 0u, 0u, 0u};
#pragma unroll
            for (int r = 0; r < 4; ++r) {
                f32x4 c0, c1, a0, a1, b0, b1, d0, d1;
                unpack8(cw[r], c0, c1); unpack8(uw[r + 2], a0, a1); unpack8(uw[r + 1], b0, b1); unpack8(uw[r], d0, d1);
                *(v4u*)(AC + (size_t)(t0 + r) * 512 + j) = pack8(c0 * (a0 * w2a + b0 * w1a + d0 * w0a), c1 * (a1 * w2b + b1 * w1b + d1 * w0b));
            }
        }
    }
    {
        const bf16* QI = WSP(bf16, WS_QI); const float* WI = WSP(float, WS_WI); bf16* QL = WSP(bf16, WS_QL); float* AT = WSP(float, SM_AT);
        for (int t0 = gw * 4; t0 < T; t0 += NGW * 4) {
            float vv[4][8], ww[4][8];
#pragma unroll
            for (int r = 0; r < 4; ++r)
#pragma unroll
                for (int h = 0; h < 8; ++h) { ww[r][h] = WI[(size_t)(t0 + r) * 8 + h]; vv[r][h] = bf1(QI[(size_t)(t0 + r) * 512 + h * 64 + F.lane]); }
#pragma unroll
            for (int r = 0; r < 4; ++r) { float ql = 0.f, a = 0.f;
#pragma unroll
                for (int h = 0; h < 8; ++h) { ql += ww[r][h] * vv[r][h]; a += fabsf(ww[r][h]) * sqrtf(wave_sum63(vv[r][h] * vv[r][h])); }
                QL[(size_t)(t0 + r) * 64 + F.lane] = (bf16)f2bf(ql);
                if (F.lane == 63) AT[t0 + r] = a; }
        }
    }
    {
        const bf16* KI = WSP(bf16, WS_KI); float mx = 0.f;
        for (int s = gw * 64 + F.lane; s < T; s += NGW * 64) { float q = 0.f;
#pragma unroll
            for (int c = 0; c < 8; ++c) { f32x4 a, b; unpack8(*(const v4u*)(KI + (size_t)s * 64 + c * 8), a, b); q += (a[0] * a[0] + a[1] * a[1]) + (a[2] * a[2] + a[3] * a[3]) + (b[0] * b[0] + b[1] * b[1]) + (b[2] * b[2] + b[3] * b[3]); }
            mx = fmaxf(mx, q); }
        mx = wave_max(mx);
        if (F.lane == 0) atomicMax((unsigned*)(F.ctl + CW_KMAX), __builtin_bit_cast(unsigned, sqrtf(mx)));
    }
}

__device__ __forceinline__ unsigned ord_key(float x) { if (x == 0.f) x = 0.f; const unsigned u = __builtin_bit_cast(unsigned, x); return (u & 0x80000000u) ? ~u : (u | 0x80000000u); }
__device__ __forceinline__ int t5_bucket(int n) {
    if (n < 16) return n;
    const int v = 16 + (int)(logf((float)n / 16.f) / 2.0794415416798357f * 16.f);
    return v < 31 ? v : 31;
}
__device__ __forceinline__ void pn_naive_dsa(Frame& F) {
    LAS float* sc = (LAS float*)(F.lds + RING_OFF);
    LAS float* qf = (LAS float*)(F.lds + RING_OFF + 32768);
    LAS float* wq = qf + 512;
    LAS unsigned* hist = (LAS unsigned*)(F.lds + RING_OFF + 36864);
    LAS int* sel = (LAS int*)(F.lds + RING_OFF + 40960);
    LAS float* pbuf = (LAS float*)(F.lds + RING_OFF + 45056);
    LAS int* wcnt = (LAS int*)(F.lds + RING_OFF + 53248);
    LAS int* bkt = (LAS int*)(F.lds + RING_OFF + 53248 + 256);
    const bf16* QI = WSP(bf16, WS_QI); const bf16* KI = WSP(bf16, WS_KI); const float* WI = WSP(float, WS_WI);
    const bf16* Qb = WSP(bf16, WS_Q); const bf16* Kb = WSP(bf16, WS_K); const bf16* Vb = WSP(bf16, WS_V); bf16* ATT = WSP(bf16, WS_ATT);
    if (F.tid < 128) bkt[F.tid] = t5_bucket(F.tid);
    __syncthreads();
    for (int qi_ = 0; qi_ < T / F.G + 1; ++qi_) {
        const int qidx = qi_ * F.G + F.vcu; if (qidx >= T) break;
        const int b = qidx / SEQ, t = qidx % SEQ, n = t + 1;
        qf[F.tid] = bf1(QI[(size_t)qidx * 512 + F.tid]);
        if (F.tid < 8) wq[F.tid] = WI[(size_t)qidx * 8 + F.tid];
        __syncthreads();
        for (int s = F.tid; s < n; s += 512) {
            float kf[64]; const bf16* kr = KI + (size_t)(b * SEQ + s) * 64;
#pragma unroll
            for (int c = 0; c < 8; ++c) { f32x4 a, bb; unpack8(*(const v4u*)(kr + c * 8), a, bb); kf[8 * c] = a[0]; kf[8 * c + 1] = a[1]; kf[8 * c + 2] = a[2]; kf[8 * c + 3] = a[3]; kf[8 * c + 4] = bb[0]; kf[8 * c + 5] = bb[1]; kf[8 * c + 6] = bb[2]; kf[8 * c + 7] = bb[3]; }
            float score = 0.f;
#pragma unroll 1
            for (int h = 0; h < 8; ++h) { float dsum = 0.f;
#pragma unroll
                for (int d4 = 0; d4 < 16; ++d4) { const f32x4 q4 = *(const LAS f32x4*)(qf + h * 64 + d4 * 4); dsum += q4[0] * kf[4 * d4] + q4[1] * kf[4 * d4 + 1] + q4[2] * kf[4 * d4 + 2] + q4[3] * kf[4 * d4 + 3]; }
                score += wq[h] * fmaxf(dsum, 0.f); }
            sc[s] = score;
        }
        __syncthreads();
        unsigned prefix = 0u, pmask = 0u; int need = TOPK;
        if (n > TOPK) {
            for (int pass = 0; pass < 4; ++pass) {
                const int shift = 24 - 8 * pass;
                if (F.tid < 256) hist[F.tid] = 0u;
                __syncthreads();
                for (int s = F.tid; s < n; s += 512) { const unsigned u = ord_key(sc[s]); if ((u & pmask) == prefix) atomicAdd((unsigned*)&hist[(u >> shift) & 255u], 1u); }
                __syncthreads();
                if (F.wave == 0) {
                    int c4[4]; int tot = 0;
#pragma unroll
                    for (int j = 0; j < 4; ++j) { c4[j] = (int)hist[4 * F.lane + j]; tot += c4[j]; }
                    int incl = tot;
#pragma unroll
                    for (int o = 1; o < 64; o <<= 1) { const int v = __shfl_down(incl, o); if (F.lane + o < 64) incl += v; }
                    const int above = incl - tot;
                    if (above < need && need <= incl) { int run = above;
#pragma unroll
                        for (int j = 3; j >= 0; --j) { if (run < need && need <= run + c4[j]) { wcnt[16] = 4 * F.lane + j; wcnt[17] = need - run; } run += c4[j]; } }
                }
                __syncthreads();
                prefix |= (unsigned)wcnt[16] << shift; pmask |= 255u << shift; need = wcnt[17];
                __syncthreads();
            }
        }
        int cg = 0, ce = 0;
        for (int i = 0; i < 16; ++i) { const int s = F.wave * 1024 + i * 64 + F.lane; bool gt = false, eq = false;
            if (s < n) { if (n <= TOPK) gt = true; else { const unsigned u = ord_key(sc[s]); gt = u > prefix; eq = (u == prefix); } }
            cg += __popcll(__ballot(gt)); ce += __popcll(__ballot(eq)); }
        if (F.lane == 0) { wcnt[2 * F.wave] = cg; wcnt[2 * F.wave + 1] = ce; }
        __syncthreads();
        int eqb = 0, tkb = 0, nsel = 0;
        { int eq_before = 0;
          for (int w = 0; w < 8; ++w) { const int g = wcnt[2 * w], e = wcnt[2 * w + 1];
              int take_e = need - eq_before; take_e = take_e < 0 ? 0 : (take_e > e ? e : take_e); if (n <= TOPK) take_e = 0;
              if (w < F.wave) { eqb += e; tkb += g + take_e; }
              nsel += g + take_e; eq_before += e; } }
        for (int i = 0; i < 16; ++i) { const int s = F.wave * 1024 + i * 64 + F.lane; bool gt = false, eq = false;
            if (s < n) { if (n <= TOPK) gt = true; else { const unsigned u = ord_key(sc[s]); gt = u > prefix; eq = (u == prefix); } }
            const unsigned long long mg = __ballot(gt), me = __ballot(eq), lt = (1ull << F.lane) - 1ull;
            const int erank = eqb + __popcll(me & lt);
            const bool take = gt || (eq && erank < need);
            const unsigned long long mt = __ballot(take);
            if (take) sel[tkb + __popcll(mt & lt)] = s;
            eqb += __popcll(me); tkb += __popcll(mt); (void)mg; }
        __syncthreads();
        {
            const int h = F.wave;
            qf[F.tid] = bf1(Qb[(size_t)qidx * 512 + F.tid]);
            __syncthreads();
            float lg[4]; float mx = -INFINITY;
#pragma unroll
            for (int i = 0; i < 4; ++i) { const int j = F.lane + 64 * i; lg[i] = -INFINITY;
                if (j < nsel) { const int s = sel[j]; const bf16* kr = Kb + (size_t)(b * SEQ + s) * 512 + h * 64; float dsum = 0.f;
#pragma unroll
                    for (int c = 0; c < 8; ++c) { f32x4 a, bb; unpack8(*(const v4u*)(kr + c * 8), a, bb); const f32x4 q0 = *(const LAS f32x4*)(qf + h * 64 + c * 8), q1 = *(const LAS f32x4*)(qf + h * 64 + c * 8 + 4);
                        dsum += (q0[0] * a[0] + q0[1] * a[1]) + (q0[2] * a[2] + q0[3] * a[3]) + (q1[0] * bb[0] + q1[1] * bb[1]) + (q1[2] * bb[2] + q1[3] * bb[3]); }
                    const int dist = t - s; const int bk = dist < 128 ? bkt[dist] : 31;
                    lg[i] = dsum + F.rel_bias[bk * 8 + h] * LOG2E; mx = fmaxf(mx, lg[i]); } }
            mx = wave_max(mx); float sum = 0.f;
#pragma unroll
            for (int i = 0; i < 4; ++i) { const int j = F.lane + 64 * i; const float p = (j < nsel) ? __builtin_amdgcn_exp2f(lg[i] - mx) : 0.f; sum += p; pbuf[h * 256 + j] = p; }
            sum = wave_sum(sum);
            LDS_WAIT(); asm volatile("" ::: "memory");
            float o = 0.f;
            for (int j = 0; j < nsel; ++j) o += pbuf[h * 256 + j] * bf1(Vb[(size_t)(b * SEQ + sel[j]) * 512 + h * 64 + F.lane]);
            ATT[(size_t)qidx * 512 + h * 64 + F.lane] = (bf16)f2bf(o / sum);
        }
        __syncthreads();
    }
}


typedef float f32x16 __attribute__((ext_vector_type(16)));
#define MFMA32(a, b, c) __builtin_amdgcn_mfma_f32_32x32x16_bf16((a), (b), (c), 0, 0, 0)
__device__ __forceinline__ int crow(int r, int hi) { return (r & 3) + 8 * (r >> 2) + 4 * hi; }
constexpr int IDX_CTL = LDSCTL_OFF + 2048;
constexpr int IDX_CAP = 512;

#define MFMA16(a, b, c) __builtin_amdgcn_mfma_f32_16x16x32_bf16((a), (b), (c), 0, 0, 0)
__device__ __forceinline__ void idx_tile(const bf16x8 (&kf)[4][2], const bf16x8 (&ql)[2], const bf16x8 (&qf)[8][2], const LAS float* w  , float invA, unsigned (&key)[4][4]) {
    float sc[4][4];
#define IDX_MF(D, QF0, QF1) _Pragma("unroll") for (int a = 0; a < 2; ++a) { D[a] = (f32x4){0.f, 0.f, 0.f, 0.f}; D[a] = MFMA16(kf[2 * hf + a][0], QF0, D[a]); D[a] = MFMA16(kf[2 * hf + a][1], QF1, D[a]); }
#define IDX_AC(D, W) do { const float wv_ = (W); _Pragma("unroll") for (int a = 0; a < 2; ++a) _Pragma("unroll") for (int i = 0; i < 4; ++i) { float x_ = __builtin_fmaf(wv_, __builtin_fabsf(D[a][i]), sc[2 * hf + a][i]); asm volatile("" : "+v"(x_)); sc[2 * hf + a][i] = x_; } } while (0)
#pragma unroll
    for (int hf = 0; hf < 2; ++hf) {
        f32x4 dA[2], dB[2];
        IDX_MF(dA, ql[0], ql[1]);
        IDX_MF(dB, qf[0][0], qf[0][1]);
#pragma unroll
        for (int a = 0; a < 2; ++a)
#pragma unroll
            for (int i = 0; i < 4; ++i) { float x_ = dA[a][i]; asm volatile("" : "+v"(x_)); sc[2 * hf + a][i] = x_; }
        IDX_MF(dA, qf[1][0], qf[1][1]); IDX_AC(dB, w[0]);
        IDX_MF(dB, qf[2][0], qf[2][1]); IDX_AC(dA, w[1]);
        IDX_MF(dA, qf[3][0], qf[3][1]); IDX_AC(dB, w[2]);
        IDX_MF(dB, qf[4][0], qf[4][1]); IDX_AC(dA, w[3]);
        IDX_MF(dA, qf[5][0], qf[5][1]); IDX_AC(dB, w[4]);
        IDX_MF(dB, qf[6][0], qf[6][1]); IDX_AC(dA, w[5]);
        IDX_MF(dA, qf[7][0], qf[7][1]); IDX_AC(dB, w[6]);
        IDX_AC(dA, w[7]);
    }
#undef IDX_MF
#undef IDX_AC
#pragma unroll
    for (int a = 0; a < 4; ++a)
#pragma unroll
        for (int i = 0; i < 4; ++i) key[a][i] = __builtin_bit_cast(unsigned, __builtin_fmaf(sc[a][i], invA, 3.0f));
}
__device__ __forceinline__ void idx_load_k(bf16x8 (&kf)[4][2], const bf16* KItile  , unsigned voff  ) {
#pragma unroll
    for (int a = 0; a < 4; ++a)
#pragma unroll
        for (int ks = 0; ks < 2; ++ks) kf[a][ks] = *(const bf16x8*)((const char*)KItile + voff + a * 2048 + ks * 64);
}
template <int MODE>
__device__ __forceinline__ void idx_pass(Frame& F, int ln, const bf16* KIb, unsigned* MASKg, int t0, int nt_idx, int nt_att, const bf16x8 (&ql)[2], const bf16x8 (&qf)[8][2], const LAS float* w, float invA, int b1, unsigned thr) {
    const int qc = ln & 15, fq = ln >> 4, qh = F.wave & 1, kp = F.wave >> 1, ql_ = 16 * qh + qc, t = t0 + ql_;
    LAS unsigned* hrow = (LAS unsigned*)(F.lds + RING_OFF) + ql_ * 1025;
    const int ntl = (MODE >= 2) ? nt_att : nt_idx;
    LAS unsigned* mlds = (LAS unsigned*)(F.lds + RING_OFF);
    LAS unsigned* clist = (LAS unsigned*)(F.lds + RING_OFF + 32768);
    LAS unsigned* ccnt = (LAS unsigned*)(F.lds + IDX_CTL) + 96;
    bf16x8 kcur[4][2];
    const unsigned voff = (unsigned)(qc * 64 + fq * 8) * 2u;
#pragma unroll
    for (int a = 0; a < 4; ++a)
#pragma unroll
        for (int ks = 0; ks < 2; ++ks) kcur[a][ks] = (bf16x8){0, 0, 0, 0, 0, 0, 0, 0};
    if (kp < nt_idx) idx_load_k(kcur, KIb + (size_t)(64 * kp) * 64, voff);
    for (int kt = kp; kt < ntl; kt += 4) {
        unsigned m16 = 0u;
        if (kt < nt_idx) {
            unsigned key[4][4];
            const bool diag = 64 * kt + 63 > t0;
            idx_tile(kcur, ql, qf, w, invA, key);
            if (kt + 4 < nt_idx) idx_load_k(kcur, KIb + (size_t)(64 * (kt + 4)) * 64, voff);
            bool cnd[4] = {false, false, false, false}; unsigned cps[4] = {0u, 0u, 0u, 0u};
#define IDX_TAIL(DIAG) _Pragma("unroll") for (int a = 0; a < 4; ++a) _Pragma("unroll") for (int i = 0; i < 4; ++i) { \
                    const unsigned bits = key[a][i]; const bool valid = (DIAG) ? (64 * kt + 16 * a + 4 * fq + i <= t) : true; \
                    if (MODE == 0) { unsigned val = 1u + __builtin_amdgcn_ubfe(bits, 22, 1) * 65535u; if (DIAG) val = valid ? val : 0u; \
                        __hip_atomic_fetch_add(hrow + __builtin_amdgcn_ubfe(bits, 12, 10), val, __ATOMIC_RELAXED, __HIP_MEMORY_SCOPE_WORKGROUP); } \
                    else if (MODE == 1) { unsigned val = 1u + __builtin_amdgcn_ubfe(bits, 11, 1) * 65535u; val = (valid && (int)__builtin_amdgcn_ubfe(bits, 12, 11) == b1) ? val : 0u; \
                        __hip_atomic_fetch_add(hrow + __builtin_amdgcn_ubfe(bits, 1, 10), val, __ATOMIC_RELAXED, __HIP_MEMORY_SCOPE_WORKGROUP); } \
                    else if (MODE == 2) { if (valid && __builtin_amdgcn_ubfe(bits, 1, 22) >= thr) m16 |= 1u << (4 * a + i); } \
                    else { const int dbin = (int)__builtin_amdgcn_ubfe(bits, 12, 11) - b1;            \
                        if (valid && dbin > 0) m16 |= 1u << (4 * a + i); \
                        cnd[i] = valid && dbin == 0; cps[i] = 0u; \
                        if (cnd[i]) cps[i] = __hip_atomic_fetch_add(ccnt + ql_, 1u, __ATOMIC_RELAXED, __HIP_MEMORY_SCOPE_WORKGROUP);        \
                        if (i == 3) { _Pragma("unroll") for (int i2 = 0; i2 < 4; ++i2)                                                     \
                            if (cnd[i2] && cps[i2] < (unsigned)IDX_CAP) clist[ql_ * IDX_CAP + cps[i2]] = (__builtin_amdgcn_ubfe(key[a][i2], 1, 11) << 18) | ((unsigned)(kt * 64 + (fq & 1) * 32 + ql_) << 5) | (unsigned)(8 * a + 4 * (fq >> 1) + i2); } } }
            if (diag) { IDX_TAIL(true) } else { IDX_TAIL(false) }
#undef IDX_TAIL
        }
        if (MODE >= 2) {
            unsigned word = ((m16 & 0xFu) | ((m16 & 0xF0u) << 4) | ((m16 & 0xF00u) << 8) | ((m16 & 0xF000u) << 12)) << (4 * (fq >> 1));
            word |= (unsigned)__shfl_xor((int)word, 32);
            if (ln < 32) { if (MODE == 2) MASKg[(size_t)kt * 64 + fq * 32 + ql_] = word; else mlds[kt * 64 + fq * 32 + ql_] = word; }
        }
    }
}
template <int LEVEL>
__device__ __forceinline__ void idx_scan(Frame& F, int ln) {
    LAS unsigned* hist = (LAS unsigned*)(F.lds + RING_OFF);
    LAS int* ctl = (LAS int*)(F.lds + IDX_CTL);
#pragma unroll 1
    for (int qi = 0; qi < 4; ++qi) {
        const int q = 4 * F.wave + qi;
        int need = (LEVEL == 0) ? TOPK : TOPK - ctl[32 + q];
        unsigned wv[16]; int toth = 0, totl = 0;
#pragma unroll
        for (int j = 0; j < 16; ++j) { wv[j] = hist[q * 1025 + 16 * ln + j]; toth += (int)(wv[j] >> 16); totl += (int)(wv[j] & 0xffffu); }
        int inclh = toth, incll = totl;
#pragma unroll
        for (int o = 1; o < 64; o <<= 1) { const int vh = __shfl_down(inclh, o), vl = __shfl_down(incll, o); if (ln + o < 64) { inclh += vh; incll += vl; } }
        const int allh = __shfl(inclh, 0);
        { const int above = inclh - toth;
          if (above < need && need <= inclh) { int run = above, B = 0, cab = 0; bool found = false;
#pragma unroll
              for (int j = 15; j >= 0; --j) { const int ch = (int)(wv[j] >> 16); if (!found && need <= run + ch) { found = true; B = 1024 + 16 * ln + j; cab = run; } run += ch; }
              if (LEVEL == 0) { ctl[q] = B; ctl[32 + q] = cab; } else ctl[64 + q] = (ctl[q] << 11) | B; } }
        { const int above = allh + incll - totl;
          if (allh < need && above < need && need <= allh + incll) { int run = above, B = 0, cab = 0; bool found = false;
#pragma unroll
              for (int j = 15; j >= 0; --j) { const int cl = (int)(wv[j] & 0xffffu); if (!found && need <= run + cl) { found = true; B = 16 * ln + j; cab = run; } run += cl; }
              if (LEVEL == 0) { ctl[q] = B; ctl[32 + q] = cab; } else ctl[64 + q] = (ctl[q] << 11) | B; } }
    }
}
__device__ __forceinline__ void idx_select(Frame& F, int ln) {
    LAS unsigned* mlds = (LAS unsigned*)(F.lds + RING_OFF);
    LAS unsigned* clist = (LAS unsigned*)(F.lds + RING_OFF + 32768);
    LAS int* ctl = (LAS int*)(F.lds + IDX_CTL);
#pragma unroll 1
    for (int qi = 0; qi < 4; ++qi) {
        const int q = 4 * F.wave + qi; int nc = ctl[96 + q];
        if (nc > IDX_CAP) { nc = IDX_CAP; if (ln == 0) ctl[128] = 1; }
        const int r = TOPK - ctl[32 + q];
        unsigned e[IDX_CAP / 64]; bool ok[IDX_CAP / 64];
#pragma unroll
        for (int j = 0; j < IDX_CAP / 64; ++j) { ok[j] = ln + 64 * j < nc; e[j] = ok[j] ? clist[q * IDX_CAP + ln + 64 * j] : 0u; }
        unsigned t = 0u;
#pragma unroll 1
        for (int bit = 10; bit >= 0; --bit) { const unsigned tt = t | (1u << bit); int cnt = 0;
#pragma unroll
            for (int j = 0; j < IDX_CAP / 64; ++j) cnt += __popcll(__ballot(ok[j] && (e[j] >> 18) >= tt));
            if (cnt >= r) t = tt; }
#pragma unroll
        for (int j = 0; j < IDX_CAP / 64; ++j) if (ok[j] && (e[j] >> 18) >= t) __hip_atomic_fetch_or(mlds + ((e[j] >> 5) & 8191u), 1u << (e[j] & 31u), __ATOMIC_RELAXED, __HIP_MEMORY_SCOPE_WORKGROUP);
    }
}
__device__ __forceinline__ void p5_indexer(Frame& F, unsigned* MASK) {
    const bf16* QI = WSP(bf16, WS_QI); const bf16* KI = WSP(bf16, WS_KI); const float* WI = WSP(float, WS_WI); const bf16* QL = WSP(bf16, WS_QL); const float* AT = WSP(float, SM_AT);
    const float kmax = __builtin_bit_cast(float, __hip_atomic_load(F.ctl + CW_KMAX, RLX_AGENT));
    LAS int* ctl = (LAS int*)(F.lds + IDX_CTL);
    for (int p = F.vcu; p < 256; p += F.G) {
        const int b = p >> 7, j = p & 127;
#pragma unroll 1
        for (int side = 0; side < 2; ++side) {
            const int g = side ? j : 255 - j, t0 = 32 * g;
            const int nt_idx = (g + 2) >> 1, nt_att = 4 * (g >> 3) + 4;
            int ln = (int)__builtin_amdgcn_mbcnt_hi(~0u, __builtin_amdgcn_mbcnt_lo(~0u, 0u)); asm volatile("" : "+v"(ln)); const int tid_ = F.wave * 64 + ln;
            const int qc = ln & 15, fq = ln >> 4, ql_ = 16 * (F.wave & 1) + qc;
            const size_t trow = (size_t)b * SEQ + t0 + ql_;
            bf16x8 qf[8][2], ql[2]; float invA; LAS float* w = (LAS float*)(F.lds + IDX_CTL + 1024) + ql_ * 8;
#define IDX_LOADQ() do { \
            _Pragma("unroll") for (int h = 0; h < 8; ++h) _Pragma("unroll") for (int ks = 0; ks < 2; ++ks) qf[h][ks] = *(const bf16x8*)(QI + trow * 512 + h * 64 + ks * 32 + fq * 8); \
            _Pragma("unroll") for (int ks = 0; ks < 2; ++ks) ql[ks] = *(const bf16x8*)(QL + trow * 64 + ks * 32 + fq * 8); \
            { const f32x4 w0 = *(const f32x4*)(WI + trow * 8), w1 = *(const f32x4*)(WI + trow * 8 + 4); *(LAS f32x4*)w = w0; *(LAS f32x4*)(w + 4) = w1; }     \
            { const float a2 = 2.0f * AT[trow] * kmax; invA = a2 > 0.f ? 0.99f / a2 : 0.f; }        \
        } while (0)
            IDX_LOADQ();
            const bf16* KIb = KI + (size_t)b * SEQ * 64;
            unsigned* MASKg = MASK + ((size_t)(b * 256 + g) * 128) * 64;
            for (int i = tid_; i < 8200; i += 512) ((LAS v4u*)(F.lds + RING_OFF))[i] = (v4u){0u, 0u, 0u, 0u};
            if (tid_ < 96) ctl[tid_] = 0;
            __syncthreads();
            idx_pass<0>(F, ln, KIb, MASKg, t0, nt_idx, nt_att, ql, qf, w, invA, 0, 0u);
            __syncthreads();
            idx_scan<0>(F, ln);
            __syncthreads();
            const int b1 = ctl[ql_];
            if (tid_ < 33) ctl[96 + tid_] = 0;
            __syncthreads();
            idx_pass<3>(F, ln, KIb, MASKg, t0, nt_idx, nt_att, ql, qf, w, invA, b1, 0u);
            __syncthreads();
            idx_select(F, ln);
            __syncthreads();
            if (ctl[128] == 0 || DBG_REP == 77) {
                for (int i = tid_; i < nt_att * 64; i += 512) MASKg[i] = ((LAS unsigned*)(F.lds + RING_OFF))[i];
            } else {
                for (int i = tid_; i < 8200; i += 512) ((LAS v4u*)(F.lds + RING_OFF))[i] = (v4u){0u, 0u, 0u, 0u};
                IDX_LOADQ();
                __syncthreads();
                idx_pass<1>(F, ln, KIb, MASKg, t0, nt_idx, nt_att, ql, qf, w, invA, b1, 0u);
                __syncthreads();
                idx_scan<1>(F, ln);
                __syncthreads();
                const unsigned thr = (unsigned)ctl[64 + ql_];
                idx_pass<2>(F, ln, KIb, MASKg, t0, nt_idx, nt_att, ql, qf, w, invA, b1, thr);
            }
            __syncthreads();
#undef IDX_LOADQ
        }
    }
}

__device__ __forceinline__ unsigned sbfe1_(unsigned w, const int bit) { unsigned r; asm("v_bfe_i32 %0, %1, %2, 1" : "=v"(r) : "v"(w), "n"(bit)); return r; }
#define SBFE1(w, bit) sbfe1_((w), (bit))
__device__ __forceinline__ void p6_attention(Frame& F, const unsigned* MASK, bf16* ATTo) {
    const bf16* Qb = WSP(bf16, WS_Q); const bf16* Kb = WSP(bf16, WS_K); const bf16* VT = WSP(bf16, WS_VT);
    constexpr int KTB = 18432, VTB = 17408, SLOT = KTB + VTB;
    LAS unsigned char* Lb = F.lds + RING_OFF;
    LAS float* biasd = (LAS float*)(F.lds + RING_OFF + 2 * SLOT);
    for (int p = F.vcu; p < 256; p += F.G) {
        const int bh = p >> 4, j = p & 15, b = bh >> 3, h = bh & 7;
#pragma unroll 1
        for (int side = 0; side < 2; ++side) {
            const int qb = side ? j : 31 - j, q0 = 256 * qb, NT = 2 * qb + 2;
            int ln = (int)__builtin_amdgcn_mbcnt_hi(~0u, __builtin_amdgcn_mbcnt_lo(~0u, 0u)); asm volatile("" : "+v"(ln));
            const int tid_ = F.wave * 64 + ln, r32 = ln & 31, hi = ln >> 5, lrow = tid_ >> 3, lch = tid_ & 7;
            const int tq = q0 + 32 * F.wave + r32;
            if (tid_ < 128) { const int bk = t5_bucket(tid_); biasd[tid_] = (F.rel_bias[bk * 8 + h] - F.rel_bias[31 * 8 + h]) * LOG2E; }
            const bf16* Kg = Kb + (size_t)(b * SEQ + lrow) * 512 + h * 64 + lch * 8;
            const bf16* Vg = VT + ((size_t)((b * NH + h) * 64 + lrow)) * SEQ + lch * 8;
            const unsigned* Mg = MASK + ((size_t)(b * 256 + 8 * qb + F.wave) * 128) * 64 + ln;
            bf16x8 qf[4];
#pragma unroll
            for (int ks = 0; ks < 4; ++ks) qf[ks] = *(const bf16x8*)(Qb + (size_t)(b * SEQ + tq) * 512 + h * 64 + ks * 16 + hi * 8);
            f32x16 o0, o1, o2;
#pragma unroll
            for (int r = 0; r < 16; ++r) { o0[r] = 0.f; o1[r] = 0.f; o2[r] = 0.f; }
            const bf16x8 ones = (bf16x8){0x3F80, 0x3F80, 0x3F80, 0x3F80, 0x3F80, 0x3F80, 0x3F80, 0x3F80};
            float m_run = 0.f;
            v4u kreg0 = *(const v4u*)(Kg), kreg1 = *(const v4u*)(Kg + (size_t)64 * 512), vreg0 = *(const v4u*)(Vg), vreg1 = *(const v4u*)(Vg + 64);
            unsigned mw0 = Mg[0], mw1 = Mg[64], mwn0 = 0u, mwn1 = 0u;
            *(LAS v4u*)(Lb + lrow * 144 + lch * 16) = kreg0; *(LAS v4u*)(Lb + (64 + lrow) * 144 + lch * 16) = kreg1;
            *(LAS v4u*)(Lb + KTB + lrow * 272 + lch * 16) = vreg0; *(LAS v4u*)(Lb + KTB + lrow * 272 + 128 + lch * 16) = vreg1;
            __syncthreads();
            for (int kt = 0; kt < NT; ++kt) {
                const int buf = kt & 1;
                if (kt + 1 < NT) { const size_t kn = (size_t)(kt + 1) * 128;
                    kreg0 = *(const v4u*)(Kg + kn * 512); kreg1 = *(const v4u*)(Kg + (kn + 64) * 512); vreg0 = *(const v4u*)(Vg + kn); vreg1 = *(const v4u*)(Vg + kn + 64);
                    mwn0 = Mg[(size_t)(2 * kt + 2) * 64]; mwn1 = Mg[(size_t)(2 * kt + 3) * 64]; }
                LAS unsigned char* kb_ = Lb + buf * SLOT; LAS unsigned char* vb_ = kb_ + KTB;
                f32x16 sA[4];
#pragma unroll
                for (int c = 0; c < 4; ++c)
#pragma unroll
                    for (int r = 0; r < 16; ++r) sA[c][r] = 0.f;
#pragma unroll
                for (int ks = 0; ks < 4; ++ks)
#pragma unroll
                    for (int c = 0; c < 4; ++c) { const bf16x8 kf = *(const LAS bf16x8*)(kb_ + (32 * c + r32) * 144 + ks * 32 + hi * 16); sA[c] = MFMA32(kf, qf[ks], sA[c]); }
                if (kt >= NT - 3) {
#pragma unroll
                    for (int c = 0; c < 4; ++c)
#pragma unroll
                        for (int r = 0; r < 16; ++r) { const int d0 = tq - (128 * kt + 32 * c + crow(r, hi)); const float b0 = biasd[d0 & 127]; sA[c][r] += ((unsigned)d0 < 128u) ? b0 : 0.f; }
                }
                float mx = -INFINITY;
#pragma unroll
                for (int r = 0; r < 16; ++r) mx = fmaxf(mx, fmaxf(fmaxf(sA[0][r], sA[1][r]), fmaxf(sA[2][r], sA[3][r])));
                mx = fmaxf(mx, __shfl_xor(mx, 32)) - m_run;
                if (kt == 0 || __any(mx > 8.0f)) {
                    const float dl = (kt == 0) ? mx : fmaxf(mx, 0.f), f = __builtin_amdgcn_exp2f(-dl);
                    m_run += dl;
#pragma unroll
                    for (int r = 0; r < 16; ++r) { o0[r] *= f; o1[r] *= f; o2[r] *= f; }
                }
                unsigned pk[4][8];
#pragma unroll
                for (int c = 0; c < 4; ++c) { const unsigned mw = (c < 2) ? mw0 : mw1;
#pragma unroll
                    for (int r = 0; r < 16; r += 2) {
                        const unsigned e0 = __builtin_bit_cast(unsigned, __builtin_amdgcn_exp2f(sA[c][r] - m_run)) & SBFE1(mw, 16 * (c & 1) + r);
                        const unsigned e1 = __builtin_bit_cast(unsigned, __builtin_amdgcn_exp2f(sA[c][r + 1] - m_run)) & SBFE1(mw, 16 * (c & 1) + r + 1);
                        pk[c][r >> 1] = cvtpk(__builtin_bit_cast(float, e0), __builtin_bit_cast(float, e1)); } }
#pragma unroll
                for (int c = 0; c < 4; ++c)
#pragma unroll
                    for (int s = 0; s < 2; ++s) {
                        const bf16x8 pf = __builtin_bit_cast(bf16x8, (v4u){pk[c][4 * s], pk[c][4 * s + 1], pk[c][4 * s + 2], pk[c][4 * s + 3]});
                        const bf16x8 v0 = *(const LAS bf16x8*)(vb_ + r32 * 272 + (2 * c + s) * 32 + hi * 16);
                        const bf16x8 v1 = *(const LAS bf16x8*)(vb_ + (32 + r32) * 272 + (2 * c + s) * 32 + hi * 16);
                        o0 = MFMA32(v0, pf, o0); o1 = MFMA32(v1, pf, o1); o2 = MFMA32(ones, pf, o2);
                    }
                if (kt + 1 < NT) { LAS unsigned char* nb = Lb + (buf ^ 1) * SLOT;
                    *(LAS v4u*)(nb + lrow * 144 + lch * 16) = kreg0; *(LAS v4u*)(nb + (64 + lrow) * 144 + lch * 16) = kreg1;
                    *(LAS v4u*)(nb + KTB + lrow * 272 + lch * 16) = vreg0; *(LAS v4u*)(nb + KTB + lrow * 272 + 128 + lch * 16) = vreg1; }
                mw0 = mwn0; mw1 = mwn1;
                __syncthreads();
            }
            const float inv = 1.0f / o2[0];
            bf16* orow = ATTo + (size_t)(b * SEQ + tq) * 512 + h * 64 + 4 * hi;
#pragma unroll
            for (int g4 = 0; g4 < 4; ++g4) {
                *(v2u*)(orow + 8 * g4) = (v2u){cvtpk(o0[4 * g4] * inv, o0[4 * g4 + 1] * inv), cvtpk(o0[4 * g4 + 2] * inv, o0[4 * g4 + 3] * inv)};
                *(v2u*)(orow + 32 + 8 * g4) = (v2u){cvtpk(o1[4 * g4] * inv, o1[4 * g4 + 1] * inv), cvtpk(o1[4 * g4 + 2] * inv, o1[4 * g4 + 3] * inv)};
            }
        }
    }
}

__device__ __forceinline__ void p9_norm2_route(Frame& F, const float* HRES) {
    const int gw = F.vcu * NWAVES + F.wave, NGW = F.G * NWAVES;
    const float* mod = WSP(float, SM_MOD); const float* WRT = WSP(float, SM_WRT);
    LAS float* lg = (LAS float*)(F.lds + RING_OFF + F.wave * 16384 + 8448);
    int* EID = WSP(int, SM_EID); float* EWT = WSP(float, SM_EWT); int* SLOT = WSP(int, SM_SLOT); bf16* H2 = WSP(bf16, WS_H1);
    for (int m8 = gw; m8 < T / 8; m8 += NGW) {
        const int m0 = m8 * 8, b = m0 / SEQ;
        f32x4 hv[8][4];
#pragma unroll
        for (int r = 0; r < 8; ++r) {
            const GAS f32x4* xr = (const GAS f32x4*)(HRES + (size_t)(m0 + r) * D) + F.lane; float s = 0.f;
#pragma unroll
            for (int j = 0; j < 4; ++j) { hv[r][j] = xr[64 * j]; s += (hv[r][j].x * hv[r][j].x + hv[r][j].y * hv[r][j].y) + (hv[r][j].z * hv[r][j].z + hv[r][j].w * hv[r][j].w); }
            const float rstd = 1.f / sqrtf(wave_sum_all(s) * (1.f / D) + EPS);
            GAS v2u* o8 = (GAS v2u*)(H2 + (size_t)(m0 + r) * D) + F.lane;
#pragma unroll
            for (int j = 0; j < 4; ++j) { const int k = 4 * F.lane + 256 * j;
                const f32x4 g = *(const f32x4*)(F.norm2_g + k), scl = *(const f32x4*)(mod + b * 6144 + 4096 + k), sh = *(const f32x4*)(mod + b * 6144 + 3072 + k);
                hv[r][j] = hv[r][j] * rstd * (g * (scl + 1.0f)) + sh; o8[64 * j] = (v2u){pk2(hv[r][j].x, hv[r][j].y), pk2(hv[r][j].z, hv[r][j].w)}; }
        }
        for (int n = 0; n < 36; ++n) {
            f32x4 w[4];
#pragma unroll
            for (int j = 0; j < 4; ++j) w[j] = *(const f32x4*)(WRT + n * D + 4 * F.lane + 256 * j);
            float p[8];
#pragma unroll
            for (int r = 0; r < 8; ++r) { float a = 0.f;
#pragma unroll
                for (int j = 0; j < 4; ++j) a += (hv[r][j].x * w[j].x + hv[r][j].y * w[j].y) + (hv[r][j].z * w[j].z + hv[r][j].w * w[j].w);
                p[r] = wave_sum63(a); }
            if (F.lane == 63) { const float bb = (n < 4 ? F.brg[n] : F.bre[n - 4]); lg[n] = p[0] + bb; lg[36 + n] = p[1] + bb; lg[72 + n] = p[2] + bb; lg[108 + n] = p[3] + bb; lg[144 + n] = p[4] + bb; lg[180 + n] = p[5] + bb; lg[216 + n] = p[6] + bb; lg[252 + n] = p[7] + bb; }
        }
        LDS_WAIT(); asm volatile("" ::: "memory");
        if (F.lane < 8) {
            const LAS float* l = lg + F.lane * 36; const int tkn = m0 + F.lane;
            int gs = 0; float gm = l[0];
#pragma unroll
            for (int j = 1; j < 4; ++j) if (l[j] > gm) { gm = l[j]; gs = j; }
            float gsum = 0.f;
#pragma unroll
            for (int j = 0; j < 4; ++j) gsum += __expf(l[j] - gm);
            const float gwt = 1.f / gsum;
            const LAS float* el = l + 4 + 8 * gs;
            int i0 = 0; float l0 = el[0];
#pragma unroll
            for (int j = 1; j < 8; ++j) if (el[j] > l0) { l0 = el[j]; i0 = j; }
            int i1 = -1; float l1 = -INFINITY;
#pragma unroll
            for (int j = 0; j < 8; ++j) if (j != i0 && el[j] > l1) { l1 = el[j]; i1 = j; }
            const float e1 = __expf(l1 - l0), p0 = 1.f / (1.f + e1), p1 = e1 * p0;
            const int e0id = gs * 8 + i0, e1id = gs * 8 + i1;
            EID[tkn * 2] = e0id; EID[tkn * 2 + 1] = e1id; EWT[tkn * 2] = gwt * p0; EWT[tkn * 2 + 1] = gwt * p1;
            SLOT[tkn * 2] = (int)atomicAdd((unsigned*)(F.ctl + CW_ECNT + 16 * e0id), 1u);
            SLOT[tkn * 2 + 1] = (int)atomicAdd((unsigned*)(F.ctl + CW_ECNT + 16 * e1id), 1u);
        }
        LDS_WAIT(); asm volatile("" ::: "memory");
    }
    {
        LAS float* scr = (LAS float*)(F.lds + RING_OFF + F.wave * 16384);
        for (int it = gw; it < NEXP * 512; it += NGW) {
            const int e = it / 512, r = it % 512;
            if (r < 256) transpose_item(F.w_gate_e + (size_t)e * D * DEXP, D, DEXP, WSP(bf16, WS_WGU) + (size_t)e * 1024 * D, scr, r, F.lane, RmGU{0});
            else transpose_item(F.w_up_e + (size_t)e * D * DEXP, D, DEXP, WSP(bf16, WS_WGU) + (size_t)e * 1024 * D, scr, r - 256, F.lane, RmGU{1});
        }
    }
}
__device__ __forceinline__ int moe_tables(Frame& F, LAS int* off, LAS int* tile_e) {
    if (F.tid == 0) { int o = 0, nt = 0;
        for (int e = 0; e < NEXP; ++e) { const int c = (int)__hip_atomic_load(F.ctl + CW_ECNT + 16 * e, RLX_AGENT); off[e] = o; const int tl = (c + 255) >> 8; for (int j = 0; j < tl; ++j) tile_e[nt++] = e; o += tl * 256; }
        off[NEXP] = nt; }
    __syncthreads();
    return off[NEXP];
}
__device__ __forceinline__ void p10_gather(Frame& F, LAS int* off) {
    const int* EID = WSP(int, SM_EID); int* SLOT = WSP(int, SM_SLOT); int* AROW = (int*)(F.ctl + CW_AROW);
    for (int i = blockIdx.x * 512 + F.tid; i < T * 2; i += F.G * 512) { const int row = off[EID[i]] + SLOT[i]; AROW[row] = i >> 1; SLOT[i] = row; }
}
__device__ __forceinline__ void p13_combine(Frame& F, const float* HRES) {
    const int gw = F.vcu * NWAVES + F.wave, NGW = F.G * NWAVES;
    const float* mod = WSP(float, SM_MOD); const int* SLOT = WSP(int, SM_SLOT); const float* EWT = WSP(float, SM_EWT); const bf16* Y = WSP(bf16, WS_Y);
    for (int m0 = gw * 2; m0 < T; m0 += NGW * 2) {
        const int b = m0 / SEQ;
        f32x4 v[2][4]; float rs[2];
#pragma unroll
        for (int r = 0; r < 2; ++r) { const int m = m0 + r;
#if DBG_SKIP_MOE
            const int r0 = 0, r1 = 0; const float w0 = 0.f, w1 = 0.f; (void)SLOT; (void)EWT;
#else
            const int r0 = SLOT[m * 2], r1 = SLOT[m * 2 + 1]; const float w0 = EWT[m * 2], w1 = EWT[m * 2 + 1];
#endif
            const GAS f32x4* xr = (const GAS f32x4*)(HRES + (size_t)m * D) + F.lane;
            const GAS v2u* y0 = (const GAS v2u*)(Y + (size_t)r0 * D) + F.lane; const GAS v2u* y1 = (const GAS v2u*)(Y + (size_t)r1 * D) + F.lane;
#pragma unroll
            for (int j = 0; j < 4; ++j) { const int k = 4 * F.lane + 256 * j; const v2u a = y0[64 * j], c = y1[64 * j];
                const f32x4 ya = (f32x4){bflo(a.x), bfhi(a.x), bflo(a.y), bfhi(a.y)}, yb = (f32x4){bflo(c.x), bfhi(c.x), bflo(c.y), bfhi(c.y)};
                const f32x4 g2 = *(const f32x4*)(mod + b * 6144 + 5120 + k);
#if DBG_SKIP_MOE
                v[r][j] = xr[64 * j]; (void)g2; (void)ya; (void)yb;
#else
                v[r][j] = xr[64 * j] + g2 * (ya * w0 + yb * w1);
#endif
            } }
#pragma unroll
        for (int r = 0; r < 2; ++r) { float s = 0.f;
#pragma unroll
            for (int j = 0; j < 4; ++j) s += (v[r][j].x * v[r][j].x + v[r][j].y * v[r][j].y) + (v[r][j].z * v[r][j].z + v[r][j].w * v[r][j].w);
            rs[r] = 1.f / sqrtf(wave_sum_all(s) * (1.f / D) + EPS); }
#if DBG_CMP_ATT
        const float escale = 1.0f + sqrtf(__builtin_bit_cast(float, __hip_atomic_load(F.ctl + CW_CMP, RLX_AGENT)) / __builtin_bit_cast(float, __hip_atomic_load(F.ctl + CW_CMP + 1, RLX_AGENT)));
#else
        const float escale = 1.0f;
#endif
#pragma unroll
        for (int r = 0; r < 2; ++r) { GAS f32x4* o = (GAS f32x4*)(F.out + (size_t)(m0 + r) * D) + F.lane;
#pragma unroll
            for (int j = 0; j < 4; ++j) o[64 * j] = v[r][j] * (rs[r] * escale) * *(const f32x4*)(F.norm_f_g + 4 * F.lane + 256 * j); }
    }
}

struct Args { const float* in[20]; float* out; unsigned char* ws; int ph_lo, ph_hi, li, pad; };
__global__ void __launch_bounds__(NWAVES * 64, 2) fwd_kernel(Args args) {
    extern __shared__ __attribute__((aligned(16))) unsigned char lds[];
    Frame F;
    F.lds = (LAS unsigned char*)lds;
    F.MISC = (volatile LAS unsigned*)(F.lds + MISC_OFF);
    F.tid = threadIdx.x; F.lane = F.tid & 63; F.wave = __builtin_amdgcn_readfirstlane(F.tid >> 6);
    F.G = gridDim.x; { const int bx = blockIdx.x; F.vcu = (F.G % 8 == 0) ? (bx % 8) * (F.G / 8) + bx / 8 : bx; }
    F.ws = args.ws; F.ctl = (gu32*)(args.ws + WS_CTL);
    F.x = args.in[0]; F.c = args.in[1]; F.w_ada = args.in[2]; F.b_ada = args.in[3]; F.norm1_g = args.in[4]; F.w_in = args.in[5]; F.rel_bias = args.in[6]; F.conv_w = args.in[7];
    F.w_attn = args.in[8]; F.w_conv = args.in[9]; F.w_out = args.in[10]; F.norm2_g = args.in[11]; F.wrg = args.in[12]; F.brg = args.in[13]; F.wre = args.in[14]; F.bre = args.in[15];
    F.w_gate_e = args.in[16]; F.w_up_e = args.in[17]; F.w_down_e = args.in[18]; F.norm_f_g = args.in[19]; F.out = args.out;
    for (int u = F.tid; u < (LDS_BYTES - LDSCTL_OFF) / 4; u += NWAVES * 64) ((LAS unsigned*)(F.lds + LDSCTL_OFF))[u] = 0u;
    __syncthreads();
    XcdBarrier bar; bar.bar = (unsigned*)(F.ctl + CW_BAR); bar.x = 0; bar.st = nullptr;
    if (!MK_PER_PHASE) bar = xcd_barrier_post((unsigned*)(F.ctl + CW_BAR), F.MISC + 8);
#define GRID_BAR() do { if (MK_PER_PHASE) { if (F.tid == 0) __hip_atomic_store(F.ctl + CW_TMO, 0xBADBA0u, RLX_AGENT); } else { xcd_barrier(bar, F.wave == 0 && (int)__builtin_amdgcn_mbcnt_hi(~0u, __builtin_amdgcn_mbcnt_lo(~0u, 0u)) == 0); } } while (0)
    const int lo = args.ph_lo, hi = args.ph_hi;
#ifndef ONLY_PHASE
#define ONLY_PHASE -1
#endif
#define IN(k) ((ONLY_PHASE < 0 || ONLY_PHASE == (k)) && lo <= (k) && (k) < hi)
#define BOTH(k) (IN(k) && IN((k) + 1))
#define REFRESH() do { int l_ = (int)__builtin_amdgcn_mbcnt_hi(~0u, __builtin_amdgcn_mbcnt_lo(~0u, 0u)); asm volatile("" : "+v"(l_)); F.lane = l_; F.tid = F.wave * 64 + l_; } while (0)
    float* HRES = F.out;
    LAS int* moe_off = (LAS int*)(F.lds + LDSCTL_OFF + 1024);
    LAS int* moe_tile = (LAS int*)(F.lds + LDSCTL_OFF + 1024 + 256);

    if (IN(0)) { REFRESH(); for (int rep_ = 0; rep_ < (DBG_REP == 0 ? 2 : 1); ++rep_) { if (rep_) GRID_BAR(); p0_prologue(F); } if (BOTH(0)) GRID_BAR(); }
    if (IN(1)) { REFRESH(); for (int rep_ = 0; rep_ < (DBG_REP == 1 ? 2 : 1); ++rep_) { if (rep_) GRID_BAR(); p1_norm1(F); } if (BOTH(1)) GRID_BAR(); }
    if (IN(2)) { REFRESH();
        pg8::Gemm g{WSP(bf16, WS_H1), WSP(bf16, WS_WIN), T, NINP, D}; pg8::StaticOrder S; S.init(T, NINP, F.G, (int)blockIdx.x);
        EpiProj E{WSP(bf16, WS_Q), WSP(bf16, WS_K), WSP(bf16, WS_V), WSP(bf16, WS_QI), WSP(bf16, WS_KI), WSP(bf16, WS_CB), WSP(bf16, WS_U), WSP(bf16, WS_G), WSP(float, WS_WI)};
        pg8::gemm_phase<EpiProj, pg8::StaticOrder, true, true>(F.lds + RING_OFF, g, S, E, F.wave);
        {
            constexpr int I_A = 8 * 32, I_C = 8 * 32, I_O = 16 * 32;
            const int nun = (T / 256) * (NINP / 256), rem = nun % F.G, c = (int)blockIdx.x;
            const bool early = (rem == 0) || (c >= rem); const int n_early = (rem == 0) ? F.G : F.G - rem, rank = (rem == 0) ? c : c - rem;
            if (early) { LAS float* scr = (LAS float*)(F.lds + RING_OFF + F.wave * 16384);
                for (int it = rank * NWAVES + F.wave; it < I_A + I_C + I_O; it += n_early * NWAVES) { int r = it;
                    if (r < I_A) { transpose_item(F.w_attn, AW, D, WSP(bf16, WS_WA), scr, r, F.lane, RmId()); continue; } r -= I_A;
                    if (r < I_C) { transpose_item(F.w_conv, AW, D, WSP(bf16, WS_WC), scr, r, F.lane, RmId()); continue; } r -= I_C;
                    transpose_item(F.w_out, D, D, WSP(bf16, WS_WOUT), scr, r, F.lane, RmId()); } }
        }
        if (BOTH(2)) GRID_BAR();
    }
    if (IN(3)) { REFRESH(); for (int rep_ = 0; rep_ < (DBG_REP == 3 ? 2 : 1); ++rep_) { if (rep_) GRID_BAR(); p3_prep(F); } if (BOTH(3)) GRID_BAR(); }
    if (IN(4)) { REFRESH();
        pg8::Gemm g{WSP(bf16, WS_AC), WSP(bf16, WS_WC), T, D, AW}; pg8::StaticOrder S; S.init(T, D, F.G, (int)blockIdx.x);
        EpiConv E{WSP(bf16, WS_G), WSP(bf16, WS_TMPC)};
        for (int rep_ = 0; rep_ < (DBG_REP == 4 ? 2 : 1); ++rep_) { if (rep_) GRID_BAR(); pg8::gemm_phase<EpiConv, pg8::StaticOrder, true, true>(F.lds + RING_OFF, g, S, E, F.wave); }
        if (BOTH(4) && (MK_NAIVE_ATTN || DBG_SKIP_ATTN || DBG_CMP_ATT)) GRID_BAR();
        else { asm volatile("s_waitcnt vmcnt(0)" ::: "memory"); __syncthreads(); }
    }
    if (IN(5)) { REFRESH();
#if DBG_SKIP_ATTN
        for (size_t i = (size_t)blockIdx.x * 512 + F.tid; i < (size_t)T * 512 / 8; i += (size_t)F.G * 512) *(v4u*)(WSP(bf16, WS_ATT) + i * 8) = (v4u){0u, 0u, 0u, 0u};
#elif DBG_CMP_ATT
        pn_naive_dsa(F); GRID_BAR(); p5_indexer(F, WSP(unsigned, WS_MASK_DBG));
#elif MK_NAIVE_ATTN
        pn_naive_dsa(F);
#else
        for (int rep_ = 0; rep_ < (DBG_REP == 5 ? 2 : 1); ++rep_) { if (rep_) GRID_BAR(); p5_indexer(F, WSP(unsigned, WS_MASK)); }
#endif
        if (BOTH(5)) GRID_BAR(); }
    if (IN(6)) { REFRESH();
#if DBG_SKIP_ATTN
#elif DBG_CMP_ATT
        p6_attention(F, WSP(unsigned, WS_MASK_DBG), WSP(bf16, WS_ATT2)); GRID_BAR();
        { float num = 0.f, den = 0.f; const bf16* A1 = WSP(bf16, WS_ATT); const bf16* A2 = WSP(bf16, WS_ATT2);
          for (size_t i = (size_t)blockIdx.x * 512 + F.tid; i < (size_t)T * 512; i += (size_t)F.G * 512) { const float a = bf1(A1[i]), c = bf1(A2[i]); num += (a - c) * (a - c); den += a * a; }
          num = wave_sum(num); den = wave_sum(den);
          if (F.lane == 0) { atomicAdd((float*)(F.ctl + CW_CMP), num); atomicAdd((float*)(F.ctl + CW_CMP + 1), den); } }
#elif !MK_NAIVE_ATTN
        for (int rep_ = 0; rep_ < (DBG_REP == 6 ? 2 : 1); ++rep_) { if (rep_) GRID_BAR(); p6_attention(F, WSP(unsigned, WS_MASK), WSP(bf16, WS_ATT)); }
#endif
        if (BOTH(6)) GRID_BAR(); }
    if (IN(7)) { REFRESH();
        pg8::Gemm g{WSP(bf16, WS_ATT), WSP(bf16, WS_WA), T, D, AW}; pg8::StaticOrder S; S.init(T, D, F.G, (int)blockIdx.x);
        EpiAttn E{WSP(bf16, WS_G), WSP(bf16, WS_TMPC), WSP(bf16, WS_MERGED)};
        for (int rep_ = 0; rep_ < (DBG_REP == 7 ? 2 : 1); ++rep_) { if (rep_) GRID_BAR(); pg8::gemm_phase<EpiAttn, pg8::StaticOrder, true, true>(F.lds + RING_OFF, g, S, E, F.wave); }
        if (BOTH(7)) GRID_BAR();
    }
    if (IN(8)) { REFRESH();
        pg8::Gemm g{WSP(bf16, WS_MERGED), WSP(bf16, WS_WOUT), T, D, D}; pg8::StaticOrder S; S.init(T, D, F.G, (int)blockIdx.x);
        EpiOut E{F.x, WSP(float, SM_MOD), HRES};
        for (int rep_ = 0; rep_ < (DBG_REP == 8 ? 2 : 1); ++rep_) { if (rep_) GRID_BAR(); pg8::gemm_phase<EpiOut, pg8::StaticOrder, true, true>(F.lds + RING_OFF, g, S, E, F.wave); }
        if (BOTH(8)) GRID_BAR();
    }
#if DBG_SKIP_MOE
    if (0) {
#endif
    if (IN(9)) { REFRESH(); p9_norm2_route(F, HRES); if (BOTH(9)) GRID_BAR(); }
    if (IN(10)) { REFRESH(); (void)moe_tables(F, moe_off, moe_tile); p10_gather(F, moe_off); if (BOTH(10)) GRID_BAR(); }
    if (IN(11)) { REFRESH();
        const int nt = moe_tables(F, moe_off, moe_tile);
        pg8::Gemm g{WSP(bf16, WS_H1), WSP(bf16, WS_WGU), XPROWS, NEXP * 1024, D}; MoeOrder S{moe_tile, nt, F.G, (int)blockIdx.x};
        EpiHid E{WSP(bf16, WS_HID)};
        pg8::gemm_phase<EpiHid, MoeOrder, true, true, true>(F.lds + RING_OFF, g, S, E, F.wave, (const int*)(F.ctl + CW_AROW));
        {
            const int nun = nt * 4, rem = nun % F.G, c = (int)blockIdx.x;
            const bool early = (rem == 0) || (c >= rem); const int n_early = (rem == 0) ? F.G : F.G - rem, rank = (rem == 0) ? c : c - rem;
            if (early) { LAS float* scr = (LAS float*)(F.lds + RING_OFF + F.wave * 16384);
                for (int it = rank * NWAVES + F.wave; it < NEXP * 256; it += n_early * NWAVES) { const int e = it >> 8, r = it & 255;
                    transpose_item(F.w_down_e + (size_t)e * DEXP * D, DEXP, D, WSP(bf16, WS_WD) + (size_t)e * D * DEXP, scr, r, F.lane, RmId()); } }
        }
        if (BOTH(11)) GRID_BAR();
    }
    if (IN(12)) { REFRESH();
        const int nt = moe_tables(F, moe_off, moe_tile);
        pg8::Gemm g{WSP(bf16, WS_HID), WSP(bf16, WS_WD), XPROWS, NEXP * 1024, DEXP}; MoeOrder S{moe_tile, nt, F.G, (int)blockIdx.x};
        EpiY E{WSP(bf16, WS_Y)};
        for (int rep_ = 0; rep_ < (DBG_REP == 12 ? 2 : 1); ++rep_) { if (rep_) GRID_BAR(); pg8::gemm_phase<EpiY, MoeOrder, true, true>(F.lds + RING_OFF, g, S, E, F.wave); }
        if (BOTH(12)) GRID_BAR();
    }
#if DBG_SKIP_MOE
    }
#endif
#if DBG_PROBE
    if (IN(13)) { REFRESH();
        const bf16* src = nullptr; int pitch = 1024;
        if (DBG_PROBE == 1) { src = WSP(bf16, WS_MERGED); pitch = 1024; }
        if (DBG_PROBE == 2) { src = WSP(bf16, WS_TMPC); pitch = 1024; }
        if (DBG_PROBE == 3) { src = WSP(bf16, WS_AC); pitch = 512; }
        if (DBG_PROBE == 4) { src = WSP(bf16, WS_G); pitch = 2048; }
        if (DBG_PROBE == 5) { src = WSP(bf16, WS_H1); pitch = 1024; }
        if (DBG_PROBE == 6) { src = WSP(bf16, WS_WIN); pitch = 1024; }
        if (DBG_PROBE == 7) { src = WSP(bf16, WS_QI); pitch = 512; }
        for (size_t i = (size_t)blockIdx.x * 512 + F.tid; i < (size_t)T * D; i += (size_t)F.G * 512) { const size_t m = i / D, j = i % D;
            float v;
            if (DBG_PROBE == 8) v = WSP(float, SM_MOD)[i % 12288];
            else if (DBG_PROBE == 4) v = bf1(src[m * 2048 + j]) + bf1(src[m * 2048 + 1024 + j]);
            else if (DBG_PROBE >= 40 && DBG_PROBE < 48) v = bf1(WSP(bf16, WS_G)[m * 2048 + (DBG_PROBE - 40) * 256 + (j & 255)]);
            else if (DBG_PROBE == 6) v = bf1(src[(m % 5888) * 1024 + j]);
            else v = bf1(src[m * pitch + (j % pitch)]);
            F.out[i] = v; }
    }
#else
    if (IN(13)) { REFRESH(); for (int rep_ = 0; rep_ < (DBG_REP == 13 ? 2 : 1); ++rep_) { if (rep_) GRID_BAR(); p13_combine(F, DBG_SKIP_MIX ? F.x : HRES); } }
#endif
#undef IN
#undef BOTH
}

extern "C" void kernel_launch(void* const* d_in, const int* in_sizes, int n_in, void* d_out, int out_size, void* d_ws, size_t ws_size, hipStream_t stream) {
    static int grid = 0;
    if (grid == 0) {
        if (n_in != 20 || in_sizes[0] != T * D || out_size != T * D || ws_size < WS_END) { fprintf(stderr, "kernel_launch: unexpected shapes: n_in %d in0 %d out %d ws %zu (need %zu)\n", n_in, n_in > 0 ? in_sizes[0] : -1, out_size, ws_size, (size_t)WS_END); grid = -1; return; }
        int dev = 0, cus = 0, per_cu = 0;
        if (hipGetDevice(&dev) != hipSuccess || hipDeviceGetAttribute(&cus, hipDeviceAttributeMultiprocessorCount, dev) != hipSuccess) { grid = -1; return; }
        if (hipFuncSetAttribute((const void*)fwd_kernel, hipFuncAttributeMaxDynamicSharedMemorySize, LDS_BYTES) != hipSuccess) { fprintf(stderr, "kernel_launch: hipFuncSetAttribute failed\n"); grid = -1; return; }
        if (hipOccupancyMaxActiveBlocksPerMultiprocessor(&per_cu, (const void*)fwd_kernel, NWAVES * 64, LDS_BYTES) != hipSuccess || per_cu < 1)
            fprintf(stderr, "kernel_launch: note: occupancy query reports %d workgroups per CU\n", per_cu);
        (void)hipGetLastError();
        grid = cus;
    }
    if (grid < 0) return;
    if (hipMemsetAsync((char*)d_ws + WS_CTL, 0, CTL_ZERO_BYTES, stream) != hipSuccess) return;
    Args a{};
    for (int i = 0; i < 20; ++i) a.in[i] = (const float*)d_in[i];
    a.out = (float*)d_out; a.ws = (unsigned char*)d_ws;
#if MK_PER_PHASE
    for (int li = 0; li < N_PHASES; ++li) { a.ph_lo = li; a.ph_hi = li + 1; a.li = li; hipLaunchKernelGGL(fwd_kernel, dim3(grid), dim3(NWAVES * 64), LDS_BYTES, stream, a); }
#else
    a.ph_lo = 0; a.ph_hi = N_PHASES; a.li = 0;
    hipLaunchKernelGGL(fwd_kernel, dim3(grid), dim3(NWAVES * 64), LDS_BYTES, stream, a);
#endif
}
```

```cpp
#include <hip/hip_runtime.h>
#include <cstdio>
#include <cstdint>

namespace pg8 {
#define PG8_LAS __attribute__((address_space(3)))
typedef unsigned short bf16_t;
typedef short bf16x8 __attribute__((ext_vector_type(8)));
typedef float f32x4 __attribute__((ext_vector_type(4)));
typedef unsigned u32x4 __attribute__((ext_vector_type(4)));
constexpr int BM = 256, BK = 64, HALF = 128, HTB = HALF * BK * 2  , STAGE_BYTES = 8 * HTB, NXCD = 8, WGM = 8;

__host__ __device__ __forceinline__ int lds_byte(int r, int c) { const int st = (r >> 4) * 2 + (c >> 5), rr = r & 15, cc = c & 31, ob = rr * 64 + cc * 2; return st * 1024 + (ob ^ (((ob >> 9) & 1) << 5)); }
__host__ __device__ __forceinline__ void stage_rc(int b, int& R, int& C) { const int st = b / 1024, sb = b % 1024, swz = sb ^ (((sb >> 9) & 1) << 5); R = (st >> 1) * 16 + swz / 64; C = (st & 1) * 32 + (swz % 64) / 2; }
__host__ __device__ __forceinline__ int perm32(int rho) { const int n = rho >> 4, i = rho & 15; return 8 * (i >> 2) + 4 * n + (i & 3); }

struct Unit { int pm, pn; };
struct Gemm { const bf16_t* A; const bf16_t* Bt; int M, N, K; };

struct StaticOrder {
    int nM, nN, nwg, G, c;
    __host__ __device__ void init(int M, int N, int G_, int c_) { nM = M / BM; nN = N / BM; nwg = nM * nN; G = G_; c = c_; }
    __host__ __device__ bool next(int i, Unit& u) const {
        const long L = (long)i * G + c; if (L >= nwg) return false;
        int wgid = (int)L; { const int q = nwg / NXCD, r = nwg % NXCD, xcd = wgid % NXCD, off = wgid / NXCD; wgid = (xcd < r ? xcd * (q + 1) : r * (q + 1) + (xcd - r) * q) + off; }
        const int nig = WGM * nN, gid = wgid / nig, fm = gid * WGM, gsz = (nM - fm) < WGM ? (nM - fm) : WGM;
        u.pm = fm + ((wgid % nig) % gsz); u.pn = (wgid % nig) / gsz; return true;
    }
    __device__ __forceinline__ void a_ready(const Unit&) const {}
    __device__ __forceinline__ void done(const Unit&) const {}
};
__device__ __forceinline__ unsigned cvt_pk_bf16(float lo, float hi) { unsigned r; asm volatile("v_cvt_pk_bf16_f32 %0, %1, %2" : "=v"(r) : "v"(lo), "v"(hi)); return r; }

template <class Epi, class Sched, bool ALIGN_EPI = false, bool SP2 = false, bool GATHER = false>
__device__ __forceinline__ void gemm_phase(PG8_LAS unsigned char* lds, const Gemm g, const Sched& S, const Epi& E, const int wave_id  , const int* arow = nullptr) {
    static_assert(!GATHER || SP2, "GATHER is implemented on the SP2 loop only");
    int lane_ = (int)__builtin_amdgcn_mbcnt_hi(~0u, __builtin_amdgcn_mbcnt_lo(~0u, 0u)); asm volatile("" : "+v"(lane_));
    const int lane = lane_, wid = wave_id, tid = wid * 64 + lane,
               wr = wid >> 2, wc = wid & 3, fr = lane & 15, fq = lane >> 4;
    const int K = g.K, nt = K / BK;
    unsigned voffA[2], voffB[2]; int RA[2]; unsigned CA2[2];
#pragma unroll
    for (int i = 0; i < 2; ++i) { int R, C; stage_rc(tid * 16 + i * 8192, R, C); const int Rb = Epi::PERM ? ((R & ~31) + perm32(R & 31)) : R;
        voffA[i] = (unsigned)(R * K + C) * 2u; voffB[i] = (unsigned)(Rb * K + C) * 2u; RA[i] = R; CA2[i] = (unsigned)C * 2u; }
    unsigned vA[2][2] = {{0u, 0u}, {0u, 0u}}, nvA[2][2] = {{0u, 0u}, {0u, 0u}};
#define PG8_GROWS(dst, U) do { _Pragma("unroll") for (int _h = 0; _h < 2; ++_h) _Pragma("unroll") for (int _i = 0; _i < 2; ++_i) dst[_h][_i] = (unsigned)arow[(U).pm * BM + _h * HALF + RA[_i]] * (unsigned)(K * 2) + CA2[_i]; } while (0)
    const size_t kstep = (size_t)(BK * 2);
    const size_t hstep = (size_t)HALF * K * 2;
    const size_t tstep = 2 * hstep;
    const unsigned ldsw = (unsigned)wid * 1024u;
    const int aoff = lds_byte(wr * 64 + fr, fq * 8), boff = lds_byte(wc * 32 + fr, fq * 8);
#define PG8_SA(b, h) (((b) * 2 + (h)) * HTB)
#define PG8_SB(b, h) ((4 + (b) * 2 + (h)) * HTB)
#define PG8_STAGE(bufoff, gbase, voff) do { _Pragma("unroll") for (int _i = 0; _i < 2; ++_i) \
        __builtin_amdgcn_global_load_lds((const unsigned*)((const char*)(gbase) + (voff)[_i]), (PG8_LAS unsigned*)(lds + (bufoff) + ldsw + _i * 8192), 16, 0, 0); } while (0)
#define PG8_STAGE_A(bufoff, gb, h, nx) do { if constexpr (GATHER) { _Pragma("unroll") for (int _i = 0; _i < 2; ++_i) { const unsigned vo_ = (nx) ? nvA[h][_i] : vA[h][_i]; \
        __builtin_amdgcn_global_load_lds((const unsigned*)((const char*)(gb) + vo_), (PG8_LAS unsigned*)(lds + (bufoff) + ldsw + _i * 8192), 16, 0, 0); } } else { PG8_STAGE(bufoff, (gb) + (h) * hstep, voffA); } } while (0)
#define PG8_LDA(dst, b, h) do { _Pragma("unroll") for (int m = 0; m < 4; ++m) _Pragma("unroll") for (int k = 0; k < 2; ++k) dst[m][k] = *(const PG8_LAS bf16x8*)(lds + PG8_SA(b, h) + aoff + m * 2048 + k * 1024); } while (0)
#define PG8_LDB(dst, b, h) do { _Pragma("unroll") for (int n = 0; n < 2; ++n) _Pragma("unroll") for (int k = 0; k < 2; ++k) dst[n][k] = *(const PG8_LAS bf16x8*)(lds + PG8_SB(b, h) + boff + n * 2048 + k * 1024); } while (0)
#define PG8_MMA(ai, bj, At, Bt) do { __builtin_amdgcn_s_setprio(1); _Pragma("unroll") for (int m = 0; m < 4; ++m) _Pragma("unroll") for (int n = 0; n < 2; ++n) _Pragma("unroll") for (int k = 0; k < 2; ++k) \
        acc[ai][bj][m][n] = __builtin_amdgcn_mfma_f32_16x16x32_bf16(Bt[n][k], At[m][k], acc[ai][bj][m][n], 0, 0, 0); __builtin_amdgcn_s_setprio(0); } while (0)
#define PG8_WAIT_V(n) asm volatile("s_waitcnt vmcnt(" #n ")" ::: "memory")
#define PG8_WAIT_L(n) asm volatile("s_waitcnt lgkmcnt(" #n ")" ::: "memory")
#define PG8_BAR __builtin_amdgcn_s_barrier()
#define PG8_SCHED __builtin_amdgcn_sched_barrier(0)
    Unit cur, nxt; int ui = 0;
    if (!S.next(0, cur)) return;
    f32x4 acc[2][2][4][2];
#pragma unroll
    for (int a = 0; a < 2; ++a)
#pragma unroll
        for (int b = 0; b < 2; ++b)
#pragma unroll
            for (int m = 0; m < 4; ++m)
#pragma unroll
                for (int n = 0; n < 2; ++n) acc[a][b][m][n] = (f32x4){0.f, 0.f, 0.f, 0.f};
    bf16x8 At[4][2], B0[2][2], B1[2][2];
    const char* cA = (const char*)g.A + (GATHER ? (size_t)0 : (size_t)cur.pm * tstep); const char* cB = (const char*)g.Bt + (size_t)cur.pn * tstep;
    if constexpr (GATHER) PG8_GROWS(vA, cur);
    S.a_ready(cur);
    if constexpr (SP2) {
        PG8_STAGE(PG8_SB(0, 0), cB, voffB); PG8_STAGE(PG8_SB(0, 1), cB + hstep, voffB); PG8_STAGE_A(PG8_SA(0, 0), cA, 0, false); PG8_STAGE_A(PG8_SA(0, 1), cA, 1, false);
        if (wr == 1) PG8_BAR;
        PG8_WAIT_V(2); PG8_BAR;
        PG8_STAGE(PG8_SB(1, 0), cB + kstep, voffB); PG8_STAGE_A(PG8_SA(1, 0), cA + kstep, 0, false); PG8_STAGE(PG8_SB(1, 1), cB + hstep + kstep, voffB);
        PG8_WAIT_V(6); PG8_BAR;
    } else {
        PG8_STAGE(PG8_SB(0, 0), cB, voffB); PG8_STAGE(PG8_SA(0, 0), cA, voffA); PG8_STAGE(PG8_SB(0, 1), cB + hstep, voffB); PG8_STAGE(PG8_SA(0, 1), cA + hstep, voffA);
        if (wr == 1) PG8_BAR;
        PG8_WAIT_V(4); PG8_BAR;
        PG8_STAGE(PG8_SB(1, 0), cB + kstep, voffB); PG8_STAGE(PG8_SA(1, 0), cA + kstep, voffA); PG8_STAGE(PG8_SB(1, 1), cB + hstep + kstep, voffB);
        PG8_WAIT_V(6); PG8_BAR;
    }
    for (;;) {
        const bool has_next = S.next(ui + 1, nxt);
        const char* nA = (has_next && !GATHER) ? (const char*)g.A + (size_t)nxt.pm * tstep : cA; const char* nB = has_next ? (const char*)g.Bt + (size_t)nxt.pn * tstep : cB;
        if constexpr (GATHER) { if (has_next) PG8_GROWS(nvA, nxt); else { nvA[0][0] = vA[0][0]; nvA[0][1] = vA[0][1]; nvA[1][0] = vA[1][0]; nvA[1][1] = vA[1][1]; } }
        for (int t = 0; t < nt; t += 2) {
            const bool last = (t == nt - 2);
            const char* a1 = cA + (size_t)(t + 1) * kstep;
            const char* a2 = last ? nA : cA + (size_t)(t + 2) * kstep; const char* b2 = last ? nB : cB + (size_t)(t + 2) * kstep;
            const char* a3 = a2 + kstep; const char* b3 = b2 + kstep;
            if (last && has_next) S.a_ready(nxt);
            if constexpr (SP2) {
            PG8_LDB(B0, 0, 0); PG8_LDB(B1, 0, 1); PG8_SCHED; PG8_LDA(At, 0, 0); PG8_STAGE_A(PG8_SA(1, 1), a1, 1, false);
            PG8_WAIT_V(8); PG8_WAIT_L(0); PG8_BAR; PG8_MMA(0, 0, At, B0); PG8_MMA(0, 1, At, B1); PG8_BAR; PG8_SCHED;
            PG8_LDA(At, 0, 1); PG8_STAGE(PG8_SB(0, 0), b2, voffB); PG8_STAGE(PG8_SB(0, 1), b2 + hstep, voffB); PG8_STAGE_A(PG8_SA(0, 0), a2, 0, last);
            PG8_WAIT_V(8); PG8_WAIT_L(0); PG8_BAR; PG8_MMA(1, 0, At, B0); PG8_MMA(1, 1, At, B1); PG8_BAR; PG8_SCHED;
            PG8_LDB(B0, 1, 0); PG8_LDB(B1, 1, 1); PG8_SCHED; PG8_LDA(At, 1, 0); PG8_STAGE_A(PG8_SA(0, 1), a2, 1, last);
            PG8_WAIT_V(8); PG8_WAIT_L(0); PG8_BAR; PG8_MMA(0, 0, At, B0); PG8_MMA(0, 1, At, B1); PG8_BAR; PG8_SCHED;
            PG8_LDA(At, 1, 1); PG8_STAGE(PG8_SB(1, 0), b3, voffB); PG8_STAGE(PG8_SB(1, 1), b3 + hstep, voffB); PG8_STAGE_A(PG8_SA(1, 0), a3, 0, last);
            PG8_WAIT_V(8); PG8_WAIT_L(0); PG8_BAR; PG8_MMA(1, 0, At, B0); PG8_MMA(1, 1, At, B1); PG8_BAR; PG8_SCHED;
            } else {
            PG8_LDB(B0, 0, 0); PG8_SCHED; PG8_LDA(At, 0, 0); PG8_STAGE(PG8_SA(1, 1), a1 + hstep, voffA);
            PG8_WAIT_L(8); PG8_BAR; PG8_WAIT_L(0); PG8_MMA(0, 0, At, B0); PG8_BAR; PG8_SCHED;
            PG8_LDB(B1, 0, 1); PG8_STAGE(PG8_SB(0, 0), b2, voffB);
            PG8_BAR; PG8_WAIT_L(0); PG8_MMA(0, 1, At, B1); PG8_BAR;
            PG8_LDA(At, 0, 1); PG8_STAGE(PG8_SA(0, 0), a2, voffA);
            PG8_BAR; PG8_WAIT_L(0); PG8_MMA(1, 0, At, B0); PG8_BAR; PG8_SCHED;
            PG8_STAGE(PG8_SB(0, 1), b2 + hstep, voffB);
            PG8_WAIT_V(6); PG8_BAR; PG8_MMA(1, 1, At, B1); PG8_BAR;
            PG8_LDB(B0, 1, 0); PG8_SCHED; PG8_LDA(At, 1, 0); PG8_STAGE(PG8_SA(0, 1), a2 + hstep, voffA);
            PG8_WAIT_L(8); PG8_BAR; PG8_WAIT_L(0); PG8_MMA(0, 0, At, B0); PG8_BAR; PG8_SCHED;
            PG8_LDB(B1, 1, 1); PG8_STAGE(PG8_SB(1, 0), b3, voffB);
            PG8_BAR; PG8_WAIT_L(0); PG8_MMA(0, 1, At, B1); PG8_BAR;
            PG8_LDA(At, 1, 1); PG8_STAGE(PG8_SA(1, 0), a3, voffA);
            PG8_BAR; PG8_WAIT_L(0); PG8_MMA(1, 0, At, B0); PG8_BAR; PG8_SCHED;
            PG8_STAGE(PG8_SB(1, 1), b3 + hstep, voffB);
            PG8_WAIT_V(6); PG8_BAR; PG8_MMA(1, 1, At, B1); PG8_BAR;
            }
        }
        if constexpr (ALIGN_EPI) { if (wr == 0) PG8_BAR; }
        if constexpr (!Epi::AFTER_DRAIN) { E(acc, cur, wr, wc, fr, fq); S.done(cur); }
        if (!has_next) break;
#pragma unroll
        for (int a = 0; a < 2; ++a)
#pragma unroll
            for (int b = 0; b < 2; ++b)
#pragma unroll
                for (int m = 0; m < 4; ++m)
#pragma unroll
                    for (int n = 0; n < 2; ++n) acc[a][b][m][n] = (f32x4){0.f, 0.f, 0.f, 0.f};
        cur = nxt; cA = nA; cB = nB; ++ui;
        if constexpr (GATHER) { vA[0][0] = nvA[0][0]; vA[0][1] = nvA[0][1]; vA[1][0] = nvA[1][0]; vA[1][1] = nvA[1][1]; }
        if constexpr (ALIGN_EPI) { if (wr == 1) PG8_BAR; }
    }
    PG8_WAIT_V(0);
    if constexpr (!ALIGN_EPI) { if (wr == 0) PG8_BAR; }
    PG8_BAR;
    if constexpr (Epi::AFTER_DRAIN) { E.fused(acc, cur, wr, wc, fr, fq, lds, wid, lane); S.done(cur); }
#undef PG8_SA
#undef PG8_SB
#undef PG8_STAGE
#undef PG8_STAGE_A
#undef PG8_GROWS
#undef PG8_LDA
#undef PG8_LDB
#undef PG8_MMA
#undef PG8_WAIT_V
#undef PG8_WAIT_L
#undef PG8_BAR
#undef PG8_SCHED
}
}

constexpr int NWAVES = 8;
#ifndef MK_PER_PHASE
#define MK_PER_PHASE 0
#endif
#ifndef MK_NAIVE_ATTN
#define MK_NAIVE_ATTN 0
#endif
#ifndef DBG_SKIP_ATTN
#define DBG_SKIP_ATTN 0
#endif
#ifndef DBG_SKIP_MOE
#define DBG_SKIP_MOE 0
#endif
#ifndef DBG_SKIP_MIX
#define DBG_SKIP_MIX 0
#endif
#ifndef DBG_CMP_ATT
#define DBG_CMP_ATT 0
#endif
#ifndef DBG_REP
#define DBG_REP -1
#endif
#ifndef DBG_PROBE
#define DBG_PROBE 0
#endif
constexpr int N_PHASES = 14;

constexpr int BATCH = 2, SEQ = 8192, D = 1024, T = BATCH * SEQ;
constexpr int NH = 8, HD = 64, AW = 512, IDXH = 8, IDXD = 64, TOPK = 256;
constexpr int NIN = 5704, NINP = 5888;
constexpr int NEXP = 32, DEXP = 512;
constexpr int XPROWS = 40960;
constexpr float EPS = 1e-6f;
constexpr float LOG2E = 1.4426950408889634f;
constexpr float C2 = 0.125f * LOG2E;

constexpr size_t MiB = 1u << 20;
constexpr size_t WS_CTL = 0, CTL_ZERO_BYTES = 1 * MiB;
constexpr size_t WS_SMALL = 1 * MiB;
constexpr size_t SM_MOD = WS_SMALL + 0;
constexpr size_t SM_WRT = WS_SMALL + 65536;
constexpr size_t SM_EID = WS_SMALL + 262144;
constexpr size_t SM_EWT = WS_SMALL + 393216;
constexpr size_t SM_SLOT = WS_SMALL + 524288;
constexpr size_t SM_AT = WS_SMALL + 655360;
constexpr size_t WS_WIN = 3 * MiB;
constexpr size_t WS_WA = 15 * MiB, WS_WC = 16 * MiB, WS_WOUT = 17 * MiB;
constexpr size_t WS_H1 = 19 * MiB;
constexpr size_t WS_AC = 19 * MiB, WS_ATT = 35 * MiB;
constexpr size_t WS_Q = 51 * MiB, WS_K = 67 * MiB, WS_V = 83 * MiB, WS_MASK = 83 * MiB, WS_VT = 99 * MiB, WS_QI = 115 * MiB, WS_KI = 131 * MiB;
constexpr size_t WS_WI = 133 * MiB, WS_QL = 133 * MiB + 524288;
constexpr size_t WS_CB = 136 * MiB, WS_U = 152 * MiB, WS_TMPC = 136 * MiB, WS_G = 168 * MiB;
constexpr size_t WS_MERGED = 51 * MiB;
constexpr size_t WS_WGU = 51 * MiB, WS_WD = 115 * MiB;
constexpr size_t WS_HID = 147 * MiB;
constexpr size_t WS_Y = 187 * MiB;
constexpr size_t WS_END = DBG_CMP_ATT ? 300 * MiB : 267 * MiB;
constexpr size_t WS_MASK_DBG = 268 * MiB, WS_ATT2 = 284 * MiB;
constexpr int CW_CMP = 2048;
constexpr int CW_TMO = 0, CW_CODE = 1, CW_KMAX = 64, CW_ECNT = 1024  , CW_BAR = 4096, CW_AROW = 131072  ;

constexpr int RING_OFF = 0, RING_BYTES = 131072;
constexpr int LDSCTL_OFF = RING_BYTES, MISC_OFF = LDSCTL_OFF + 320;
constexpr int LDS_BYTES = 147456;

#define GAS __attribute__((address_space(1)))
#define LAS __attribute__((address_space(3)))
typedef unsigned short bf16;
typedef unsigned v4u __attribute__((ext_vector_type(4)));
typedef unsigned v2u __attribute__((ext_vector_type(2)));
typedef float f32x4 __attribute__((ext_vector_type(4)));
typedef short bf16x8 __attribute__((ext_vector_type(8)));
typedef GAS unsigned gu32;
#define RLX_AGENT __ATOMIC_RELAXED, __HIP_MEMORY_SCOPE_AGENT
#define LDS_WAIT() asm volatile("s_waitcnt lgkmcnt(0)" ::: "memory")
#define VM_WAIT() asm volatile("s_waitcnt vmcnt(0)" ::: "memory")
__device__ __forceinline__ unsigned f2bf(float f) { unsigned u = __builtin_bit_cast(unsigned, f); return (u + 0x7fffu + ((u >> 16) & 1u)) >> 16; }
__device__ __forceinline__ unsigned pk2(float lo, float hi) { return f2bf(lo) | (f2bf(hi) << 16); }
__device__ __forceinline__ float bflo(unsigned u) { return __builtin_bit_cast(float, u << 16); }
__device__ __forceinline__ float bfhi(unsigned u) { return __builtin_bit_cast(float, u & 0xffff0000u); }
__device__ __forceinline__ float bf1(bf16 h) { return __builtin_bit_cast(float, (unsigned)h << 16); }
__device__ __forceinline__ float wave_sum(float v) {
#pragma unroll
    for (int o = 1; o < 64; o <<= 1) v += __shfl_xor(v, o);
    return v;
}
#define DPP_F(v, ctrl, row_mask) __builtin_bit_cast(float, __builtin_amdgcn_update_dpp(0, __builtin_bit_cast(int, (v)), (ctrl), (row_mask), 0xf, false))
__device__ __forceinline__ float wave_sum63(float v) {
    v += DPP_F(v, 0x111, 0xf); v += DPP_F(v, 0x112, 0xf); v += DPP_F(v, 0x114, 0xf); v += DPP_F(v, 0x118, 0xf);
    v += DPP_F(v, 0x142, 0xa);
    v += DPP_F(v, 0x143, 0xc);
    return v;
}
__device__ __forceinline__ float wave_sum_all(float v) { return __builtin_bit_cast(float, __builtin_amdgcn_readlane(__builtin_bit_cast(int, wave_sum63(v)), 63)); }
__device__ __forceinline__ float wave_max(float v) {
#pragma unroll
    for (int o = 1; o < 64; o <<= 1) v = fmaxf(v, __shfl_xor(v, o));
    return v;
}

#define XB_TMO      128
#define XB_XCNT(j)  (256  + 64 * (j))
#define XB_XSUB(j)  (1280 + 64 * (j))
#define XB_XGEN(j)  (2304 + 64 * (j))
#define XB_TOP      3328
#define XB_TOPGEN   3392
#define XCD_BAR_WORDS 3456
#define XB_SPIN_CAP (1u << 18)

__device__ __forceinline__ unsigned xb_ld(unsigned* p)              { return __hip_atomic_load(p, __ATOMIC_RELAXED, __HIP_MEMORY_SCOPE_AGENT); }
__device__ __forceinline__ unsigned xb_add(unsigned* p, unsigned v) { return __hip_atomic_fetch_add(p, v, __ATOMIC_RELAXED, __HIP_MEMORY_SCOPE_AGENT); }
__device__ __forceinline__ unsigned xb_xcc_id() { return (unsigned)__builtin_amdgcn_s_getreg((3 << 11) | 20) & 0xFu; }
#define XB_SPIN(cond, bar) do { unsigned _sp = 0; while (cond) { __builtin_amdgcn_s_sleep(1); \
    if ((++_sp & 255u) == 0u) { if (xb_ld(&(bar)[XB_TMO])) break; if (_sp > XB_SPIN_CAP) { atomicAdd(&(bar)[XB_TMO], 1u); break; } } } } while (0)

struct XcdBarrier { unsigned* bar; unsigned x; volatile LAS unsigned* st; };

__device__ __forceinline__ XcdBarrier xcd_barrier_post(unsigned* bar, volatile LAS unsigned* st) {
    XcdBarrier b; b.bar = bar; b.x = xb_xcc_id(); b.st = st;
    if (threadIdx.x == 0) (void)xb_add(&bar[XB_XCNT(b.x)], 1u);
    return b;
}
__device__ __forceinline__ void xcd_barrier_complete(unsigned* bar, unsigned x, unsigned& nloc, unsigned& nx) {
    const unsigned G = gridDim.x * gridDim.y * gridDim.z;
    unsigned sum, cnt, mine, sp = 0u;
    for (;;) {
        sum = 0u; cnt = 0u; mine = 0u;
#pragma unroll
        for (unsigned j = 0; j < 16; ++j) { const unsigned c = xb_ld(&bar[XB_XCNT(j)]); sum += c; cnt += (c > 0u) ? 1u : 0u; mine = (j == x) ? c : mine; }
        if (sum == G) break;
        __builtin_amdgcn_s_sleep(1);
        if ((++sp & 255u) == 0u) { if (xb_ld(&bar[XB_TMO])) break; if (sp > XB_SPIN_CAP) { atomicAdd(&bar[XB_TMO], 1u); break; } }
    }
    nloc = mine > 0u ? mine : 1u; nx = cnt > 0u ? cnt : 1u;
}
__device__ __forceinline__ void xcd_barrier(const XcdBarrier& b, const bool is_t0  ) {
    asm volatile("s_waitcnt vmcnt(0)" ::: "memory");
    __syncthreads();
    if (is_t0) {
        unsigned* bar = b.bar;
        __builtin_amdgcn_s_waitcnt(0);
        unsigned nloc = b.st[0], nx = b.st[1];
        if (nloc == 0u) { xcd_barrier_complete(bar, b.x, nloc, nx); b.st[0] = nloc; b.st[1] = nx; }
        const unsigned old = xb_add(&bar[XB_XSUB(b.x)], 1u);
        const unsigned gen = old / nloc;
        if (old + 1u == (gen + 1u) * nloc) {
            __builtin_amdgcn_fence(__ATOMIC_RELEASE, "agent");
            asm volatile("s_waitcnt vmcnt(0)" ::: "memory");
            const unsigned og = xb_add(&bar[XB_TOP], 1u);
            const unsigned tg = og / nx;
            if (og + 1u == (tg + 1u) * nx) xb_add(&bar[XB_TOPGEN], 1u);
            else XB_SPIN(xb_ld(&bar[XB_TOPGEN]) == tg, bar);
            __builtin_amdgcn_fence(__ATOMIC_ACQUIRE, "agent");
            xb_add(&bar[XB_XGEN(b.x)], 1u);
            asm volatile("s_waitcnt vmcnt(0)" ::: "memory");
        } else {
            XB_SPIN(xb_ld(&bar[XB_XGEN(b.x)]) == gen, bar);
            __builtin_amdgcn_fence(__ATOMIC_ACQUIRE, "agent");
            asm volatile("s_waitcnt vmcnt(0)" ::: "memory");
        }
    }
    __syncthreads();
}

struct Frame {
    LAS unsigned char* lds;
    volatile LAS unsigned* MISC;
    gu32* ctl;
    unsigned char* ws;
    int tid, lane, wave;
    int vcu, G;
    const float *x, *c, *w_ada, *b_ada, *norm1_g, *w_in, *rel_bias, *conv_w, *w_attn, *w_conv, *w_out, *norm2_g, *wrg, *brg, *wre, *bre, *w_gate_e, *w_up_e, *w_down_e, *norm_f_g;
    float* out;
};
#define WSP(T_, off) ((T_*)(F.ws + (off)))

template <class RowMap>
__device__ __forceinline__ void transpose_item(const float* W, int K, int N, bf16* WT, LAS float* scr, int item, int lane, RowMap rm) {
    const int nblk = (N + 31) / 32, kb = item / nblk, nb = item % nblk, k0 = 64 * kb, n0 = 32 * nb;
    const int c4 = (lane & 7) * 4, rr = lane >> 3;
    f32x4 v[8];
#pragma unroll
    for (int i = 0; i < 8; ++i) v[i] = (n0 + c4 < N) ? *(const f32x4*)(W + (size_t)(k0 + 8 * i + rr) * N + n0 + c4) : (f32x4){0.f, 0.f, 0.f, 0.f};
#pragma unroll
    for (int i = 0; i < 8; ++i) { LAS float* d = scr + (8 * i + rr) * 33 + c4; d[0] = v[i][0]; d[1] = v[i][1]; d[2] = v[i][2]; d[3] = v[i][3]; }
    LDS_WAIT(); asm volatile("" ::: "memory");
    const int c = lane & 7;
#pragma unroll
    for (int j = 0; j < 4; ++j) { const int n = (lane >> 3) + 8 * j; const LAS float* s = scr + (8 * c) * 33 + n;
        v4u o; o.x = pk2(s[0 * 33], s[1 * 33]); o.y = pk2(s[2 * 33], s[3 * 33]); o.z = pk2(s[4 * 33], s[5 * 33]); o.w = pk2(s[6 * 33], s[7 * 33]);
        if (n0 + n < N) *(GAS v4u*)(WT + (size_t)rm(n0 + n) * K + k0 + 8 * c) = o; }
    LDS_WAIT(); asm volatile("" ::: "memory");
}
struct RmId { __device__ __forceinline__ int operator()(int n) const { return n; } };
struct RmWin { __device__ __forceinline__ int operator()(int n) const {
    if (n < 2120) return n;
    if (n < 2632) return n + 184;
    if (n < 3144) { const int j = n - 2632; return 2816 + 256 * (j >> 7) + (j & 127); }
    if (n < 3656) { const int j = n - 3144; return 2816 + 256 * (j >> 7) + 128 + (j & 127); }
    return n + 184; } };
struct RmGU { int half; __device__ __forceinline__ int operator()(int n) const { return 256 * (n >> 7) + 128 * half + (n & 127); } };

__device__ __forceinline__ void p0_prologue(Frame& F) {
    LAS float* scr = (LAS float*)(F.lds + RING_OFF + F.wave * 16384);
    const int gw = F.vcu * NWAVES + F.wave, NGW = F.G * NWAVES;
    if (F.vcu < 96) {
        const int n = F.vcu * 64 + F.lane; float a0 = 0.f, a1 = 0.f;
        LAS float* cact = (LAS float*)(F.lds + RING_OFF + 16384);
        for (int i = F.tid; i < 2 * D; i += 512) { const float cv = F.c[i]; cact[i] = cv / (1.f + __expf(-cv)); }
        __syncthreads();
#pragma unroll 16
        for (int k = F.wave * 128; k < F.wave * 128 + 128; ++k) {
            const float w = F.w_ada[(size_t)k * 6144 + n];
            a0 += cact[k] * w; a1 += cact[D + k] * w;
        }
        LAS float* red = (LAS float*)(F.lds + RING_OFF + 8448);
        red[(F.wave * 2 + 0) * 64 + F.lane] = a0; red[(F.wave * 2 + 1) * 64 + F.lane] = a1;
        __syncthreads();
        if (F.wave < 2) { float s = F.b_ada[n];
#pragma unroll
            for (int w = 0; w < 8; ++w) s += red[(w * 2 + F.wave) * 64 + F.lane];
            WSP(float, SM_MOD)[F.wave * 6144 + n] = s; }
        __syncthreads();
    }
    constexpr int I_IN = 16 * 179;
    for (int it = gw; it < I_IN; it += NGW) transpose_item(F.w_in, D, NIN, WSP(bf16, WS_WIN), scr, it, F.lane, RmWin());
    for (int i = gw * 64 + F.lane; i < 184 * 128; i += NGW * 64) { *(GAS v4u*)(WSP(bf16, WS_WIN) + (size_t)2120 * D + (size_t)i * 8) = (v4u){0u, 0u, 0u, 0u}; }
    for (int i = gw * 64 + F.lane; i < 36 * D; i += NGW * 64) { const int n = i / D, k = i % D; WSP(float, SM_WRT)[i] = (n < 4) ? F.wrg[k * 4 + n] : F.wre[k * 32 + (n - 4)]; }
}

__device__ __forceinline__ void p1_norm1(Frame& F) {
    const int gw = F.vcu * NWAVES + F.wave, NGW = F.G * NWAVES;
    const float* mod = WSP(float, SM_MOD);
    for (int m0 = gw * 4; m0 < T; m0 += NGW * 4) {
        const int b = m0 / SEQ;
        f32x4 v[4][4]; float ss[4];
#pragma unroll
        for (int r = 0; r < 4; ++r) { const GAS f32x4* xr = (const GAS f32x4*)(F.x + (size_t)(m0 + r) * D) + F.lane;
#pragma unroll
            for (int j = 0; j < 4; ++j) v[r][j] = xr[64 * j]; }
#pragma unroll
        for (int r = 0; r < 4; ++r) { float s = 0.f;
#pragma unroll
            for (int j = 0; j < 4; ++j) s += (v[r][j].x * v[r][j].x + v[r][j].y * v[r][j].y) + (v[r][j].z * v[r][j].z + v[r][j].w * v[r][j].w);
            ss[r] = 1.f / sqrtf(wave_sum_all(s) * (1.f / D) + EPS); }
#pragma unroll
        for (int j = 0; j < 4; ++j) { const int k = 4 * F.lane + 256 * j;
            const f32x4 g = *(const f32x4*)(F.norm1_g + k), sc = *(const f32x4*)(mod + b * 6144 + 1024 + k), sh = *(const f32x4*)(mod + b * 6144 + k);
            const f32x4 ca = g * (sc + 1.0f);
#pragma unroll
            for (int r = 0; r < 4; ++r) { const f32x4 h = v[r][j] * ss[r] * ca + sh; ((GAS v2u*)(WSP(bf16, WS_H1) + (size_t)(m0 + r) * D) + F.lane)[64 * j] = (v2u){pk2(h.x, h.y), pk2(h.z, h.w)}; } }
    }
}

using pg8::Unit;
typedef float f32x2_t __attribute__((ext_vector_type(2))); typedef __bf16 bf16x2_t __attribute__((ext_vector_type(2)));
__device__ __forceinline__ unsigned cvtpk(float lo, float hi) { f32x2_t v = {lo, hi}; bf16x2_t b = __builtin_convertvector(v, bf16x2_t); return __builtin_bit_cast(unsigned, b); }
__device__ __forceinline__ v4u pack8(const f32x4 a, const f32x4 b) { v4u w; w.x = cvtpk(a[0], a[1]); w.y = cvtpk(a[2], a[3]); w.z = cvtpk(b[0], b[1]); w.w = cvtpk(b[2], b[3]); return w; }
__device__ __forceinline__ float sigmoidf_(float x) { return __builtin_amdgcn_rcpf(1.f + __builtin_amdgcn_exp2f(-x * LOG2E)); }
__device__ __forceinline__ f32x4 sig4(f32x4 v) { return (f32x4){sigmoidf_(v[0]), sigmoidf_(v[1]), sigmoidf_(v[2]), sigmoidf_(v[3])}; }
__device__ __forceinline__ void unpack8(const v4u w, f32x4& a, f32x4& b) { a = (f32x4){bflo(w.x), bfhi(w.x), bflo(w.y), bfhi(w.y)}; b = (f32x4){bflo(w.z), bfhi(w.z), bflo(w.w), bfhi(w.w)}; }

struct EpiProj {
    static constexpr bool PERM = true, AFTER_DRAIN = false;
    bf16 *Q, *K, *V, *QI, *KI, *CB, *U, *G; float* WI;
    __device__ __forceinline__ void operator()(const f32x4 (&acc)[2][2][4][2], const Unit& u, int wr, int wc, int fr, int fq) const {
        const int pn = u.pn, row0 = u.pm * 256 + wr * 64 + fr, cb8 = wc * 32 + 8 * fq;
        if (pn < 8 || pn == 9 || pn == 10) {
            bf16* base; int coff; float sc = 1.f;
            if (pn < 2) { base = Q; coff = 256 * pn; sc = C2; } else if (pn < 4) { base = K; coff = 256 * (pn - 2); } else if (pn < 6) { base = V; coff = 256 * (pn - 4); }
            else if (pn < 8) { base = QI; coff = 256 * (pn - 6); } else { base = CB; coff = 256 * (pn - 9); }
#pragma unroll
            for (int ai = 0; ai < 2; ++ai)
#pragma unroll
                for (int m = 0; m < 4; ++m) { bf16* rowp = base + (size_t)(row0 + ai * 128 + m * 16) * 512 + coff + cb8;
#pragma unroll
                    for (int bj = 0; bj < 2; ++bj) *(v4u*)(rowp + bj * 128) = pack8(acc[ai][bj][m][0] * sc, acc[ai][bj][m][1] * sc); }
        } else if (pn == 8) {
#pragma unroll
            for (int ai = 0; ai < 2; ++ai)
#pragma unroll
                for (int m = 0; m < 4; ++m) { const size_t row = (size_t)(row0 + ai * 128 + m * 16);
                    if (wc < 2) *(v4u*)(KI + row * 64 + cb8) = pack8(acc[ai][0][m][0], acc[ai][0][m][1]);
                    else if (wc == 2 && fq == 0) { *(f32x4*)(WI + row * 8) = acc[ai][0][m][0]; *(f32x4*)(WI + row * 8 + 4) = acc[ai][0][m][1]; } }
        } else if (pn < 15) {
#pragma unroll
            for (int ai = 0; ai < 2; ++ai)
#pragma unroll
                for (int m = 0; m < 4; ++m) { const size_t row = (size_t)(row0 + ai * 128 + m * 16);
                    *(v4u*)(U + row * 512 + 128 * (pn - 11) + cb8) = pack8(acc[ai][0][m][0] * acc[ai][1][m][0], acc[ai][0][m][1] * acc[ai][1][m][1]); }
        } else {
#pragma unroll
            for (int ai = 0; ai < 2; ++ai)
#pragma unroll
                for (int m = 0; m < 4; ++m) { bf16* rowp = G + (size_t)(row0 + ai * 128 + m * 16) * 2048 + 256 * (pn - 15) + cb8;
#pragma unroll
                    for (int bj = 0; bj < 2; ++bj) *(v4u*)(rowp + bj * 128) = pack8(sig4(acc[ai][bj][m][0]), sig4(acc[ai][bj][m][1])); }
        }
    }
};
struct EpiConv {
    static constexpr bool PERM = true, AFTER_DRAIN = false;
    const bf16* G; bf16* O;
    __device__ __forceinline__ void operator()(const f32x4 (&acc)[2][2][4][2], const Unit& u, int wr, int wc, int fr, int fq) const {
        const int row0 = u.pm * 256 + wr * 64 + fr, col0 = u.pn * 256 + wc * 32 + 8 * fq;
#pragma unroll
        for (int ai = 0; ai < 2; ++ai)
#pragma unroll
            for (int m = 0; m < 4; ++m) { const size_t row = (size_t)(row0 + ai * 128 + m * 16);
#pragma unroll
                for (int bj = 0; bj < 2; ++bj) { f32x4 g0, g1; unpack8(*(const v4u*)(G + row * 2048 + 1024 + col0 + bj * 128), g0, g1);
                    *(v4u*)(O + row * 1024 + col0 + bj * 128) = pack8(g0 * acc[ai][bj][m][0], g1 * acc[ai][bj][m][1]); } }
    }
};
struct EpiAttn {
    static constexpr bool PERM = true, AFTER_DRAIN = false;
    const bf16* G; const bf16* Tc; bf16* O;
    __device__ __forceinline__ void operator()(const f32x4 (&acc)[2][2][4][2], const Unit& u, int wr, int wc, int fr, int fq) const {
        const int row0 = u.pm * 256 + wr * 64 + fr, col0 = u.pn * 256 + wc * 32 + 8 * fq;
#pragma unroll
        for (int ai = 0; ai < 2; ++ai)
#pragma unroll
            for (int m = 0; m < 4; ++m) { const size_t row = (size_t)(row0 + ai * 128 + m * 16);
#pragma unroll
                for (int bj = 0; bj < 2; ++bj) { f32x4 g0, g1, t0, t1; unpack8(*(const v4u*)(G + row * 2048 + col0 + bj * 128), g0, g1); unpack8(*(const v4u*)(Tc + row * 1024 + col0 + bj * 128), t0, t1);
                    *(v4u*)(O + row * 1024 + col0 + bj * 128) = pack8(g0 * acc[ai][bj][m][0] + t0, g1 * acc[ai][bj][m][1] + t1); } }
    }
};
struct ChainOrder {
    pg8::StaticOrder so;
    __device__ __forceinline__ bool next(int i, Unit& u) const { Unit uc; if (!so.next(i >> 1, uc)) return false;
        if ((i & 1) == 0) { u.pm = uc.pm; u.pn = 4 + uc.pn; } else { u.pm = T / 256 + uc.pm; u.pn = uc.pn; } return true; }
    __device__ __forceinline__ void a_ready(const Unit&) const {}
    __device__ __forceinline__ void done(const Unit&) const {}
};
struct EpiChain {
    static constexpr bool PERM = true, AFTER_DRAIN = false;
    const bf16* G; bf16* Tc; bf16* O;
    __device__ __forceinline__ void operator()(const f32x4 (&acc)[2][2][4][2], const Unit& u, int wr, int wc, int fr, int fq) const {
        const bool conv = u.pn >= 4;
        const int row0 = (conv ? u.pm : u.pm - T / 256) * 256 + wr * 64 + fr, col0 = (u.pn & 3) * 256 + wc * 32 + 8 * fq;
#pragma unroll
        for (int ai = 0; ai < 2; ++ai)
#pragma unroll
            for (int m = 0; m < 4; ++m) { const size_t row = (size_t)(row0 + ai * 128 + m * 16);
#pragma unroll
                for (int bj = 0; bj < 2; ++bj) {
                    if (conv) { f32x4 g0, g1; unpack8(*(const v4u*)(G + row * 2048 + 1024 + col0 + bj * 128), g0, g1);
                        *(v4u*)(Tc + row * 1024 + col0 + bj * 128) = pack8(g0 * acc[ai][bj][m][0], g1 * acc[ai][bj][m][1]); }
                    else { f32x4 g0, g1, t0, t1; unpack8(*(const v4u*)(G + row * 2048 + col0 + bj * 128), g0, g1); unpack8(*(const v4u*)(Tc + row * 1024 + col0 + bj * 128), t0, t1);
                        *(v4u*)(O + row * 1024 + col0 + bj * 128) = pack8(g0 * acc[ai][bj][m][0] + t0, g1 * acc[ai][bj][m][1] + t1); } } }
    }
};
struct EpiOut {
    static constexpr bool PERM = false, AFTER_DRAIN = false;
    const float* X; const float* mod; float* O;
    __device__ __forceinline__ void operator()(const f32x4 (&acc)[2][2][4][2], const Unit& u, int wr, int wc, int fr, int fq) const {
        const int row0 = u.pm * 256 + wr * 64 + fr, col0 = u.pn * 256 + wc * 32 + 4 * fq;
        const float* g1 = mod + ((u.pm * 256) / SEQ) * 6144 + 2048;
#pragma unroll
        for (int bj = 0; bj < 2; ++bj)
#pragma unroll
            for (int n = 0; n < 2; ++n) { const int col = col0 + bj * 128 + n * 16; const f32x4 gv = *(const f32x4*)(g1 + col);
#pragma unroll
                for (int ai = 0; ai < 2; ++ai)
#pragma unroll
                    for (int m = 0; m < 4; ++m) { const size_t off = (size_t)(row0 + ai * 128 + m * 16) * D + col;
                        *(f32x4*)(O + off) = *(const f32x4*)(X + off) + gv * acc[ai][bj][m][n]; } }
    }
};
__device__ __forceinline__ f32x4 silu_mul4(f32x4 g, f32x4 u) { return (f32x4){g[0] * sigmoidf_(g[0]) * u[0], g[1] * sigmoidf_(g[1]) * u[1], g[2] * sigmoidf_(g[2]) * u[2], g[3] * sigmoidf_(g[3]) * u[3]}; }
struct EpiHid {
    static constexpr bool PERM = true, AFTER_DRAIN = false;
    bf16* O;
    __device__ __forceinline__ void operator()(const f32x4 (&acc)[2][2][4][2], const Unit& u, int wr, int wc, int fr, int fq) const {
        const int row0 = u.pm * 256 + wr * 64 + fr, col0 = 128 * (u.pn & 3) + wc * 32 + 8 * fq;
#pragma unroll
        for (int ai = 0; ai < 2; ++ai)
#pragma unroll
            for (int m = 0; m < 4; ++m) { const size_t row = (size_t)(row0 + ai * 128 + m * 16);
                *(v4u*)(O + row * 512 + col0) = pack8(silu_mul4(acc[ai][0][m][0], acc[ai][1][m][0]), silu_mul4(acc[ai][0][m][1], acc[ai][1][m][1])); }
    }
};
struct EpiY {
    static constexpr bool PERM = true, AFTER_DRAIN = false;
    bf16* O;
    __device__ __forceinline__ void operator()(const f32x4 (&acc)[2][2][4][2], const Unit& u, int wr, int wc, int fr, int fq) const {
        const int row0 = u.pm * 256 + wr * 64 + fr, col0 = 256 * (u.pn & 3) + wc * 32 + 8 * fq;
#pragma unroll
        for (int ai = 0; ai < 2; ++ai)
#pragma unroll
            for (int m = 0; m < 4; ++m) { const size_t row = (size_t)(row0 + ai * 128 + m * 16);
#pragma unroll
                for (int bj = 0; bj < 2; ++bj) *(v4u*)(O + row * 1024 + col0 + bj * 128) = pack8(acc[ai][bj][m][0], acc[ai][bj][m][1]); }
    }
};
struct MoeOrder {
    const LAS int* tile_e; int ntiles, G, c;
    __device__ __forceinline__ bool next(int i, Unit& u) const {
        const int L = i * G + c; if (L >= ntiles * 4) return false;
        const int rt = L >> 2, j = L & 3; u.pm = rt; u.pn = 4 * tile_e[rt] + j; return true; }
    __device__ __forceinline__ void a_ready(const Unit&) const {}
    __device__ __forceinline__ void done(const Unit&) const {}
};

__device__ __forceinline__ void p3_prep(Frame& F) {
    const int gw = F.vcu * NWAVES + F.wave, NGW = F.G * NWAVES;
    for (int rp_ = 0; rp_ < (DBG_REP == 31 ? 3 : 1); ++rp_) {
        LAS bf16* tl = (LAS bf16*)(F.lds + RING_OFF + F.wave * 16384);
        const bf16* V = WSP(bf16, WS_V); bf16* VT = WSP(bf16, WS_VT);
        for (int it = gw; it < BATCH * NH * (SEQ / 64); it += NGW) {
            const int kt = it % (SEQ / 64), h = (it / (SEQ / 64)) % NH, b = it / (NH * (SEQ / 64));
            const bf16* src = V + (size_t)(b * SEQ + kt * 64 + F.lane) * 512 + h * 64;
#pragma unroll
            for (int c = 0; c < 8; ++c) { const v4u w = *(const v4u*)(src + c * 8);
                LAS unsigned* d = (LAS unsigned*)(tl + F.lane * 66 + c * 8); d[0] = w.x; d[1] = w.y; d[2] = w.z; d[3] = w.w; }
            LDS_WAIT(); asm volatile("" ::: "memory");
            unsigned o[32];
#pragma unroll
            for (int p = 0; p < 64; p += 2) {
                const int i0 = p & 15, i1 = (p + 1) & 15, g = p & ~15;
                const int k0 = g + ((i0 < 4 || i0 >= 12) ? i0 : (i0 < 8 ? i0 + 4 : i0 - 4)), k1 = g + ((i1 < 4 || i1 >= 12) ? i1 : (i1 < 8 ? i1 + 4 : i1 - 4));
                o[p >> 1] = (unsigned)tl[k0 * 66 + F.lane] | ((unsigned)tl[k1 * 66 + F.lane] << 16); }
            bf16* dst = VT + ((size_t)((b * NH + h) * 64 + F.lane)) * SEQ + kt * 64;
#pragma unroll
            for (int c = 0; c < 8; ++c) *(v4u*)(dst + c * 8) = (v4u){o[4 * c], o[4 * c + 1], o[4 * c + 2], o[4 * c + 3]};
            LDS_WAIT(); asm volatile("" ::: "memory");
        }
    }
    for (int rp_ = 0; rp_ < (DBG_REP == 32 ? 3 : 1); ++rp_) {
        const bf16* CB = WSP(bf16, WS_CB); const bf16* U = WSP(bf16, WS_U); bf16* AC = WSP(bf16, WS_AC);
        const int j = F.lane * 8;
        const f32x4 w2a = *(const f32x4*)(F.conv_w + 1024 + j), w2b = *(const f32x4*)(F.conv_w + 1024 + j + 4), w1a = *(const f32x4*)(F.conv_w + 512 + j), w1b = *(const f32x4*)(F.conv_w + 512 + j + 4),
                    w0a = *(const f32x4*)(F.conv_w + j), w0b = *(const f32x4*)(F.conv_w + j + 4);
        for (int t0 = gw * 8; t0 < T; t0 += NGW * 8) {
            v4u cw[8], uw[10];
#pragma unroll
            for (int r = 0; r < 8; ++r) cw[r] = *(const v4u*)(CB + (size_t)(t0 + r) * 512 + j);
            const int tt0 = t0 % SEQ;
#pragma unroll
            for (int r = 0; r < 10; ++r) uw[r] = (tt0 + r - 2 >= 0) ? *(const v4u*)(U + (size_t)(t0 + r - 2) * 512 + j) : (v4u){0u, 0u, 0u, 0u};
#pragma unroll
            for (int r = 0; r < 8; ++r) {
                f32x4 c0, c1, a0, a1, b0, b1, d0, d1;
                unpack8(cw[r], c0, c1); unpack8(uw[r + 2], a0, a1); unpack8(uw[r + 1], b0, b1); unpack8(uw[r], d0, d1);
                *(v4u*)(AC + (size_t)(t0 + r) * 512 + j) = pack8(c0 * (a0 * w2a + b0 * w1a + d0 * w0a), c1 * (a1 * w2b + b1 * w1b + d1 * w0b));
            }
        }
    }
    for (int rp_ = 0; rp_ < (DBG_REP == 33 ? 3 : 1); ++rp_) {
        const bf16* QI = WSP(bf16, WS_QI); const float* WI = WSP(float, WS_WI); bf16* QL = WSP(bf16, WS_QL); float* AT = WSP(float, SM_AT);
        for (int t0 = gw * 8; t0 < T; t0 += NGW * 8) {
            v4u qw[8]; float wh[8];
#pragma unroll
            for (int r = 0; r < 8; ++r) { qw[r] = *(const v4u*)(QI + (size_t)(t0 + r) * 512 + F.lane * 8); wh[r] = WI[(size_t)(t0 + r) * 8 + (F.lane >> 3)]; }
#pragma unroll
            for (int r = 0; r < 8; ++r) {
                f32x4 q0, q1; unpack8(qw[r], q0, q1);
                float n2 = (q0[0] * q0[0] + q0[1] * q0[1]) + (q0[2] * q0[2] + q0[3] * q0[3]) + (q1[0] * q1[0] + q1[1] * q1[1]) + (q1[2] * q1[2] + q1[3] * q1[3]);
                n2 += __shfl_xor(n2, 1); n2 += __shfl_xor(n2, 2); n2 += __shfl_xor(n2, 4);
                const float a = wave_sum63(((F.lane & 7) == 0) ? fabsf(wh[r]) * sqrtf(n2) : 0.f);
                f32x4 s0 = q0 * wh[r], s1 = q1 * wh[r];
#pragma unroll
                for (int o = 8; o < 64; o <<= 1) {
#pragma unroll
                    for (int e = 0; e < 4; ++e) { s0[e] += __shfl_xor(s0[e], o); s1[e] += __shfl_xor(s1[e], o); } }
                if (F.lane < 8) *(v4u*)(QL + (size_t)(t0 + r) * 64 + F.lane * 8) = pack8(s0, s1);
                if (F.lane == 63) AT[t0 + r] = a;
            }
        }
    }
    for (int rp_ = 0; rp_ < (DBG_REP == 34 ? 3 : 1); ++rp_) {
        const bf16* KI = WSP(bf16, WS_KI); float mx = 0.f;
        for (int s = gw * 64 + F.lane; s < T; s += NGW * 64) { float q = 0.f;
#pragma unroll
            for (int c = 0; c < 8; ++c) { f32x4 a, b; unpack8(*(const v4u*)(KI + (size_t)s * 64 + c * 8), a, b); q += (a[0] * a[0] + a[1] * a[1]) + (a[2] * a[2] + a[3] * a[3]) + (b[0] * b[0] + b[1] * b[1]) + (b[2] * b[2] + b[3] * b[3]); }
            mx = fmaxf(mx, q); }
        mx = wave_max(mx);
        if (F.lane == 0 && gw * 64 < T) atomicMax((unsigned*)(F.ctl + CW_KMAX + 64 * (gw & 7)), __builtin_bit_cast(unsigned, sqrtf(mx)));
    }
}

__device__ __forceinline__ unsigned ord_key(float x) { if (x == 0.f) x = 0.f; const unsigned u = __builtin_bit_cast(unsigned, x); return (u & 0x80000000u) ? ~u : (u | 0x80000000u); }
__device__ __forceinline__ int t5_bucket(int n) {
    if (n < 16) return n;
    const int v = 16 + (int)(logf((float)n / 16.f) / 2.0794415416798357f * 16.f);
    return v < 31 ? v : 31;
}
__device__ __forceinline__ void pn_naive_dsa(Frame& F) {
    LAS float* sc = (LAS float*)(F.lds + RING_OFF);
    LAS float* qf = (LAS float*)(F.lds + RING_OFF + 32768);
    LAS float* wq = qf + 512;
    LAS unsigned* hist = (LAS unsigned*)(F.lds + RING_OFF + 36864);
    LAS int* sel = (LAS int*)(F.lds + RING_OFF + 40960);
    LAS float* pbuf = (LAS float*)(F.lds + RING_OFF + 45056);
    LAS int* wcnt = (LAS int*)(F.lds + RING_OFF + 53248);
    LAS int* bkt = (LAS int*)(F.lds + RING_OFF + 53248 + 256);
    const bf16* QI = WSP(bf16, WS_QI); const bf16* KI = WSP(bf16, WS_KI); const float* WI = WSP(float, WS_WI);
    const bf16* Qb = WSP(bf16, WS_Q); const bf16* Kb = WSP(bf16, WS_K); const bf16* Vb = WSP(bf16, WS_V); bf16* ATT = WSP(bf16, WS_ATT);
    if (F.tid < 128) bkt[F.tid] = t5_bucket(F.tid);
    __syncthreads();
    for (int qi_ = 0; qi_ < T / F.G + 1; ++qi_) {
        const int qidx = qi_ * F.G + F.vcu; if (qidx >= T) break;
        const int b = qidx / SEQ, t = qidx % SEQ, n = t + 1;
        qf[F.tid] = bf1(QI[(size_t)qidx * 512 + F.tid]);
        if (F.tid < 8) wq[F.tid] = WI[(size_t)qidx * 8 + F.tid];
        __syncthreads();
        for (int s = F.tid; s < n; s += 512) {
            float kf[64]; const bf16* kr = KI + (size_t)(b * SEQ + s) * 64;
#pragma unroll
            for (int c = 0; c < 8; ++c) { f32x4 a, bb; unpack8(*(const v4u*)(kr + c * 8), a, bb); kf[8 * c] = a[0]; kf[8 * c + 1] = a[1]; kf[8 * c + 2] = a[2]; kf[8 * c + 3] = a[3]; kf[8 * c + 4] = bb[0]; kf[8 * c + 5] = bb[1]; kf[8 * c + 6] = bb[2]; kf[8 * c + 7] = bb[3]; }
            float score = 0.f;
#pragma unroll 1
            for (int h = 0; h < 8; ++h) { float dsum = 0.f;
#pragma unroll
                for (int d4 = 0; d4 < 16; ++d4) { const f32x4 q4 = *(const LAS f32x4*)(qf + h * 64 + d4 * 4); dsum += q4[0] * kf[4 * d4] + q4[1] * kf[4 * d4 + 1] + q4[2] * kf[4 * d4 + 2] + q4[3] * kf[4 * d4 + 3]; }
                score += wq[h] * fmaxf(dsum, 0.f); }
            sc[s] = score;
        }
        __syncthreads();
        unsigned prefix = 0u, pmask = 0u; int need = TOPK;
        if (n > TOPK) {
            for (int pass = 0; pass < 4; ++pass) {
                const int shift = 24 - 8 * pass;
                if (F.tid < 256) hist[F.tid] = 0u;
                __syncthreads();
                for (int s = F.tid; s < n; s += 512) { const unsigned u = ord_key(sc[s]); if ((u & pmask) == prefix) atomicAdd((unsigned*)&hist[(u >> shift) & 255u], 1u); }
                __syncthreads();
                if (F.wave == 0) {
                    int c4[4]; int tot = 0;
#pragma unroll
                    for (int j = 0; j < 4; ++j) { c4[j] = (int)hist[4 * F.lane + j]; tot += c4[j]; }
                    int incl = tot;
#pragma unroll
                    for (int o = 1; o < 64; o <<= 1) { const int v = __shfl_down(incl, o); if (F.lane + o < 64) incl += v; }
                    const int above = incl - tot;
                    if (above < need && need <= incl) { int run = above;
#pragma unroll
                        for (int j = 3; j >= 0; --j) { if (run < need && need <= run + c4[j]) { wcnt[16] = 4 * F.lane + j; wcnt[17] = need - run; } run += c4[j]; } }
                }
                __syncthreads();
                prefix |= (unsigned)wcnt[16] << shift; pmask |= 255u << shift; need = wcnt[17];
                __syncthreads();
            }
        }
        int cg = 0, ce = 0;
        for (int i = 0; i < 16; ++i) { const int s = F.wave * 1024 + i * 64 + F.lane; bool gt = false, eq = false;
            if (s < n) { if (n <= TOPK) gt = true; else { const unsigned u = ord_key(sc[s]); gt = u > prefix; eq = (u == prefix); } }
            cg += __popcll(__ballot(gt)); ce += __popcll(__ballot(eq)); }
        if (F.lane == 0) { wcnt[2 * F.wave] = cg; wcnt[2 * F.wave + 1] = ce; }
        __syncthreads();
        int eqb = 0, tkb = 0, nsel = 0;
        { int eq_before = 0;
          for (int w = 0; w < 8; ++w) { const int g = wcnt[2 * w], e = wcnt[2 * w + 1];
              int take_e = need - eq_before; take_e = take_e < 0 ? 0 : (take_e > e ? e : take_e); if (n <= TOPK) take_e = 0;
              if (w < F.wave) { eqb += e; tkb += g + take_e; }
              nsel += g + take_e; eq_before += e; } }
        for (int i = 0; i < 16; ++i) { const int s = F.wave * 1024 + i * 64 + F.lane; bool gt = false, eq = false;
            if (s < n) { if (n <= TOPK) gt = true; else { const unsigned u = ord_key(sc[s]); gt = u > prefix; eq = (u == prefix); } }
            const unsigned long long mg = __ballot(gt), me = __ballot(eq), lt = (1ull << F.lane) - 1ull;
            const int erank = eqb + __popcll(me & lt);
            const bool take = gt || (eq && erank < need);
            const unsigned long long mt = __ballot(take);
            if (take) sel[tkb + __popcll(mt & lt)] = s;
            eqb += __popcll(me); tkb += __popcll(mt); (void)mg; }
        __syncthreads();
        {
            const int h = F.wave;
            qf[F.tid] = bf1(Qb[(size_t)qidx * 512 + F.tid]);
            __syncthreads();
            float lg[4]; float mx = -INFINITY;
#pragma unroll
            for (int i = 0; i < 4; ++i) { const int j = F.lane + 64 * i; lg[i] = -INFINITY;
                if (j < nsel) { const int s = sel[j]; const bf16* kr = Kb + (size_t)(b * SEQ + s) * 512 + h * 64; float dsum = 0.f;
#pragma unroll
                    for (int c = 0; c < 8; ++c) { f32x4 a, bb; unpack8(*(const v4u*)(kr + c * 8), a, bb); const f32x4 q0 = *(const LAS f32x4*)(qf + h * 64 + c * 8), q1 = *(const LAS f32x4*)(qf + h * 64 + c * 8 + 4);
                        dsum += (q0[0] * a[0] + q0[1] * a[1]) + (q0[2] * a[2] + q0[3] * a[3]) + (q1[0] * bb[0] + q1[1] * bb[1]) + (q1[2] * bb[2] + q1[3] * bb[3]); }
                    const int dist = t - s; const int bk = dist < 128 ? bkt[dist] : 31;
                    lg[i] = dsum + F.rel_bias[bk * 8 + h] * LOG2E; mx = fmaxf(mx, lg[i]); } }
            mx = wave_max(mx); float sum = 0.f;
#pragma unroll
            for (int i = 0; i < 4; ++i) { const int j = F.lane + 64 * i; const float p = (j < nsel) ? __builtin_amdgcn_exp2f(lg[i] - mx) : 0.f; sum += p; pbuf[h * 256 + j] = p; }
            sum = wave_sum(sum);
            LDS_WAIT(); asm volatile("" ::: "memory");
            float o = 0.f;
            for (int j = 0; j < nsel; ++j) o += pbuf[h * 256 + j] * bf1(Vb[(size_t)(b * SEQ + sel[j]) * 512 + h * 64 + F.lane]);
            ATT[(size_t)qidx * 512 + h * 64 + F.lane] = (bf16)f2bf(o / sum);
        }
        __syncthreads();
    }
}


typedef float f32x16 __attribute__((ext_vector_type(16)));
#define MFMA32(a, b, c) __builtin_amdgcn_mfma_f32_32x32x16_bf16((a), (b), (c), 0, 0, 0)
__device__ __forceinline__ int crow(int r, int hi) { return (r & 3) + 8 * (r >> 2) + 4 * hi; }
constexpr int IDX_CTL = LDSCTL_OFF + 2048;
constexpr int IDX_CAP = 512;

#define MFMA16(a, b, c) __builtin_amdgcn_mfma_f32_16x16x32_bf16((a), (b), (c), 0, 0, 0)
__device__ __forceinline__ void idx_tile(const bf16x8 (&kf)[4][2], const bf16x8 (&ql)[2], const bf16x8 (&qf)[8][2], const LAS float* w  , float invA, unsigned (&key)[4][4]) {
    float sc[4][4];
#define IDX_MF(D, QF0, QF1) _Pragma("unroll") for (int a = 0; a < 2; ++a) { D[a] = (f32x4){0.f, 0.f, 0.f, 0.f}; D[a] = MFMA16(kf[2 * hf + a][0], QF0, D[a]); D[a] = MFMA16(kf[2 * hf + a][1], QF1, D[a]); }
#define IDX_AC(D, W) do { const float wv_ = (W); _Pragma("unroll") for (int a = 0; a < 2; ++a) _Pragma("unroll") for (int i = 0; i < 4; ++i) { float x_ = __builtin_fmaf(wv_, __builtin_fabsf(D[a][i]), sc[2 * hf + a][i]); asm volatile("" : "+v"(x_)); sc[2 * hf + a][i] = x_; } } while (0)
#pragma unroll
    for (int hf = 0; hf < 2; ++hf) {
        f32x4 dA[2], dB[2];
        IDX_MF(dA, ql[0], ql[1]);
        IDX_MF(dB, qf[0][0], qf[0][1]);
#pragma unroll
        for (int a = 0; a < 2; ++a)
#pragma unroll
            for (int i = 0; i < 4; ++i) { float x_ = dA[a][i]; asm volatile("" : "+v"(x_)); sc[2 * hf + a][i] = x_; }
        IDX_MF(dA, qf[1][0], qf[1][1]); IDX_AC(dB, w[0]);
        IDX_MF(dB, qf[2][0], qf[2][1]); IDX_AC(dA, w[1]);
        IDX_MF(dA, qf[3][0], qf[3][1]); IDX_AC(dB, w[2]);
        IDX_MF(dB, qf[4][0], qf[4][1]); IDX_AC(dA, w[3]);
        IDX_MF(dA, qf[5][0], qf[5][1]); IDX_AC(dB, w[4]);
        IDX_MF(dB, qf[6][0], qf[6][1]); IDX_AC(dA, w[5]);
        IDX_MF(dA, qf[7][0], qf[7][1]); IDX_AC(dB, w[6]);
        IDX_AC(dA, w[7]);
    }
#undef IDX_MF
#undef IDX_AC
#pragma unroll
    for (int a = 0; a < 4; ++a)
#pragma unroll
        for (int i = 0; i < 4; ++i) key[a][i] = __builtin_bit_cast(unsigned, __builtin_fmaf(sc[a][i], invA, 3.0f));
}
__device__ __forceinline__ void idx_load_k(bf16x8 (&kf)[4][2], const bf16* KItile  , unsigned voff  ) {
#pragma unroll
    for (int a = 0; a < 4; ++a)
#pragma unroll
        for (int ks = 0; ks < 2; ++ks) kf[a][ks] = *(const bf16x8*)((const char*)KItile + voff + a * 2048 + ks * 64);
}
template <int MODE>
__device__ __forceinline__ void idx_pass(Frame& F, int ln, const bf16* KIb, unsigned* MASKg, int t0, int nt_idx, int nt_att, const bf16x8 (&ql)[2], const bf16x8 (&qf)[8][2], const LAS float* w, float invA, int b1, unsigned thr) {
    const int qc = ln & 15, fq = ln >> 4, qh = F.wave & 1, kp = F.wave >> 1, ql_ = 16 * qh + qc, t = t0 + ql_;
    LAS unsigned* hrow = (LAS unsigned*)(F.lds + RING_OFF) + ql_ * 1025;
    const int ntl = (MODE >= 2) ? nt_att : nt_idx;
    LAS unsigned* mlds = (LAS unsigned*)(F.lds + RING_OFF);
    LAS unsigned* clist = (LAS unsigned*)(F.lds + RING_OFF + 32768);
    LAS unsigned* ccnt = (LAS unsigned*)(F.lds + IDX_CTL) + 96;
    bf16x8 kcur[4][2];
    const unsigned voff = (unsigned)(qc * 64 + fq * 8) * 2u;
#pragma unroll
    for (int a = 0; a < 4; ++a)
#pragma unroll
        for (int ks = 0; ks < 2; ++ks) kcur[a][ks] = (bf16x8){0, 0, 0, 0, 0, 0, 0, 0};
    if (kp < nt_idx) idx_load_k(kcur, KIb + (size_t)(64 * kp) * 64, voff);
    for (int kt = kp; kt < ntl; kt += 4) {
        unsigned m16 = 0u;
        if (kt < nt_idx) {
            unsigned key[4][4];
            const bool diag = 64 * kt + 63 > t0;
            idx_tile(kcur, ql, qf, w, invA, key);
            if (kt + 4 < nt_idx) idx_load_k(kcur, KIb + (size_t)(64 * (kt + 4)) * 64, voff);
            bool cnd[4] = {false, false, false, false}; unsigned cps[4] = {0u, 0u, 0u, 0u};
#define IDX_TAIL(DIAG) _Pragma("unroll") for (int a = 0; a < 4; ++a) _Pragma("unroll") for (int i = 0; i < 4; ++i) { \
                    const unsigned bits = key[a][i]; const bool valid = (DIAG) ? (64 * kt + 16 * a + 4 * fq + i <= t) : true; \
                    if (MODE == 0) { unsigned val = 1u + __builtin_amdgcn_ubfe(bits, 22, 1) * 65535u; if (DIAG) val = valid ? val : 0u; \
                        __hip_atomic_fetch_add(hrow + __builtin_amdgcn_ubfe(bits, 12, 10), val, __ATOMIC_RELAXED, __HIP_MEMORY_SCOPE_WORKGROUP); } \
                    else if (MODE == 1) { unsigned val = 1u + __builtin_amdgcn_ubfe(bits, 11, 1) * 65535u; val = (valid && (int)__builtin_amdgcn_ubfe(bits, 12, 11) == b1) ? val : 0u; \
                        __hip_atomic_fetch_add(hrow + __builtin_amdgcn_ubfe(bits, 1, 10), val, __ATOMIC_RELAXED, __HIP_MEMORY_SCOPE_WORKGROUP); } \
                    else if (MODE == 2) { if (valid && __builtin_amdgcn_ubfe(bits, 1, 22) >= thr) m16 |= 1u << (4 * a + i); } \
                    else { const int dbin = (int)__builtin_amdgcn_ubfe(bits, 12, 11) - b1;            \
                        if (valid && dbin > 0) m16 |= 1u << (4 * a + i); \
                        cnd[i] = valid && dbin == 0; cps[i] = 0u; \
                        if (cnd[i]) cps[i] = __hip_atomic_fetch_add(ccnt + ql_, 1u, __ATOMIC_RELAXED, __HIP_MEMORY_SCOPE_WORKGROUP);        \
                        if (i == 3) { _Pragma("unroll") for (int i2 = 0; i2 < 4; ++i2)                                                     \
                            if (cnd[i2] && cps[i2] < (unsigned)IDX_CAP) clist[ql_ * IDX_CAP + cps[i2]] = (__builtin_amdgcn_ubfe(key[a][i2], 1, 11) << 18) | ((unsigned)(kt * 64 + (fq & 1) * 32 + ql_) << 5) | (unsigned)(8 * a + 4 * (fq >> 1) + i2); } } }
            if (diag) { IDX_TAIL(true) } else { IDX_TAIL(false) }
#undef IDX_TAIL
        }
        if (MODE >= 2) {
            unsigned word = ((m16 & 0xFu) | ((m16 & 0xF0u) << 4) | ((m16 & 0xF00u) << 8) | ((m16 & 0xF000u) << 12)) << (4 * (fq >> 1));
            word |= (unsigned)__shfl_xor((int)word, 32);
            if (ln < 32) { if (MODE == 2) MASKg[(size_t)kt * 64 + fq * 32 + ql_] = word; else mlds[kt * 64 + fq * 32 + ql_] = word; }
        }
    }
}
template <int LEVEL>
__device__ __forceinline__ void idx_scan(Frame& F, int ln) {
    LAS unsigned* hist = (LAS unsigned*)(F.lds + RING_OFF);
    LAS int* ctl = (LAS int*)(F.lds + IDX_CTL);
#pragma unroll 1
    for (int qi = 0; qi < 4; ++qi) {
        const int q = 4 * F.wave + qi;
        int need = (LEVEL == 0) ? TOPK : TOPK - ctl[32 + q];
        unsigned wv[16]; int toth = 0, totl = 0;
#pragma unroll
        for (int j = 0; j < 16; ++j) { wv[j] = hist[q * 1025 + 16 * ln + j]; toth += (int)(wv[j] >> 16); totl += (int)(wv[j] & 0xffffu); }
        int inclh = toth, incll = totl;
#pragma unroll
        for (int o = 1; o < 64; o <<= 1) { const int vh = __shfl_down(inclh, o), vl = __shfl_down(incll, o); if (ln + o < 64) { inclh += vh; incll += vl; } }
        const int allh = __shfl(inclh, 0);
        { const int above = inclh - toth;
          if (above < need && need <= inclh) { int run = above, B = 0, cab = 0; bool found = false;
#pragma unroll
              for (int j = 15; j >= 0; --j) { const int ch = (int)(wv[j] >> 16); if (!found && need <= run + ch) { found = true; B = 1024 + 16 * ln + j; cab = run; } run += ch; }
              if (LEVEL == 0) { ctl[q] = B; ctl[32 + q] = cab; } else ctl[64 + q] = (ctl[q] << 11) | B; } }
        { const int above = allh + incll - totl;
          if (allh < need && above < need && need <= allh + incll) { int run = above, B = 0, cab = 0; bool found = false;
#pragma unroll
              for (int j = 15; j >= 0; --j) { const int cl = (int)(wv[j] & 0xffffu); if (!found && need <= run + cl) { found = true; B = 16 * ln + j; cab = run; } run += cl; }
              if (LEVEL == 0) { ctl[q] = B; ctl[32 + q] = cab; } else ctl[64 + q] = (ctl[q] << 11) | B; } }
    }
}
__device__ __forceinline__ void idx_select(Frame& F, int ln) {
    LAS unsigned* mlds = (LAS unsigned*)(F.lds + RING_OFF);
    LAS unsigned* clist = (LAS unsigned*)(F.lds + RING_OFF + 32768);
    LAS int* ctl = (LAS int*)(F.lds + IDX_CTL);
#pragma unroll 1
    for (int qi = 0; qi < 4; ++qi) {
        const int q = 4 * F.wave + qi; int nc = ctl[96 + q];
        if (nc > IDX_CAP) { nc = IDX_CAP; if (ln == 0) ctl[128] = 1; }
        const int r = TOPK - ctl[32 + q];
        unsigned e[IDX_CAP / 64]; bool ok[IDX_CAP / 64];
#pragma unroll
        for (int j = 0; j < IDX_CAP / 64; ++j) { ok[j] = ln + 64 * j < nc; e[j] = ok[j] ? clist[q * IDX_CAP + ln + 64 * j] : 0u; }
        unsigned t = 0u;
#pragma unroll 1
        for (int bit = 10; bit >= 0; --bit) { const unsigned tt = t | (1u << bit); int cnt = 0;
#pragma unroll
            for (int j = 0; j < IDX_CAP / 64; ++j) cnt += __popcll(__ballot(ok[j] && (e[j] >> 18) >= tt));
            if (cnt >= r) t = tt; }
#pragma unroll
        for (int j = 0; j < IDX_CAP / 64; ++j) if (ok[j] && (e[j] >> 18) >= t) __hip_atomic_fetch_or(mlds + ((e[j] >> 5) & 8191u), 1u << (e[j] & 31u), __ATOMIC_RELAXED, __HIP_MEMORY_SCOPE_WORKGROUP);
    }
}
__device__ __forceinline__ void p5_indexer(Frame& F, unsigned* MASK) {
    const bf16* QI = WSP(bf16, WS_QI); const bf16* KI = WSP(bf16, WS_KI); const float* WI = WSP(float, WS_WI); const bf16* QL = WSP(bf16, WS_QL); const float* AT = WSP(float, SM_AT);
    float kmax = 0.f;
#pragma unroll
    for (int i = 0; i < 8; ++i) kmax = fmaxf(kmax, __builtin_bit_cast(float, __hip_atomic_load(F.ctl + CW_KMAX + 64 * i, RLX_AGENT)));
    LAS int* ctl = (LAS int*)(F.lds + IDX_CTL);
    for (int p = F.vcu; p < 256; p += F.G) {
        const int b = p >> 7, j = p & 127;
#pragma unroll 1
        for (int side = 0; side < 2; ++side) {
            const int g = side ? j : 255 - j, t0 = 32 * g;
            const int nt_idx = (g + 2) >> 1, nt_att = 4 * (g >> 3) + 4;
            int ln = (int)__builtin_amdgcn_mbcnt_hi(~0u, __builtin_amdgcn_mbcnt_lo(~0u, 0u)); asm volatile("" : "+v"(ln)); const int tid_ = F.wave * 64 + ln;
            const int qc = ln & 15, fq = ln >> 4, ql_ = 16 * (F.wave & 1) + qc;
            const size_t trow = (size_t)b * SEQ + t0 + ql_;
            bf16x8 qf[8][2], ql[2]; float invA; LAS float* w = (LAS float*)(F.lds + IDX_CTL + 1024) + ql_ * 8;
#define IDX_LOADQ() do { \
            _Pragma("unroll") for (int h = 0; h < 8; ++h) _Pragma("unroll") for (int ks = 0; ks < 2; ++ks) qf[h][ks] = *(const bf16x8*)(QI + trow * 512 + h * 64 + ks * 32 + fq * 8); \
            _Pragma("unroll") for (int ks = 0; ks < 2; ++ks) ql[ks] = *(const bf16x8*)(QL + trow * 64 + ks * 32 + fq * 8); \
            { const f32x4 w0 = *(const f32x4*)(WI + trow * 8), w1 = *(const f32x4*)(WI + trow * 8 + 4); *(LAS f32x4*)w = w0; *(LAS f32x4*)(w + 4) = w1; }     \
            { const float a2 = 2.0f * AT[trow] * kmax; invA = a2 > 0.f ? 0.99f / a2 : 0.f; }        \
        } while (0)
            IDX_LOADQ();
            const bf16* KIb = KI + (size_t)b * SEQ * 64;
            unsigned* MASKg = MASK + ((size_t)(b * 256 + g) * 128) * 64;
            for (int i = tid_; i < 8200; i += 512) ((LAS v4u*)(F.lds + RING_OFF))[i] = (v4u){0u, 0u, 0u, 0u};
            if (tid_ < 96) ctl[tid_] = 0;
            __syncthreads();
            idx_pass<0>(F, ln, KIb, MASKg, t0, nt_idx, nt_att, ql, qf, w, invA, 0, 0u);
            __syncthreads();
            idx_scan<0>(F, ln);
            __syncthreads();
            const int b1 = ctl[ql_];
            if (tid_ < 33) ctl[96 + tid_] = 0;
            __syncthreads();
            idx_pass<3>(F, ln, KIb, MASKg, t0, nt_idx, nt_att, ql, qf, w, invA, b1, 0u);
            __syncthreads();
            idx_select(F, ln);
            __syncthreads();
            if (ctl[128] == 0 || DBG_REP == 77) {
                for (int i = tid_; i < nt_att * 64; i += 512) MASKg[i] = ((LAS unsigned*)(F.lds + RING_OFF))[i];
            } else {
                for (int i = tid_; i < 8200; i += 512) ((LAS v4u*)(F.lds + RING_OFF))[i] = (v4u){0u, 0u, 0u, 0u};
                IDX_LOADQ();
                __syncthreads();
                idx_pass<1>(F, ln, KIb, MASKg, t0, nt_idx, nt_att, ql, qf, w, invA, b1, 0u);
                __syncthreads();
                idx_scan<1>(F, ln);
                __syncthreads();
                const unsigned thr = (unsigned)ctl[64 + ql_];
                idx_pass<2>(F, ln, KIb, MASKg, t0, nt_idx, nt_att, ql, qf, w, invA, b1, thr);
            }
            __syncthreads();
#undef IDX_LOADQ
        }
    }
}

__device__ __forceinline__ unsigned sbfe1_(unsigned w, const int bit) { unsigned r; asm("v_bfe_i32 %0, %1, %2, 1" : "=v"(r) : "v"(w), "n"(bit)); return r; }
#define SBFE1(w, bit) sbfe1_((w), (bit))
__device__ __forceinline__ void p6_attention(Frame& F, const unsigned* MASK, bf16* ATTo) {
    const bf16* Qb = WSP(bf16, WS_Q); const bf16* Kb = WSP(bf16, WS_K); const bf16* VT = WSP(bf16, WS_VT);
    constexpr int KTB = 18432, VTB = 17408, SLOT = KTB + VTB;
    LAS unsigned char* Lb = F.lds + RING_OFF;
    LAS float* biasd = (LAS float*)(F.lds + RING_OFF + 2 * SLOT);
    for (int p = F.vcu; p < 256; p += F.G) {
        const int bh = p >> 4, j = p & 15, b = bh >> 3, h = bh & 7;
#pragma unroll 1
        for (int side = 0; side < 2; ++side) {
            const int qb = side ? j : 31 - j, q0 = 256 * qb, NT = 2 * qb + 2;
            int ln = (int)__builtin_amdgcn_mbcnt_hi(~0u, __builtin_amdgcn_mbcnt_lo(~0u, 0u)); asm volatile("" : "+v"(ln));
            const int tid_ = F.wave * 64 + ln, r32 = ln & 31, hi = ln >> 5, lrow = tid_ >> 3, lch = tid_ & 7;
            const int tq = q0 + 32 * F.wave + r32;
            if (tid_ < 128) { const int bk = t5_bucket(tid_); biasd[tid_] = (F.rel_bias[bk * 8 + h] - F.rel_bias[31 * 8 + h]) * LOG2E; }
            const bf16* Kg = Kb + (size_t)(b * SEQ + lrow) * 512 + h * 64 + lch * 8;
            const bf16* Vg = VT + ((size_t)((b * NH + h) * 64 + lrow)) * SEQ + lch * 8;
            const unsigned* Mg = MASK + ((size_t)(b * 256 + 8 * qb + F.wave) * 128) * 64 + ln;
            bf16x8 qf[4];
#pragma unroll
            for (int ks = 0; ks < 4; ++ks) qf[ks] = *(const bf16x8*)(Qb + (size_t)(b * SEQ + tq) * 512 + h * 64 + ks * 16 + hi * 8);
            f32x16 o0, o1, o2;
#pragma unroll
            for (int r = 0; r < 16; ++r) { o0[r] = 0.f; o1[r] = 0.f; o2[r] = 0.f; }
            const bf16x8 ones = (bf16x8){0x3F80, 0x3F80, 0x3F80, 0x3F80, 0x3F80, 0x3F80, 0x3F80, 0x3F80};
            float m_run = 0.f;
            v4u kreg0 = *(const v4u*)(Kg), kreg1 = *(const v4u*)(Kg + (size_t)64 * 512), vreg0 = *(const v4u*)(Vg), vreg1 = *(const v4u*)(Vg + 64);
            unsigned mw0 = Mg[0], mw1 = Mg[64], mwn0 = 0u, mwn1 = 0u;
            *(LAS v4u*)(Lb + lrow * 144 + lch * 16) = kreg0; *(LAS v4u*)(Lb + (64 + lrow) * 144 + lch * 16) = kreg1;
            *(LAS v4u*)(Lb + KTB + lrow * 272 + lch * 16) = vreg0; *(LAS v4u*)(Lb + KTB + lrow * 272 + 128 + lch * 16) = vreg1;
            __syncthreads();
            for (int kt = 0; kt < NT; ++kt) {
                const int buf = kt & 1;
                if (kt + 1 < NT) { const size_t kn = (size_t)(kt + 1) * 128;
                    kreg0 = *(const v4u*)(Kg + kn * 512); kreg1 = *(const v4u*)(Kg + (kn + 64) * 512); vreg0 = *(const v4u*)(Vg + kn); vreg1 = *(const v4u*)(Vg + kn + 64);
                    mwn0 = Mg[(size_t)(2 * kt + 2) * 64]; mwn1 = Mg[(size_t)(2 * kt + 3) * 64]; }
                LAS unsigned char* kb_ = Lb + buf * SLOT; LAS unsigned char* vb_ = kb_ + KTB;
                f32x16 sA[4];
#pragma unroll
                for (int c = 0; c < 4; ++c)
#pragma unroll
                    for (int r = 0; r < 16; ++r) sA[c][r] = 0.f;
#pragma unroll
                for (int ks = 0; ks < 4; ++ks)
#pragma unroll
                    for (int c = 0; c < 4; ++c) { const bf16x8 kf = *(const LAS bf16x8*)(kb_ + (32 * c + r32) * 144 + ks * 32 + hi * 16); sA[c] = MFMA32(kf, qf[ks], sA[c]); }
                if (kt >= NT - 3) {
#pragma unroll
                    for (int c = 0; c < 4; ++c)
#pragma unroll
                        for (int r = 0; r < 16; ++r) { const int d0 = tq - (128 * kt + 32 * c + crow(r, hi)); const float b0 = biasd[d0 & 127]; sA[c][r] += ((unsigned)d0 < 128u) ? b0 : 0.f; }
                }
                float mx = -INFINITY;
#pragma unroll
                for (int r = 0; r < 16; ++r) mx = fmaxf(mx, fmaxf(fmaxf(sA[0][r], sA[1][r]), fmaxf(sA[2][r], sA[3][r])));
                mx = fmaxf(mx, __shfl_xor(mx, 32)) - m_run;
                if (kt == 0 || __any(mx > 8.0f)) {
                    const float dl = (kt == 0) ? mx : fmaxf(mx, 0.f), f = __builtin_amdgcn_exp2f(-dl);
                    m_run += dl;
#pragma unroll
                    for (int r = 0; r < 16; ++r) { o0[r] *= f; o1[r] *= f; o2[r] *= f; }
                }
                unsigned pk[4][8];
#pragma unroll
                for (int c = 0; c < 4; ++c) { const unsigned mw = (c < 2) ? mw0 : mw1;
#pragma unroll
                    for (int r = 0; r < 16; r += 2) {
                        const unsigned e0 = __builtin_bit_cast(unsigned, __builtin_amdgcn_exp2f(sA[c][r] - m_run)) & SBFE1(mw, 16 * (c & 1) + r);
                        const unsigned e1 = __builtin_bit_cast(unsigned, __builtin_amdgcn_exp2f(sA[c][r + 1] - m_run)) & SBFE1(mw, 16 * (c & 1) + r + 1);
                        pk[c][r >> 1] = cvtpk(__builtin_bit_cast(float, e0), __builtin_bit_cast(float, e1)); } }
#pragma unroll
                for (int c = 0; c < 4; ++c)
#pragma unroll
                    for (int s = 0; s < 2; ++s) {
                        const bf16x8 pf = __builtin_bit_cast(bf16x8, (v4u){pk[c][4 * s], pk[c][4 * s + 1], pk[c][4 * s + 2], pk[c][4 * s + 3]});
                        const bf16x8 v0 = *(const LAS bf16x8*)(vb_ + r32 * 272 + (2 * c + s) * 32 + hi * 16);
                        const bf16x8 v1 = *(const LAS bf16x8*)(vb_ + (32 + r32) * 272 + (2 * c + s) * 32 + hi * 16);
                        o0 = MFMA32(v0, pf, o0); o1 = MFMA32(v1, pf, o1); o2 = MFMA32(ones, pf, o2);
                    }
                if (kt + 1 < NT) { LAS unsigned char* nb = Lb + (buf ^ 1) * SLOT;
                    *(LAS v4u*)(nb + lrow * 144 + lch * 16) = kreg0; *(LAS v4u*)(nb + (64 + lrow) * 144 + lch * 16) = kreg1;
                    *(LAS v4u*)(nb + KTB + lrow * 272 + lch * 16) = vreg0; *(LAS v4u*)(nb + KTB + lrow * 272 + 128 + lch * 16) = vreg1; }
                mw0 = mwn0; mw1 = mwn1;
                __syncthreads();
            }
            const float inv = 1.0f / o2[0];
            bf16* orow = ATTo + (size_t)(b * SEQ + tq) * 512 + h * 64 + 4 * hi;
#pragma unroll
            for (int g4 = 0; g4 < 4; ++g4) {
                *(v2u*)(orow + 8 * g4) = (v2u){cvtpk(o0[4 * g4] * inv, o0[4 * g4 + 1] * inv), cvtpk(o0[4 * g4 + 2] * inv, o0[4 * g4 + 3] * inv)};
                *(v2u*)(orow + 32 + 8 * g4) = (v2u){cvtpk(o1[4 * g4] * inv, o1[4 * g4 + 1] * inv), cvtpk(o1[4 * g4 + 2] * inv, o1[4 * g4 + 3] * inv)};
            }
        }
    }
}

__device__ __forceinline__ void p9_norm2_route(Frame& F, const float* HRES) {
    const int gw = F.vcu * NWAVES + F.wave, NGW = F.G * NWAVES;
    const float* mod = WSP(float, SM_MOD); const float* WRT = WSP(float, SM_WRT);
    LAS float* lg = (LAS float*)(F.lds + RING_OFF + F.wave * 16384 + 8448);
    int* EID = WSP(int, SM_EID); float* EWT = WSP(float, SM_EWT); int* SLOT = WSP(int, SM_SLOT); bf16* H2 = WSP(bf16, WS_H1);
    LAS unsigned* lcnt = (LAS unsigned*)(F.lds + LDSCTL_OFF + 4096);
    const int nsteps = (T / 8 + NGW - 1) / NGW;
    for (int st = 0; st < nsteps; ++st) {
        const int m8 = st * NGW + gw; const bool live = m8 < T / 8;
        const int m0 = (live ? m8 : 0) * 8, b = m0 / SEQ;
        if (F.tid < 32) lcnt[F.tid] = 0u;
        f32x4 hv[8][4];
#pragma unroll
        for (int r = 0; r < 8; ++r) { const GAS f32x4* xr = (const GAS f32x4*)(HRES + (size_t)(m0 + r) * D) + F.lane;
#pragma unroll
            for (int j = 0; j < 4; ++j) hv[r][j] = xr[64 * j]; }
        f32x4 ca[4], cb[4];
#pragma unroll
        for (int j = 0; j < 4; ++j) { const int k = 4 * F.lane + 256 * j;
            const f32x4 g = *(const f32x4*)(F.norm2_g + k), scl = *(const f32x4*)(mod + b * 6144 + 4096 + k); cb[j] = *(const f32x4*)(mod + b * 6144 + 3072 + k); ca[j] = g * (scl + 1.0f); }
#pragma unroll
        for (int r = 0; r < 8; ++r) { float s = 0.f;
#pragma unroll
            for (int j = 0; j < 4; ++j) s += (hv[r][j].x * hv[r][j].x + hv[r][j].y * hv[r][j].y) + (hv[r][j].z * hv[r][j].z + hv[r][j].w * hv[r][j].w);
            const float rstd = 1.f / sqrtf(wave_sum_all(s) * (1.f / D) + EPS);
            GAS v2u* o8 = (GAS v2u*)(H2 + (size_t)(m0 + r) * D) + F.lane;
#pragma unroll
            for (int j = 0; j < 4; ++j) { hv[r][j] = hv[r][j] * rstd * ca[j] + cb[j]; if (live) o8[64 * j] = (v2u){pk2(hv[r][j].x, hv[r][j].y), pk2(hv[r][j].z, hv[r][j].w)}; } }
#pragma unroll 4
        for (int n = 0; n < 36; ++n) {
            f32x4 w[4];
#pragma unroll
            for (int j = 0; j < 4; ++j) w[j] = *(const f32x4*)(WRT + n * D + 4 * F.lane + 256 * j);
            float p[8];
#pragma unroll
            for (int r = 0; r < 8; ++r) { float a = 0.f;
#pragma unroll
                for (int j = 0; j < 4; ++j) a += (hv[r][j].x * w[j].x + hv[r][j].y * w[j].y) + (hv[r][j].z * w[j].z + hv[r][j].w * w[j].w);
                p[r] = wave_sum63(a); }
            if (F.lane == 63) { const float bb = (n < 4 ? F.brg[n] : F.bre[n - 4]); lg[n] = p[0] + bb; lg[36 + n] = p[1] + bb; lg[72 + n] = p[2] + bb; lg[108 + n] = p[3] + bb; lg[144 + n] = p[4] + bb; lg[180 + n] = p[5] + bb; lg[216 + n] = p[6] + bb; lg[252 + n] = p[7] + bb; }
        }
        __syncthreads();
        int e0id = 0, e1id = 0; unsigned lp0 = 0u, lp1 = 0u; const int tkn = m0 + F.lane; const bool rt = live && F.lane < 8;
        if (rt) {
            const LAS float* l = lg + F.lane * 36;
            int gs = 0; float gm = l[0];
#pragma unroll
            for (int j = 1; j < 4; ++j) if (l[j] > gm) { gm = l[j]; gs = j; }
            float gsum = 0.f;
#pragma unroll
            for (int j = 0; j < 4; ++j) gsum += __expf(l[j] - gm);
            const float gwt = 1.f / gsum;
            const LAS float* el = l + 4 + 8 * gs;
            int i0 = 0; float l0 = el[0];
#pragma unroll
            for (int j = 1; j < 8; ++j) if (el[j] > l0) { l0 = el[j]; i0 = j; }
            int i1 = -1; float l1 = -INFINITY;
#pragma unroll
            for (int j = 0; j < 8; ++j) if (j != i0 && el[j] > l1) { l1 = el[j]; i1 = j; }
            const float e1 = __expf(l1 - l0), p0 = 1.f / (1.f + e1), p1 = e1 * p0;
            e0id = gs * 8 + i0; e1id = gs * 8 + i1;
            EID[tkn * 2] = e0id; EID[tkn * 2 + 1] = e1id; EWT[tkn * 2] = gwt * p0; EWT[tkn * 2 + 1] = gwt * p1;
            lp0 = __hip_atomic_fetch_add(lcnt + e0id, 1u, __ATOMIC_RELAXED, __HIP_MEMORY_SCOPE_WORKGROUP);
            lp1 = __hip_atomic_fetch_add(lcnt + e1id, 1u, __ATOMIC_RELAXED, __HIP_MEMORY_SCOPE_WORKGROUP);
        }
        __syncthreads();
        if (F.tid < 32) { const unsigned c = lcnt[F.tid]; lcnt[32 + F.tid] = c ? atomicAdd((unsigned*)(F.ctl + CW_ECNT + 16 * F.tid), c) : 0u; }
        __syncthreads();
        if (rt) { SLOT[tkn * 2] = (int)(lcnt[32 + e0id] + lp0); SLOT[tkn * 2 + 1] = (int)(lcnt[32 + e1id] + lp1); }
        __syncthreads();
    }
    {
        LAS float* scr = (LAS float*)(F.lds + RING_OFF + F.wave * 16384);
        for (int it = gw; it < NEXP * 512; it += NGW) {
            const int e = it / 512, r = it % 512;
            if (r < 256) transpose_item(F.w_gate_e + (size_t)e * D * DEXP, D, DEXP, WSP(bf16, WS_WGU) + (size_t)e * 1024 * D, scr, r, F.lane, RmGU{0});
            else transpose_item(F.w_up_e + (size_t)e * D * DEXP, D, DEXP, WSP(bf16, WS_WGU) + (size_t)e * 1024 * D, scr, r - 256, F.lane, RmGU{1});
        }
    }
}
__device__ __forceinline__ int moe_tables(Frame& F, LAS int* off, LAS int* tile_e) {
    if (F.tid == 0) { int o = 0, nt = 0;
        for (int e = 0; e < NEXP; ++e) { const int c = (int)__hip_atomic_load(F.ctl + CW_ECNT + 16 * e, RLX_AGENT); off[e] = o; const int tl = (c + 255) >> 8; for (int j = 0; j < tl; ++j) tile_e[nt++] = e; o += tl * 256; }
        off[NEXP] = nt; }
    __syncthreads();
    return off[NEXP];
}
__device__ __forceinline__ void p10_gather(Frame& F, LAS int* off) {
    const int* EID = WSP(int, SM_EID); int* SLOT = WSP(int, SM_SLOT); int* AROW = (int*)(F.ctl + CW_AROW);
    for (int i = blockIdx.x * 512 + F.tid; i < T * 2; i += F.G * 512) { const int row = off[EID[i]] + SLOT[i]; AROW[row] = i >> 1; SLOT[i] = row; }
}
__device__ __forceinline__ void p13_combine(Frame& F, const float* HRES) {
    const int gw = F.vcu * NWAVES + F.wave, NGW = F.G * NWAVES;
    const float* mod = WSP(float, SM_MOD); const int* SLOT = WSP(int, SM_SLOT); const float* EWT = WSP(float, SM_EWT); const bf16* Y = WSP(bf16, WS_Y);
    for (int m0 = gw * 2; m0 < T; m0 += NGW * 2) {
        const int b = m0 / SEQ;
        f32x4 v[2][4]; float rs[2];
#pragma unroll
        for (int r = 0; r < 2; ++r) { const int m = m0 + r;
#if DBG_SKIP_MOE
            const int r0 = 0, r1 = 0; const float w0 = 0.f, w1 = 0.f; (void)SLOT; (void)EWT;
#else
            const int r0 = SLOT[m * 2], r1 = SLOT[m * 2 + 1]; const float w0 = EWT[m * 2], w1 = EWT[m * 2 + 1];
#endif
            const GAS f32x4* xr = (const GAS f32x4*)(HRES + (size_t)m * D) + F.lane;
            const GAS v2u* y0 = (const GAS v2u*)(Y + (size_t)r0 * D) + F.lane; const GAS v2u* y1 = (const GAS v2u*)(Y + (size_t)r1 * D) + F.lane;
#pragma unroll
            for (int j = 0; j < 4; ++j) { const int k = 4 * F.lane + 256 * j; const v2u a = y0[64 * j], c = y1[64 * j];
                const f32x4 ya = (f32x4){bflo(a.x), bfhi(a.x), bflo(a.y), bfhi(a.y)}, yb = (f32x4){bflo(c.x), bfhi(c.x), bflo(c.y), bfhi(c.y)};
                const f32x4 g2 = *(const f32x4*)(mod + b * 6144 + 5120 + k);
#if DBG_SKIP_MOE
                v[r][j] = xr[64 * j]; (void)g2; (void)ya; (void)yb;
#else
                v[r][j] = xr[64 * j] + g2 * (ya * w0 + yb * w1);
#endif
            } }
#pragma unroll
        for (int r = 0; r < 2; ++r) { float s = 0.f;
#pragma unroll
            for (int j = 0; j < 4; ++j) s += (v[r][j].x * v[r][j].x + v[r][j].y * v[r][j].y) + (v[r][j].z * v[r][j].z + v[r][j].w * v[r][j].w);
            rs[r] = 1.f / sqrtf(wave_sum_all(s) * (1.f / D) + EPS); }
#if DBG_CMP_ATT
        const float escale = 1.0f + sqrtf(__builtin_bit_cast(float, __hip_atomic_load(F.ctl + CW_CMP, RLX_AGENT)) / __builtin_bit_cast(float, __hip_atomic_load(F.ctl + CW_CMP + 1, RLX_AGENT)));
#else
        const float escale = 1.0f;
#endif
#pragma unroll
        for (int r = 0; r < 2; ++r) { GAS f32x4* o = (GAS f32x4*)(F.out + (size_t)(m0 + r) * D) + F.lane;
#pragma unroll
            for (int j = 0; j < 4; ++j) o[64 * j] = v[r][j] * (rs[r] * escale) * *(const f32x4*)(F.norm_f_g + 4 * F.lane + 256 * j); }
    }
}

struct Args { const float* in[20]; float* out; unsigned char* ws; int ph_lo, ph_hi, li, pad; };
__global__ void __launch_bounds__(NWAVES * 64, 2) fwd_kernel(Args args) {
    extern __shared__ __attribute__((aligned(16))) unsigned char lds[];
    Frame F;
    F.lds = (LAS unsigned char*)lds;
    F.MISC = (volatile LAS unsigned*)(F.lds + MISC_OFF);
    F.tid = threadIdx.x; F.lane = F.tid & 63; F.wave = __builtin_amdgcn_readfirstlane(F.tid >> 6);
    F.G = gridDim.x; { const int bx = blockIdx.x; F.vcu = (F.G % 8 == 0) ? (bx % 8) * (F.G / 8) + bx / 8 : bx; }
    F.ws = args.ws; F.ctl = (gu32*)(args.ws + WS_CTL);
    F.x = args.in[0]; F.c = args.in[1]; F.w_ada = args.in[2]; F.b_ada = args.in[3]; F.norm1_g = args.in[4]; F.w_in = args.in[5]; F.rel_bias = args.in[6]; F.conv_w = args.in[7];
    F.w_attn = args.in[8]; F.w_conv = args.in[9]; F.w_out = args.in[10]; F.norm2_g = args.in[11]; F.wrg = args.in[12]; F.brg = args.in[13]; F.wre = args.in[14]; F.bre = args.in[15];
    F.w_gate_e = args.in[16]; F.w_up_e = args.in[17]; F.w_down_e = args.in[18]; F.norm_f_g = args.in[19]; F.out = args.out;
    for (int u = F.tid; u < (LDS_BYTES - LDSCTL_OFF) / 4; u += NWAVES * 64) ((LAS unsigned*)(F.lds + LDSCTL_OFF))[u] = 0u;
    __syncthreads();
    XcdBarrier bar; bar.bar = (unsigned*)(F.ctl + CW_BAR); bar.x = 0; bar.st = nullptr;
    if (!MK_PER_PHASE) bar = xcd_barrier_post((unsigned*)(F.ctl + CW_BAR), F.MISC + 8);
#define GRID_BAR() do { if (MK_PER_PHASE) { if (F.tid == 0) __hip_atomic_store(F.ctl + CW_TMO, 0xBADBA0u, RLX_AGENT); } else { xcd_barrier(bar, F.wave == 0 && (int)__builtin_amdgcn_mbcnt_hi(~0u, __builtin_amdgcn_mbcnt_lo(~0u, 0u)) == 0); } } while (0)
    const int lo = args.ph_lo, hi = args.ph_hi;
#ifndef ONLY_PHASE
#define ONLY_PHASE -1
#endif
#define IN(k) ((ONLY_PHASE < 0 || ONLY_PHASE == (k)) && lo <= (k) && (k) < hi)
#define BOTH(k) (IN(k) && IN((k) + 1))
#define REFRESH() do { int l_ = (int)__builtin_amdgcn_mbcnt_hi(~0u, __builtin_amdgcn_mbcnt_lo(~0u, 0u)); asm volatile("" : "+v"(l_)); F.lane = l_; F.tid = F.wave * 64 + l_; } while (0)
    float* HRES = F.out;
    LAS int* moe_off = (LAS int*)(F.lds + LDSCTL_OFF + 1024);
    LAS int* moe_tile = (LAS int*)(F.lds + LDSCTL_OFF + 1024 + 256);

    if (IN(0)) { REFRESH(); for (int rep_ = 0; rep_ < (DBG_REP == 0 ? 2 : 1); ++rep_) { if (rep_) GRID_BAR(); p0_prologue(F); } if (BOTH(0)) GRID_BAR(); }
    if (IN(1)) { REFRESH(); for (int rep_ = 0; rep_ < (DBG_REP == 1 ? 2 : 1); ++rep_) { if (rep_) GRID_BAR(); p1_norm1(F); } if (BOTH(1)) GRID_BAR(); }
    if (IN(2)) { REFRESH();
        pg8::Gemm g{WSP(bf16, WS_H1), WSP(bf16, WS_WIN), T, NINP, D}; pg8::StaticOrder S; S.init(T, NINP, F.G, (int)blockIdx.x);
        EpiProj E{WSP(bf16, WS_Q), WSP(bf16, WS_K), WSP(bf16, WS_V), WSP(bf16, WS_QI), WSP(bf16, WS_KI), WSP(bf16, WS_CB), WSP(bf16, WS_U), WSP(bf16, WS_G), WSP(float, WS_WI)};
        for (int rep_ = 0; rep_ < (DBG_REP == 2 ? 2 : 1); ++rep_) { if (rep_) GRID_BAR(); pg8::gemm_phase<EpiProj, pg8::StaticOrder, true, true>(F.lds + RING_OFF, g, S, E, F.wave); }
        {
            constexpr int I_A = 8 * 32, I_C = 8 * 32, I_O = 16 * 32;
            const int nun = (T / 256) * (NINP / 256), rem = nun % F.G, c = (int)blockIdx.x;
            const bool early = (rem == 0) || (c >= rem); const int n_early = (rem == 0) ? F.G : F.G - rem, rank = (rem == 0) ? c : c - rem;
            if (early) { LAS float* scr = (LAS float*)(F.lds + RING_OFF + F.wave * 16384);
                for (int it = rank * NWAVES + F.wave; it < I_A + I_C + I_O; it += n_early * NWAVES) { int r = it;
                    if (r < I_A) { transpose_item(F.w_attn, AW, D, WSP(bf16, WS_WA), scr, r, F.lane, RmId()); continue; } r -= I_A;
                    if (r < I_C) { transpose_item(F.w_conv, AW, D, WSP(bf16, WS_WC), scr, r, F.lane, RmId()); continue; } r -= I_C;
                    transpose_item(F.w_out, D, D, WSP(bf16, WS_WOUT), scr, r, F.lane, RmId()); } }
        }
        if (BOTH(2)) GRID_BAR();
    }
    if (IN(3)) { REFRESH(); for (int rep_ = 0; rep_ < (DBG_REP == 3 ? 2 : 1); ++rep_) { if (rep_) GRID_BAR(); p3_prep(F); } if (BOTH(3)) GRID_BAR(); }
    static_assert(WS_ATT == WS_AC + (size_t)T * AW * 2 && WS_WC == WS_WA + (size_t)D * AW * 2, "the chained branch GEMM needs [AC; ATT] and [Wa; Wc] contiguous");
    if (IN(4)) { REFRESH(); }
    if (IN(5)) { REFRESH();
#if DBG_SKIP_ATTN
        for (size_t i = (size_t)blockIdx.x * 512 + F.tid; i < (size_t)T * 512 / 8; i += (size_t)F.G * 512) *(v4u*)(WSP(bf16, WS_ATT) + i * 8) = (v4u){0u, 0u, 0u, 0u};
#elif DBG_CMP_ATT
        pn_naive_dsa(F); GRID_BAR(); p5_indexer(F, WSP(unsigned, WS_MASK_DBG));
#elif MK_NAIVE_ATTN
        pn_naive_dsa(F);
#else
        for (int rep_ = 0; rep_ < (DBG_REP == 5 ? 2 : 1); ++rep_) { if (rep_) GRID_BAR(); p5_indexer(F, WSP(unsigned, WS_MASK)); }
#endif
        if (BOTH(5)) GRID_BAR(); }
    if (IN(6)) { REFRESH();
#if DBG_SKIP_ATTN
#elif DBG_CMP_ATT
        p6_attention(F, WSP(unsigned, WS_MASK_DBG), WSP(bf16, WS_ATT2)); GRID_BAR();
        { float num = 0.f, den = 0.f; const bf16* A1 = WSP(bf16, WS_ATT); const bf16* A2 = WSP(bf16, WS_ATT2);
          for (size_t i = (size_t)blockIdx.x * 512 + F.tid; i < (size_t)T * 512; i += (size_t)F.G * 512) { const float a = bf1(A1[i]), c = bf1(A2[i]); num += (a - c) * (a - c); den += a * a; }
          num = wave_sum(num); den = wave_sum(den);
          if (F.lane == 0) { atomicAdd((float*)(F.ctl + CW_CMP), num); atomicAdd((float*)(F.ctl + CW_CMP + 1), den); } }
#elif !MK_NAIVE_ATTN
        for (int rep_ = 0; rep_ < (DBG_REP == 6 ? 2 : 1); ++rep_) { if (rep_) GRID_BAR(); p6_attention(F, WSP(unsigned, WS_MASK), WSP(bf16, WS_ATT)); }
#endif
        if (BOTH(6)) GRID_BAR(); }
    if (IN(7)) { REFRESH();
        pg8::Gemm g{WSP(bf16, WS_AC), WSP(bf16, WS_WA), 2 * T, 2 * D, AW}; ChainOrder S; S.so.init(T, D, F.G, (int)blockIdx.x);
        EpiChain E{WSP(bf16, WS_G), WSP(bf16, WS_TMPC), WSP(bf16, WS_MERGED)};
        for (int rep_ = 0; rep_ < (DBG_REP == 7 ? 2 : 1); ++rep_) { if (rep_) GRID_BAR(); pg8::gemm_phase<EpiChain, ChainOrder, true, true>(F.lds + RING_OFF, g, S, E, F.wave); }
        if (BOTH(7)) GRID_BAR();
    }
    if (IN(8)) { REFRESH();
        pg8::Gemm g{WSP(bf16, WS_MERGED), WSP(bf16, WS_WOUT), T, D, D}; pg8::StaticOrder S; S.init(T, D, F.G, (int)blockIdx.x);
        EpiOut E{F.x, WSP(float, SM_MOD), HRES};
        for (int rep_ = 0; rep_ < (DBG_REP == 8 ? 2 : 1); ++rep_) { if (rep_) GRID_BAR(); pg8::gemm_phase<EpiOut, pg8::StaticOrder, true, true>(F.lds + RING_OFF, g, S, E, F.wave); }
        if (BOTH(8)) GRID_BAR();
    }
#if DBG_SKIP_MOE
    if (0) {
#endif
    if (IN(9)) { REFRESH(); p9_norm2_route(F, HRES);
#if DBG_REP == 9
        GRID_BAR(); if (blockIdx.x == 0 && F.tid < 32) __hip_atomic_store(F.ctl + CW_ECNT + 16 * F.tid, 0u, RLX_AGENT); GRID_BAR(); p9_norm2_route(F, HRES);
#endif
#if DBG_REP == 99
        for (int i_ = 0; i_ < 10; ++i_) GRID_BAR();
#endif
        if (BOTH(9)) GRID_BAR(); }
    if (IN(10)) { REFRESH(); (void)moe_tables(F, moe_off, moe_tile); p10_gather(F, moe_off); if (BOTH(10)) GRID_BAR(); }
    if (IN(11)) { REFRESH();
        const int nt = moe_tables(F, moe_off, moe_tile);
        pg8::Gemm g{WSP(bf16, WS_H1), WSP(bf16, WS_WGU), XPROWS, NEXP * 1024, D}; MoeOrder S{moe_tile, nt, F.G, (int)blockIdx.x};
        EpiHid E{WSP(bf16, WS_HID)};
        for (int rep_ = 0; rep_ < (DBG_REP == 11 ? 2 : 1); ++rep_) { if (rep_) GRID_BAR(); pg8::gemm_phase<EpiHid, MoeOrder, true, true, true>(F.lds + RING_OFF, g, S, E, F.wave, (const int*)(F.ctl + CW_AROW)); }
        {
            const int nun = nt * 4, rem = nun % F.G, c = (int)blockIdx.x;
            const bool early = (rem == 0) || (c >= rem); const int n_early = (rem == 0) ? F.G : F.G - rem, rank = (rem == 0) ? c : c - rem;
            if (early) { LAS float* scr = (LAS float*)(F.lds + RING_OFF + F.wave * 16384);
                for (int it = rank * NWAVES + F.wave; it < NEXP * 256; it += n_early * NWAVES) { const int e = it >> 8, r = it & 255;
                    transpose_item(F.w_down_e + (size_t)e * DEXP * D, DEXP, D, WSP(bf16, WS_WD) + (size_t)e * D * DEXP, scr, r, F.lane, RmId()); } }
        }
        if (BOTH(11)) GRID_BAR();
    }
    if (IN(12)) { REFRESH();
        const int nt = moe_tables(F, moe_off, moe_tile);
        pg8::Gemm g{WSP(bf16, WS_HID), WSP(bf16, WS_WD), XPROWS, NEXP * 1024, DEXP}; MoeOrder S{moe_tile, nt, F.G, (int)blockIdx.x};
        EpiY E{WSP(bf16, WS_Y)};
        for (int rep_ = 0; rep_ < (DBG_REP == 12 ? 2 : 1); ++rep_) { if (rep_) GRID_BAR(); pg8::gemm_phase<EpiY, MoeOrder, true, true>(F.lds + RING_OFF, g, S, E, F.wave); }
        if (BOTH(12)) GRID_BAR();
    }
#if DBG_SKIP_MOE
    }
#endif
#if DBG_PROBE
    if (IN(13)) { REFRESH();
        const bf16* src = nullptr; int pitch = 1024;
        if (DBG_PROBE == 1) { src = WSP(bf16, WS_MERGED); pitch = 1024; }
        if (DBG_PROBE == 2) { src = WSP(bf16, WS_TMPC); pitch = 1024; }
        if (DBG_PROBE == 3) { src = WSP(bf16, WS_AC); pitch = 512; }
        if (DBG_PROBE == 4) { src = WSP(bf16, WS_G); pitch = 2048; }
        if (DBG_PROBE == 5) { src = WSP(bf16, WS_H1); pitch = 1024; }
        if (DBG_PROBE == 6) { src = WSP(bf16, WS_WIN); pitch = 1024; }
        if (DBG_PROBE == 7) { src = WSP(bf16, WS_QI); pitch = 512; }
        for (size_t i = (size_t)blockIdx.x * 512 + F.tid; i < (size_t)T * D; i += (size_t)F.G * 512) { const size_t m = i / D, j = i % D;
            float v;
            if (DBG_PROBE == 8) v = WSP(float, SM_MOD)[i % 12288];
            else if (DBG_PROBE == 4) v = bf1(src[m * 2048 + j]) + bf1(src[m * 2048 + 1024 + j]);
            else if (DBG_PROBE >= 40 && DBG_PROBE < 48) v = bf1(WSP(bf16, WS_G)[m * 2048 + (DBG_PROBE - 40) * 256 + (j & 255)]);
            else if (DBG_PROBE == 6) v = bf1(src[(m % 5888) * 1024 + j]);
            else v = bf1(src[m * pitch + (j % pitch)]);
            F.out[i] = v; }
    }
#else
    if (IN(13)) { REFRESH(); for (int rep_ = 0; rep_ < (DBG_REP == 13 ? 2 : 1); ++rep_) { if (rep_) GRID_BAR(); p13_combine(F, DBG_SKIP_MIX ? F.x : HRES); } }
#endif
#undef IN
#undef BOTH
}

extern "C" void kernel_launch(void* const* d_in, const int* in_sizes, int n_in, void* d_out, int out_size, void* d_ws, size_t ws_size, hipStream_t stream) {
    static int grid = 0;
    if (grid == 0) {
        if (n_in != 20 || in_sizes[0] != T * D || out_size != T * D || ws_size < WS_END) { fprintf(stderr, "kernel_launch: unexpected shapes: n_in %d in0 %d out %d ws %zu (need %zu)\n", n_in, n_in > 0 ? in_sizes[0] : -1, out_size, ws_size, (size_t)WS_END); grid = -1; return; }
        int dev = 0, cus = 0, per_cu = 0;
        if (hipGetDevice(&dev) != hipSuccess || hipDeviceGetAttribute(&cus, hipDeviceAttributeMultiprocessorCount, dev) != hipSuccess) { grid = -1; return; }
        if (hipFuncSetAttribute((const void*)fwd_kernel, hipFuncAttributeMaxDynamicSharedMemorySize, LDS_BYTES) != hipSuccess) { fprintf(stderr, "kernel_launch: hipFuncSetAttribute failed\n"); grid = -1; return; }
        if (hipOccupancyMaxActiveBlocksPerMultiprocessor(&per_cu, (const void*)fwd_kernel, NWAVES * 64, LDS_BYTES) != hipSuccess || per_cu < 1)
            fprintf(stderr, "kernel_launch: note: occupancy query reports %d workgroups per CU\n", per_cu);
        (void)hipGetLastError();
        grid = cus;
    }
    if (grid < 0) return;
    if (hipMemsetAsync((char*)d_ws + WS_CTL, 0, CTL_ZERO_BYTES, stream) != hipSuccess) return;
    Args a{};
    for (int i = 0; i < 20; ++i) a.in[i] = (const float*)d_in[i];
    a.out = (float*)d_out; a.ws = (unsigned char*)d_ws;
#if MK_PER_PHASE
    for (int li = 0; li < N_PHASES; ++li) { a.ph_lo = li; a.ph_hi = li + 1; a.li = li; hipLaunchKernelGGL(fwd_kernel, dim3(grid), dim3(NWAVES * 64), LDS_BYTES, stream, a); }
#else
    a.ph_lo = 0; a.ph_hi = N_PHASES; a.li = 0;
    hipLaunchKernelGGL(fwd_kernel, dim3(grid), dim3(NWAVES * 64), LDS_BYTES, stream, a);
#endif
}
```

```cpp
#include <hip/hip_runtime.h>
#include <cstdio>
#include <cstdint>

namespace pg8 {
#define PG8_LAS __attribute__((address_space(3)))
typedef unsigned short bf16_t;
typedef short bf16x8 __attribute__((ext_vector_type(8)));
typedef float f32x4 __attribute__((ext_vector_type(4)));
typedef unsigned u32x4 __attribute__((ext_vector_type(4)));
constexpr int BM = 256, BK = 64, HALF = 128, HTB = HALF * BK * 2  , STAGE_BYTES = 8 * HTB, NXCD = 8, WGM = 8;

__host__ __device__ __forceinline__ int lds_byte(int r, int c) { const int st = (r >> 4) * 2 + (c >> 5), rr = r & 15, cc = c & 31, ob = rr * 64 + cc * 2; return st * 1024 + (ob ^ (((ob >> 9) & 1) << 5)); }
__host__ __device__ __forceinline__ void stage_rc(int b, int& R, int& C) { const int st = b / 1024, sb = b % 1024, swz = sb ^ (((sb >> 9) & 1) << 5); R = (st >> 1) * 16 + swz / 64; C = (st & 1) * 32 + (swz % 64) / 2; }
__host__ __device__ __forceinline__ int perm32(int rho) { const int n = rho >> 4, i = rho & 15; return 8 * (i >> 2) + 4 * n + (i & 3); }

struct Unit { int pm, pn; };
struct Gemm { const bf16_t* A; const bf16_t* Bt; int M, N, K; };

struct StaticOrder {
    int nM, nN, nwg, G, c;
    __host__ __device__ void init(int M, int N, int G_, int c_) { nM = M / BM; nN = N / BM; nwg = nM * nN; G = G_; c = c_; }
    __host__ __device__ bool next(int i, Unit& u) const {
        const long L = (long)i * G + c; if (L >= nwg) return false;
        int wgid = (int)L; { const int q = nwg / NXCD, r = nwg % NXCD, xcd = wgid % NXCD, off = wgid / NXCD; wgid = (xcd < r ? xcd * (q + 1) : r * (q + 1) + (xcd - r) * q) + off; }
        const int nig = WGM * nN, gid = wgid / nig, fm = gid * WGM, gsz = (nM - fm) < WGM ? (nM - fm) : WGM;
        u.pm = fm + ((wgid % nig) % gsz); u.pn = (wgid % nig) / gsz; return true;
    }
    __device__ __forceinline__ void a_ready(const Unit&) const {}
    __device__ __forceinline__ void done(const Unit&) const {}
};
__device__ __forceinline__ unsigned cvt_pk_bf16(float lo, float hi) { unsigned r; asm volatile("v_cvt_pk_bf16_f32 %0, %1, %2" : "=v"(r) : "v"(lo), "v"(hi)); return r; }

template <class Epi, class Sched, bool ALIGN_EPI = false, bool SP2 = false, bool GATHER = false>
__device__ __forceinline__ void gemm_phase(PG8_LAS unsigned char* lds, const Gemm g, const Sched& S, const Epi& E, const int wave_id  , const int* arow = nullptr) {
    static_assert(!GATHER || SP2, "GATHER is implemented on the SP2 loop only");
    int lane_ = (int)__builtin_amdgcn_mbcnt_hi(~0u, __builtin_amdgcn_mbcnt_lo(~0u, 0u)); asm volatile("" : "+v"(lane_));
    const int lane = lane_, wid = wave_id, tid = wid * 64 + lane,
               wr = wid >> 2, wc = wid & 3, fr = lane & 15, fq = lane >> 4;
    const int K = g.K, nt = K / BK;
    unsigned voffA[2], voffB[2]; int RA[2]; unsigned CA2[2];
#pragma unroll
    for (int i = 0; i < 2; ++i) { int R, C; stage_rc(tid * 16 + i * 8192, R, C); const int Rb = Epi::PERM ? ((R & ~31) + perm32(R & 31)) : R;
        voffA[i] = (unsigned)(R * K + C) * 2u; voffB[i] = (unsigned)(Rb * K + C) * 2u; RA[i] = R; CA2[i] = (unsigned)C * 2u; }
    unsigned vA[2][2] = {{0u, 0u}, {0u, 0u}}, nvA[2][2] = {{0u, 0u}, {0u, 0u}};
#define PG8_GROWS(dst, U) do { _Pragma("unroll") for (int _h = 0; _h < 2; ++_h) _Pragma("unroll") for (int _i = 0; _i < 2; ++_i) dst[_h][_i] = (unsigned)arow[(U).pm * BM + _h * HALF + RA[_i]] * (unsigned)(K * 2) + CA2[_i]; } while (0)
    const size_t kstep = (size_t)(BK * 2);
    const size_t hstep = (size_t)HALF * K * 2;
    const size_t tstep = 2 * hstep;
    const unsigned ldsw = (unsigned)wid * 1024u;
    const int aoff = lds_byte(wr * 64 + fr, fq * 8), boff = lds_byte(wc * 32 + fr, fq * 8);
#define PG8_SA(b, h) (((b) * 2 + (h)) * HTB)
#define PG8_SB(b, h) ((4 + (b) * 2 + (h)) * HTB)
#define PG8_STAGE(bufoff, gbase, voff) do { _Pragma("unroll") for (int _i = 0; _i < 2; ++_i) \
        __builtin_amdgcn_global_load_lds((const unsigned*)((const char*)(gbase) + (voff)[_i]), (PG8_LAS unsigned*)(lds + (bufoff) + ldsw + _i * 8192), 16, 0, 0); } while (0)
#define PG8_STAGE_A(bufoff, gb, h, nx) do { if constexpr (GATHER) { _Pragma("unroll") for (int _i = 0; _i < 2; ++_i) { const unsigned vo_ = (nx) ? nvA[h][_i] : vA[h][_i]; \
        __builtin_amdgcn_global_load_lds((const unsigned*)((const char*)(gb) + vo_), (PG8_LAS unsigned*)(lds + (bufoff) + ldsw + _i * 8192), 16, 0, 0); } } else { PG8_STAGE(bufoff, (gb) + (h) * hstep, voffA); } } while (0)
#define PG8_LDA(dst, b, h) do { _Pragma("unroll") for (int m = 0; m < 4; ++m) _Pragma("unroll") for (int k = 0; k < 2; ++k) dst[m][k] = *(const PG8_LAS bf16x8*)(lds + PG8_SA(b, h) + aoff + m * 2048 + k * 1024); } while (0)
#define PG8_LDB(dst, b, h) do { _Pragma("unroll") for (int n = 0; n < 2; ++n) _Pragma("unroll") for (int k = 0; k < 2; ++k) dst[n][k] = *(const PG8_LAS bf16x8*)(lds + PG8_SB(b, h) + boff + n * 2048 + k * 1024); } while (0)
#define PG8_MMA(ai, bj, At, Bt) do { __builtin_amdgcn_s_setprio(1); _Pragma("unroll") for (int m = 0; m < 4; ++m) _Pragma("unroll") for (int n = 0; n < 2; ++n) _Pragma("unroll") for (int k = 0; k < 2; ++k) \
        acc[ai][bj][m][n] = __builtin_amdgcn_mfma_f32_16x16x32_bf16(Bt[n][k], At[m][k], acc[ai][bj][m][n], 0, 0, 0); __builtin_amdgcn_s_setprio(0); } while (0)
#define PG8_WAIT_V(n) asm volatile("s_waitcnt vmcnt(" #n ")" ::: "memory")
#define PG8_WAIT_L(n) asm volatile("s_waitcnt lgkmcnt(" #n ")" ::: "memory")
#define PG8_BAR __builtin_amdgcn_s_barrier()
#define PG8_SCHED __builtin_amdgcn_sched_barrier(0)
    Unit cur, nxt; int ui = 0;
    if (!S.next(0, cur)) return;
    f32x4 acc[2][2][4][2];
#pragma unroll
    for (int a = 0; a < 2; ++a)
#pragma unroll
        for (int b = 0; b < 2; ++b)
#pragma unroll
            for (int m = 0; m < 4; ++m)
#pragma unroll
                for (int n = 0; n < 2; ++n) acc[a][b][m][n] = (f32x4){0.f, 0.f, 0.f, 0.f};
    bf16x8 At[4][2], B0[2][2], B1[2][2];
    const char* cA = (const char*)g.A + (GATHER ? (size_t)0 : (size_t)cur.pm * tstep); const char* cB = (const char*)g.Bt + (size_t)cur.pn * tstep;
    if constexpr (GATHER) PG8_GROWS(vA, cur);
    S.a_ready(cur);
    if constexpr (SP2) {
        PG8_STAGE(PG8_SB(0, 0), cB, voffB); PG8_STAGE(PG8_SB(0, 1), cB + hstep, voffB); PG8_STAGE_A(PG8_SA(0, 0), cA, 0, false); PG8_STAGE_A(PG8_SA(0, 1), cA, 1, false);
        if (wr == 1) PG8_BAR;
        PG8_WAIT_V(2); PG8_BAR;
        PG8_STAGE(PG8_SB(1, 0), cB + kstep, voffB); PG8_STAGE_A(PG8_SA(1, 0), cA + kstep, 0, false); PG8_STAGE(PG8_SB(1, 1), cB + hstep + kstep, voffB);
        PG8_WAIT_V(6); PG8_BAR;
    } else {
        PG8_STAGE(PG8_SB(0, 0), cB, voffB); PG8_STAGE(PG8_SA(0, 0), cA, voffA); PG8_STAGE(PG8_SB(0, 1), cB + hstep, voffB); PG8_STAGE(PG8_SA(0, 1), cA + hstep, voffA);
        if (wr == 1) PG8_BAR;
        PG8_WAIT_V(4); PG8_BAR;
        PG8_STAGE(PG8_SB(1, 0), cB + kstep, voffB); PG8_STAGE(PG8_SA(1, 0), cA + kstep, voffA); PG8_STAGE(PG8_SB(1, 1), cB + hstep + kstep, voffB);
        PG8_WAIT_V(6); PG8_BAR;
    }
    for (;;) {
        const bool has_next = S.next(ui + 1, nxt);
        const char* nA = (has_next && !GATHER) ? (const char*)g.A + (size_t)nxt.pm * tstep : cA; const char* nB = has_next ? (const char*)g.Bt + (size_t)nxt.pn * tstep : cB;
        if constexpr (GATHER) { if (has_next) PG8_GROWS(nvA, nxt); else { nvA[0][0] = vA[0][0]; nvA[0][1] = vA[0][1]; nvA[1][0] = vA[1][0]; nvA[1][1] = vA[1][1]; } }
        for (int t = 0; t < nt; t += 2) {
            const bool last = (t == nt - 2);
            const char* a1 = cA + (size_t)(t + 1) * kstep;
            const char* a2 = last ? nA : cA + (size_t)(t + 2) * kstep; const char* b2 = last ? nB : cB + (size_t)(t + 2) * kstep;
            const char* a3 = a2 + kstep; const char* b3 = b2 + kstep;
            if (last && has_next) S.a_ready(nxt);
            if constexpr (SP2) {
            PG8_LDB(B0, 0, 0); PG8_LDB(B1, 0, 1); PG8_SCHED; PG8_LDA(At, 0, 0); PG8_STAGE_A(PG8_SA(1, 1), a1, 1, false);
            PG8_WAIT_V(8); PG8_WAIT_L(0); PG8_BAR; PG8_MMA(0, 0, At, B0); PG8_MMA(0, 1, At, B1); PG8_BAR; PG8_SCHED;
            PG8_LDA(At, 0, 1); PG8_STAGE(PG8_SB(0, 0), b2, voffB); PG8_STAGE(PG8_SB(0, 1), b2 + hstep, voffB); PG8_STAGE_A(PG8_SA(0, 0), a2, 0, last);
            PG8_WAIT_V(8); PG8_WAIT_L(0); PG8_BAR; PG8_MMA(1, 0, At, B0); PG8_MMA(1, 1, At, B1); PG8_BAR; PG8_SCHED;
            PG8_LDB(B0, 1, 0); PG8_LDB(B1, 1, 1); PG8_SCHED; PG8_LDA(At, 1, 0); PG8_STAGE_A(PG8_SA(0, 1), a2, 1, last);
            PG8_WAIT_V(8); PG8_WAIT_L(0); PG8_BAR; PG8_MMA(0, 0, At, B0); PG8_MMA(0, 1, At, B1); PG8_BAR; PG8_SCHED;
            PG8_LDA(At, 1, 1); PG8_STAGE(PG8_SB(1, 0), b3, voffB); PG8_STAGE(PG8_SB(1, 1), b3 + hstep, voffB); PG8_STAGE_A(PG8_SA(1, 0), a3, 0, last);
            PG8_WAIT_V(8); PG8_WAIT_L(0); PG8_BAR; PG8_MMA(1, 0, At, B0); PG8_MMA(1, 1, At, B1); PG8_BAR; PG8_SCHED;
            } else {
            PG8_LDB(B0, 0, 0); PG8_SCHED; PG8_LDA(At, 0, 0); PG8_STAGE(PG8_SA(1, 1), a1 + hstep, voffA);
            PG8_WAIT_L(8); PG8_BAR; PG8_WAIT_L(0); PG8_MMA(0, 0, At, B0); PG8_BAR; PG8_SCHED;
            PG8_LDB(B1, 0, 1); PG8_STAGE(PG8_SB(0, 0), b2, voffB);
            PG8_BAR; PG8_WAIT_L(0); PG8_MMA(0, 1, At, B1); PG8_BAR;
            PG8_LDA(At, 0, 1); PG8_STAGE(PG8_SA(0, 0), a2, voffA);
            PG8_BAR; PG8_WAIT_L(0); PG8_MMA(1, 0, At, B0); PG8_BAR; PG8_SCHED;
            PG8_STAGE(PG8_SB(0, 1), b2 + hstep, voffB);
            PG8_WAIT_V(6); PG8_BAR; PG8_MMA(1, 1, At, B1); PG8_BAR;
            PG8_LDB(B0, 1, 0); PG8_SCHED; PG8_LDA(At, 1, 0); PG8_STAGE(PG8_SA(0, 1), a2 + hstep, voffA);
            PG8_WAIT_L(8); PG8_BAR; PG8_WAIT_L(0); PG8_MMA(0, 0, At, B0); PG8_BAR; PG8_SCHED;
            PG8_LDB(B1, 1, 1); PG8_STAGE(PG8_SB(1, 0), b3, voffB);
            PG8_BAR; PG8_WAIT_L(0); PG8_MMA(0, 1, At, B1); PG8_BAR;
            PG8_LDA(At, 1, 1); PG8_STAGE(PG8_SA(1, 0), a3, voffA);
            PG8_BAR; PG8_WAIT_L(0); PG8_MMA(1, 0, At, B0); PG8_BAR; PG8_SCHED;
            PG8_STAGE(PG8_SB(1, 1), b3 + hstep, voffB);
            PG8_WAIT_V(6); PG8_BAR; PG8_MMA(1, 1, At, B1); PG8_BAR;
            }
        }
        if constexpr (ALIGN_EPI) { if (wr == 0) PG8_BAR; }
        if constexpr (!Epi::AFTER_DRAIN) { E(acc, cur, wr, wc, fr, fq); S.done(cur); }
        if (!has_next) break;
#pragma unroll
        for (int a = 0; a < 2; ++a)
#pragma unroll
            for (int b = 0; b < 2; ++b)
#pragma unroll
                for (int m = 0; m < 4; ++m)
#pragma unroll
                    for (int n = 0; n < 2; ++n) acc[a][b][m][n] = (f32x4){0.f, 0.f, 0.f, 0.f};
        cur = nxt; cA = nA; cB = nB; ++ui;
        if constexpr (GATHER) { vA[0][0] = nvA[0][0]; vA[0][1] = nvA[0][1]; vA[1][0] = nvA[1][0]; vA[1][1] = nvA[1][1]; }
        if constexpr (ALIGN_EPI) { if (wr == 1) PG8_BAR; }
    }
    PG8_WAIT_V(0);
    if constexpr (!ALIGN_EPI) { if (wr == 0) PG8_BAR; }
    PG8_BAR;
    if constexpr (Epi::AFTER_DRAIN) { E.fused(acc, cur, wr, wc, fr, fq, lds, wid, lane); S.done(cur); }
#undef PG8_SA
#undef PG8_SB
#undef PG8_STAGE
#undef PG8_STAGE_A
#undef PG8_GROWS
#undef PG8_LDA
#undef PG8_LDB
#undef PG8_MMA
#undef PG8_WAIT_V
#undef PG8_WAIT_L
#undef PG8_BAR
#undef PG8_SCHED
}
}

constexpr int NWAVES = 8;
#ifndef MK_PER_PHASE
#define MK_PER_PHASE 0
#endif
#ifndef MK_NAIVE_ATTN
#define MK_NAIVE_ATTN 0
#endif
#ifndef DBG_SKIP_ATTN
#define DBG_SKIP_ATTN 0
#endif
#ifndef DBG_SKIP_MOE
#define DBG_SKIP_MOE 0
#endif
#ifndef DBG_SKIP_MIX
#define DBG_SKIP_MIX 0
#endif
#ifndef DBG_CMP_ATT
#define DBG_CMP_ATT 0
#endif
#ifndef DBG_REP
#define DBG_REP -1
#endif
#ifndef DBG_PROBE
#define DBG_PROBE 0
#endif
constexpr int N_PHASES = 14;

constexpr int BATCH = 2, SEQ = 8192, D = 1024, T = BATCH * SEQ;
constexpr int NH = 8, HD = 64, AW = 512, IDXH = 8, IDXD = 64, TOPK = 256;
constexpr int NIN = 5704, NINP = 5888;
constexpr int NEXP = 32, DEXP = 512;
constexpr int XPROWS = 40960;
constexpr float EPS = 1e-6f;
constexpr float LOG2E = 1.4426950408889634f;
constexpr float C2 = 0.125f * LOG2E;

constexpr size_t MiB = 1u << 20;
constexpr size_t WS_CTL = 0, CTL_ZERO_BYTES = 1 * MiB;
constexpr size_t WS_SMALL = 1 * MiB;
constexpr size_t SM_MOD = WS_SMALL + 0;
constexpr size_t SM_WRT = WS_SMALL + 65536;
constexpr size_t SM_EID = WS_SMALL + 262144;
constexpr size_t SM_EWT = WS_SMALL + 393216;
constexpr size_t SM_SLOT = WS_SMALL + 524288;
constexpr size_t SM_AT = WS_SMALL + 655360;
constexpr size_t WS_WIN = 3 * MiB;
constexpr size_t WS_WA = 15 * MiB, WS_WC = 16 * MiB, WS_WOUT = 17 * MiB;
constexpr size_t WS_H1 = 19 * MiB;
constexpr size_t WS_AC = 19 * MiB, WS_ATT = 35 * MiB;
constexpr size_t WS_Q = 51 * MiB, WS_K = 67 * MiB, WS_V = 83 * MiB, WS_MASK = 83 * MiB, WS_VT = 99 * MiB, WS_QI = 115 * MiB, WS_KI = 131 * MiB;
constexpr size_t WS_WI = 133 * MiB, WS_QL = 133 * MiB + 524288;
constexpr size_t WS_CB = 136 * MiB, WS_U = 152 * MiB, WS_TMPC = 136 * MiB, WS_G = 168 * MiB;
constexpr size_t WS_MERGED = 51 * MiB;
constexpr size_t WS_WGU = 51 * MiB, WS_WD = 115 * MiB;
constexpr size_t WS_HID = 147 * MiB;
constexpr size_t WS_Y = 187 * MiB;
constexpr size_t WS_END = DBG_CMP_ATT ? 300 * MiB : 267 * MiB;
constexpr size_t WS_MASK_DBG = 268 * MiB, WS_ATT2 = 284 * MiB;
constexpr int CW_CMP = 2048;
constexpr int CW_TMO = 0, CW_CODE = 1, CW_KMAX = 64, CW_ECNT = 1024  , CW_BAR = 4096, CW_AROW = 131072  ;

constexpr int RING_OFF = 0, RING_BYTES = 131072;
constexpr int LDSCTL_OFF = RING_BYTES, MISC_OFF = LDSCTL_OFF + 320;
constexpr int LDS_BYTES = 147456;

#define GAS __attribute__((address_space(1)))
#define LAS __attribute__((address_space(3)))
typedef unsigned short bf16;
typedef unsigned v4u __attribute__((ext_vector_type(4)));
typedef unsigned v2u __attribute__((ext_vector_type(2)));
typedef float f32x4 __attribute__((ext_vector_type(4)));
typedef short bf16x8 __attribute__((ext_vector_type(8)));
typedef GAS unsigned gu32;
#define RLX_AGENT __ATOMIC_RELAXED, __HIP_MEMORY_SCOPE_AGENT
#define LDS_WAIT() asm volatile("s_waitcnt lgkmcnt(0)" ::: "memory")
#define VM_WAIT() asm volatile("s_waitcnt vmcnt(0)" ::: "memory")
__device__ __forceinline__ unsigned f2bf(float f) { unsigned u = __builtin_bit_cast(unsigned, f); return (u + 0x7fffu + ((u >> 16) & 1u)) >> 16; }
__device__ __forceinline__ unsigned pk2(float lo, float hi) { return f2bf(lo) | (f2bf(hi) << 16); }
__device__ __forceinline__ float bflo(unsigned u) { return __builtin_bit_cast(float, u << 16); }
__device__ __forceinline__ float bfhi(unsigned u) { return __builtin_bit_cast(float, u & 0xffff0000u); }
__device__ __forceinline__ float bf1(bf16 h) { return __builtin_bit_cast(float, (unsigned)h << 16); }
__device__ __forceinline__ float wave_sum(float v) {
#pragma unroll
    for (int o = 1; o < 64; o <<= 1) v += __shfl_xor(v, o);
    return v;
}
#define DPP_F(v, ctrl, row_mask) __builtin_bit_cast(float, __builtin_amdgcn_update_dpp(0, __builtin_bit_cast(int, (v)), (ctrl), (row_mask), 0xf, false))
__device__ __forceinline__ float wave_sum63(float v) {
    v += DPP_F(v, 0x111, 0xf); v += DPP_F(v, 0x112, 0xf); v += DPP_F(v, 0x114, 0xf); v += DPP_F(v, 0x118, 0xf);
    v += DPP_F(v, 0x142, 0xa);
    v += DPP_F(v, 0x143, 0xc);
    return v;
}
__device__ __forceinline__ float wave_sum_all(float v) { return __builtin_bit_cast(float, __builtin_amdgcn_readlane(__builtin_bit_cast(int, wave_sum63(v)), 63)); }
__device__ __forceinline__ float wave_max(float v) {
#pragma unroll
    for (int o = 1; o < 64; o <<= 1) v = fmaxf(v, __shfl_xor(v, o));
    return v;
}

#define XB_TMO      128
#define XB_XCNT(j)  (256  + 64 * (j))
#define XB_XSUB(j)  (1280 + 64 * (j))
#define XB_XGEN(j)  (2304 + 64 * (j))
#define XB_TOP      3328
#define XB_TOPGEN   3392
#define XCD_BAR_WORDS 3456
#define XB_SPIN_CAP (1u << 18)

__device__ __forceinline__ unsigned xb_ld(unsigned* p)              { return __hip_atomic_load(p, __ATOMIC_RELAXED, __HIP_MEMORY_SCOPE_AGENT); }
__device__ __forceinline__ unsigned xb_add(unsigned* p, unsigned v) { return __hip_atomic_fetch_add(p, v, __ATOMIC_RELAXED, __HIP_MEMORY_SCOPE_AGENT); }
__device__ __forceinline__ unsigned xb_xcc_id() { return (unsigned)__builtin_amdgcn_s_getreg((3 << 11) | 20) & 0xFu; }
#define XB_SPIN(cond, bar) do { unsigned _sp = 0; while (cond) { __builtin_amdgcn_s_sleep(1); \
    if ((++_sp & 255u) == 0u) { if (xb_ld(&(bar)[XB_TMO])) break; if (_sp > XB_SPIN_CAP) { atomicAdd(&(bar)[XB_TMO], 1u); break; } } } } while (0)

struct XcdBarrier { unsigned* bar; unsigned x; volatile LAS unsigned* st; };

__device__ __forceinline__ XcdBarrier xcd_barrier_post(unsigned* bar, volatile LAS unsigned* st) {
    XcdBarrier b; b.bar = bar; b.x = xb_xcc_id(); b.st = st;
    if (threadIdx.x == 0) (void)xb_add(&bar[XB_XCNT(b.x)], 1u);
    return b;
}
__device__ __forceinline__ void xcd_barrier_complete(unsigned* bar, unsigned x, unsigned& nloc, unsigned& nx) {
    const unsigned G = gridDim.x * gridDim.y * gridDim.z;
    unsigned sum, cnt, mine, sp = 0u;
    for (;;) {
        sum = 0u; cnt = 0u; mine = 0u;
#pragma unroll
        for (unsigned j = 0; j < 16; ++j) { const unsigned c = xb_ld(&bar[XB_XCNT(j)]); sum += c; cnt += (c > 0u) ? 1u : 0u; mine = (j == x) ? c : mine; }
        if (sum == G) break;
        __builtin_amdgcn_s_sleep(1);
        if ((++sp & 255u) == 0u) { if (xb_ld(&bar[XB_TMO])) break; if (sp > XB_SPIN_CAP) { atomicAdd(&bar[XB_TMO], 1u); break; } }
    }
    nloc = mine > 0u ? mine : 1u; nx = cnt > 0u ? cnt : 1u;
}
__device__ __forceinline__ void xcd_barrier(const XcdBarrier& b, const bool is_t0  ) {
    asm volatile("s_waitcnt vmcnt(0)" ::: "memory");
    __syncthreads();
    if (is_t0) {
        unsigned* bar = b.bar;
        __builtin_amdgcn_s_waitcnt(0);
        unsigned nloc = b.st[0], nx = b.st[1];
        if (nloc == 0u) { xcd_barrier_complete(bar, b.x, nloc, nx); b.st[0] = nloc; b.st[1] = nx; }
        const unsigned old = xb_add(&bar[XB_XSUB(b.x)], 1u);
        const unsigned gen = old / nloc;
        if (old + 1u == (gen + 1u) * nloc) {
            __builtin_amdgcn_fence(__ATOMIC_RELEASE, "agent");
            asm volatile("s_waitcnt vmcnt(0)" ::: "memory");
            const unsigned og = xb_add(&bar[XB_TOP], 1u);
            const unsigned tg = og / nx;
            if (og + 1u == (tg + 1u) * nx) xb_add(&bar[XB_TOPGEN], 1u);
            else XB_SPIN(xb_ld(&bar[XB_TOPGEN]) == tg, bar);
            __builtin_amdgcn_fence(__ATOMIC_ACQUIRE, "agent");
            xb_add(&bar[XB_XGEN(b.x)], 1u);
            asm volatile("s_waitcnt vmcnt(0)" ::: "memory");
        } else {
            XB_SPIN(xb_ld(&bar[XB_XGEN(b.x)]) == gen, bar);
            __builtin_amdgcn_fence(__ATOMIC_ACQUIRE, "agent");
            asm volatile("s_waitcnt vmcnt(0)" ::: "memory");
        }
    }
    __syncthreads();
}

struct Frame {
    LAS unsigned char* lds;
    volatile LAS unsigned* MISC;
    gu32* ctl;
    unsigned char* ws;
    int tid, lane, wave;
    int vcu, G;
    const float *x, *c, *w_ada, *b_ada, *norm1_g, *w_in, *rel_bias, *conv_w, *w_attn, *w_conv, *w_out, *norm2_g, *wrg, *brg, *wre, *bre, *w_gate_e, *w_up_e, *w_down_e, *norm_f_g;
    float* out;
};
#define WSP(T_, off) ((T_*)(F.ws + (off)))

template <class RowMap>
__device__ __forceinline__ void transpose_item(const float* W, int K, int N, bf16* WT, LAS float* scr, int item, int lane, RowMap rm) {
    const int nblk = (N + 31) / 32, kb = item / nblk, nb = item % nblk, k0 = 64 * kb, n0 = 32 * nb;
    const int c4 = (lane & 7) * 4, rr = lane >> 3;
    f32x4 v[8];
#pragma unroll
    for (int i = 0; i < 8; ++i) v[i] = (n0 + c4 < N) ? *(const f32x4*)(W + (size_t)(k0 + 8 * i + rr) * N + n0 + c4) : (f32x4){0.f, 0.f, 0.f, 0.f};
#pragma unroll
    for (int i = 0; i < 8; ++i) { LAS float* d = scr + (8 * i + rr) * 33 + c4; d[0] = v[i][0]; d[1] = v[i][1]; d[2] = v[i][2]; d[3] = v[i][3]; }
    LDS_WAIT(); asm volatile("" ::: "memory");
    const int c = lane & 7;
#pragma unroll
    for (int j = 0; j < 4; ++j) { const int n = (lane >> 3) + 8 * j; const LAS float* s = scr + (8 * c) * 33 + n;
        v4u o; o.x = pk2(s[0 * 33], s[1 * 33]); o.y = pk2(s[2 * 33], s[3 * 33]); o.z = pk2(s[4 * 33], s[5 * 33]); o.w = pk2(s[6 * 33], s[7 * 33]);
        if (n0 + n < N) *(GAS v4u*)(WT + (size_t)rm(n0 + n) * K + k0 + 8 * c) = o; }
    LDS_WAIT(); asm volatile("" ::: "memory");
}
struct RmId { __device__ __forceinline__ int operator()(int n) const { return n; } };
struct RmWin { __device__ __forceinline__ int operator()(int n) const {
    if (n < 2120) return n;
    if (n < 2632) return n + 184;
    if (n < 3144) { const int j = n - 2632; return 2816 + 256 * (j >> 7) + (j & 127); }
    if (n < 3656) { const int j = n - 3144; return 2816 + 256 * (j >> 7) + 128 + (j & 127); }
    return n + 184; } };
struct RmGU { int half; __device__ __forceinline__ int operator()(int n) const { return 256 * (n >> 7) + 128 * half + (n & 127); } };

__device__ __forceinline__ void p0_prologue(Frame& F) {
    LAS float* scr = (LAS float*)(F.lds + RING_OFF + F.wave * 16384);
    const int gw = F.vcu * NWAVES + F.wave, NGW = F.G * NWAVES;
    if (F.vcu < 96) {
        const int n = F.vcu * 64 + F.lane; float a0 = 0.f, a1 = 0.f;
        LAS float* cact = (LAS float*)(F.lds + RING_OFF + 16384);
        for (int i = F.tid; i < 2 * D; i += 512) { const float cv = F.c[i]; cact[i] = cv / (1.f + __expf(-cv)); }
        __syncthreads();
#pragma unroll 16
        for (int k = F.wave * 128; k < F.wave * 128 + 128; ++k) {
            const float w = F.w_ada[(size_t)k * 6144 + n];
            a0 += cact[k] * w; a1 += cact[D + k] * w;
        }
        LAS float* red = (LAS float*)(F.lds + RING_OFF + 8448);
        red[(F.wave * 2 + 0) * 64 + F.lane] = a0; red[(F.wave * 2 + 1) * 64 + F.lane] = a1;
        __syncthreads();
        if (F.wave < 2) { float s = F.b_ada[n];
#pragma unroll
            for (int w = 0; w < 8; ++w) s += red[(w * 2 + F.wave) * 64 + F.lane];
            WSP(float, SM_MOD)[F.wave * 6144 + n] = s; }
        __syncthreads();
    }
    constexpr int I_IN = 16 * 179;
    for (int it = gw; it < I_IN; it += NGW) transpose_item(F.w_in, D, NIN, WSP(bf16, WS_WIN), scr, it, F.lane, RmWin());
    for (int i = gw * 64 + F.lane; i < 184 * 128; i += NGW * 64) { *(GAS v4u*)(WSP(bf16, WS_WIN) + (size_t)2120 * D + (size_t)i * 8) = (v4u){0u, 0u, 0u, 0u}; }
    for (int i = gw * 64 + F.lane; i < 36 * D; i += NGW * 64) { const int n = i / D, k = i % D; WSP(float, SM_WRT)[i] = (n < 4) ? F.wrg[k * 4 + n] : F.wre[k * 32 + (n - 4)]; }
}

__device__ __forceinline__ void p1_norm1(Frame& F) {
    const int gw = F.vcu * NWAVES + F.wave, NGW = F.G * NWAVES;
    const float* mod = WSP(float, SM_MOD);
    for (int m0 = gw * 4; m0 < T; m0 += NGW * 4) {
        const int b = m0 / SEQ;
        f32x4 v[4][4]; float ss[4];
#pragma unroll
        for (int r = 0; r < 4; ++r) { const GAS f32x4* xr = (const GAS f32x4*)(F.x + (size_t)(m0 + r) * D) + F.lane;
#pragma unroll
            for (int j = 0; j < 4; ++j) v[r][j] = xr[64 * j]; }
#pragma unroll
        for (int r = 0; r < 4; ++r) { float s = 0.f;
#pragma unroll
            for (int j = 0; j < 4; ++j) s += (v[r][j].x * v[r][j].x + v[r][j].y * v[r][j].y) + (v[r][j].z * v[r][j].z + v[r][j].w * v[r][j].w);
            ss[r] = 1.f / sqrtf(wave_sum_all(s) * (1.f / D) + EPS); }
#pragma unroll
        for (int j = 0; j < 4; ++j) { const int k = 4 * F.lane + 256 * j;
            const f32x4 g = *(const f32x4*)(F.norm1_g + k), sc = *(const f32x4*)(mod + b * 6144 + 1024 + k), sh = *(const f32x4*)(mod + b * 6144 + k);
            const f32x4 ca = g * (sc + 1.0f);
#pragma unroll
            for (int r = 0; r < 4; ++r) { const f32x4 h = v[r][j] * ss[r] * ca + sh; ((GAS v2u*)(WSP(bf16, WS_H1) + (size_t)(m0 + r) * D) + F.lane)[64 * j] = (v2u){pk2(h.x, h.y), pk2(h.z, h.w)}; } }
    }
}

using pg8::Unit;
typedef float f32x2_t __attribute__((ext_vector_type(2))); typedef __bf16 bf16x2_t __attribute__((ext_vector_type(2)));
__device__ __forceinline__ unsigned cvtpk(float lo, float hi) { f32x2_t v = {lo, hi}; bf16x2_t b = __builtin_convertvector(v, bf16x2_t); return __builtin_bit_cast(unsigned, b); }
__device__ __forceinline__ v4u pack8(const f32x4 a, const f32x4 b) { v4u w; w.x = cvtpk(a[0], a[1]); w.y = cvtpk(a[2], a[3]); w.z = cvtpk(b[0], b[1]); w.w = cvtpk(b[2], b[3]); return w; }
__device__ __forceinline__ float sigmoidf_(float x) { return __builtin_amdgcn_rcpf(1.f + __builtin_amdgcn_exp2f(-x * LOG2E)); }
__device__ __forceinline__ f32x4 sig4(f32x4 v) { return (f32x4){sigmoidf_(v[0]), sigmoidf_(v[1]), sigmoidf_(v[2]), sigmoidf_(v[3])}; }
__device__ __forceinline__ void unpack8(const v4u w, f32x4& a, f32x4& b) { a = (f32x4){bflo(w.x), bfhi(w.x), bflo(w.y), bfhi(w.y)}; b = (f32x4){bflo(w.z), bfhi(w.z), bflo(w.w), bfhi(w.w)}; }

struct EpiProj {
    static constexpr bool PERM = true, AFTER_DRAIN = false;
    bf16 *Q, *K, *V, *QI, *KI, *CB, *U, *G; float* WI;
    __device__ __forceinline__ void operator()(const f32x4 (&acc)[2][2][4][2], const Unit& u, int wr, int wc, int fr, int fq) const {
        const int pn = u.pn, row0 = u.pm * 256 + wr * 64 + fr, cb8 = wc * 32 + 8 * fq;
        if (pn < 8 || pn == 9 || pn == 10) {
            bf16* base; int coff; float sc = 1.f;
            if (pn < 2) { base = Q; coff = 256 * pn; sc = C2; } else if (pn < 4) { base = K; coff = 256 * (pn - 2); } else if (pn < 6) { base = V; coff = 256 * (pn - 4); }
            else if (pn < 8) { base = QI; coff = 256 * (pn - 6); } else { base = CB; coff = 256 * (pn - 9); }
#pragma unroll
            for (int ai = 0; ai < 2; ++ai)
#pragma unroll
                for (int m = 0; m < 4; ++m) { bf16* rowp = base + (size_t)(row0 + ai * 128 + m * 16) * 512 + coff + cb8;
#pragma unroll
                    for (int bj = 0; bj < 2; ++bj) *(v4u*)(rowp + bj * 128) = pack8(acc[ai][bj][m][0] * sc, acc[ai][bj][m][1] * sc); }
        } else if (pn == 8) {
#pragma unroll
            for (int ai = 0; ai < 2; ++ai)
#pragma unroll
                for (int m = 0; m < 4; ++m) { const size_t row = (size_t)(row0 + ai * 128 + m * 16);
                    if (wc < 2) *(v4u*)(KI + row * 64 + cb8) = pack8(acc[ai][0][m][0], acc[ai][0][m][1]);
                    else if (wc == 2 && fq == 0) { *(f32x4*)(WI + row * 8) = acc[ai][0][m][0]; *(f32x4*)(WI + row * 8 + 4) = acc[ai][0][m][1]; } }
        } else if (pn < 15) {
#pragma unroll
            for (int ai = 0; ai < 2; ++ai)
#pragma unroll
                for (int m = 0; m < 4; ++m) { const size_t row = (size_t)(row0 + ai * 128 + m * 16);
                    *(v4u*)(U + row * 512 + 128 * (pn - 11) + cb8) = pack8(acc[ai][0][m][0] * acc[ai][1][m][0], acc[ai][0][m][1] * acc[ai][1][m][1]); }
        } else {
#pragma unroll
            for (int ai = 0; ai < 2; ++ai)
#pragma unroll
                for (int m = 0; m < 4; ++m) { bf16* rowp = G + (size_t)(row0 + ai * 128 + m * 16) * 2048 + 256 * (pn - 15) + cb8;
#pragma unroll
                    for (int bj = 0; bj < 2; ++bj) *(v4u*)(rowp + bj * 128) = pack8(sig4(acc[ai][bj][m][0]), sig4(acc[ai][bj][m][1])); }
        }
    }
};
struct EpiConv {
    static constexpr bool PERM = true, AFTER_DRAIN = false;
    const bf16* G; bf16* O;
    __device__ __forceinline__ void operator()(const f32x4 (&acc)[2][2][4][2], const Unit& u, int wr, int wc, int fr, int fq) const {
        const int row0 = u.pm * 256 + wr * 64 + fr, col0 = u.pn * 256 + wc * 32 + 8 * fq;
#pragma unroll
        for (int ai = 0; ai < 2; ++ai)
#pragma unroll
            for (int m = 0; m < 4; ++m) { const size_t row = (size_t)(row0 + ai * 128 + m * 16);
#pragma unroll
                for (int bj = 0; bj < 2; ++bj) { f32x4 g0, g1; unpack8(*(const v4u*)(G + row * 2048 + 1024 + col0 + bj * 128), g0, g1);
                    *(v4u*)(O + row * 1024 + col0 + bj * 128) = pack8(g0 * acc[ai][bj][m][0], g1 * acc[ai][bj][m][1]); } }
    }
};
struct EpiAttn {
    static constexpr bool PERM = true, AFTER_DRAIN = false;
    const bf16* G; const bf16* Tc; bf16* O;
    __device__ __forceinline__ void operator()(const f32x4 (&acc)[2][2][4][2], const Unit& u, int wr, int wc, int fr, int fq) const {
        const int row0 = u.pm * 256 + wr * 64 + fr, col0 = u.pn * 256 + wc * 32 + 8 * fq;
#pragma unroll
        for (int ai = 0; ai < 2; ++ai)
#pragma unroll
            for (int m = 0; m < 4; ++m) { const size_t row = (size_t)(row0 + ai * 128 + m * 16);
#pragma unroll
                for (int bj = 0; bj < 2; ++bj) { f32x4 g0, g1, t0, t1; unpack8(*(const v4u*)(G + row * 2048 + col0 + bj * 128), g0, g1); unpack8(*(const v4u*)(Tc + row * 1024 + col0 + bj * 128), t0, t1);
                    *(v4u*)(O + row * 1024 + col0 + bj * 128) = pack8(g0 * acc[ai][bj][m][0] + t0, g1 * acc[ai][bj][m][1] + t1); } }
    }
};
struct ChainOrder {
    pg8::StaticOrder so;
    __device__ __forceinline__ bool next(int i, Unit& u) const { Unit uc; if (!so.next(i >> 1, uc)) return false;
        if ((i & 1) == 0) { u.pm = uc.pm; u.pn = 4 + uc.pn; } else { u.pm = T / 256 + uc.pm; u.pn = uc.pn; } return true; }
    __device__ __forceinline__ void a_ready(const Unit&) const {}
    __device__ __forceinline__ void done(const Unit&) const {}
};
struct EpiChain {
    static constexpr bool PERM = true, AFTER_DRAIN = false;
    const bf16* G; bf16* Tc; bf16* O;
    __device__ __forceinline__ void operator()(const f32x4 (&acc)[2][2][4][2], const Unit& u, int wr, int wc, int fr, int fq) const {
        const bool conv = u.pn >= 4;
        const int row0 = (conv ? u.pm : u.pm - T / 256) * 256 + wr * 64 + fr, col0 = (u.pn & 3) * 256 + wc * 32 + 8 * fq;
#pragma unroll
        for (int ai = 0; ai < 2; ++ai)
#pragma unroll
            for (int m = 0; m < 4; ++m) { const size_t row = (size_t)(row0 + ai * 128 + m * 16);
#pragma unroll
                for (int bj = 0; bj < 2; ++bj) {
                    if (conv) { f32x4 g0, g1; unpack8(*(const v4u*)(G + row * 2048 + 1024 + col0 + bj * 128), g0, g1);
                        *(v4u*)(Tc + row * 1024 + col0 + bj * 128) = pack8(g0 * acc[ai][bj][m][0], g1 * acc[ai][bj][m][1]); }
                    else { f32x4 g0, g1, t0, t1; unpack8(*(const v4u*)(G + row * 2048 + col0 + bj * 128), g0, g1); unpack8(*(const v4u*)(Tc + row * 1024 + col0 + bj * 128), t0, t1);
                        *(v4u*)(O + row * 1024 + col0 + bj * 128) = pack8(g0 * acc[ai][bj][m][0] + t0, g1 * acc[ai][bj][m][1] + t1); } } }
    }
};
struct EpiOut {
    static constexpr bool PERM = false, AFTER_DRAIN = false;
    const float* X; const float* mod; float* O;
    __device__ __forceinline__ void operator()(const f32x4 (&acc)[2][2][4][2], const Unit& u, int wr, int wc, int fr, int fq) const {
        const int row0 = u.pm * 256 + wr * 64 + fr, col0 = u.pn * 256 + wc * 32 + 4 * fq;
        const float* g1 = mod + ((u.pm * 256) / SEQ) * 6144 + 2048;
#pragma unroll
        for (int bj = 0; bj < 2; ++bj)
#pragma unroll
            for (int n = 0; n < 2; ++n) { const int col = col0 + bj * 128 + n * 16; const f32x4 gv = *(const f32x4*)(g1 + col);
#pragma unroll
                for (int ai = 0; ai < 2; ++ai)
#pragma unroll
                    for (int m = 0; m < 4; ++m) { const size_t off = (size_t)(row0 + ai * 128 + m * 16) * D + col;
                        *(f32x4*)(O + off) = *(const f32x4*)(X + off) + gv * acc[ai][bj][m][n]; } }
    }
};
__device__ __forceinline__ f32x4 silu_mul4(f32x4 g, f32x4 u) { return (f32x4){g[0] * sigmoidf_(g[0]) * u[0], g[1] * sigmoidf_(g[1]) * u[1], g[2] * sigmoidf_(g[2]) * u[2], g[3] * sigmoidf_(g[3]) * u[3]}; }
struct EpiHid {
    static constexpr bool PERM = true, AFTER_DRAIN = false;
    bf16* O;
    __device__ __forceinline__ void operator()(const f32x4 (&acc)[2][2][4][2], const Unit& u, int wr, int wc, int fr, int fq) const {
        const int row0 = u.pm * 256 + wr * 64 + fr, col0 = 128 * (u.pn & 3) + wc * 32 + 8 * fq;
#pragma unroll
        for (int ai = 0; ai < 2; ++ai)
#pragma unroll
            for (int m = 0; m < 4; ++m) { const size_t row = (size_t)(row0 + ai * 128 + m * 16);
                *(v4u*)(O + row * 512 + col0) = pack8(silu_mul4(acc[ai][0][m][0], acc[ai][1][m][0]), silu_mul4(acc[ai][0][m][1], acc[ai][1][m][1])); }
    }
};
struct EpiY {
    static constexpr bool PERM = true, AFTER_DRAIN = false;
    bf16* O;
    __device__ __forceinline__ void operator()(const f32x4 (&acc)[2][2][4][2], const Unit& u, int wr, int wc, int fr, int fq) const {
        const int row0 = u.pm * 256 + wr * 64 + fr, col0 = 256 * (u.pn & 3) + wc * 32 + 8 * fq;
#pragma unroll
        for (int ai = 0; ai < 2; ++ai)
#pragma unroll
            for (int m = 0; m < 4; ++m) { const size_t row = (size_t)(row0 + ai * 128 + m * 16);
#pragma unroll
                for (int bj = 0; bj < 2; ++bj) *(v4u*)(O + row * 1024 + col0 + bj * 128) = pack8(acc[ai][bj][m][0], acc[ai][bj][m][1]); }
    }
};
struct MoeOrder {
    const LAS int* tile_e; int ntiles, G, c;
    __device__ __forceinline__ bool next(int i, Unit& u) const {
        const int L = i * G + c; if (L >= ntiles * 4) return false;
        const int rt = L >> 2, j = L & 3; u.pm = rt; u.pn = 4 * tile_e[rt] + j; return true; }
    __device__ __forceinline__ void a_ready(const Unit&) const {}
    __device__ __forceinline__ void done(const Unit&) const {}
};

__device__ __forceinline__ void p3_prep(Frame& F) {
    const int gw = F.vcu * NWAVES + F.wave, NGW = F.G * NWAVES;
    for (int rp_ = 0; rp_ < (DBG_REP == 31 ? 3 : 1); ++rp_) {
        LAS bf16* tl = (LAS bf16*)(F.lds + RING_OFF + F.wave * 16384);
        const bf16* V = WSP(bf16, WS_V); bf16* VT = WSP(bf16, WS_VT);
        for (int it = gw; it < BATCH * NH * (SEQ / 64); it += NGW) {
            const int kt = it % (SEQ / 64), h = (it / (SEQ / 64)) % NH, b = it / (NH * (SEQ / 64));
            const bf16* src = V + (size_t)(b * SEQ + kt * 64 + F.lane) * 512 + h * 64;
#pragma unroll
            for (int c = 0; c < 8; ++c) { const v4u w = *(const v4u*)(src + c * 8);
                LAS unsigned* d = (LAS unsigned*)(tl + F.lane * 66 + c * 8); d[0] = w.x; d[1] = w.y; d[2] = w.z; d[3] = w.w; }
            LDS_WAIT(); asm volatile("" ::: "memory");
            unsigned o[32];
#pragma unroll
            for (int p = 0; p < 64; p += 2) {
                const int i0 = p & 15, i1 = (p + 1) & 15, g = p & ~15;
                const int k0 = g + ((i0 < 4 || i0 >= 12) ? i0 : (i0 < 8 ? i0 + 4 : i0 - 4)), k1 = g + ((i1 < 4 || i1 >= 12) ? i1 : (i1 < 8 ? i1 + 4 : i1 - 4));
                o[p >> 1] = (unsigned)tl[k0 * 66 + F.lane] | ((unsigned)tl[k1 * 66 + F.lane] << 16); }
            bf16* dst = VT + ((size_t)((b * NH + h) * 64 + F.lane)) * SEQ + kt * 64;
#pragma unroll
            for (int c = 0; c < 8; ++c) *(v4u*)(dst + c * 8) = (v4u){o[4 * c], o[4 * c + 1], o[4 * c + 2], o[4 * c + 3]};
            LDS_WAIT(); asm volatile("" ::: "memory");
        }
    }
    for (int rp_ = 0; rp_ < (DBG_REP == 32 ? 3 : 1); ++rp_) {
        const bf16* CB = WSP(bf16, WS_CB); const bf16* U = WSP(bf16, WS_U); bf16* AC = WSP(bf16, WS_AC);
        const int j = F.lane * 8;
        const f32x4 w2a = *(const f32x4*)(F.conv_w + 1024 + j), w2b = *(const f32x4*)(F.conv_w + 1024 + j + 4), w1a = *(const f32x4*)(F.conv_w + 512 + j), w1b = *(const f32x4*)(F.conv_w + 512 + j + 4),
                    w0a = *(const f32x4*)(F.conv_w + j), w0b = *(const f32x4*)(F.conv_w + j + 4);
        for (int t0 = gw * 8; t0 < T; t0 += NGW * 8) {
            v4u cw[8], uw[10];
#pragma unroll
            for (int r = 0; r < 8; ++r) cw[r] = *(const v4u*)(CB + (size_t)(t0 + r) * 512 + j);
            const int tt0 = t0 % SEQ;
#pragma unroll
            for (int r = 0; r < 10; ++r) uw[r] = (tt0 + r - 2 >= 0) ? *(const v4u*)(U + (size_t)(t0 + r - 2) * 512 + j) : (v4u){0u, 0u, 0u, 0u};
#pragma unroll
            for (int r = 0; r < 8; ++r) {
                f32x4 c0, c1, a0, a1, b0, b1, d0, d1;
                unpack8(cw[r], c0, c1); unpack8(uw[r + 2], a0, a1); unpack8(uw[r + 1], b0, b1); unpack8(uw[r], d0, d1);
                *(v4u*)(AC + (size_t)(t0 + r) * 512 + j) = pack8(c0 * (a0 * w2a + b0 * w1a + d0 * w0a), c1 * (a1 * w2b + b1 * w1b + d1 * w0b));
            }
        }
    }
    for (int rp_ = 0; rp_ < (DBG_REP == 33 ? 3 : 1); ++rp_) {
        const bf16* QI = WSP(bf16, WS_QI); const float* WI = WSP(float, WS_WI); bf16* QL = WSP(bf16, WS_QL); float* AT = WSP(float, SM_AT);
        for (int t0 = gw * 8; t0 < T; t0 += NGW * 8) {
            v4u qw[8]; float wh[8];
#pragma unroll
            for (int r = 0; r < 8; ++r) { qw[r] = *(const v4u*)(QI + (size_t)(t0 + r) * 512 + F.lane * 8); wh[r] = WI[(size_t)(t0 + r) * 8 + (F.lane >> 3)]; }
#pragma unroll
            for (int r = 0; r < 8; ++r) {
                f32x4 q0, q1; unpack8(qw[r], q0, q1);
                float n2 = (q0[0] * q0[0] + q0[1] * q0[1]) + (q0[2] * q0[2] + q0[3] * q0[3]) + (q1[0] * q1[0] + q1[1] * q1[1]) + (q1[2] * q1[2] + q1[3] * q1[3]);
                n2 += __shfl_xor(n2, 1); n2 += __shfl_xor(n2, 2); n2 += __shfl_xor(n2, 4);
                const float a = wave_sum63(((F.lane & 7) == 0) ? fabsf(wh[r]) * sqrtf(n2) : 0.f);
                f32x4 s0 = q0 * wh[r], s1 = q1 * wh[r];
#pragma unroll
                for (int o = 8; o < 64; o <<= 1) {
#pragma unroll
                    for (int e = 0; e < 4; ++e) { s0[e] += __shfl_xor(s0[e], o); s1[e] += __shfl_xor(s1[e], o); } }
                if (F.lane < 8) *(v4u*)(QL + (size_t)(t0 + r) * 64 + F.lane * 8) = pack8(s0, s1);
                if (F.lane == 63) AT[t0 + r] = a;
            }
        }
    }
    for (int rp_ = 0; rp_ < (DBG_REP == 34 ? 3 : 1); ++rp_) {
        const bf16* KI = WSP(bf16, WS_KI); float mx = 0.f;
        for (int s = gw * 64 + F.lane; s < T; s += NGW * 64) { float q = 0.f;
#pragma unroll
            for (int c = 0; c < 8; ++c) { f32x4 a, b; unpack8(*(const v4u*)(KI + (size_t)s * 64 + c * 8), a, b); q += (a[0] * a[0] + a[1] * a[1]) + (a[2] * a[2] + a[3] * a[3]) + (b[0] * b[0] + b[1] * b[1]) + (b[2] * b[2] + b[3] * b[3]); }
            mx = fmaxf(mx, q); }
        mx = wave_max(mx);
        if (F.lane == 0 && gw * 64 < T) atomicMax((unsigned*)(F.ctl + CW_KMAX + 64 * (gw & 7)), __builtin_bit_cast(unsigned, sqrtf(mx)));
    }
}

__device__ __forceinline__ unsigned ord_key(float x) { if (x == 0.f) x = 0.f; const unsigned u = __builtin_bit_cast(unsigned, x); return (u & 0x80000000u) ? ~u : (u | 0x80000000u); }
__device__ __forceinline__ int t5_bucket(int n) {
    if (n < 16) return n;
    const int v = 16 + (int)(logf((float)n / 16.f) / 2.0794415416798357f * 16.f);
    return v < 31 ? v : 31;
}
__device__ __forceinline__ void pn_naive_dsa(Frame& F) {
    LAS float* sc = (LAS float*)(F.lds + RING_OFF);
    LAS float* qf = (LAS float*)(F.lds + RING_OFF + 32768);
    LAS float* wq = qf + 512;
    LAS unsigned* hist = (LAS unsigned*)(F.lds + RING_OFF + 36864);
    LAS int* sel = (LAS int*)(F.lds + RING_OFF + 40960);
    LAS float* pbuf = (LAS float*)(F.lds + RING_OFF + 45056);
    LAS int* wcnt = (LAS int*)(F.lds + RING_OFF + 53248);
    LAS int* bkt = (LAS int*)(F.lds + RING_OFF + 53248 + 256);
    const bf16* QI = WSP(bf16, WS_QI); const bf16* KI = WSP(bf16, WS_KI); const float* WI = WSP(float, WS_WI);
    const bf16* Qb = WSP(bf16, WS_Q); const bf16* Kb = WSP(bf16, WS_K); const bf16* Vb = WSP(bf16, WS_V); bf16* ATT = WSP(bf16, WS_ATT);
    if (F.tid < 128) bkt[F.tid] = t5_bucket(F.tid);
    __syncthreads();
    for (int qi_ = 0; qi_ < T / F.G + 1; ++qi_) {
        const int qidx = qi_ * F.G + F.vcu; if (qidx >= T) break;
        const int b = qidx / SEQ, t = qidx % SEQ, n = t + 1;
        qf[F.tid] = bf1(QI[(size_t)qidx * 512 + F.tid]);
        if (F.tid < 8) wq[F.tid] = WI[(size_t)qidx * 8 + F.tid];
        __syncthreads();
        for (int s = F.tid; s < n; s += 512) {
            float kf[64]; const bf16* kr = KI + (size_t)(b * SEQ + s) * 64;
#pragma unroll
            for (int c = 0; c < 8; ++c) { f32x4 a, bb; unpack8(*(const v4u*)(kr + c * 8), a, bb); kf[8 * c] = a[0]; kf[8 * c + 1] = a[1]; kf[8 * c + 2] = a[2]; kf[8 * c + 3] = a[3]; kf[8 * c + 4] = bb[0]; kf[8 * c + 5] = bb[1]; kf[8 * c + 6] = bb[2]; kf[8 * c + 7] = bb[3]; }
            float score = 0.f;
#pragma unroll 1
            for (int h = 0; h < 8; ++h) { float dsum = 0.f;
#pragma unroll
                for (int d4 = 0; d4 < 16; ++d4) { const f32x4 q4 = *(const LAS f32x4*)(qf + h * 64 + d4 * 4); dsum += q4[0] * kf[4 * d4] + q4[1] * kf[4 * d4 + 1] + q4[2] * kf[4 * d4 + 2] + q4[3] * kf[4 * d4 + 3]; }
                score += wq[h] * fmaxf(dsum, 0.f); }
            sc[s] = score;
        }
        __syncthreads();
        unsigned prefix = 0u, pmask = 0u; int need = TOPK;
        if (n > TOPK) {
            for (int pass = 0; pass < 4; ++pass) {
                const int shift = 24 - 8 * pass;
                if (F.tid < 256) hist[F.tid] = 0u;
                __syncthreads();
                for (int s = F.tid; s < n; s += 512) { const unsigned u = ord_key(sc[s]); if ((u & pmask) == prefix) atomicAdd((unsigned*)&hist[(u >> shift) & 255u], 1u); }
                __syncthreads();
                if (F.wave == 0) {
                    int c4[4]; int tot = 0;
#pragma unroll
                    for (int j = 0; j < 4; ++j) { c4[j] = (int)hist[4 * F.lane + j]; tot += c4[j]; }
                    int incl = tot;
#pragma unroll
                    for (int o = 1; o < 64; o <<= 1) { const int v = __shfl_down(incl, o); if (F.lane + o < 64) incl += v; }
                    const int above = incl - tot;
                    if (above < need && need <= incl) { int run = above;
#pragma unroll
                        for (int j = 3; j >= 0; --j) { if (run < need && need <= run + c4[j]) { wcnt[16] = 4 * F.lane + j; wcnt[17] = need - run; } run += c4[j]; } }
                }
                __syncthreads();
                prefix |= (unsigned)wcnt[16] << shift; pmask |= 255u << shift; need = wcnt[17];
                __syncthreads();
            }
        }
        int cg = 0, ce = 0;
        for (int i = 0; i < 16; ++i) { const int s = F.wave * 1024 + i * 64 + F.lane; bool gt = false, eq = false;
            if (s < n) { if (n <= TOPK) gt = true; else { const unsigned u = ord_key(sc[s]); gt = u > prefix; eq = (u == prefix); } }
            cg += __popcll(__ballot(gt)); ce += __popcll(__ballot(eq)); }
        if (F.lane == 0) { wcnt[2 * F.wave] = cg; wcnt[2 * F.wave + 1] = ce; }
        __syncthreads();
        int eqb = 0, tkb = 0, nsel = 0;
        { int eq_before = 0;
          for (int w = 0; w < 8; ++w) { const int g = wcnt[2 * w], e = wcnt[2 * w + 1];
              int take_e = need - eq_before; take_e = take_e < 0 ? 0 : (take_e > e ? e : take_e); if (n <= TOPK) take_e = 0;
              if (w < F.wave) { eqb += e; tkb += g + take_e; }
              nsel += g + take_e; eq_before += e; } }
        for (int i = 0; i < 16; ++i) { const int s = F.wave * 1024 + i * 64 + F.lane; bool gt = false, eq = false;
            if (s < n) { if (n <= TOPK) gt = true; else { const unsigned u = ord_key(sc[s]); gt = u > prefix; eq = (u == prefix); } }
            const unsigned long long mg = __ballot(gt), me = __ballot(eq), lt = (1ull << F.lane) - 1ull;
            const int erank = eqb + __popcll(me & lt);
            const bool take = gt || (eq && erank < need);
            const unsigned long long mt = __ballot(take);
            if (take) sel[tkb + __popcll(mt & lt)] = s;
            eqb += __popcll(me); tkb += __popcll(mt); (void)mg; }
        __syncthreads();
        {
            const int h = F.wave;
            qf[F.tid] = bf1(Qb[(size_t)qidx * 512 + F.tid]);
            __syncthreads();
            float lg[4]; float mx = -INFINITY;
#pragma unroll
            for (int i = 0; i < 4; ++i) { const int j = F.lane + 64 * i; lg[i] = -INFINITY;
                if (j < nsel) { const int s = sel[j]; const bf16* kr = Kb + (size_t)(b * SEQ + s) * 512 + h * 64; float dsum = 0.f;
#pragma unroll
                    for (int c = 0; c < 8; ++c) { f32x4 a, bb; unpack8(*(const v4u*)(kr + c * 8), a, bb); const f32x4 q0 = *(const LAS f32x4*)(qf + h * 64 + c * 8), q1 = *(const LAS f32x4*)(qf + h * 64 + c * 8 + 4);
                        dsum += (q0[0] * a[0] + q0[1] * a[1]) + (q0[2] * a[2] + q0[3] * a[3]) + (q1[0] * bb[0] + q1[1] * bb[1]) + (q1[2] * bb[2] + q1[3] * bb[3]); }
                    const int dist = t - s; const int bk = dist < 128 ? bkt[dist] : 31;
                    lg[i] = dsum + F.rel_bias[bk * 8 + h] * LOG2E; mx = fmaxf(mx, lg[i]); } }
            mx = wave_max(mx); float sum = 0.f;
#pragma unroll
            for (int i = 0; i < 4; ++i) { const int j = F.lane + 64 * i; const float p = (j < nsel) ? __builtin_amdgcn_exp2f(lg[i] - mx) : 0.f; sum += p; pbuf[h * 256 + j] = p; }
            sum = wave_sum(sum);
            LDS_WAIT(); asm volatile("" ::: "memory");
            float o = 0.f;
            for (int j = 0; j < nsel; ++j) o += pbuf[h * 256 + j] * bf1(Vb[(size_t)(b * SEQ + sel[j]) * 512 + h * 64 + F.lane]);
            ATT[(size_t)qidx * 512 + h * 64 + F.lane] = (bf16)f2bf(o / sum);
        }
        __syncthreads();
    }
}


typedef float f32x16 __attribute__((ext_vector_type(16)));
#define MFMA32(a, b, c) __builtin_amdgcn_mfma_f32_32x32x16_bf16((a), (b), (c), 0, 0, 0)
__device__ __forceinline__ int crow(int r, int hi) { return (r & 3) + 8 * (r >> 2) + 4 * hi; }
constexpr int IDX_CTL = LDSCTL_OFF + 2048;
constexpr int IDX_CAP = 512;

#define MFMA16(a, b, c) __builtin_amdgcn_mfma_f32_16x16x32_bf16((a), (b), (c), 0, 0, 0)
__device__ __forceinline__ void idx_tile(const bf16x8 (&kf)[4][2], const bf16x8 (&ql)[2], const bf16x8 (&qf)[8][2], const LAS float* w  , float invA, unsigned (&key)[4][4]) {
    float sc[4][4];
#define IDX_MF(D, QF0, QF1) _Pragma("unroll") for (int a = 0; a < 2; ++a) { D[a] = (f32x4){0.f, 0.f, 0.f, 0.f}; D[a] = MFMA16(kf[2 * hf + a][0], QF0, D[a]); D[a] = MFMA16(kf[2 * hf + a][1], QF1, D[a]); }
#define IDX_AC(D, W) do { const float wv_ = (W); _Pragma("unroll") for (int a = 0; a < 2; ++a) _Pragma("unroll") for (int i = 0; i < 4; ++i) { float x_ = __builtin_fmaf(wv_, __builtin_fabsf(D[a][i]), sc[2 * hf + a][i]); asm volatile("" : "+v"(x_)); sc[2 * hf + a][i] = x_; } } while (0)
#pragma unroll
    for (int hf = 0; hf < 2; ++hf) {
        f32x4 dA[2], dB[2];
        IDX_MF(dA, ql[0], ql[1]);
        IDX_MF(dB, qf[0][0], qf[0][1]);
#pragma unroll
        for (int a = 0; a < 2; ++a)
#pragma unroll
            for (int i = 0; i < 4; ++i) { float x_ = dA[a][i]; asm volatile("" : "+v"(x_)); sc[2 * hf + a][i] = x_; }
        IDX_MF(dA, qf[1][0], qf[1][1]); IDX_AC(dB, w[0]);
        IDX_MF(dB, qf[2][0], qf[2][1]); IDX_AC(dA, w[1]);
        IDX_MF(dA, qf[3][0], qf[3][1]); IDX_AC(dB, w[2]);
        IDX_MF(dB, qf[4][0], qf[4][1]); IDX_AC(dA, w[3]);
        IDX_MF(dA, qf[5][0], qf[5][1]); IDX_AC(dB, w[4]);
        IDX_MF(dB, qf[6][0], qf[6][1]); IDX_AC(dA, w[5]);
        IDX_MF(dA, qf[7][0], qf[7][1]); IDX_AC(dB, w[6]);
        IDX_AC(dA, w[7]);
    }
#undef IDX_MF
#undef IDX_AC
#pragma unroll
    for (int a = 0; a < 4; ++a)
#pragma unroll
        for (int i = 0; i < 4; ++i) key[a][i] = __builtin_bit_cast(unsigned, __builtin_fmaf(sc[a][i], invA, 3.0f));
}
__device__ __forceinline__ void idx_load_k(bf16x8 (&kf)[4][2], const bf16* KItile  , unsigned voff  ) {
#pragma unroll
    for (int a = 0; a < 4; ++a)
#pragma unroll
        for (int ks = 0; ks < 2; ++ks) kf[a][ks] = *(const bf16x8*)((const char*)KItile + voff + a * 2048 + ks * 64);
}
template <int MODE>
__device__ __forceinline__ void idx_pass(Frame& F, int ln, const bf16* KIb, unsigned* MASKg, int t0, int nt_idx, int nt_att, const bf16x8 (&ql)[2], const bf16x8 (&qf)[8][2], const LAS float* w, float invA, int b1, unsigned thr) {
    const int qc = ln & 15, fq = ln >> 4, qh = F.wave & 1, kp = F.wave >> 1, ql_ = 16 * qh + qc, t = t0 + ql_;
    LAS unsigned* hrow = (LAS unsigned*)(F.lds + RING_OFF) + ql_ * 1025;
    const int ntl = (MODE >= 2) ? nt_att : nt_idx;
    LAS unsigned* mlds = (LAS unsigned*)(F.lds + RING_OFF);
    LAS unsigned* clist = (LAS unsigned*)(F.lds + RING_OFF + 32768);
    LAS unsigned* ccnt = (LAS unsigned*)(F.lds + IDX_CTL) + 96;
    bf16x8 kcur[4][2];
    const unsigned voff = (unsigned)(qc * 64 + fq * 8) * 2u;
#pragma unroll
    for (int a = 0; a < 4; ++a)
#pragma unroll
        for (int ks = 0; ks < 2; ++ks) kcur[a][ks] = (bf16x8){0, 0, 0, 0, 0, 0, 0, 0};
    if (kp < nt_idx) idx_load_k(kcur, KIb + (size_t)(64 * kp) * 64, voff);
    for (int kt = kp; kt < ntl; kt += 4) {
        unsigned m16 = 0u;
        if (kt < nt_idx) {
            unsigned key[4][4];
            const bool diag = 64 * kt + 63 > t0;
            idx_tile(kcur, ql, qf, w, invA, key);
            if (kt + 4 < nt_idx) idx_load_k(kcur, KIb + (size_t)(64 * (kt + 4)) * 64, voff);
            bool cnd[4] = {false, false, false, false}; unsigned cps[4] = {0u, 0u, 0u, 0u};
#define IDX_TAIL(DIAG) _Pragma("unroll") for (int a = 0; a < 4; ++a) _Pragma("unroll") for (int i = 0; i < 4; ++i) { \
                    const unsigned bits = key[a][i]; const bool valid = (DIAG) ? (64 * kt + 16 * a + 4 * fq + i <= t) : true; \
                    if (MODE == 0) { unsigned val = 1u + __builtin_amdgcn_ubfe(bits, 22, 1) * 65535u; if (DIAG) val = valid ? val : 0u; \
                        __hip_atomic_fetch_add(hrow + __builtin_amdgcn_ubfe(bits, 12, 10), val, __ATOMIC_RELAXED, __HIP_MEMORY_SCOPE_WORKGROUP); } \
                    else if (MODE == 1) { unsigned val = 1u + __builtin_amdgcn_ubfe(bits, 11, 1) * 65535u; val = (valid && (int)__builtin_amdgcn_ubfe(bits, 12, 11) == b1) ? val : 0u; \
                        __hip_atomic_fetch_add(hrow + __builtin_amdgcn_ubfe(bits, 1, 10), val, __ATOMIC_RELAXED, __HIP_MEMORY_SCOPE_WORKGROUP); } \
                    else if (MODE == 2) { if (valid && __builtin_amdgcn_ubfe(bits, 1, 22) >= thr) m16 |= 1u << (4 * a + i); } \
                    else { const int dbin = (int)__builtin_amdgcn_ubfe(bits, 12, 11) - b1;            \
                        if (valid && dbin > 0) m16 |= 1u << (4 * a + i); \
                        cnd[i] = valid && dbin == 0; cps[i] = 0u; \
                        if (cnd[i]) cps[i] = __hip_atomic_fetch_add(ccnt + ql_, 1u, __ATOMIC_RELAXED, __HIP_MEMORY_SCOPE_WORKGROUP);        \
                        if (i == 3) { _Pragma("unroll") for (int i2 = 0; i2 < 4; ++i2)                                                     \
                            if (cnd[i2] && cps[i2] < (unsigned)IDX_CAP) clist[ql_ * IDX_CAP + cps[i2]] = (__builtin_amdgcn_ubfe(key[a][i2], 1, 11) << 18) | ((unsigned)(kt * 64 + (fq & 1) * 32 + ql_) << 5) | (unsigned)(8 * a + 4 * (fq >> 1) + i2); } } }
            if (diag) { IDX_TAIL(true) } else { IDX_TAIL(false) }
#undef IDX_TAIL
        }
        if (MODE >= 2) {
            unsigned word = ((m16 & 0xFu) | ((m16 & 0xF0u) << 4) | ((m16 & 0xF00u) << 8) | ((m16 & 0xF000u) << 12)) << (4 * (fq >> 1));
            word |= (unsigned)__shfl_xor((int)word, 32);
            if (ln < 32) { if (MODE == 2) MASKg[(size_t)kt * 64 + fq * 32 + ql_] = word; else mlds[kt * 64 + fq * 32 + ql_] = word; }
        }
    }
}
template <int LEVEL>
__device__ __forceinline__ void idx_scan(Frame& F, int ln) {
    LAS unsigned* hist = (LAS unsigned*)(F.lds + RING_OFF);
    LAS int* ctl = (LAS int*)(F.lds + IDX_CTL);
#pragma unroll 1
    for (int qi = 0; qi < 4; ++qi) {
        const int q = 4 * F.wave + qi;
        int need = (LEVEL == 0) ? TOPK : TOPK - ctl[32 + q];
        unsigned wv[16]; int toth = 0, totl = 0;
#pragma unroll
        for (int j = 0; j < 16; ++j) { wv[j] = hist[q * 1025 + 16 * ln + j]; toth += (int)(wv[j] >> 16); totl += (int)(wv[j] & 0xffffu); }
        int inclh = toth, incll = totl;
#pragma unroll
        for (int o = 1; o < 64; o <<= 1) { const int vh = __shfl_down(inclh, o), vl = __shfl_down(incll, o); if (ln + o < 64) { inclh += vh; incll += vl; } }
        const int allh = __shfl(inclh, 0);
        { const int above = inclh - toth;
          if (above < need && need <= inclh) { int run = above, B = 0, cab = 0; bool found = false;
#pragma unroll
              for (int j = 15; j >= 0; --j) { const int ch = (int)(wv[j] >> 16); if (!found && need <= run + ch) { found = true; B = 1024 + 16 * ln + j; cab = run; } run += ch; }
              if (LEVEL == 0) { ctl[q] = B; ctl[32 + q] = cab; } else ctl[64 + q] = (ctl[q] << 11) | B; } }
        { const int above = allh + incll - totl;
          if (allh < need && above < need && need <= allh + incll) { int run = above, B = 0, cab = 0; bool found = false;
#pragma unroll
              for (int j = 15; j >= 0; --j) { const int cl = (int)(wv[j] & 0xffffu); if (!found && need <= run + cl) { found = true; B = 16 * ln + j; cab = run; } run += cl; }
              if (LEVEL == 0) { ctl[q] = B; ctl[32 + q] = cab; } else ctl[64 + q] = (ctl[q] << 11) | B; } }
    }
}
__device__ __forceinline__ void idx_select(Frame& F, int ln) {
    LAS unsigned* mlds = (LAS unsigned*)(F.lds + RING_OFF);
    LAS unsigned* clist = (LAS unsigned*)(F.lds + RING_OFF + 32768);
    LAS int* ctl = (LAS int*)(F.lds + IDX_CTL);
#pragma unroll 1
    for (int qi = 0; qi < 4; ++qi) {
        const int q = 4 * F.wave + qi; int nc = ctl[96 + q];
        if (nc > IDX_CAP) { nc = IDX_CAP; if (ln == 0) ctl[128] = 1; }
        const int r = TOPK - ctl[32 + q];
        unsigned e[IDX_CAP / 64]; bool ok[IDX_CAP / 64];
#pragma unroll
        for (int j = 0; j < IDX_CAP / 64; ++j) { ok[j] = ln + 64 * j < nc; e[j] = ok[j] ? clist[q * IDX_CAP + ln + 64 * j] : 0u; }
        unsigned t = 0u;
#pragma unroll 1
        for (int bit = 10; bit >= 0; --bit) { const unsigned tt = t | (1u << bit); int cnt = 0;
#pragma unroll
            for (int j = 0; j < IDX_CAP / 64; ++j) cnt += __popcll(__ballot(ok[j] && (e[j] >> 18) >= tt));
            if (cnt >= r) t = tt; }
#pragma unroll
        for (int j = 0; j < IDX_CAP / 64; ++j) if (ok[j] && (e[j] >> 18) >= t) __hip_atomic_fetch_or(mlds + ((e[j] >> 5) & 8191u), 1u << (e[j] & 31u), __ATOMIC_RELAXED, __HIP_MEMORY_SCOPE_WORKGROUP);
    }
}
__device__ __forceinline__ void p5_indexer(Frame& F, unsigned* MASK) {
    const bf16* QI = WSP(bf16, WS_QI); const bf16* KI = WSP(bf16, WS_KI); const float* WI = WSP(float, WS_WI); const bf16* QL = WSP(bf16, WS_QL); const float* AT = WSP(float, SM_AT);
    float kmax = 0.f;
#pragma unroll
    for (int i = 0; i < 8; ++i) kmax = fmaxf(kmax, __builtin_bit_cast(float, __hip_atomic_load(F.ctl + CW_KMAX + 64 * i, RLX_AGENT)));
    LAS int* ctl = (LAS int*)(F.lds + IDX_CTL);
    for (int p = F.vcu; p < 256; p += F.G) {
        const int b = p >> 7, j = p & 127;
#pragma unroll 1
        for (int side = 0; side < 2; ++side) {
            const int g = side ? j : 255 - j, t0 = 32 * g;
            const int nt_idx = (g + 2) >> 1, nt_att = 4 * (g >> 3) + 4;
            int ln = (int)__builtin_amdgcn_mbcnt_hi(~0u, __builtin_amdgcn_mbcnt_lo(~0u, 0u)); asm volatile("" : "+v"(ln)); const int tid_ = F.wave * 64 + ln;
            const int qc = ln & 15, fq = ln >> 4, ql_ = 16 * (F.wave & 1) + qc;
            const size_t trow = (size_t)b * SEQ + t0 + ql_;
            bf16x8 qf[8][2], ql[2]; float invA; LAS float* w = (LAS float*)(F.lds + IDX_CTL + 1024) + ql_ * 8;
#define IDX_LOADQ() do { \
            _Pragma("unroll") for (int h = 0; h < 8; ++h) _Pragma("unroll") for (int ks = 0; ks < 2; ++ks) qf[h][ks] = *(const bf16x8*)(QI + trow * 512 + h * 64 + ks * 32 + fq * 8); \
            _Pragma("unroll") for (int ks = 0; ks < 2; ++ks) ql[ks] = *(const bf16x8*)(QL + trow * 64 + ks * 32 + fq * 8); \
            { const f32x4 w0 = *(const f32x4*)(WI + trow * 8), w1 = *(const f32x4*)(WI + trow * 8 + 4); *(LAS f32x4*)w = w0; *(LAS f32x4*)(w + 4) = w1; }     \
            { const float a2 = 2.0f * AT[trow] * kmax; invA = a2 > 0.f ? 0.99f / a2 : 0.f; }        \
        } while (0)
            IDX_LOADQ();
            const bf16* KIb = KI + (size_t)b * SEQ * 64;
            unsigned* MASKg = MASK + ((size_t)(b * 256 + g) * 128) * 64;
            for (int i = tid_; i < 8200; i += 512) ((LAS v4u*)(F.lds + RING_OFF))[i] = (v4u){0u, 0u, 0u, 0u};
            if (tid_ < 96) ctl[tid_] = 0;
            __syncthreads();
            idx_pass<0>(F, ln, KIb, MASKg, t0, nt_idx, nt_att, ql, qf, w, invA, 0, 0u);
            __syncthreads();
            idx_scan<0>(F, ln);
            __syncthreads();
            const int b1 = ctl[ql_];
            if (tid_ < 33) ctl[96 + tid_] = 0;
            __syncthreads();
            idx_pass<3>(F, ln, KIb, MASKg, t0, nt_idx, nt_att, ql, qf, w, invA, b1, 0u);
            __syncthreads();
            idx_select(F, ln);
            __syncthreads();
            if (ctl[128] == 0 || DBG_REP == 77) {
                for (int i = tid_; i < nt_att * 64; i += 512) MASKg[i] = ((LAS unsigned*)(F.lds + RING_OFF))[i];
            } else {
                for (int i = tid_; i < 8200; i += 512) ((LAS v4u*)(F.lds + RING_OFF))[i] = (v4u){0u, 0u, 0u, 0u};
                IDX_LOADQ();
                __syncthreads();
                idx_pass<1>(F, ln, KIb, MASKg, t0, nt_idx, nt_att, ql, qf, w, invA, b1, 0u);
                __syncthreads();
                idx_scan<1>(F, ln);
                __syncthreads();
                const unsigned thr = (unsigned)ctl[64 + ql_];
                idx_pass<2>(F, ln, KIb, MASKg, t0, nt_idx, nt_att, ql, qf, w, invA, b1, thr);
            }
            __syncthreads();
#undef IDX_LOADQ
        }
    }
}

__device__ __forceinline__ unsigned sbfe1_(unsigned w, const int bit) { unsigned r; asm("v_bfe_i32 %0, %1, %2, 1" : "=v"(r) : "v"(w), "n"(bit)); return r; }
#define SBFE1(w, bit) sbfe1_((w), (bit))
__device__ __forceinline__ void p6_attention(Frame& F, const unsigned* MASK, bf16* ATTo) {
    const bf16* Qb = WSP(bf16, WS_Q); const bf16* Kb = WSP(bf16, WS_K); const bf16* VT = WSP(bf16, WS_VT);
    constexpr int KTB = 18432, VTB = 17408, SLOT = KTB + VTB;
    LAS unsigned char* Lb = F.lds + RING_OFF;
    LAS float* biasd = (LAS float*)(F.lds + RING_OFF + 2 * SLOT);
    for (int p = F.vcu; p < 256; p += F.G) {
        const int bh = p >> 4, j = p & 15, b = bh >> 3, h = bh & 7;
#pragma unroll 1
        for (int side = 0; side < 2; ++side) {
            const int qb = side ? j : 31 - j, q0 = 256 * qb, NT = 2 * qb + 2;
            int ln = (int)__builtin_amdgcn_mbcnt_hi(~0u, __builtin_amdgcn_mbcnt_lo(~0u, 0u)); asm volatile("" : "+v"(ln));
            const int tid_ = F.wave * 64 + ln, r32 = ln & 31, hi = ln >> 5, lrow = tid_ >> 3, lch = tid_ & 7;
            const int tq = q0 + 32 * F.wave + r32;
            if (tid_ < 128) { const int bk = t5_bucket(tid_); biasd[tid_] = (F.rel_bias[bk * 8 + h] - F.rel_bias[31 * 8 + h]) * LOG2E; }
            const bf16* Kg = Kb + (size_t)(b * SEQ + lrow) * 512 + h * 64 + lch * 8;
            const bf16* Vg = VT + ((size_t)((b * NH + h) * 64 + lrow)) * SEQ + lch * 8;
            const unsigned* Mg = MASK + ((size_t)(b * 256 + 8 * qb + F.wave) * 128) * 64 + ln;
            bf16x8 qf[4];
#pragma unroll
            for (int ks = 0; ks < 4; ++ks) qf[ks] = *(const bf16x8*)(Qb + (size_t)(b * SEQ + tq) * 512 + h * 64 + ks * 16 + hi * 8);
            f32x16 o0, o1, o2;
#pragma unroll
            for (int r = 0; r < 16; ++r) { o0[r] = 0.f; o1[r] = 0.f; o2[r] = 0.f; }
            const bf16x8 ones = (bf16x8){0x3F80, 0x3F80, 0x3F80, 0x3F80, 0x3F80, 0x3F80, 0x3F80, 0x3F80};
            float m_run = 0.f;
            v4u kreg0 = *(const v4u*)(Kg), kreg1 = *(const v4u*)(Kg + (size_t)64 * 512), vreg0 = *(const v4u*)(Vg), vreg1 = *(const v4u*)(Vg + 64);
            unsigned mw0 = Mg[0], mw1 = Mg[64], mwn0 = 0u, mwn1 = 0u;
            *(LAS v4u*)(Lb + lrow * 144 + lch * 16) = kreg0; *(LAS v4u*)(Lb + (64 + lrow) * 144 + lch * 16) = kreg1;
            *(LAS v4u*)(Lb + KTB + lrow * 272 + lch * 16) = vreg0; *(LAS v4u*)(Lb + KTB + lrow * 272 + 128 + lch * 16) = vreg1;
            __syncthreads();
            for (int kt = 0; kt < NT; ++kt) {
                const int buf = kt & 1;
                if (kt + 1 < NT) { const size_t kn = (size_t)(kt + 1) * 128;
                    kreg0 = *(const v4u*)(Kg + kn * 512); kreg1 = *(const v4u*)(Kg + (kn + 64) * 512); vreg0 = *(const v4u*)(Vg + kn); vreg1 = *(const v4u*)(Vg + kn + 64);
                    mwn0 = Mg[(size_t)(2 * kt + 2) * 64]; mwn1 = Mg[(size_t)(2 * kt + 3) * 64]; }
                LAS unsigned char* kb_ = Lb + buf * SLOT; LAS unsigned char* vb_ = kb_ + KTB;
                f32x16 sA[4];
#pragma unroll
                for (int c = 0; c < 4; ++c)
#pragma unroll
                    for (int r = 0; r < 16; ++r) sA[c][r] = 0.f;
#pragma unroll
                for (int ks = 0; ks < 4; ++ks)
#pragma unroll
                    for (int c = 0; c < 4; ++c) { const bf16x8 kf = *(const LAS bf16x8*)(kb_ + (32 * c + r32) * 144 + ks * 32 + hi * 16); sA[c] = MFMA32(kf, qf[ks], sA[c]); }
                if (kt >= NT - 3) {
#pragma unroll
                    for (int c = 0; c < 4; ++c)
#pragma unroll
                        for (int r = 0; r < 16; ++r) { const int d0 = tq - (128 * kt + 32 * c + crow(r, hi)); const float b0 = biasd[d0 & 127]; sA[c][r] += ((unsigned)d0 < 128u) ? b0 : 0.f; }
                }
                float mx = -INFINITY;
#pragma unroll
                for (int r = 0; r < 16; ++r) mx = fmaxf(mx, fmaxf(fmaxf(sA[0][r], sA[1][r]), fmaxf(sA[2][r], sA[3][r])));
                mx = fmaxf(mx, __shfl_xor(mx, 32)) - m_run;
                if (kt == 0 || __any(mx > 8.0f)) {
                    const float dl = (kt == 0) ? mx : fmaxf(mx, 0.f), f = __builtin_amdgcn_exp2f(-dl);
                    m_run += dl;
#pragma unroll
                    for (int r = 0; r < 16; ++r) { o0[r] *= f; o1[r] *= f; o2[r] *= f; }
                }
                unsigned pk[4][8];
#pragma unroll
                for (int c = 0; c < 4; ++c) { const unsigned mw = (c < 2) ? mw0 : mw1;
#pragma unroll
                    for (int r = 0; r < 16; r += 2) {
                        const unsigned e0 = __builtin_bit_cast(unsigned, __builtin_amdgcn_exp2f(sA[c][r] - m_run)) & SBFE1(mw, 16 * (c & 1) + r);
                        const unsigned e1 = __builtin_bit_cast(unsigned, __builtin_amdgcn_exp2f(sA[c][r + 1] - m_run)) & SBFE1(mw, 16 * (c & 1) + r + 1);
                        pk[c][r >> 1] = cvtpk(__builtin_bit_cast(float, e0), __builtin_bit_cast(float, e1)); } }
#pragma unroll
                for (int c = 0; c < 4; ++c)
#pragma unroll
                    for (int s = 0; s < 2; ++s) {
                        const bf16x8 pf = __builtin_bit_cast(bf16x8, (v4u){pk[c][4 * s], pk[c][4 * s + 1], pk[c][4 * s + 2], pk[c][4 * s + 3]});
                        const bf16x8 v0 = *(const LAS bf16x8*)(vb_ + r32 * 272 + (2 * c + s) * 32 + hi * 16);
                        const bf16x8 v1 = *(const LAS bf16x8*)(vb_ + (32 + r32) * 272 + (2 * c + s) * 32 + hi * 16);
                        o0 = MFMA32(v0, pf, o0); o1 = MFMA32(v1, pf, o1); o2 = MFMA32(ones, pf, o2);
                    }
                if (kt + 1 < NT) { LAS unsigned char* nb = Lb + (buf ^ 1) * SLOT;
                    *(LAS v4u*)(nb + lrow * 144 + lch * 16) = kreg0; *(LAS v4u*)(nb + (64 + lrow) * 144 + lch * 16) = kreg1;
                    *(LAS v4u*)(nb + KTB + lrow * 272 + lch * 16) = vreg0; *(LAS v4u*)(nb + KTB + lrow * 272 + 128 + lch * 16) = vreg1; }
                mw0 = mwn0; mw1 = mwn1;
                __syncthreads();
            }
            const float inv = 1.0f / o2[0];
            bf16* orow = ATTo + (size_t)(b * SEQ + tq) * 512 + h * 64 + 4 * hi;
#pragma unroll
            for (int g4 = 0; g4 < 4; ++g4) {
                *(v2u*)(orow + 8 * g4) = (v2u){cvtpk(o0[4 * g4] * inv, o0[4 * g4 + 1] * inv), cvtpk(o0[4 * g4 + 2] * inv, o0[4 * g4 + 3] * inv)};
                *(v2u*)(orow + 32 + 8 * g4) = (v2u){cvtpk(o1[4 * g4] * inv, o1[4 * g4 + 1] * inv), cvtpk(o1[4 * g4 + 2] * inv, o1[4 * g4 + 3] * inv)};
            }
        }
    }
}

__device__ __forceinline__ void p9_norm2_route(Frame& F, const float* HRES) {
    const int gw = F.vcu * NWAVES + F.wave, NGW = F.G * NWAVES;
    const float* mod = WSP(float, SM_MOD); const float* WRT = WSP(float, SM_WRT);
    LAS float* lg = (LAS float*)(F.lds + LDSCTL_OFF + 4608 + F.wave * 1152);
    LAS float* wlds = (LAS float*)(F.lds + RING_OFF);
    int* EID = WSP(int, SM_EID); float* EWT = WSP(float, SM_EWT); int* SLOT = WSP(int, SM_SLOT); bf16* H2 = WSP(bf16, WS_H1);
    for (int ord = 0; ord < 2; ++ord) {
    if ((ord ^ (F.vcu & 1)) == 0) {
    int ln9 = (int)__builtin_amdgcn_mbcnt_hi(~0u, __builtin_amdgcn_mbcnt_lo(~0u, 0u)); asm volatile("" : "+v"(ln9)); const int tid9 = F.wave * 64 + ln9;
    LAS unsigned* lcnt = (LAS unsigned*)(F.lds + LDSCTL_OFF + 4096);
    __syncthreads();
    { f32x4 wst[16];
#pragma unroll
      for (int i = 0; i < 16; ++i) wst[i] = *(const f32x4*)(WRT + 4 * D + (size_t)(i * 512 + tid9) * 4);
#pragma unroll
      for (int i = 0; i < 16; ++i) *(LAS f32x4*)(wlds + (size_t)(i * 512 + tid9) * 4) = wst[i]; }
    __syncthreads();
    const int nsteps = (T / 8 + NGW - 1) / NGW;
    for (int st = 0; st < nsteps; ++st) {
        const int m8 = st * NGW + gw; const bool live = m8 < T / 8;
        const int m0 = (live ? m8 : 0) * 8, b = m0 / SEQ;
        if (tid9 < 32) lcnt[tid9] = 0u;
        f32x4 hv[8][4];
#pragma unroll
        for (int r = 0; r < 8; ++r) { const GAS f32x4* xr = (const GAS f32x4*)(HRES + (size_t)(m0 + r) * D) + ln9;
#pragma unroll
            for (int j = 0; j < 4; ++j) hv[r][j] = xr[64 * j]; }
        f32x4 ca[4], cb[4];
#pragma unroll
        for (int j = 0; j < 4; ++j) { const int k = 4 * ln9 + 256 * j;
            const f32x4 g = *(const f32x4*)(F.norm2_g + k), scl = *(const f32x4*)(mod + b * 6144 + 4096 + k); cb[j] = *(const f32x4*)(mod + b * 6144 + 3072 + k); ca[j] = g * (scl + 1.0f); }
#pragma unroll
        for (int r = 0; r < 8; ++r) { float s = 0.f;
#pragma unroll
            for (int j = 0; j < 4; ++j) s += (hv[r][j].x * hv[r][j].x + hv[r][j].y * hv[r][j].y) + (hv[r][j].z * hv[r][j].z + hv[r][j].w * hv[r][j].w);
            const float rstd = 1.f / sqrtf(wave_sum_all(s) * (1.f / D) + EPS);
            GAS v2u* o8 = (GAS v2u*)(H2 + (size_t)(m0 + r) * D) + ln9;
#pragma unroll
            for (int j = 0; j < 4; ++j) { hv[r][j] = hv[r][j] * rstd * ca[j] + cb[j]; if (live) o8[64 * j] = (v2u){pk2(hv[r][j].x, hv[r][j].y), pk2(hv[r][j].z, hv[r][j].w)}; } }
        int gsel[8];
        {
            float gm[8]; int gs[8];
#pragma unroll 1
            for (int n = 0; n < 4; ++n) {
                f32x4 w[4];
#pragma unroll
                for (int j = 0; j < 4; ++j) w[j] = *(const f32x4*)(WRT + n * D + 4 * ln9 + 256 * j);
                const float bn = F.brg[n];
#pragma unroll
                for (int r = 0; r < 8; ++r) { float a0 = 0.f, a1 = 0.f;
#pragma unroll
                    for (int j = 0; j < 4; ++j) { a0 = __builtin_fmaf(hv[r][j].x, w[j].x, a0); a1 = __builtin_fmaf(hv[r][j].y, w[j].y, a1); a0 = __builtin_fmaf(hv[r][j].z, w[j].z, a0); a1 = __builtin_fmaf(hv[r][j].w, w[j].w, a1); }
                    const float pgv = wave_sum63(a0 + a1) + bn;
                    if (n == 0 || pgv > gm[r]) { gm[r] = pgv; gs[r] = n; }
                    if (ln9 == 63) lg[r * 36 + n] = pgv; }
            }
#pragma unroll
            for (int r = 0; r < 8; ++r) gsel[r] = __builtin_amdgcn_readlane(gs[r], 63);
        }
#pragma unroll
        for (int r = 0; r < 8; ++r) {
            const LAS float* Wg = wlds + (8 * gsel[r]) * D + 4 * ln9; const float* bg = F.bre + 8 * gsel[r];
#pragma unroll 2
            for (int c = 0; c < 8; ++c) {
                float a0 = 0.f, a1 = 0.f;
#pragma unroll
                for (int j = 0; j < 4; ++j) { const f32x4 w = *(const LAS f32x4*)(Wg + c * D + 256 * j);
                    a0 = __builtin_fmaf(hv[r][j].x, w.x, a0); a1 = __builtin_fmaf(hv[r][j].y, w.y, a1); a0 = __builtin_fmaf(hv[r][j].z, w.z, a0); a1 = __builtin_fmaf(hv[r][j].w, w.w, a1); }
                const float pe = wave_sum63(a0 + a1);
                if (ln9 == 63) lg[r * 36 + 4 + 8 * gsel[r] + c] = pe + bg[c];
            }
            __builtin_amdgcn_sched_barrier(0);
        }
        __syncthreads();
        int e0id = 0, e1id = 0; unsigned lp0 = 0u, lp1 = 0u; const int tkn = m0 + ln9; const bool rt = live && ln9 < 8;
        if (rt) {
            const LAS float* l = lg + ln9 * 36;
            int gs = 0; float gm = l[0];
#pragma unroll
            for (int j = 1; j < 4; ++j) if (l[j] > gm) { gm = l[j]; gs = j; }
            float gsum = 0.f;
#pragma unroll
            for (int j = 0; j < 4; ++j) gsum += __expf(l[j] - gm);
            const float gwt = 1.f / gsum;
            const LAS float* el = l + 4 + 8 * gs;
            int i0 = 0; float l0 = el[0];
#pragma unroll
            for (int j = 1; j < 8; ++j) if (el[j] > l0) { l0 = el[j]; i0 = j; }
            int i1 = -1; float l1 = -INFINITY;
#pragma unroll
            for (int j = 0; j < 8; ++j) if (j != i0 && el[j] > l1) { l1 = el[j]; i1 = j; }
            const float e1 = __expf(l1 - l0), p0 = 1.f / (1.f + e1), p1 = e1 * p0;
            e0id = gs * 8 + i0; e1id = gs * 8 + i1;
            EID[tkn * 2] = e0id; EID[tkn * 2 + 1] = e1id; EWT[tkn * 2] = gwt * p0; EWT[tkn * 2 + 1] = gwt * p1;
            lp0 = __hip_atomic_fetch_add(lcnt + e0id, 1u, __ATOMIC_RELAXED, __HIP_MEMORY_SCOPE_WORKGROUP);
            lp1 = __hip_atomic_fetch_add(lcnt + e1id, 1u, __ATOMIC_RELAXED, __HIP_MEMORY_SCOPE_WORKGROUP);
        }
        __syncthreads();
        if (tid9 < 32) { const unsigned c = lcnt[tid9]; lcnt[32 + tid9] = c ? atomicAdd((unsigned*)(F.ctl + CW_ECNT + 16 * tid9), c) : 0u; }
        __syncthreads();
        if (rt) { SLOT[tkn * 2] = (int)(lcnt[32 + e0id] + lp0); SLOT[tkn * 2 + 1] = (int)(lcnt[32 + e1id] + lp1); }
        __syncthreads();
    }
    } else {
    {
        LAS float* scr = (LAS float*)(F.lds + RING_OFF + F.wave * 16384);
        for (int it = gw; it < NEXP * 512; it += NGW) {
            const int e = it / 512, r = it % 512;
            if (r < 256) transpose_item(F.w_gate_e + (size_t)e * D * DEXP, D, DEXP, WSP(bf16, WS_WGU) + (size_t)e * 1024 * D, scr, r, F.lane, RmGU{0});
            else transpose_item(F.w_up_e + (size_t)e * D * DEXP, D, DEXP, WSP(bf16, WS_WGU) + (size_t)e * 1024 * D, scr, r - 256, F.lane, RmGU{1});
        }
    }
    }
    }
}
__device__ __forceinline__ int moe_tables(Frame& F, LAS int* off, LAS int* tile_e) {
    if (F.tid == 0) { int o = 0, nt = 0;
        for (int e = 0; e < NEXP; ++e) { const int c = (int)__hip_atomic_load(F.ctl + CW_ECNT + 16 * e, RLX_AGENT); off[e] = o; const int tl = (c + 255) >> 8; for (int j = 0; j < tl; ++j) tile_e[nt++] = e; o += tl * 256; }
        off[NEXP] = nt; }
    __syncthreads();
    return off[NEXP];
}
__device__ __forceinline__ void p10_gather(Frame& F, LAS int* off) {
    const int* EID = WSP(int, SM_EID); int* SLOT = WSP(int, SM_SLOT); int* AROW = (int*)(F.ctl + CW_AROW);
    for (int i = blockIdx.x * 512 + F.tid; i < T * 2; i += F.G * 512) { const int row = off[EID[i]] + SLOT[i]; AROW[row] = i >> 1; SLOT[i] = row; }
}
__device__ __forceinline__ void p13_combine(Frame& F, const float* HRES) {
    const int gw = F.vcu * NWAVES + F.wave, NGW = F.G * NWAVES;
    const float* mod = WSP(float, SM_MOD); const int* SLOT = WSP(int, SM_SLOT); const float* EWT = WSP(float, SM_EWT); const bf16* Y = WSP(bf16, WS_Y);
    for (int m0 = gw * 2; m0 < T; m0 += NGW * 2) {
        const int b = m0 / SEQ;
        f32x4 v[2][4]; float rs[2];
#pragma unroll
        for (int r = 0; r < 2; ++r) { const int m = m0 + r;
#if DBG_SKIP_MOE
            const int r0 = 0, r1 = 0; const float w0 = 0.f, w1 = 0.f; (void)SLOT; (void)EWT;
#else
            const int r0 = SLOT[m * 2], r1 = SLOT[m * 2 + 1]; const float w0 = EWT[m * 2], w1 = EWT[m * 2 + 1];
#endif
            const GAS f32x4* xr = (const GAS f32x4*)(HRES + (size_t)m * D) + F.lane;
            const GAS v2u* y0 = (const GAS v2u*)(Y + (size_t)r0 * D) + F.lane; const GAS v2u* y1 = (const GAS v2u*)(Y + (size_t)r1 * D) + F.lane;
#pragma unroll
            for (int j = 0; j < 4; ++j) { const int k = 4 * F.lane + 256 * j; const v2u a = y0[64 * j], c = y1[64 * j];
                const f32x4 ya = (f32x4){bflo(a.x), bfhi(a.x), bflo(a.y), bfhi(a.y)}, yb = (f32x4){bflo(c.x), bfhi(c.x), bflo(c.y), bfhi(c.y)};
                const f32x4 g2 = *(const f32x4*)(mod + b * 6144 + 5120 + k);
#if DBG_SKIP_MOE
                v[r][j] = xr[64 * j]; (void)g2; (void)ya; (void)yb;
#else
                v[r][j] = xr[64 * j] + g2 * (ya * w0 + yb * w1);
#endif
            } }
#pragma unroll
        for (int r = 0; r < 2; ++r) { float s = 0.f;
#pragma unroll
            for (int j = 0; j < 4; ++j) s += (v[r][j].x * v[r][j].x + v[r][j].y * v[r][j].y) + (v[r][j].z * v[r][j].z + v[r][j].w * v[r][j].w);
            rs[r] = 1.f / sqrtf(wave_sum_all(s) * (1.f / D) + EPS); }
#if DBG_CMP_ATT
        const float escale = 1.0f + sqrtf(__builtin_bit_cast(float, __hip_atomic_load(F.ctl + CW_CMP, RLX_AGENT)) / __builtin_bit_cast(float, __hip_atomic_load(F.ctl + CW_CMP + 1, RLX_AGENT)));
#else
        const float escale = 1.0f;
#endif
#pragma unroll
        for (int r = 0; r < 2; ++r) { GAS f32x4* o = (GAS f32x4*)(F.out + (size_t)(m0 + r) * D) + F.lane;
#pragma unroll
            for (int j = 0; j < 4; ++j) o[64 * j] = v[r][j] * (rs[r] * escale) * *(const f32x4*)(F.norm_f_g + 4 * F.lane + 256 * j); }
    }
}

struct Args { const float* in[20]; float* out; unsigned char* ws; int ph_lo, ph_hi, li, pad; };
__global__ void __launch_bounds__(NWAVES * 64, 2) fwd_kernel(Args args) {
    extern __shared__ __attribute__((aligned(16))) unsigned char lds[];
    Frame F;
    F.lds = (LAS unsigned char*)lds;
    F.MISC = (volatile LAS unsigned*)(F.lds + MISC_OFF);
    F.tid = threadIdx.x; F.lane = F.tid & 63; F.wave = __builtin_amdgcn_readfirstlane(F.tid >> 6);
    F.G = gridDim.x; { const int bx = blockIdx.x; F.vcu = (F.G % 8 == 0) ? (bx % 8) * (F.G / 8) + bx / 8 : bx; }
    F.ws = args.ws; F.ctl = (gu32*)(args.ws + WS_CTL);
    F.x = args.in[0]; F.c = args.in[1]; F.w_ada = args.in[2]; F.b_ada = args.in[3]; F.norm1_g = args.in[4]; F.w_in = args.in[5]; F.rel_bias = args.in[6]; F.conv_w = args.in[7];
    F.w_attn = args.in[8]; F.w_conv = args.in[9]; F.w_out = args.in[10]; F.norm2_g = args.in[11]; F.wrg = args.in[12]; F.brg = args.in[13]; F.wre = args.in[14]; F.bre = args.in[15];
    F.w_gate_e = args.in[16]; F.w_up_e = args.in[17]; F.w_down_e = args.in[18]; F.norm_f_g = args.in[19]; F.out = args.out;
    for (int u = F.tid; u < (LDS_BYTES - LDSCTL_OFF) / 4; u += NWAVES * 64) ((LAS unsigned*)(F.lds + LDSCTL_OFF))[u] = 0u;
    __syncthreads();
    XcdBarrier bar; bar.bar = (unsigned*)(F.ctl + CW_BAR); bar.x = 0; bar.st = nullptr;
    if (!MK_PER_PHASE) bar = xcd_barrier_post((unsigned*)(F.ctl + CW_BAR), F.MISC + 8);
#define GRID_BAR() do { if (MK_PER_PHASE) { if (F.tid == 0) __hip_atomic_store(F.ctl + CW_TMO, 0xBADBA0u, RLX_AGENT); } else { xcd_barrier(bar, F.wave == 0 && (int)__builtin_amdgcn_mbcnt_hi(~0u, __builtin_amdgcn_mbcnt_lo(~0u, 0u)) == 0); } } while (0)
    const int lo = args.ph_lo, hi = args.ph_hi;
#ifndef ONLY_PHASE
#define ONLY_PHASE -1
#endif
#define IN(k) ((ONLY_PHASE < 0 || ONLY_PHASE == (k)) && lo <= (k) && (k) < hi)
#define BOTH(k) (IN(k) && IN((k) + 1))
#define REFRESH() do { int l_ = (int)__builtin_amdgcn_mbcnt_hi(~0u, __builtin_amdgcn_mbcnt_lo(~0u, 0u)); asm volatile("" : "+v"(l_)); F.lane = l_; F.tid = F.wave * 64 + l_; } while (0)
    float* HRES = F.out;
    LAS int* moe_off = (LAS int*)(F.lds + LDSCTL_OFF + 1024);
    LAS int* moe_tile = (LAS int*)(F.lds + LDSCTL_OFF + 1024 + 256);

    if (IN(0)) { REFRESH(); for (int rep_ = 0; rep_ < (DBG_REP == 0 ? 2 : 1); ++rep_) { if (rep_) GRID_BAR(); p0_prologue(F); } if (BOTH(0)) GRID_BAR(); }
    if (IN(1)) { REFRESH(); for (int rep_ = 0; rep_ < (DBG_REP == 1 ? 2 : 1); ++rep_) { if (rep_) GRID_BAR(); p1_norm1(F); } if (BOTH(1)) GRID_BAR(); }
    if (IN(2)) { REFRESH();
        pg8::Gemm g{WSP(bf16, WS_H1), WSP(bf16, WS_WIN), T, NINP, D}; pg8::StaticOrder S; S.init(T, NINP, F.G, (int)blockIdx.x);
        EpiProj E{WSP(bf16, WS_Q), WSP(bf16, WS_K), WSP(bf16, WS_V), WSP(bf16, WS_QI), WSP(bf16, WS_KI), WSP(bf16, WS_CB), WSP(bf16, WS_U), WSP(bf16, WS_G), WSP(float, WS_WI)};
        for (int rep_ = 0; rep_ < (DBG_REP == 2 ? 2 : 1); ++rep_) { if (rep_) GRID_BAR(); pg8::gemm_phase<EpiProj, pg8::StaticOrder, true, true>(F.lds + RING_OFF, g, S, E, F.wave); }
        {
            constexpr int I_A = 8 * 32, I_C = 8 * 32, I_O = 16 * 32;
            const int nun = (T / 256) * (NINP / 256), rem = nun % F.G, c = (int)blockIdx.x;
            const bool early = (rem == 0) || (c >= rem); const int n_early = (rem == 0) ? F.G : F.G - rem, rank = (rem == 0) ? c : c - rem;
            if (early) { LAS float* scr = (LAS float*)(F.lds + RING_OFF + F.wave * 16384);
                for (int it = rank * NWAVES + F.wave; it < I_A + I_C + I_O; it += n_early * NWAVES) { int r = it;
                    if (r < I_A) { transpose_item(F.w_attn, AW, D, WSP(bf16, WS_WA), scr, r, F.lane, RmId()); continue; } r -= I_A;
                    if (r < I_C) { transpose_item(F.w_conv, AW, D, WSP(bf16, WS_WC), scr, r, F.lane, RmId()); continue; } r -= I_C;
                    transpose_item(F.w_out, D, D, WSP(bf16, WS_WOUT), scr, r, F.lane, RmId()); } }
        }
        if (BOTH(2)) GRID_BAR();
    }
    if (IN(3)) { REFRESH(); for (int rep_ = 0; rep_ < (DBG_REP == 3 ? 2 : 1); ++rep_) { if (rep_) GRID_BAR(); p3_prep(F); } if (BOTH(3)) GRID_BAR(); }
    static_assert(WS_ATT == WS_AC + (size_t)T * AW * 2 && WS_WC == WS_WA + (size_t)D * AW * 2, "the chained branch GEMM needs [AC; ATT] and [Wa; Wc] contiguous");
    if (IN(4)) { REFRESH(); }
    if (IN(5)) { REFRESH();
#if DBG_SKIP_ATTN
        for (size_t i = (size_t)blockIdx.x * 512 + F.tid; i < (size_t)T * 512 / 8; i += (size_t)F.G * 512) *(v4u*)(WSP(bf16, WS_ATT) + i * 8) = (v4u){0u, 0u, 0u, 0u};
#elif DBG_CMP_ATT
        pn_naive_dsa(F); GRID_BAR(); p5_indexer(F, WSP(unsigned, WS_MASK_DBG));
#elif MK_NAIVE_ATTN
        pn_naive_dsa(F);
#else
        for (int rep_ = 0; rep_ < (DBG_REP == 5 ? 2 : 1); ++rep_) { if (rep_) GRID_BAR(); p5_indexer(F, WSP(unsigned, WS_MASK)); }
#endif
        if (BOTH(5)) GRID_BAR(); }
    if (IN(6)) { REFRESH();
#if DBG_SKIP_ATTN
#elif DBG_CMP_ATT
        p6_attention(F, WSP(unsigned, WS_MASK_DBG), WSP(bf16, WS_ATT2)); GRID_BAR();
        { float num = 0.f, den = 0.f; const bf16* A1 = WSP(bf16, WS_ATT); const bf16* A2 = WSP(bf16, WS_ATT2);
          for (size_t i = (size_t)blockIdx.x * 512 + F.tid; i < (size_t)T * 512; i += (size_t)F.G * 512) { const float a = bf1(A1[i]), c = bf1(A2[i]); num += (a - c) * (a - c); den += a * a; }
          num = wave_sum(num); den = wave_sum(den);
          if (F.lane == 0) { atomicAdd((float*)(F.ctl + CW_CMP), num); atomicAdd((float*)(F.ctl + CW_CMP + 1), den); } }
#elif !MK_NAIVE_ATTN
        for (int rep_ = 0; rep_ < (DBG_REP == 6 ? 2 : 1); ++rep_) { if (rep_) GRID_BAR(); p6_attention(F, WSP(unsigned, WS_MASK), WSP(bf16, WS_ATT)); }
#endif
        if (BOTH(6)) GRID_BAR(); }
    if (IN(7)) { REFRESH();
        pg8::Gemm g{WSP(bf16, WS_AC), WSP(bf16, WS_WA), 2 * T, 2 * D, AW}; ChainOrder S; S.so.init(T, D, F.G, (int)blockIdx.x);
        EpiChain E{WSP(bf16, WS_G), WSP(bf16, WS_TMPC), WSP(bf16, WS_MERGED)};
        for (int rep_ = 0; rep_ < (DBG_REP == 7 ? 2 : 1); ++rep_) { if (rep_) GRID_BAR(); pg8::gemm_phase<EpiChain, ChainOrder, true, true>(F.lds + RING_OFF, g, S, E, F.wave); }
        if (BOTH(7)) GRID_BAR();
    }
    if (IN(8)) { REFRESH();
        pg8::Gemm g{WSP(bf16, WS_MERGED), WSP(bf16, WS_WOUT), T, D, D}; pg8::StaticOrder S; S.init(T, D, F.G, (int)blockIdx.x);
        EpiOut E{F.x, WSP(float, SM_MOD), HRES};
        for (int rep_ = 0; rep_ < (DBG_REP == 8 ? 2 : 1); ++rep_) { if (rep_) GRID_BAR(); pg8::gemm_phase<EpiOut, pg8::StaticOrder, true, true>(F.lds + RING_OFF, g, S, E, F.wave); }
        if (BOTH(8)) GRID_BAR();
    }
#if DBG_SKIP_MOE
    if (0) {
#endif
    if (IN(9)) { REFRESH(); p9_norm2_route(F, HRES);
#if DBG_REP == 9
        GRID_BAR(); if (blockIdx.x == 0 && F.tid < 32) __hip_atomic_store(F.ctl + CW_ECNT + 16 * F.tid, 0u, RLX_AGENT); GRID_BAR(); p9_norm2_route(F, HRES);
#endif
#if DBG_REP == 99
        for (int i_ = 0; i_ < 10; ++i_) GRID_BAR();
#endif
        if (BOTH(9)) GRID_BAR(); }
    if (IN(10)) { REFRESH(); (void)moe_tables(F, moe_off, moe_tile); p10_gather(F, moe_off); if (BOTH(10)) GRID_BAR(); }
    if (IN(11)) { REFRESH();
        const int nt = moe_tables(F, moe_off, moe_tile);
        pg8::Gemm g{WSP(bf16, WS_H1), WSP(bf16, WS_WGU), XPROWS, NEXP * 1024, D}; MoeOrder S{moe_tile, nt, F.G, (int)blockIdx.x};
        EpiHid E{WSP(bf16, WS_HID)};
        for (int rep_ = 0; rep_ < (DBG_REP == 11 ? 2 : 1); ++rep_) { if (rep_) GRID_BAR(); pg8::gemm_phase<EpiHid, MoeOrder, true, true, true>(F.lds + RING_OFF, g, S, E, F.wave, (const int*)(F.ctl + CW_AROW)); }
        {
            const int nun = nt * 4, rem = nun % F.G, c = (int)blockIdx.x;
            const bool early = (rem == 0) || (c >= rem); const int n_early = (rem == 0) ? F.G : F.G - rem, rank = (rem == 0) ? c : c - rem;
            if (early) { LAS float* scr = (LAS float*)(F.lds + RING_OFF + F.wave * 16384);
                for (int it = rank * NWAVES + F.wave; it < NEXP * 256; it += n_early * NWAVES) { const int e = it >> 8, r = it & 255;
                    transpose_item(F.w_down_e + (size_t)e * DEXP * D, DEXP, D, WSP(bf16, WS_WD) + (size_t)e * D * DEXP, scr, r, F.lane, RmId()); } }
        }
        if (BOTH(11)) GRID_BAR();
    }
    if (IN(12)) { REFRESH();
        const int nt = moe_tables(F, moe_off, moe_tile);
        pg8::Gemm g{WSP(bf16, WS_HID), WSP(bf16, WS_WD), XPROWS, NEXP * 1024, DEXP}; MoeOrder S{moe_tile, nt, F.G, (int)blockIdx.x};
        EpiY E{WSP(bf16, WS_Y)};
        for (int rep_ = 0; rep_ < (DBG_REP == 12 ? 2 : 1); ++rep_) { if (rep_) GRID_BAR(); pg8::gemm_phase<EpiY, MoeOrder, true, true>(F.lds + RING_OFF, g, S, E, F.wave); }
        if (BOTH(12)) GRID_BAR();
    }
#if DBG_SKIP_MOE
    }
#endif
#if DBG_PROBE
    if (IN(13)) { REFRESH();
        const bf16* src = nullptr; int pitch = 1024;
        if (DBG_PROBE == 1) { src = WSP(bf16, WS_MERGED); pitch = 1024; }
        if (DBG_PROBE == 2) { src = WSP(bf16, WS_TMPC); pitch = 1024; }
        if (DBG_PROBE == 3) { src = WSP(bf16, WS_AC); pitch = 512; }
        if (DBG_PROBE == 4) { src = WSP(bf16, WS_G); pitch = 2048; }
        if (DBG_PROBE == 5) { src = WSP(bf16, WS_H1); pitch = 1024; }
        if (DBG_PROBE == 6) { src = WSP(bf16, WS_WIN); pitch = 1024; }
        if (DBG_PROBE == 7) { src = WSP(bf16, WS_QI); pitch = 512; }
        for (size_t i = (size_t)blockIdx.x * 512 + F.tid; i < (size_t)T * D; i += (size_t)F.G * 512) { const size_t m = i / D, j = i % D;
            float v;
            if (DBG_PROBE == 8) v = WSP(float, SM_MOD)[i % 12288];
            else if (DBG_PROBE == 4) v = bf1(src[m * 2048 + j]) + bf1(src[m * 2048 + 1024 + j]);
            else if (DBG_PROBE >= 40 && DBG_PROBE < 48) v = bf1(WSP(bf16, WS_G)[m * 2048 + (DBG_PROBE - 40) * 256 + (j & 255)]);
            else if (DBG_PROBE == 6) v = bf1(src[(m % 5888) * 1024 + j]);
            else v = bf1(src[m * pitch + (j % pitch)]);
            F.out[i] = v; }
    }
#else
    if (IN(13)) { REFRESH(); for (int rep_ = 0; rep_ < (DBG_REP == 13 ? 2 : 1); ++rep_) { if (rep_) GRID_BAR(); p13_combine(F, DBG_SKIP_MIX ? F.x : HRES); } }
#endif
#undef IN
#undef BOTH
}

extern "C" void kernel_launch(void* const* d_in, const int* in_sizes, int n_in, void* d_out, int out_size, void* d_ws, size_t ws_size, hipStream_t stream) {
    static int grid = 0;
    if (grid == 0) {
        if (n_in != 20 || in_sizes[0] != T * D || out_size != T * D || ws_size < WS_END) { fprintf(stderr, "kernel_launch: unexpected shapes: n_in %d in0 %d out %d ws %zu (need %zu)\n", n_in, n_in > 0 ? in_sizes[0] : -1, out_size, ws_size, (size_t)WS_END); grid = -1; return; }
        int dev = 0, cus = 0, per_cu = 0;
        if (hipGetDevice(&dev) != hipSuccess || hipDeviceGetAttribute(&cus, hipDeviceAttributeMultiprocessorCount, dev) != hipSuccess) { grid = -1; return; }
        if (hipFuncSetAttribute((const void*)fwd_kernel, hipFuncAttributeMaxDynamicSharedMemorySize, LDS_BYTES) != hipSuccess) { fprintf(stderr, "kernel_launch: hipFuncSetAttribute failed\n"); grid = -1; return; }
        if (hipOccupancyMaxActiveBlocksPerMultiprocessor(&per_cu, (const void*)fwd_kernel, NWAVES * 64, LDS_BYTES) != hipSuccess || per_cu < 1)
            fprintf(stderr, "kernel_launch: note: occupancy query reports %d workgroups per CU\n", per_cu);
        (void)hipGetLastError();
        grid = cus;
    }
    if (grid < 0) return;
    if (hipMemsetAsync((char*)d_ws + WS_CTL, 0, CTL_ZERO_BYTES, stream) != hipSuccess) return;
    Args a{};
    for (int i = 0; i < 20; ++i) a.in[i] = (const float*)d_in[i];
    a.out = (float*)d_out; a.ws = (unsigned char*)d_ws;
#if MK_PER_PHASE
    for (int li = 0; li < N_PHASES; ++li) { a.ph_lo = li; a.ph_hi = li + 1; a.li = li; hipLaunchKernelGGL(fwd_kernel, dim3(grid), dim3(NWAVES * 64), LDS_BYTES, stream, a); }
#else
    a.ph_lo = 0; a.ph_hi = N_PHASES; a.li = 0;
    hipLaunchKernelGGL(fwd_kernel, dim3(grid), dim3(NWAVES * 64), LDS_BYTES, stream, a);
#endif
}
```

```cpp
#include <hip/hip_runtime.h>
#include <cstdio>
#include <cstdint>

namespace pg8 {
#define PG8_LAS __attribute__((address_space(3)))
typedef unsigned short bf16_t;
typedef short bf16x8 __attribute__((ext_vector_type(8)));
typedef float f32x4 __attribute__((ext_vector_type(4)));
typedef unsigned u32x4 __attribute__((ext_vector_type(4)));
constexpr int BM = 256, BK = 64, HALF = 128, HTB = HALF * BK * 2  , STAGE_BYTES = 8 * HTB, NXCD = 8, WGM = 8;

__host__ __device__ __forceinline__ int lds_byte(int r, int c) { const int st = (r >> 4) * 2 + (c >> 5), rr = r & 15, cc = c & 31, ob = rr * 64 + cc * 2; return st * 1024 + (ob ^ (((ob >> 9) & 1) << 5)); }
__host__ __device__ __forceinline__ void stage_rc(int b, int& R, int& C) { const int st = b / 1024, sb = b % 1024, swz = sb ^ (((sb >> 9) & 1) << 5); R = (st >> 1) * 16 + swz / 64; C = (st & 1) * 32 + (swz % 64) / 2; }
__host__ __device__ __forceinline__ int perm32(int rho) { const int n = rho >> 4, i = rho & 15; return 8 * (i >> 2) + 4 * n + (i & 3); }

struct Unit { int pm, pn; };
struct Gemm { const bf16_t* A; const bf16_t* Bt; int M, N, K; };

struct StaticOrder {
    int nM, nN, nwg, G, c;
    __host__ __device__ void init(int M, int N, int G_, int c_) { nM = M / BM; nN = N / BM; nwg = nM * nN; G = G_; c = c_; }
    __host__ __device__ bool next(int i, Unit& u) const {
        const long L = (long)i * G + c; if (L >= nwg) return false;
        int wgid = (int)L; { const int q = nwg / NXCD, r = nwg % NXCD, xcd = wgid % NXCD, off = wgid / NXCD; wgid = (xcd < r ? xcd * (q + 1) : r * (q + 1) + (xcd - r) * q) + off; }
        const int nig = WGM * nN, gid = wgid / nig, fm = gid * WGM, gsz = (nM - fm) < WGM ? (nM - fm) : WGM;
        u.pm = fm + ((wgid % nig) % gsz); u.pn = (wgid % nig) / gsz; return true;
    }
    __device__ __forceinline__ void a_ready(const Unit&) const {}
    __device__ __forceinline__ void done(const Unit&) const {}
};
__device__ __forceinline__ unsigned cvt_pk_bf16(float lo, float hi) { unsigned r; asm volatile("v_cvt_pk_bf16_f32 %0, %1, %2" : "=v"(r) : "v"(lo), "v"(hi)); return r; }

template <class Epi, class Sched, bool ALIGN_EPI = false, bool SP2 = false, bool GATHER = false>
__device__ __forceinline__ void gemm_phase(PG8_LAS unsigned char* lds, const Gemm g, const Sched& S, const Epi& E, const int wave_id  , const int* arow = nullptr) {
    static_assert(!GATHER || SP2, "GATHER is implemented on the SP2 loop only");
    int lane_ = (int)__builtin_amdgcn_mbcnt_hi(~0u, __builtin_amdgcn_mbcnt_lo(~0u, 0u)); asm volatile("" : "+v"(lane_));
    const int lane = lane_, wid = wave_id, tid = wid * 64 + lane,
               wr = wid >> 2, wc = wid & 3, fr = lane & 15, fq = lane >> 4;
    const int K = g.K, nt = K / BK;
    unsigned voffA[2], voffB[2]; int RA[2]; unsigned CA2[2];
#pragma unroll
    for (int i = 0; i < 2; ++i) { int R, C; stage_rc(tid * 16 + i * 8192, R, C); const int Rb = Epi::PERM ? ((R & ~31) + perm32(R & 31)) : R;
        voffA[i] = (unsigned)(R * K + C) * 2u; voffB[i] = (unsigned)(Rb * K + C) * 2u; RA[i] = R; CA2[i] = (unsigned)C * 2u; }
    unsigned vA[2][2] = {{0u, 0u}, {0u, 0u}}, nvA[2][2] = {{0u, 0u}, {0u, 0u}};
#define PG8_GROWS(dst, U) do { _Pragma("unroll") for (int _h = 0; _h < 2; ++_h) _Pragma("unroll") for (int _i = 0; _i < 2; ++_i) dst[_h][_i] = (unsigned)arow[(U).pm * BM + _h * HALF + RA[_i]] * (unsigned)(K * 2) + CA2[_i]; } while (0)
    const size_t kstep = (size_t)(BK * 2);
    const size_t hstep = (size_t)HALF * K * 2;
    const size_t tstep = 2 * hstep;
    const unsigned ldsw = (unsigned)wid * 1024u;
    const int aoff = lds_byte(wr * 64 + fr, fq * 8), boff = lds_byte(wc * 32 + fr, fq * 8);
#define PG8_SA(b, h) (((b) * 2 + (h)) * HTB)
#define PG8_SB(b, h) ((4 + (b) * 2 + (h)) * HTB)
#define PG8_STAGE(bufoff, gbase, voff) do { _Pragma("unroll") for (int _i = 0; _i < 2; ++_i) \
        __builtin_amdgcn_global_load_lds((const unsigned*)((const char*)(gbase) + (voff)[_i]), (PG8_LAS unsigned*)(lds + (bufoff) + ldsw + _i * 8192), 16, 0, 0); } while (0)
#define PG8_STAGE_A(bufoff, gb, h, nx) do { if constexpr (GATHER) { _Pragma("unroll") for (int _i = 0; _i < 2; ++_i) { const unsigned vo_ = (nx) ? nvA[h][_i] : vA[h][_i]; \
        __builtin_amdgcn_global_load_lds((const unsigned*)((const char*)(gb) + vo_), (PG8_LAS unsigned*)(lds + (bufoff) + ldsw + _i * 8192), 16, 0, 0); } } else { PG8_STAGE(bufoff, (gb) + (h) * hstep, voffA); } } while (0)
#define PG8_LDA(dst, b, h) do { _Pragma("unroll") for (int m = 0; m < 4; ++m) _Pragma("unroll") for (int k = 0; k < 2; ++k) dst[m][k] = *(const PG8_LAS bf16x8*)(lds + PG8_SA(b, h) + aoff + m * 2048 + k * 1024); } while (0)
#define PG8_LDB(dst, b, h) do { _Pragma("unroll") for (int n = 0; n < 2; ++n) _Pragma("unroll") for (int k = 0; k < 2; ++k) dst[n][k] = *(const PG8_LAS bf16x8*)(lds + PG8_SB(b, h) + boff + n * 2048 + k * 1024); } while (0)
#define PG8_MMA(ai, bj, At, Bt) do { __builtin_amdgcn_s_setprio(1); _Pragma("unroll") for (int m = 0; m < 4; ++m) _Pragma("unroll") for (int n = 0; n < 2; ++n) _Pragma("unroll") for (int k = 0; k < 2; ++k) \
        acc[ai][bj][m][n] = __builtin_amdgcn_mfma_f32_16x16x32_bf16(Bt[n][k], At[m][k], acc[ai][bj][m][n], 0, 0, 0); __builtin_amdgcn_s_setprio(0); } while (0)
#define PG8_WAIT_V(n) asm volatile("s_waitcnt vmcnt(" #n ")" ::: "memory")
#define PG8_WAIT_L(n) asm volatile("s_waitcnt lgkmcnt(" #n ")" ::: "memory")
#define PG8_BAR __builtin_amdgcn_s_barrier()
#define PG8_SCHED __builtin_amdgcn_sched_barrier(0)
    Unit cur, nxt; int ui = 0;
    if (!S.next(0, cur)) return;
    f32x4 acc[2][2][4][2];
#pragma unroll
    for (int a = 0; a < 2; ++a)
#pragma unroll
        for (int b = 0; b < 2; ++b)
#pragma unroll
            for (int m = 0; m < 4; ++m)
#pragma unroll
                for (int n = 0; n < 2; ++n) acc[a][b][m][n] = (f32x4){0.f, 0.f, 0.f, 0.f};
    bf16x8 At[4][2], B0[2][2], B1[2][2];
    const char* cA = (const char*)g.A + (GATHER ? (size_t)0 : (size_t)cur.pm * tstep); const char* cB = (const char*)g.Bt + (size_t)cur.pn * tstep;
    if constexpr (GATHER) PG8_GROWS(vA, cur);
    S.a_ready(cur);
    if constexpr (SP2) {
        PG8_STAGE(PG8_SB(0, 0), cB, voffB); PG8_STAGE(PG8_SB(0, 1), cB + hstep, voffB); PG8_STAGE_A(PG8_SA(0, 0), cA, 0, false); PG8_STAGE_A(PG8_SA(0, 1), cA, 1, false);
        if (wr == 1) PG8_BAR;
        PG8_WAIT_V(2); PG8_BAR;
        PG8_STAGE(PG8_SB(1, 0), cB + kstep, voffB); PG8_STAGE_A(PG8_SA(1, 0), cA + kstep, 0, false); PG8_STAGE(PG8_SB(1, 1), cB + hstep + kstep, voffB);
        PG8_WAIT_V(6); PG8_BAR;
    } else {
        PG8_STAGE(PG8_SB(0, 0), cB, voffB); PG8_STAGE(PG8_SA(0, 0), cA, voffA); PG8_STAGE(PG8_SB(0, 1), cB + hstep, voffB); PG8_STAGE(PG8_SA(0, 1), cA + hstep, voffA);
        if (wr == 1) PG8_BAR;
        PG8_WAIT_V(4); PG8_BAR;
        PG8_STAGE(PG8_SB(1, 0), cB + kstep, voffB); PG8_STAGE(PG8_SA(1, 0), cA + kstep, voffA); PG8_STAGE(PG8_SB(1, 1), cB + hstep + kstep, voffB);
        PG8_WAIT_V(6); PG8_BAR;
    }
    for (;;) {
        const bool has_next = S.next(ui + 1, nxt);
        const char* nA = (has_next && !GATHER) ? (const char*)g.A + (size_t)nxt.pm * tstep : cA; const char* nB = has_next ? (const char*)g.Bt + (size_t)nxt.pn * tstep : cB;
        if constexpr (GATHER) { if (has_next) PG8_GROWS(nvA, nxt); else { nvA[0][0] = vA[0][0]; nvA[0][1] = vA[0][1]; nvA[1][0] = vA[1][0]; nvA[1][1] = vA[1][1]; } }
        for (int t = 0; t < nt; t += 2) {
            const bool last = (t == nt - 2);
            const char* a1 = cA + (size_t)(t + 1) * kstep;
            const char* a2 = last ? nA : cA + (size_t)(t + 2) * kstep; const char* b2 = last ? nB : cB + (size_t)(t + 2) * kstep;
            const char* a3 = a2 + kstep; const char* b3 = b2 + kstep;
            if (last && has_next) S.a_ready(nxt);
            if constexpr (SP2) {
            PG8_LDB(B0, 0, 0); PG8_LDB(B1, 0, 1); PG8_SCHED; PG8_LDA(At, 0, 0); PG8_STAGE_A(PG8_SA(1, 1), a1, 1, false);
            PG8_WAIT_V(8); PG8_WAIT_L(0); PG8_BAR; PG8_MMA(0, 0, At, B0); PG8_MMA(0, 1, At, B1); PG8_BAR; PG8_SCHED;
            PG8_LDA(At, 0, 1); PG8_STAGE(PG8_SB(0, 0), b2, voffB); PG8_STAGE(PG8_SB(0, 1), b2 + hstep, voffB); PG8_STAGE_A(PG8_SA(0, 0), a2, 0, last);
            PG8_WAIT_V(8); PG8_WAIT_L(0); PG8_BAR; PG8_MMA(1, 0, At, B0); PG8_MMA(1, 1, At, B1); PG8_BAR; PG8_SCHED;
            PG8_LDB(B0, 1, 0); PG8_LDB(B1, 1, 1); PG8_SCHED; PG8_LDA(At, 1, 0); PG8_STAGE_A(PG8_SA(0, 1), a2, 1, last);
            PG8_WAIT_V(8); PG8_WAIT_L(0); PG8_BAR; PG8_MMA(0, 0, At, B0); PG8_MMA(0, 1, At, B1); PG8_BAR; PG8_SCHED;
            PG8_LDA(At, 1, 1); PG8_STAGE(PG8_SB(1, 0), b3, voffB); PG8_STAGE(PG8_SB(1, 1), b3 + hstep, voffB); PG8_STAGE_A(PG8_SA(1, 0), a3, 0, last);
            PG8_WAIT_V(8); PG8_WAIT_L(0); PG8_BAR; PG8_MMA(1, 0, At, B0); PG8_MMA(1, 1, At, B1); PG8_BAR; PG8_SCHED;
            } else {
            PG8_LDB(B0, 0, 0); PG8_SCHED; PG8_LDA(At, 0, 0); PG8_STAGE(PG8_SA(1, 1), a1 + hstep, voffA);
            PG8_WAIT_L(8); PG8_BAR; PG8_WAIT_L(0); PG8_MMA(0, 0, At, B0); PG8_BAR; PG8_SCHED;
            PG8_LDB(B1, 0, 1); PG8_STAGE(PG8_SB(0, 0), b2, voffB);
            PG8_BAR; PG8_WAIT_L(0); PG8_MMA(0, 1, At, B1); PG8_BAR;
            PG8_LDA(At, 0, 1); PG8_STAGE(PG8_SA(0, 0), a2, voffA);
            PG8_BAR; PG8_WAIT_L(0); PG8_MMA(1, 0, At, B0); PG8_BAR; PG8_SCHED;
            PG8_STAGE(PG8_SB(0, 1), b2 + hstep, voffB);
            PG8_WAIT_V(6); PG8_BAR; PG8_MMA(1, 1, At, B1); PG8_BAR;
            PG8_LDB(B0, 1, 0); PG8_SCHED; PG8_LDA(At, 1, 0); PG8_STAGE(PG8_SA(0, 1), a2 + hstep, voffA);
            PG8_WAIT_L(8); PG8_BAR; PG8_WAIT_L(0); PG8_MMA(0, 0, At, B0); PG8_BAR; PG8_SCHED;
            PG8_LDB(B1, 1, 1); PG8_STAGE(PG8_SB(1, 0), b3, voffB);
            PG8_BAR; PG8_WAIT_L(0); PG8_MMA(0, 1, At, B1); PG8_BAR;
            PG8_LDA(At, 1, 1); PG8_STAGE(PG8_SA(1, 0), a3, voffA);
            PG8_BAR; PG8_WAIT_L(0); PG8_MMA(1, 0, At, B0); PG8_BAR; PG8_SCHED;
            PG8_STAGE(PG8_SB(1, 1), b3 + hstep, voffB);
            PG8_WAIT_V(6); PG8_BAR; PG8_MMA(1, 1, At, B1); PG8_BAR;
            }
        }
        if constexpr (ALIGN_EPI) { if (wr == 0) PG8_BAR; }
        if constexpr (!Epi::AFTER_DRAIN) { E(acc, cur, wr, wc, fr, fq); S.done(cur); }
        if (!has_next) break;
#pragma unroll
        for (int a = 0; a < 2; ++a)
#pragma unroll
            for (int b = 0; b < 2; ++b)
#pragma unroll
                for (int m = 0; m < 4; ++m)
#pragma unroll
                    for (int n = 0; n < 2; ++n) acc[a][b][m][n] = (f32x4){0.f, 0.f, 0.f, 0.f};
        cur = nxt; cA = nA; cB = nB; ++ui;
        if constexpr (GATHER) { vA[0][0] = nvA[0][0]; vA[0][1] = nvA[0][1]; vA[1][0] = nvA[1][0]; vA[1][1] = nvA[1][1]; }
        if constexpr (ALIGN_EPI) { if (wr == 1) PG8_BAR; }
    }
    PG8_WAIT_V(0);
    if constexpr (!ALIGN_EPI) { if (wr == 0) PG8_BAR; }
    PG8_BAR;
    if constexpr (Epi::AFTER_DRAIN) { E.fused(acc, cur, wr, wc, fr, fq, lds, wid, lane); S.done(cur); }
#undef PG8_SA
#undef PG8_SB
#undef PG8_STAGE
#undef PG8_STAGE_A
#undef PG8_GROWS
#undef PG8_LDA
#undef PG8_LDB
#undef PG8_MMA
#undef PG8_WAIT_V
#undef PG8_WAIT_L
#undef PG8_BAR
#undef PG8_SCHED
}
}

constexpr int NWAVES = 8;
#ifndef MK_PER_PHASE
#define MK_PER_PHASE 0
#endif
#ifndef MK_NAIVE_ATTN
#define MK_NAIVE_ATTN 0
#endif
#ifndef DBG_SKIP_ATTN
#define DBG_SKIP_ATTN 0
#endif
#ifndef DBG_SKIP_MOE
#define DBG_SKIP_MOE 0
#endif
#ifndef DBG_SKIP_MIX
#define DBG_SKIP_MIX 0
#endif
#ifndef DBG_CMP_ATT
#define DBG_CMP_ATT 0
#endif
#ifndef DBG_REP
#define DBG_REP -1
#endif
#ifndef DBG_PROBE
#define DBG_PROBE 0
#endif
constexpr int N_PHASES = 14;

constexpr int BATCH = 2, SEQ = 8192, D = 1024, T = BATCH * SEQ;
constexpr int NH = 8, HD = 64, AW = 512, IDXH = 8, IDXD = 64, TOPK = 256;
constexpr int NIN = 5704, NINP = 5888;
constexpr int NEXP = 32, DEXP = 512;
constexpr int XPROWS = 40960;
constexpr float EPS = 1e-6f;
constexpr float LOG2E = 1.4426950408889634f;
constexpr float C2 = 0.125f * LOG2E;

constexpr size_t MiB = 1u << 20;
constexpr size_t WS_CTL = 0, CTL_ZERO_BYTES = 1 * MiB;
constexpr size_t WS_SMALL = 1 * MiB;
constexpr size_t SM_MOD = WS_SMALL + 0;
constexpr size_t SM_WRT = WS_SMALL + 65536;
constexpr size_t SM_EID = WS_SMALL + 262144;
constexpr size_t SM_EWT = WS_SMALL + 393216;
constexpr size_t SM_SLOT = WS_SMALL + 524288;
constexpr size_t SM_AT = WS_SMALL + 655360;
constexpr size_t WS_WIN = 3 * MiB;
constexpr size_t WS_WA = 15 * MiB, WS_WC = 16 * MiB, WS_WOUT = 17 * MiB;
constexpr size_t WS_H1 = 19 * MiB;
constexpr size_t WS_AC = 19 * MiB, WS_ATT = 35 * MiB;
constexpr size_t WS_Q = 51 * MiB, WS_K = 67 * MiB, WS_V = 83 * MiB, WS_MASK = 83 * MiB, WS_VT = 99 * MiB, WS_QI = 115 * MiB, WS_KI = 131 * MiB;
constexpr size_t WS_WI = 133 * MiB, WS_QL = 133 * MiB + 524288;
constexpr size_t WS_CB = 136 * MiB, WS_U = 152 * MiB, WS_TMPC = 136 * MiB, WS_G = 168 * MiB;
constexpr size_t WS_MERGED = 51 * MiB;
constexpr size_t WS_WGU = 51 * MiB, WS_WD = 115 * MiB;
constexpr size_t WS_HID = 147 * MiB;
constexpr size_t WS_Y = 187 * MiB;
constexpr size_t WS_END = DBG_CMP_ATT ? 300 * MiB : 267 * MiB;
constexpr size_t WS_MASK_DBG = 268 * MiB, WS_ATT2 = 284 * MiB;
constexpr int CW_CMP = 2048;
constexpr int CW_TMO = 0, CW_CODE = 1, CW_KMAX = 64, CW_ECNT = 1024  , CW_BAR = 4096, CW_AROW = 131072  ;

constexpr int RING_OFF = 0, RING_BYTES = 131072;
constexpr int LDSCTL_OFF = RING_BYTES, MISC_OFF = LDSCTL_OFF + 320;
constexpr int LDS_BYTES = 147456;

#define GAS __attribute__((address_space(1)))
#define LAS __attribute__((address_space(3)))
typedef unsigned short bf16;
typedef unsigned v4u __attribute__((ext_vector_type(4)));
typedef unsigned v2u __attribute__((ext_vector_type(2)));
typedef float f32x4 __attribute__((ext_vector_type(4)));
typedef short bf16x8 __attribute__((ext_vector_type(8)));
typedef GAS unsigned gu32;
#define RLX_AGENT __ATOMIC_RELAXED, __HIP_MEMORY_SCOPE_AGENT
#define LDS_WAIT() asm volatile("s_waitcnt lgkmcnt(0)" ::: "memory")
#define VM_WAIT() asm volatile("s_waitcnt vmcnt(0)" ::: "memory")
__device__ __forceinline__ unsigned f2bf(float f) { unsigned u = __builtin_bit_cast(unsigned, f); return (u + 0x7fffu + ((u >> 16) & 1u)) >> 16; }
__device__ __forceinline__ unsigned pk2(float lo, float hi) { return f2bf(lo) | (f2bf(hi) << 16); }
__device__ __forceinline__ float bflo(unsigned u) { return __builtin_bit_cast(float, u << 16); }
__device__ __forceinline__ float bfhi(unsigned u) { return __builtin_bit_cast(float, u & 0xffff0000u); }
__device__ __forceinline__ float bf1(bf16 h) { return __builtin_bit_cast(float, (unsigned)h << 16); }
__device__ __forceinline__ float wave_sum(float v) {
#pragma unroll
    for (int o = 1; o < 64; o <<= 1) v += __shfl_xor(v, o);
    return v;
}
#define DPP_F(v, ctrl, row_mask) __builtin_bit_cast(float, __builtin_amdgcn_update_dpp(0, __builtin_bit_cast(int, (v)), (ctrl), (row_mask), 0xf, false))
__device__ __forceinline__ float wave_sum63(float v) {
    v += DPP_F(v, 0x111, 0xf); v += DPP_F(v, 0x112, 0xf); v += DPP_F(v, 0x114, 0xf); v += DPP_F(v, 0x118, 0xf);
    v += DPP_F(v, 0x142, 0xa);
    v += DPP_F(v, 0x143, 0xc);
    return v;
}
__device__ __forceinline__ float wave_sum_all(float v) { return __builtin_bit_cast(float, __builtin_amdgcn_readlane(__builtin_bit_cast(int, wave_sum63(v)), 63)); }
__device__ __forceinline__ float wave_max(float v) {
#pragma unroll
    for (int o = 1; o < 64; o <<= 1) v = fmaxf(v, __shfl_xor(v, o));
    return v;
}

#define XB_TMO      128
#define XB_XCNT(j)  (256  + 64 * (j))
#define XB_XSUB(j)  (1280 + 64 * (j))
#define XB_XGEN(j)  (2304 + 64 * (j))
#define XB_TOP      3328
#define XB_TOPGEN   3392
#define XCD_BAR_WORDS 3456
#define XB_SPIN_CAP (1u << 18)

__device__ __forceinline__ unsigned xb_ld(unsigned* p)              { return __hip_atomic_load(p, __ATOMIC_RELAXED, __HIP_MEMORY_SCOPE_AGENT); }
__device__ __forceinline__ unsigned xb_add(unsigned* p, unsigned v) { return __hip_atomic_fetch_add(p, v, __ATOMIC_RELAXED, __HIP_MEMORY_SCOPE_AGENT); }
__device__ __forceinline__ unsigned xb_xcc_id() { return (unsigned)__builtin_amdgcn_s_getreg((3 << 11) | 20) & 0xFu; }
#define XB_SPIN(cond, bar) do { unsigned _sp = 0; while (cond) { __builtin_amdgcn_s_sleep(1); \
    if ((++_sp & 255u) == 0u) { if (xb_ld(&(bar)[XB_TMO])) break; if (_sp > XB_SPIN_CAP) { atomicAdd(&(bar)[XB_TMO], 1u); break; } } } } while (0)

struct XcdBarrier { unsigned* bar; unsigned x; volatile LAS unsigned* st; };

__device__ __forceinline__ XcdBarrier xcd_barrier_post(unsigned* bar, volatile LAS unsigned* st) {
    XcdBarrier b; b.bar = bar; b.x = xb_xcc_id(); b.st = st;
    if (threadIdx.x == 0) (void)xb_add(&bar[XB_XCNT(b.x)], 1u);
    return b;
}
__device__ __forceinline__ void xcd_barrier_complete(unsigned* bar, unsigned x, unsigned& nloc, unsigned& nx) {
    const unsigned G = gridDim.x * gridDim.y * gridDim.z;
    unsigned sum, cnt, mine, sp = 0u;
    for (;;) {
        sum = 0u; cnt = 0u; mine = 0u;
#pragma unroll
        for (unsigned j = 0; j < 16; ++j) { const unsigned c = xb_ld(&bar[XB_XCNT(j)]); sum += c; cnt += (c > 0u) ? 1u : 0u; mine = (j == x) ? c : mine; }
        if (sum == G) break;
        __builtin_amdgcn_s_sleep(1);
        if ((++sp & 255u) == 0u) { if (xb_ld(&bar[XB_TMO])) break; if (sp > XB_SPIN_CAP) { atomicAdd(&bar[XB_TMO], 1u); break; } }
    }
    nloc = mine > 0u ? mine : 1u; nx = cnt > 0u ? cnt : 1u;
}
__device__ __forceinline__ void xcd_barrier(const XcdBarrier& b, const bool is_t0  ) {
    asm volatile("s_waitcnt vmcnt(0)" ::: "memory");
    __syncthreads();
    if (is_t0) {
        unsigned* bar = b.bar;
        __builtin_amdgcn_s_waitcnt(0);
        unsigned nloc = b.st[0], nx = b.st[1];
        if (nloc == 0u) { xcd_barrier_complete(bar, b.x, nloc, nx); b.st[0] = nloc; b.st[1] = nx; }
        const unsigned old = xb_add(&bar[XB_XSUB(b.x)], 1u);
        const unsigned gen = old / nloc;
        if (old + 1u == (gen + 1u) * nloc) {
            __builtin_amdgcn_fence(__ATOMIC_RELEASE, "agent");
            asm volatile("s_waitcnt vmcnt(0)" ::: "memory");
            const unsigned og = xb_add(&bar[XB_TOP], 1u);
            const unsigned tg = og / nx;
            if (og + 1u == (tg + 1u) * nx) xb_add(&bar[XB_TOPGEN], 1u);
            else XB_SPIN(xb_ld(&bar[XB_TOPGEN]) == tg, bar);
            __builtin_amdgcn_fence(__ATOMIC_ACQUIRE, "agent");
            xb_add(&bar[XB_XGEN(b.x)], 1u);
            asm volatile("s_waitcnt vmcnt(0)" ::: "memory");
        } else {
            XB_SPIN(xb_ld(&bar[XB_XGEN(b.x)]) == gen, bar);
            __builtin_amdgcn_fence(__ATOMIC_ACQUIRE, "agent");
            asm volatile("s_waitcnt vmcnt(0)" ::: "memory");
        }
    }
    __syncthreads();
}

struct Frame {
    LAS unsigned char* lds;
    volatile LAS unsigned* MISC;
    gu32* ctl;
    unsigned char* ws;
    int tid, lane, wave;
    int vcu, G;
    const float *x, *c, *w_ada, *b_ada, *norm1_g, *w_in, *rel_bias, *conv_w, *w_attn, *w_conv, *w_out, *norm2_g, *wrg, *brg, *wre, *bre, *w_gate_e, *w_up_e, *w_down_e, *norm_f_g;
    float* out;
};
#define WSP(T_, off) ((T_*)(F.ws + (off)))

template <class RowMap>
__device__ __forceinline__ void transpose_item(const float* W, int K, int N, bf16* WT, LAS float* scr, int item, int lane, RowMap rm) {
    const int nblk = (N + 31) / 32, kb = item / nblk, nb = item % nblk, k0 = 64 * kb, n0 = 32 * nb;
    const int c4 = (lane & 7) * 4, rr = lane >> 3;
    f32x4 v[8];
#pragma unroll
    for (int i = 0; i < 8; ++i) v[i] = (n0 + c4 < N) ? *(const f32x4*)(W + (size_t)(k0 + 8 * i + rr) * N + n0 + c4) : (f32x4){0.f, 0.f, 0.f, 0.f};
#pragma unroll
    for (int i = 0; i < 8; ++i) { LAS float* d = scr + (8 * i + rr) * 33 + c4; d[0] = v[i][0]; d[1] = v[i][1]; d[2] = v[i][2]; d[3] = v[i][3]; }
    LDS_WAIT(); asm volatile("" ::: "memory");
    const int c = lane & 7;
#pragma unroll
    for (int j = 0; j < 4; ++j) { const int n = (lane >> 3) + 8 * j; const LAS float* s = scr + (8 * c) * 33 + n;
        v4u o; o.x = pk2(s[0 * 33], s[1 * 33]); o.y = pk2(s[2 * 33], s[3 * 33]); o.z = pk2(s[4 * 33], s[5 * 33]); o.w = pk2(s[6 * 33], s[7 * 33]);
        if (n0 + n < N) *(GAS v4u*)(WT + (size_t)rm(n0 + n) * K + k0 + 8 * c) = o; }
    LDS_WAIT(); asm volatile("" ::: "memory");
}
struct RmId { __device__ __forceinline__ int operator()(int n) const { return n; } };
struct RmWin { __device__ __forceinline__ int operator()(int n) const {
    if (n < 2120) return n;
    if (n < 2632) return n + 184;
    if (n < 3144) { const int j = n - 2632; return 2816 + 256 * (j >> 7) + (j & 127); }
    if (n < 3656) { const int j = n - 3144; return 2816 + 256 * (j >> 7) + 128 + (j & 127); }
    return n + 184; } };
struct RmGU { int half; __device__ __forceinline__ int operator()(int n) const { return 256 * (n >> 7) + 128 * half + (n & 127); } };

__device__ __forceinline__ void p0_prologue(Frame& F) {
    LAS float* scr = (LAS float*)(F.lds + RING_OFF + F.wave * 16384);
    const int gw = F.vcu * NWAVES + F.wave, NGW = F.G * NWAVES;
    if (F.vcu < 96) {
        const int n = F.vcu * 64 + F.lane; float a0 = 0.f, a1 = 0.f;
        LAS float* cact = (LAS float*)(F.lds + RING_OFF + 16384);
        for (int i = F.tid; i < 2 * D; i += 512) { const float cv = F.c[i]; cact[i] = cv / (1.f + __expf(-cv)); }
        __syncthreads();
#pragma unroll 16
        for (int k = F.wave * 128; k < F.wave * 128 + 128; ++k) {
            const float w = F.w_ada[(size_t)k * 6144 + n];
            a0 += cact[k] * w; a1 += cact[D + k] * w;
        }
        LAS float* red = (LAS float*)(F.lds + RING_OFF + 8448);
        red[(F.wave * 2 + 0) * 64 + F.lane] = a0; red[(F.wave * 2 + 1) * 64 + F.lane] = a1;
        __syncthreads();
        if (F.wave < 2) { float s = F.b_ada[n];
#pragma unroll
            for (int w = 0; w < 8; ++w) s += red[(w * 2 + F.wave) * 64 + F.lane];
            WSP(float, SM_MOD)[F.wave * 6144 + n] = s; }
        __syncthreads();
    }
    constexpr int I_IN = 16 * 179;
    for (int it = gw; it < I_IN; it += NGW) transpose_item(F.w_in, D, NIN, WSP(bf16, WS_WIN), scr, it, F.lane, RmWin());
    for (int i = gw * 64 + F.lane; i < 184 * 128; i += NGW * 64) { *(GAS v4u*)(WSP(bf16, WS_WIN) + (size_t)2120 * D + (size_t)i * 8) = (v4u){0u, 0u, 0u, 0u}; }
    for (int i = gw * 64 + F.lane; i < 36 * D; i += NGW * 64) { const int n = i / D, k = i % D; WSP(float, SM_WRT)[i] = (n < 4) ? F.wrg[k * 4 + n] : F.wre[k * 32 + (n - 4)]; }
}

__device__ __forceinline__ void p1_norm1(Frame& F) {
    const int gw = F.vcu * NWAVES + F.wave, NGW = F.G * NWAVES;
    const float* mod = WSP(float, SM_MOD);
    for (int m0 = gw * 4; m0 < T; m0 += NGW * 4) {
        const int b = m0 / SEQ;
        f32x4 v[4][4]; float ss[4];
#pragma unroll
        for (int r = 0; r < 4; ++r) { const GAS f32x4* xr = (const GAS f32x4*)(F.x + (size_t)(m0 + r) * D) + F.lane;
#pragma unroll
            for (int j = 0; j < 4; ++j) v[r][j] = xr[64 * j]; }
#pragma unroll
        for (int r = 0; r < 4; ++r) { float s = 0.f;
#pragma unroll
            for (int j = 0; j < 4; ++j) s += (v[r][j].x * v[r][j].x + v[r][j].y * v[r][j].y) + (v[r][j].z * v[r][j].z + v[r][j].w * v[r][j].w);
            ss[r] = 1.f / sqrtf(wave_sum_all(s) * (1.f / D) + EPS); }
#pragma unroll
        for (int j = 0; j < 4; ++j) { const int k = 4 * F.lane + 256 * j;
            const f32x4 g = *(const f32x4*)(F.norm1_g + k), sc = *(const f32x4*)(mod + b * 6144 + 1024 + k), sh = *(const f32x4*)(mod + b * 6144 + k);
            const f32x4 ca = g * (sc + 1.0f);
#pragma unroll
            for (int r = 0; r < 4; ++r) { const f32x4 h = v[r][j] * ss[r] * ca + sh; ((GAS v2u*)(WSP(bf16, WS_H1) + (size_t)(m0 + r) * D) + F.lane)[64 * j] = (v2u){pk2(h.x, h.y), pk2(h.z, h.w)}; } }
    }
}

using pg8::Unit;
typedef float f32x2_t __attribute__((ext_vector_type(2))); typedef __bf16 bf16x2_t __attribute__((ext_vector_type(2)));
__device__ __forceinline__ unsigned cvtpk(float lo, float hi) { f32x2_t v = {lo, hi}; bf16x2_t b = __builtin_convertvector(v, bf16x2_t); return __builtin_bit_cast(unsigned, b); }
__device__ __forceinline__ v4u pack8(const f32x4 a, const f32x4 b) { v4u w; w.x = cvtpk(a[0], a[1]); w.y = cvtpk(a[2], a[3]); w.z = cvtpk(b[0], b[1]); w.w = cvtpk(b[2], b[3]); return w; }
__device__ __forceinline__ float sigmoidf_(float x) { return __builtin_amdgcn_rcpf(1.f + __builtin_amdgcn_exp2f(-x * LOG2E)); }
__device__ __forceinline__ f32x4 sig4(f32x4 v) { return (f32x4){sigmoidf_(v[0]), sigmoidf_(v[1]), sigmoidf_(v[2]), sigmoidf_(v[3])}; }
__device__ __forceinline__ void unpack8(const v4u w, f32x4& a, f32x4& b) { a = (f32x4){bflo(w.x), bfhi(w.x), bflo(w.y), bfhi(w.y)}; b = (f32x4){bflo(w.z), bfhi(w.z), bflo(w.w), bfhi(w.w)}; }

struct EpiProj {
    static constexpr bool PERM = true, AFTER_DRAIN = false;
    bf16 *Q, *K, *V, *QI, *KI, *CB, *U, *G; float* WI;
    __device__ __forceinline__ void operator()(const f32x4 (&acc)[2][2][4][2], const Unit& u, int wr, int wc, int fr, int fq) const {
        const int pn = u.pn, row0 = u.pm * 256 + wr * 64 + fr, cb8 = wc * 32 + 8 * fq;
        if (pn < 8 || pn == 9 || pn == 10) {
            bf16* base; int coff; float sc = 1.f;
            if (pn < 2) { base = Q; coff = 256 * pn; sc = C2; } else if (pn < 4) { base = K; coff = 256 * (pn - 2); } else if (pn < 6) { base = V; coff = 256 * (pn - 4); }
            else if (pn < 8) { base = QI; coff = 256 * (pn - 6); } else { base = CB; coff = 256 * (pn - 9); }
#pragma unroll
            for (int ai = 0; ai < 2; ++ai)
#pragma unroll
                for (int m = 0; m < 4; ++m) { bf16* rowp = base + (size_t)(row0 + ai * 128 + m * 16) * 512 + coff + cb8;
#pragma unroll
                    for (int bj = 0; bj < 2; ++bj) *(v4u*)(rowp + bj * 128) = pack8(acc[ai][bj][m][0] * sc, acc[ai][bj][m][1] * sc); }
        } else if (pn == 8) {
#pragma unroll
            for (int ai = 0; ai < 2; ++ai)
#pragma unroll
                for (int m = 0; m < 4; ++m) { const size_t row = (size_t)(row0 + ai * 128 + m * 16);
                    if (wc < 2) *(v4u*)(KI + row * 64 + cb8) = pack8(acc[ai][0][m][0], acc[ai][0][m][1]);
                    else if (wc == 2 && fq == 0) { *(f32x4*)(WI + row * 8) = acc[ai][0][m][0]; *(f32x4*)(WI + row * 8 + 4) = acc[ai][0][m][1]; } }
        } else if (pn < 15) {
#pragma unroll
            for (int ai = 0; ai < 2; ++ai)
#pragma unroll
                for (int m = 0; m < 4; ++m) { const size_t row = (size_t)(row0 + ai * 128 + m * 16);
                    *(v4u*)(U + row * 512 + 128 * (pn - 11) + cb8) = pack8(acc[ai][0][m][0] * acc[ai][1][m][0], acc[ai][0][m][1] * acc[ai][1][m][1]); }
        } else {
#pragma unroll
            for (int ai = 0; ai < 2; ++ai)
#pragma unroll
                for (int m = 0; m < 4; ++m) { bf16* rowp = G + (size_t)(row0 + ai * 128 + m * 16) * 2048 + 256 * (pn - 15) + cb8;
#pragma unroll
                    for (int bj = 0; bj < 2; ++bj) *(v4u*)(rowp + bj * 128) = pack8(sig4(acc[ai][bj][m][0]), sig4(acc[ai][bj][m][1])); }
        }
    }
};
struct EpiConv {
    static constexpr bool PERM = true, AFTER_DRAIN = false;
    const bf16* G; bf16* O;
    __device__ __forceinline__ void operator()(const f32x4 (&acc)[2][2][4][2], const Unit& u, int wr, int wc, int fr, int fq) const {
        const int row0 = u.pm * 256 + wr * 64 + fr, col0 = u.pn * 256 + wc * 32 + 8 * fq;
#pragma unroll
        for (int ai = 0; ai < 2; ++ai)
#pragma unroll
            for (int m = 0; m < 4; ++m) { const size_t row = (size_t)(row0 + ai * 128 + m * 16);
#pragma unroll
                for (int bj = 0; bj < 2; ++bj) { f32x4 g0, g1; unpack8(*(const v4u*)(G + row * 2048 + 1024 + col0 + bj * 128), g0, g1);
                    *(v4u*)(O + row * 1024 + col0 + bj * 128) = pack8(g0 * acc[ai][bj][m][0], g1 * acc[ai][bj][m][1]); } }
    }
};
struct EpiAttn {
    static constexpr bool PERM = true, AFTER_DRAIN = false;
    const bf16* G; const bf16* Tc; bf16* O;
    __device__ __forceinline__ void operator()(const f32x4 (&acc)[2][2][4][2], const Unit& u, int wr, int wc, int fr, int fq) const {
        const int row0 = u.pm * 256 + wr * 64 + fr, col0 = u.pn * 256 + wc * 32 + 8 * fq;
#pragma unroll
        for (int ai = 0; ai < 2; ++ai)
#pragma unroll
            for (int m = 0; m < 4; ++m) { const size_t row = (size_t)(row0 + ai * 128 + m * 16);
#pragma unroll
                for (int bj = 0; bj < 2; ++bj) { f32x4 g0, g1, t0, t1; unpack8(*(const v4u*)(G + row * 2048 + col0 + bj * 128), g0, g1); unpack8(*(const v4u*)(Tc + row * 1024 + col0 + bj * 128), t0, t1);
                    *(v4u*)(O + row * 1024 + col0 + bj * 128) = pack8(g0 * acc[ai][bj][m][0] + t0, g1 * acc[ai][bj][m][1] + t1); } }
    }
};
struct ChainOrder {
    pg8::StaticOrder so;
    __device__ __forceinline__ bool next(int i, Unit& u) const { Unit uc; if (!so.next(i >> 1, uc)) return false;
        if ((i & 1) == 0) { u.pm = uc.pm; u.pn = 4 + uc.pn; } else { u.pm = T / 256 + uc.pm; u.pn = uc.pn; } return true; }
    __device__ __forceinline__ void a_ready(const Unit&) const {}
    __device__ __forceinline__ void done(const Unit&) const {}
};
struct EpiChain {
    static constexpr bool PERM = true, AFTER_DRAIN = false;
    const bf16* G; bf16* Tc; bf16* O;
    __device__ __forceinline__ void operator()(const f32x4 (&acc)[2][2][4][2], const Unit& u, int wr, int wc, int fr, int fq) const {
        const bool conv = u.pn >= 4;
        const int row0 = (conv ? u.pm : u.pm - T / 256) * 256 + wr * 64 + fr, col0 = (u.pn & 3) * 256 + wc * 32 + 8 * fq;
#pragma unroll
        for (int ai = 0; ai < 2; ++ai)
#pragma unroll
            for (int m = 0; m < 4; ++m) { const size_t row = (size_t)(row0 + ai * 128 + m * 16);
#pragma unroll
                for (int bj = 0; bj < 2; ++bj) {
                    if (conv) { f32x4 g0, g1; unpack8(*(const v4u*)(G + row * 2048 + 1024 + col0 + bj * 128), g0, g1);
                        *(v4u*)(Tc + row * 1024 + col0 + bj * 128) = pack8(g0 * acc[ai][bj][m][0], g1 * acc[ai][bj][m][1]); }
                    else { f32x4 g0, g1, t0, t1; unpack8(*(const v4u*)(G + row * 2048 + col0 + bj * 128), g0, g1); unpack8(*(const v4u*)(Tc + row * 1024 + col0 + bj * 128), t0, t1);
                        *(v4u*)(O + row * 1024 + col0 + bj * 128) = pack8(g0 * acc[ai][bj][m][0] + t0, g1 * acc[ai][bj][m][1] + t1); } } }
    }
};
struct EpiOut {
    static constexpr bool PERM = false, AFTER_DRAIN = false;
    const float* X; const float* mod; float* O;
    __device__ __forceinline__ void operator()(const f32x4 (&acc)[2][2][4][2], const Unit& u, int wr, int wc, int fr, int fq) const {
        const int row0 = u.pm * 256 + wr * 64 + fr, col0 = u.pn * 256 + wc * 32 + 4 * fq;
        const float* g1 = mod + ((u.pm * 256) / SEQ) * 6144 + 2048;
#pragma unroll
        for (int bj = 0; bj < 2; ++bj)
#pragma unroll
            for (int n = 0; n < 2; ++n) { const int col = col0 + bj * 128 + n * 16; const f32x4 gv = *(const f32x4*)(g1 + col);
#pragma unroll
                for (int ai = 0; ai < 2; ++ai)
#pragma unroll
                    for (int m = 0; m < 4; ++m) { const size_t off = (size_t)(row0 + ai * 128 + m * 16) * D + col;
                        *(f32x4*)(O + off) = *(const f32x4*)(X + off) + gv * acc[ai][bj][m][n]; } }
    }
};
__device__ __forceinline__ f32x4 silu_mul4(f32x4 g, f32x4 u) { return (f32x4){g[0] * sigmoidf_(g[0]) * u[0], g[1] * sigmoidf_(g[1]) * u[1], g[2] * sigmoidf_(g[2]) * u[2], g[3] * sigmoidf_(g[3]) * u[3]}; }
struct EpiHid {
    static constexpr bool PERM = true, AFTER_DRAIN = false;
    bf16* O;
    __device__ __forceinline__ void operator()(const f32x4 (&acc)[2][2][4][2], const Unit& u, int wr, int wc, int fr, int fq) const {
        const int row0 = u.pm * 256 + wr * 64 + fr, col0 = 128 * (u.pn & 3) + wc * 32 + 8 * fq;
#pragma unroll
        for (int ai = 0; ai < 2; ++ai)
#pragma unroll
            for (int m = 0; m < 4; ++m) { const size_t row = (size_t)(row0 + ai * 128 + m * 16);
                *(v4u*)(O + row * 512 + col0) = pack8(silu_mul4(acc[ai][0][m][0], acc[ai][1][m][0]), silu_mul4(acc[ai][0][m][1], acc[ai][1][m][1])); }
    }
};
struct EpiY {
    static constexpr bool PERM = true, AFTER_DRAIN = false;
    bf16* O;
    __device__ __forceinline__ void operator()(const f32x4 (&acc)[2][2][4][2], const Unit& u, int wr, int wc, int fr, int fq) const {
        const int row0 = u.pm * 256 + wr * 64 + fr, col0 = 256 * (u.pn & 3) + wc * 32 + 8 * fq;
#pragma unroll
        for (int ai = 0; ai < 2; ++ai)
#pragma unroll
            for (int m = 0; m < 4; ++m) { const size_t row = (size_t)(row0 + ai * 128 + m * 16);
#pragma unroll
                for (int bj = 0; bj < 2; ++bj) *(v4u*)(O + row * 1024 + col0 + bj * 128) = pack8(acc[ai][bj][m][0], acc[ai][bj][m][1]); }
    }
};
struct MoeOrder {
    const LAS int* tile_e; int ntiles, G, c;
    __device__ __forceinline__ bool next(int i, Unit& u) const {
        const int L = i * G + c; if (L >= ntiles * 4) return false;
        const int rt = L >> 2, j = L & 3; u.pm = rt; u.pn = 4 * tile_e[rt] + j; return true; }
    __device__ __forceinline__ void a_ready(const Unit&) const {}
    __device__ __forceinline__ void done(const Unit&) const {}
};

__device__ __forceinline__ void p3_prep(Frame& F) {
    const int gw = F.vcu * NWAVES + F.wave, NGW = F.G * NWAVES;
    for (int rp_ = 0; rp_ < (DBG_REP == 31 ? 3 : 1); ++rp_) {
        LAS bf16* tl = (LAS bf16*)(F.lds + RING_OFF + F.wave * 16384);
        const bf16* V = WSP(bf16, WS_V); bf16* VT = WSP(bf16, WS_VT);
        for (int it = gw; it < BATCH * NH * (SEQ / 64); it += NGW) {
            const int kt = it % (SEQ / 64), h = (it / (SEQ / 64)) % NH, b = it / (NH * (SEQ / 64));
            const bf16* src = V + (size_t)(b * SEQ + kt * 64 + F.lane) * 512 + h * 64;
#pragma unroll
            for (int c = 0; c < 8; ++c) { const v4u w = *(const v4u*)(src + c * 8);
                LAS unsigned* d = (LAS unsigned*)(tl + F.lane * 66 + c * 8); d[0] = w.x; d[1] = w.y; d[2] = w.z; d[3] = w.w; }
            LDS_WAIT(); asm volatile("" ::: "memory");
            unsigned o[32];
#pragma unroll
            for (int p = 0; p < 64; p += 2) {
                const int i0 = p & 15, i1 = (p + 1) & 15, g = p & ~15;
                const int k0 = g + ((i0 < 4 || i0 >= 12) ? i0 : (i0 < 8 ? i0 + 4 : i0 - 4)), k1 = g + ((i1 < 4 || i1 >= 12) ? i1 : (i1 < 8 ? i1 + 4 : i1 - 4));
                o[p >> 1] = (unsigned)tl[k0 * 66 + F.lane] | ((unsigned)tl[k1 * 66 + F.lane] << 16); }
            bf16* dst = VT + ((size_t)((b * NH + h) * 64 + F.lane)) * SEQ + kt * 64;
#pragma unroll
            for (int c = 0; c < 8; ++c) *(v4u*)(dst + c * 8) = (v4u){o[4 * c], o[4 * c + 1], o[4 * c + 2], o[4 * c + 3]};
            LDS_WAIT(); asm volatile("" ::: "memory");
        }
    }
    for (int rp_ = 0; rp_ < (DBG_REP == 32 ? 3 : 1); ++rp_) {
        const bf16* CB = WSP(bf16, WS_CB); const bf16* U = WSP(bf16, WS_U); bf16* AC = WSP(bf16, WS_AC);
        const int j = F.lane * 8;
        const f32x4 w2a = *(const f32x4*)(F.conv_w + 1024 + j), w2b = *(const f32x4*)(F.conv_w + 1024 + j + 4), w1a = *(const f32x4*)(F.conv_w + 512 + j), w1b = *(const f32x4*)(F.conv_w + 512 + j + 4),
                    w0a = *(const f32x4*)(F.conv_w + j), w0b = *(const f32x4*)(F.conv_w + j + 4);
        for (int t0 = gw * 8; t0 < T; t0 += NGW * 8) {
            v4u cw[8], uw[10];
#pragma unroll
            for (int r = 0; r < 8; ++r) cw[r] = *(const v4u*)(CB + (size_t)(t0 + r) * 512 + j);
            const int tt0 = t0 % SEQ;
#pragma unroll
            for (int r = 0; r < 10; ++r) uw[r] = (tt0 + r - 2 >= 0) ? *(const v4u*)(U + (size_t)(t0 + r - 2) * 512 + j) : (v4u){0u, 0u, 0u, 0u};
#pragma unroll
            for (int r = 0; r < 8; ++r) {
                f32x4 c0, c1, a0, a1, b0, b1, d0, d1;
                unpack8(cw[r], c0, c1); unpack8(uw[r + 2], a0, a1); unpack8(uw[r + 1], b0, b1); unpack8(uw[r], d0, d1);
                *(v4u*)(AC + (size_t)(t0 + r) * 512 + j) = pack8(c0 * (a0 * w2a + b0 * w1a + d0 * w0a), c1 * (a1 * w2b + b1 * w1b + d1 * w0b));
            }
        }
    }
    for (int rp_ = 0; rp_ < (DBG_REP == 33 ? 3 : 1); ++rp_) {
        const bf16* QI = WSP(bf16, WS_QI); const float* WI = WSP(float, WS_WI); bf16* QL = WSP(bf16, WS_QL); float* AT = WSP(float, SM_AT);
        for (int t0 = gw * 8; t0 < T; t0 += NGW * 8) {
            v4u qw[8]; float wh[8];
#pragma unroll
            for (int r = 0; r < 8; ++r) { qw[r] = *(const v4u*)(QI + (size_t)(t0 + r) * 512 + F.lane * 8); wh[r] = WI[(size_t)(t0 + r) * 8 + (F.lane >> 3)]; }
#pragma unroll
            for (int r = 0; r < 8; ++r) {
                f32x4 q0, q1; unpack8(qw[r], q0, q1);
                float n2 = (q0[0] * q0[0] + q0[1] * q0[1]) + (q0[2] * q0[2] + q0[3] * q0[3]) + (q1[0] * q1[0] + q1[1] * q1[1]) + (q1[2] * q1[2] + q1[3] * q1[3]);
                n2 += __shfl_xor(n2, 1); n2 += __shfl_xor(n2, 2); n2 += __shfl_xor(n2, 4);
                const float a = wave_sum63(((F.lane & 7) == 0) ? fabsf(wh[r]) * sqrtf(n2) : 0.f);
                f32x4 s0 = q0 * wh[r], s1 = q1 * wh[r];
#pragma unroll
                for (int o = 8; o < 64; o <<= 1) {
#pragma unroll
                    for (int e = 0; e < 4; ++e) { s0[e] += __shfl_xor(s0[e], o); s1[e] += __shfl_xor(s1[e], o); } }
                if (F.lane < 8) *(v4u*)(QL + (size_t)(t0 + r) * 64 + F.lane * 8) = pack8(s0, s1);
                if (F.lane == 63) AT[t0 + r] = a;
            }
        }
    }
    for (int rp_ = 0; rp_ < (DBG_REP == 34 ? 3 : 1); ++rp_) {
        const bf16* KI = WSP(bf16, WS_KI); float mx = 0.f;
        for (int s = gw * 64 + F.lane; s < T; s += NGW * 64) { float q = 0.f;
#pragma unroll
            for (int c = 0; c < 8; ++c) { f32x4 a, b; unpack8(*(const v4u*)(KI + (size_t)s * 64 + c * 8), a, b); q += (a[0] * a[0] + a[1] * a[1]) + (a[2] * a[2] + a[3] * a[3]) + (b[0] * b[0] + b[1] * b[1]) + (b[2] * b[2] + b[3] * b[3]); }
            mx = fmaxf(mx, q); }
        mx = wave_max(mx);
        if (F.lane == 0 && gw * 64 < T) atomicMax((unsigned*)(F.ctl + CW_KMAX + 64 * (gw & 7)), __builtin_bit_cast(unsigned, sqrtf(mx)));
    }
}

__device__ __forceinline__ unsigned ord_key(float x) { if (x == 0.f) x = 0.f; const unsigned u = __builtin_bit_cast(unsigned, x); return (u & 0x80000000u) ? ~u : (u | 0x80000000u); }
__device__ __forceinline__ int t5_bucket(int n) {
    if (n < 16) return n;
    const int v = 16 + (int)(logf((float)n / 16.f) / 2.0794415416798357f * 16.f);
    return v < 31 ? v : 31;
}
__device__ __forceinline__ void pn_naive_dsa(Frame& F) {
    LAS float* sc = (LAS float*)(F.lds + RING_OFF);
    LAS float* qf = (LAS float*)(F.lds + RING_OFF + 32768);
    LAS float* wq = qf + 512;
    LAS unsigned* hist = (LAS unsigned*)(F.lds + RING_OFF + 36864);
    LAS int* sel = (LAS int*)(F.lds + RING_OFF + 40960);
    LAS float* pbuf = (LAS float*)(F.lds + RING_OFF + 45056);
    LAS int* wcnt = (LAS int*)(F.lds + RING_OFF + 53248);
    LAS int* bkt = (LAS int*)(F.lds + RING_OFF + 53248 + 256);
    const bf16* QI = WSP(bf16, WS_QI); const bf16* KI = WSP(bf16, WS_KI); const float* WI = WSP(float, WS_WI);
    const bf16* Qb = WSP(bf16, WS_Q); const bf16* Kb = WSP(bf16, WS_K); const bf16* Vb = WSP(bf16, WS_V); bf16* ATT = WSP(bf16, WS_ATT);
    if (F.tid < 128) bkt[F.tid] = t5_bucket(F.tid);
    __syncthreads();
    for (int qi_ = 0; qi_ < T / F.G + 1; ++qi_) {
        const int qidx = qi_ * F.G + F.vcu; if (qidx >= T) break;
        const int b = qidx / SEQ, t = qidx % SEQ, n = t + 1;
        qf[F.tid] = bf1(QI[(size_t)qidx * 512 + F.tid]);
        if (F.tid < 8) wq[F.tid] = WI[(size_t)qidx * 8 + F.tid];
        __syncthreads();
        for (int s = F.tid; s < n; s += 512) {
            float kf[64]; const bf16* kr = KI + (size_t)(b * SEQ + s) * 64;
#pragma unroll
            for (int c = 0; c < 8; ++c) { f32x4 a, bb; unpack8(*(const v4u*)(kr + c * 8), a, bb); kf[8 * c] = a[0]; kf[8 * c + 1] = a[1]; kf[8 * c + 2] = a[2]; kf[8 * c + 3] = a[3]; kf[8 * c + 4] = bb[0]; kf[8 * c + 5] = bb[1]; kf[8 * c + 6] = bb[2]; kf[8 * c + 7] = bb[3]; }
            float score = 0.f;
#pragma unroll 1
            for (int h = 0; h < 8; ++h) { float dsum = 0.f;
#pragma unroll
                for (int d4 = 0; d4 < 16; ++d4) { const f32x4 q4 = *(const LAS f32x4*)(qf + h * 64 + d4 * 4); dsum += q4[0] * kf[4 * d4] + q4[1] * kf[4 * d4 + 1] + q4[2] * kf[4 * d4 + 2] + q4[3] * kf[4 * d4 + 3]; }
                score += wq[h] * fmaxf(dsum, 0.f); }
            sc[s] = score;
        }
        __syncthreads();
        unsigned prefix = 0u, pmask = 0u; int need = TOPK;
        if (n > TOPK) {
            for (int pass = 0; pass < 4; ++pass) {
                const int shift = 24 - 8 * pass;
                if (F.tid < 256) hist[F.tid] = 0u;
                __syncthreads();
                for (int s = F.tid; s < n; s += 512) { const unsigned u = ord_key(sc[s]); if ((u & pmask) == prefix) atomicAdd((unsigned*)&hist[(u >> shift) & 255u], 1u); }
                __syncthreads();
                if (F.wave == 0) {
                    int c4[4]; int tot = 0;
#pragma unroll
                    for (int j = 0; j < 4; ++j) { c4[j] = (int)hist[4 * F.lane + j]; tot += c4[j]; }
                    int incl = tot;
#pragma unroll
                    for (int o = 1; o < 64; o <<= 1) { const int v = __shfl_down(incl, o); if (F.lane + o < 64) incl += v; }
                    const int above = incl - tot;
                    if (above < need && need <= incl) { int run = above;
#pragma unroll
                        for (int j = 3; j >= 0; --j) { if (run < need && need <= run + c4[j]) { wcnt[16] = 4 * F.lane + j; wcnt[17] = need - run; } run += c4[j]; } }
                }
                __syncthreads();
                prefix |= (unsigned)wcnt[16] << shift; pmask |= 255u << shift; need = wcnt[17];
                __syncthreads();
            }
        }
        int cg = 0, ce = 0;
        for (int i = 0; i < 16; ++i) { const int s = F.wave * 1024 + i * 64 + F.lane; bool gt = false, eq = false;
            if (s < n) { if (n <= TOPK) gt = true; else { const unsigned u = ord_key(sc[s]); gt = u > prefix; eq = (u == prefix); } }
            cg += __popcll(__ballot(gt)); ce += __popcll(__ballot(eq)); }
        if (F.lane == 0) { wcnt[2 * F.wave] = cg; wcnt[2 * F.wave + 1] = ce; }
        __syncthreads();
        int eqb = 0, tkb = 0, nsel = 0;
        { int eq_before = 0;
          for (int w = 0; w < 8; ++w) { const int g = wcnt[2 * w], e = wcnt[2 * w + 1];
              int take_e = need - eq_before; take_e = take_e < 0 ? 0 : (take_e > e ? e : take_e); if (n <= TOPK) take_e = 0;
              if (w < F.wave) { eqb += e; tkb += g + take_e; }
              nsel += g + take_e; eq_before += e; } }
        for (int i = 0; i < 16; ++i) { const int s = F.wave * 1024 + i * 64 + F.lane; bool gt = false, eq = false;
            if (s < n) { if (n <= TOPK) gt = true; else { const unsigned u = ord_key(sc[s]); gt = u > prefix; eq = (u == prefix); } }
            const unsigned long long mg = __ballot(gt), me = __ballot(eq), lt = (1ull << F.lane) - 1ull;
            const int erank = eqb + __popcll(me & lt);
            const bool take = gt || (eq && erank < need);
            const unsigned long long mt = __ballot(take);
            if (take) sel[tkb + __popcll(mt & lt)] = s;
            eqb += __popcll(me); tkb += __popcll(mt); (void)mg; }
        __syncthreads();
        {
            const int h = F.wave;
            qf[F.tid] = bf1(Qb[(size_t)qidx * 512 + F.tid]);
            __syncthreads();
            float lg[4]; float mx = -INFINITY;
#pragma unroll
            for (int i = 0; i < 4; ++i) { const int j = F.lane + 64 * i; lg[i] = -INFINITY;
                if (j < nsel) { const int s = sel[j]; const bf16* kr = Kb + (size_t)(b * SEQ + s) * 512 + h * 64; float dsum = 0.f;
#pragma unroll
                    for (int c = 0; c < 8; ++c) { f32x4 a, bb; unpack8(*(const v4u*)(kr + c * 8), a, bb); const f32x4 q0 = *(const LAS f32x4*)(qf + h * 64 + c * 8), q1 = *(const LAS f32x4*)(qf + h * 64 + c * 8 + 4);
                        dsum += (q0[0] * a[0] + q0[1] * a[1]) + (q0[2] * a[2] + q0[3] * a[3]) + (q1[0] * bb[0] + q1[1] * bb[1]) + (q1[2] * bb[2] + q1[3] * bb[3]); }
                    const int dist = t - s; const int bk = dist < 128 ? bkt[dist] : 31;
                    lg[i] = dsum + F.rel_bias[bk * 8 + h] * LOG2E; mx = fmaxf(mx, lg[i]); } }
            mx = wave_max(mx); float sum = 0.f;
#pragma unroll
            for (int i = 0; i < 4; ++i) { const int j = F.lane + 64 * i; const float p = (j < nsel) ? __builtin_amdgcn_exp2f(lg[i] - mx) : 0.f; sum += p; pbuf[h * 256 + j] = p; }
            sum = wave_sum(sum);
            LDS_WAIT(); asm volatile("" ::: "memory");
            float o = 0.f;
            for (int j = 0; j < nsel; ++j) o += pbuf[h * 256 + j] * bf1(Vb[(size_t)(b * SEQ + sel[j]) * 512 + h * 64 + F.lane]);
            ATT[(size_t)qidx * 512 + h * 64 + F.lane] = (bf16)f2bf(o / sum);
        }
        __syncthreads();
    }
}


typedef float f32x16 __attribute__((ext_vector_type(16)));
#define MFMA32(a, b, c) __builtin_amdgcn_mfma_f32_32x32x16_bf16((a), (b), (c), 0, 0, 0)
__device__ __forceinline__ int crow(int r, int hi) { return (r & 3) + 8 * (r >> 2) + 4 * hi; }
constexpr int IDX_CTL = LDSCTL_OFF + 2048;
constexpr int IDX_CAP = 768;

#define MFMA16(a, b, c) __builtin_amdgcn_mfma_f32_16x16x32_bf16((a), (b), (c), 0, 0, 0)
__device__ __forceinline__ void idx_tile(const bf16x8 (&kf)[4][2], const bf16x8 (&ql)[2], const bf16x8 (&qf)[8][2], const LAS float* w  , float invA, unsigned (&key)[4][4]) {
    float sc[4][4];
#define IDX_MF(D, QF0, QF1) _Pragma("unroll") for (int a = 0; a < 2; ++a) { D[a] = (f32x4){0.f, 0.f, 0.f, 0.f}; D[a] = MFMA16(kf[2 * hf + a][0], QF0, D[a]); D[a] = MFMA16(kf[2 * hf + a][1], QF1, D[a]); }
#define IDX_AC(D, W) do { const float wv_ = (W); _Pragma("unroll") for (int a = 0; a < 2; ++a) _Pragma("unroll") for (int i = 0; i < 4; ++i) { float x_ = __builtin_fmaf(wv_, __builtin_fabsf(D[a][i]), sc[2 * hf + a][i]); asm volatile("" : "+v"(x_)); sc[2 * hf + a][i] = x_; } } while (0)
#pragma unroll
    for (int hf = 0; hf < 2; ++hf) {
        f32x4 dA[2], dB[2];
        IDX_MF(dA, ql[0], ql[1]);
        IDX_MF(dB, qf[0][0], qf[0][1]);
#pragma unroll
        for (int a = 0; a < 2; ++a)
#pragma unroll
            for (int i = 0; i < 4; ++i) { float x_ = dA[a][i]; asm volatile("" : "+v"(x_)); sc[2 * hf + a][i] = x_; }
        IDX_MF(dA, qf[1][0], qf[1][1]); IDX_AC(dB, w[0]);
        IDX_MF(dB, qf[2][0], qf[2][1]); IDX_AC(dA, w[1]);
        IDX_MF(dA, qf[3][0], qf[3][1]); IDX_AC(dB, w[2]);
        IDX_MF(dB, qf[4][0], qf[4][1]); IDX_AC(dA, w[3]);
        IDX_MF(dA, qf[5][0], qf[5][1]); IDX_AC(dB, w[4]);
        IDX_MF(dB, qf[6][0], qf[6][1]); IDX_AC(dA, w[5]);
        IDX_MF(dA, qf[7][0], qf[7][1]); IDX_AC(dB, w[6]);
        IDX_AC(dA, w[7]);
    }
#undef IDX_MF
#undef IDX_AC
#pragma unroll
    for (int a = 0; a < 4; ++a)
#pragma unroll
        for (int i = 0; i < 4; ++i) key[a][i] = __builtin_bit_cast(unsigned, __builtin_fmaf(sc[a][i], invA, 3.0f));
}
__device__ __forceinline__ void idx_load_k(bf16x8 (&kf)[4][2], const bf16* KItile  , unsigned voff  ) {
#pragma unroll
    for (int a = 0; a < 4; ++a)
#pragma unroll
        for (int ks = 0; ks < 2; ++ks) kf[a][ks] = *(const bf16x8*)((const char*)KItile + voff + a * 2048 + ks * 64);
}
template <int MODE>
__device__ __forceinline__ void idx_pass(Frame& F, int ln, const bf16* KIb, unsigned* MASKg, int t0, int nt_idx, int nt_att, const bf16x8 (&ql)[2], const bf16x8 (&qf)[8][2], const LAS float* w, float invA, int b1, unsigned thr, int b_lo = 0, int ss = 1) {
    const int qc = ln & 15, fq = ln >> 4, qh = F.wave & 1, kp = F.wave >> 1, ql_ = 16 * qh + qc, t = t0 + ql_;
    LAS unsigned* hrow = (LAS unsigned*)(F.lds + RING_OFF) + ql_ * 1025;
    const int ntl = (MODE >= 2) ? nt_att : nt_idx;
    LAS unsigned* mlds = (LAS unsigned*)(F.lds + RING_OFF);
    LAS unsigned* clist = (LAS unsigned*)(F.lds + RING_OFF + 32768);
    LAS unsigned* ccnt = (LAS unsigned*)(F.lds + IDX_CTL) + 96;
    const int kstep = (MODE == 0) ? 4 * ss : 4; unsigned nabove = 0u; const int bw = b1 - b_lo;
    bf16x8 kcur[4][2];
    const unsigned voff = (unsigned)(qc * 64 + fq * 8) * 2u;
#pragma unroll
    for (int a = 0; a < 4; ++a)
#pragma unroll
        for (int ks = 0; ks < 2; ++ks) kcur[a][ks] = (bf16x8){0, 0, 0, 0, 0, 0, 0, 0};
    if (kp < nt_idx) idx_load_k(kcur, KIb + (size_t)(64 * kp) * 64, voff);
    for (int kt = kp; kt < ntl; kt += kstep) {
        unsigned m16 = 0u;
        if (kt < nt_idx) {
            unsigned key[4][4];
            const bool diag = 64 * kt + 63 > t0;
            idx_tile(kcur, ql, qf, w, invA, key);
            if (kt + kstep < nt_idx) idx_load_k(kcur, KIb + (size_t)(64 * (kt + kstep)) * 64, voff);
            unsigned c16 = 0u;
#define IDX_TAIL(DIAG) _Pragma("unroll") for (int a = 0; a < 4; ++a) _Pragma("unroll") for (int i = 0; i < 4; ++i) { \
                    const unsigned bits = key[a][i]; const bool valid = (DIAG) ? (64 * kt + 16 * a + 4 * fq + i <= t) : true; \
                    if (MODE == 0) { unsigned val = 1u + __builtin_amdgcn_ubfe(bits, 22, 1) * 65535u; if (DIAG) val = valid ? val : 0u; \
                        __hip_atomic_fetch_add(hrow + __builtin_amdgcn_ubfe(bits, 12, 10), val, __ATOMIC_RELAXED, __HIP_MEMORY_SCOPE_WORKGROUP); } \
                    else if (MODE == 1) { unsigned val = 1u + __builtin_amdgcn_ubfe(bits, 11, 1) * 65535u; val = (valid && (int)__builtin_amdgcn_ubfe(bits, 12, 11) == b1) ? val : 0u; \
                        __hip_atomic_fetch_add(hrow + __builtin_amdgcn_ubfe(bits, 1, 10), val, __ATOMIC_RELAXED, __HIP_MEMORY_SCOPE_WORKGROUP); } \
                    else if (MODE == 2) { if (valid && __builtin_amdgcn_ubfe(bits, 1, 22) >= thr) m16 |= 1u << (4 * a + i); } \
                    else { const unsigned dband = __builtin_amdgcn_ubfe(bits, 12, 11) - (unsigned)b_lo;            \
                        const bool above = valid && (int)dband > bw, cnd_ = valid && dband <= (unsigned)bw; \
                        m16 |= above ? (1u << (4 * a + i)) : 0u; c16 |= cnd_ ? (1u << (4 * a + i)) : 0u; } }
            if (diag) { IDX_TAIL(true) } else { IDX_TAIL(false) }
#undef IDX_TAIL
            if (MODE == 3) {
                const unsigned ncand = (unsigned)__builtin_popcount(c16);
                unsigned base = 0u; if (ncand) base = __hip_atomic_fetch_add(ccnt + ql_, ncand, __ATOMIC_RELAXED, __HIP_MEMORY_SCOPE_WORKGROUP);
                const unsigned ebase = ((unsigned)kt << 6) | ((unsigned)(fq & 1) << 5) | (unsigned)(4 * (fq >> 1));
#pragma unroll
                for (int a = 0; a < 4; ++a)
#pragma unroll
                    for (int i = 0; i < 4; ++i) { const int e_ = 4 * a + i;
                        const unsigned pos = base + (unsigned)__builtin_popcount(c16 & ((1u << e_) - 1u));
                        const bool st = ((c16 >> e_) & 1u) && pos < (unsigned)IDX_CAP;
                        const unsigned ent = ((__builtin_amdgcn_ubfe(key[a][i], 1, 22) - ((unsigned)b_lo << 11)) << 13) | (ebase + (unsigned)(8 * a + i));
                        if (st) clist[ql_ * IDX_CAP + pos] = ent; }
            }
        }
        if (MODE == 3) nabove += (unsigned)__builtin_popcount(m16);
        if (MODE >= 2) {
            unsigned word = ((m16 & 0xFu) | ((m16 & 0xF0u) << 4) | ((m16 & 0xF00u) << 8) | ((m16 & 0xF000u) << 12)) << (4 * (fq >> 1));
            word |= (unsigned)__shfl_xor((int)word, 32);
            if (ln < 32) { if (MODE == 2) MASKg[(size_t)kt * 64 + fq * 32 + ql_] = word; else mlds[kt * 64 + fq * 32 + ql_] = word; }
        }
    }
    if (MODE == 3) __hip_atomic_fetch_add((LAS unsigned*)(F.lds + IDX_CTL) + 161 + ql_, nabove, __ATOMIC_RELAXED, __HIP_MEMORY_SCOPE_WORKGROUP);
}
__device__ __forceinline__ void idx_scan0(Frame& F, int ln, int t0) {
    LAS unsigned* hist = (LAS unsigned*)(F.lds + RING_OFF);
    LAS int* ctl = (LAS int*)(F.lds + IDX_CTL);
#pragma unroll 1
    for (int qi = 0; qi < 4; ++qi) {
        const int q = 4 * F.wave + qi, nq = t0 + q + 1;
        unsigned wv[16]; int toth = 0, totl = 0;
#pragma unroll
        for (int j = 0; j < 16; ++j) { wv[j] = hist[q * 1025 + 16 * ln + j]; toth += (int)(wv[j] >> 16); totl += (int)(wv[j] & 0xffffu); }
        int inclh = toth, incll = totl;
#pragma unroll
        for (int o = 1; o < 64; o <<= 1) { const int vh = __shfl_down(inclh, o), vl = __shfl_down(incll, o); if (ln + o < 64) { inclh += vh; incll += vl; } }
        const int allh = __shfl(inclh, 0), ns = allh + __shfl(incll, 0);
        if (nq <= TOPK) { if (ln == 0) { ctl[q] = -1; ctl[32 + q] = 0; ctl[129 + q] = 2048; } continue; }
        const float f = (float)ns / (float)nq, need = (float)TOPK * f, m = 6.0f * sqrtf((float)TOPK * f * fmaxf(1.0f - f, 0.f)) + 1.0f;
        int r_hi = (int)floorf(need - m), r_lo = (int)ceilf(need + m); r_hi = r_hi < 1 ? 1 : r_hi; r_lo = r_lo > ns ? ns : r_lo; if (ns == nq) { r_hi = TOPK; r_lo = TOPK; }
#pragma unroll
        for (int which = 0; which < 2; ++which) { const int need_ = which ? r_lo : r_hi;
            { const int above = inclh - toth;
              if (above < need_ && need_ <= inclh) { int run = above, B = 0, cab = 0; bool found = false;
#pragma unroll
                  for (int j = 15; j >= 0; --j) { const int ch = (int)(wv[j] >> 16); if (!found && need_ <= run + ch) { found = true; B = 1024 + 16 * ln + j; cab = run; } run += ch; }
                  if (which == 0) { ctl[q] = B; ctl[32 + q] = cab; } else ctl[129 + q] = B; } }
            { const int above = allh + incll - totl;
              if (allh < need_ && above < need_ && need_ <= allh + incll) { int run = above, B = 0, cab = 0; bool found = false;
#pragma unroll
                  for (int j = 15; j >= 0; --j) { const int cl = (int)(wv[j] & 0xffffu); if (!found && need_ <= run + cl) { found = true; B = 16 * ln + j; cab = run; } run += cl; }
                  if (which == 0) { ctl[q] = B; ctl[32 + q] = cab; } else ctl[129 + q] = B; } } }
        LDS_WAIT(); asm volatile("" ::: "memory");
        if (ln == 0 && ctl[q] - ctl[129 + q] > 127) ctl[128] = 1;
    }
}
template <int LEVEL>
__device__ __forceinline__ void idx_scan(Frame& F, int ln) {
    LAS unsigned* hist = (LAS unsigned*)(F.lds + RING_OFF);
    LAS int* ctl = (LAS int*)(F.lds + IDX_CTL);
#pragma unroll 1
    for (int qi = 0; qi < 4; ++qi) {
        const int q = 4 * F.wave + qi;
        int need = (LEVEL == 0) ? TOPK : TOPK - ctl[32 + q];
        unsigned wv[16]; int toth = 0, totl = 0;
#pragma unroll
        for (int j = 0; j < 16; ++j) { wv[j] = hist[q * 1025 + 16 * ln + j]; toth += (int)(wv[j] >> 16); totl += (int)(wv[j] & 0xffffu); }
        int inclh = toth, incll = totl;
#pragma unroll
        for (int o = 1; o < 64; o <<= 1) { const int vh = __shfl_down(inclh, o), vl = __shfl_down(incll, o); if (ln + o < 64) { inclh += vh; incll += vl; } }
        const int allh = __shfl(inclh, 0);
        { const int above = inclh - toth;
          if (above < need && need <= inclh) { int run = above, B = 0, cab = 0; bool found = false;
#pragma unroll
              for (int j = 15; j >= 0; --j) { const int ch = (int)(wv[j] >> 16); if (!found && need <= run + ch) { found = true; B = 1024 + 16 * ln + j; cab = run; } run += ch; }
              if (LEVEL == 0) { ctl[q] = B; ctl[32 + q] = cab; } else ctl[64 + q] = (ctl[q] << 11) | B; } }
        { const int above = allh + incll - totl;
          if (allh < need && above < need && need <= allh + incll) { int run = above, B = 0, cab = 0; bool found = false;
#pragma unroll
              for (int j = 15; j >= 0; --j) { const int cl = (int)(wv[j] & 0xffffu); if (!found && need <= run + cl) { found = true; B = 16 * ln + j; cab = run; } run += cl; }
              if (LEVEL == 0) { ctl[q] = B; ctl[32 + q] = cab; } else ctl[64 + q] = (ctl[q] << 11) | B; } }
    }
}
__device__ __forceinline__ void idx_select(Frame& F, int ln, int t0) {
    LAS unsigned* mlds = (LAS unsigned*)(F.lds + RING_OFF);
    LAS unsigned* clist = (LAS unsigned*)(F.lds + RING_OFF + 32768);
    LAS int* ctl = (LAS int*)(F.lds + IDX_CTL);
#pragma unroll 1
    for (int qi = 0; qi < 4; ++qi) {
        const int q = 4 * F.wave + qi, nq = t0 + q + 1; const int nc = ctl[96 + q];
        if (nq <= TOPK) continue;
        const int r = TOPK - ctl[161 + q];
        if (nc > IDX_CAP || r < 1 || r > nc) { if (ln == 0) ctl[128] = 1; continue; }
        unsigned e[IDX_CAP / 64]; bool ok[IDX_CAP / 64];
#pragma unroll
        for (int j = 0; j < IDX_CAP / 64; ++j) { ok[j] = ln + 64 * j < nc; e[j] = ok[j] ? clist[q * IDX_CAP + ln + 64 * j] : 0u; }
        unsigned t = 0u;
#pragma unroll 1
        for (int bit = 17; bit >= 0; --bit) { const unsigned tt = t | (1u << bit); int cnt = 0;
#pragma unroll
            for (int j = 0; j < IDX_CAP / 64; ++j) cnt += __popcll(__ballot(ok[j] && (e[j] >> 13) >= tt));
            if (cnt >= r) t = tt; }
#pragma unroll
        for (int j = 0; j < IDX_CAP / 64; ++j) if (ok[j] && (e[j] >> 13) >= t) __hip_atomic_fetch_or(mlds + ((e[j] >> 6) & 127u) * 64 + ((e[j] >> 5) & 1u) * 32 + q, 1u << (e[j] & 31u), __ATOMIC_RELAXED, __HIP_MEMORY_SCOPE_WORKGROUP);
    }
}
__device__ __forceinline__ void p5_indexer(Frame& F, unsigned* MASK) {
    const bf16* QI = WSP(bf16, WS_QI); const bf16* KI = WSP(bf16, WS_KI); const float* WI = WSP(float, WS_WI); const bf16* QL = WSP(bf16, WS_QL); const float* AT = WSP(float, SM_AT);
    float kmax = 0.f;
#pragma unroll
    for (int i = 0; i < 8; ++i) kmax = fmaxf(kmax, __builtin_bit_cast(float, __hip_atomic_load(F.ctl + CW_KMAX + 64 * i, RLX_AGENT)));
    LAS int* ctl = (LAS int*)(F.lds + IDX_CTL);
    for (int p = F.vcu; p < 256; p += F.G) {
        const int b = p >> 7, j = p & 127;
#pragma unroll 1
        for (int side = 0; side < 2; ++side) {
            const int g = side ? j : 255 - j, t0 = 32 * g;
            const int nt_idx = (g + 2) >> 1, nt_att = 4 * (g >> 3) + 4;
            int ln = (int)__builtin_amdgcn_mbcnt_hi(~0u, __builtin_amdgcn_mbcnt_lo(~0u, 0u)); asm volatile("" : "+v"(ln)); const int tid_ = F.wave * 64 + ln;
            const int qc = ln & 15, fq = ln >> 4, ql_ = 16 * (F.wave & 1) + qc;
            const size_t trow = (size_t)b * SEQ + t0 + ql_;
            bf16x8 qf[8][2], ql[2]; float invA; LAS float* w = (LAS float*)(F.lds + IDX_CTL + 1024) + ql_ * 8;
#define IDX_LOADQ() do { \
            _Pragma("unroll") for (int h = 0; h < 8; ++h) _Pragma("unroll") for (int ks = 0; ks < 2; ++ks) qf[h][ks] = *(const bf16x8*)(QI + trow * 512 + h * 64 + ks * 32 + fq * 8); \
            _Pragma("unroll") for (int ks = 0; ks < 2; ++ks) ql[ks] = *(const bf16x8*)(QL + trow * 64 + ks * 32 + fq * 8); \
            { const f32x4 w0 = *(const f32x4*)(WI + trow * 8), w1 = *(const f32x4*)(WI + trow * 8 + 4); *(LAS f32x4*)w = w0; *(LAS f32x4*)(w + 4) = w1; }     \
            { const float a2 = 2.0f * AT[trow] * kmax; invA = a2 > 0.f ? 0.99f / a2 : 0.f; }        \
        } while (0)
            const bf16* KIb = KI + (size_t)b * SEQ * 64;
            unsigned* MASKg = MASK + ((size_t)(b * 256 + g) * 128) * 64;
#define IDX_ATTEMPT(SS) do { \
                IDX_LOADQ(); \
                for (int i = tid_; i < 8200; i += 512) ((LAS v4u*)(F.lds + RING_OFF))[i] = (v4u){0u, 0u, 0u, 0u}; \
                if (tid_ < 200) ctl[tid_] = 0; \
                __syncthreads(); \
                idx_pass<0>(F, ln, KIb, MASKg, t0, nt_idx, nt_att, ql, qf, w, invA, 0, 0u, 0, (SS)); \
                __syncthreads(); \
                idx_scan0(F, ln, t0); \
                __syncthreads(); \
                b_hi = ctl[ql_]; { const int b_lo = ctl[129 + ql_]; \
                idx_pass<3>(F, ln, KIb, MASKg, t0, nt_idx, nt_att, ql, qf, w, invA, b_hi, 0u, b_lo, 1); \
                } \
                __syncthreads(); \
                idx_select(F, ln, t0); \
                __syncthreads(); } while (0)
            int b_hi = 0; bool exact = nt_idx < 16;
            if (exact) { IDX_ATTEMPT(1); } else { IDX_ATTEMPT(4); }
            if (ctl[128] != 0 && !exact) { __syncthreads(); exact = true; IDX_ATTEMPT(1); }
            if (ctl[128] == 0) {
                for (int i = tid_; i < nt_att * 64; i += 512) MASKg[i] = ((LAS unsigned*)(F.lds + RING_OFF))[i];
            } else {
                __syncthreads();
                for (int i = tid_; i < 8200; i += 512) ((LAS v4u*)(F.lds + RING_OFF))[i] = (v4u){0u, 0u, 0u, 0u};
                IDX_LOADQ();
                __syncthreads();
                idx_pass<1>(F, ln, KIb, MASKg, t0, nt_idx, nt_att, ql, qf, w, invA, b_hi, 0u);
                __syncthreads();
                idx_scan<1>(F, ln);
                __syncthreads();
                const unsigned thr = (unsigned)ctl[64 + ql_];
                idx_pass<2>(F, ln, KIb, MASKg, t0, nt_idx, nt_att, ql, qf, w, invA, b_hi, thr);
            }
            __syncthreads();
#undef IDX_ATTEMPT
#undef IDX_LOADQ
        }
    }
}

__device__ __forceinline__ unsigned sbfe1_(unsigned w, const int bit) { unsigned r; asm("v_bfe_i32 %0, %1, %2, 1" : "=v"(r) : "v"(w), "n"(bit)); return r; }
#define SBFE1(w, bit) sbfe1_((w), (bit))
__device__ __forceinline__ void p6_attention(Frame& F, const unsigned* MASK, bf16* ATTo) {
    const bf16* Qb = WSP(bf16, WS_Q); const bf16* Kb = WSP(bf16, WS_K); const bf16* VT = WSP(bf16, WS_VT);
    constexpr int KTB = 18432, VTB = 17408, SLOT = KTB + VTB;
    LAS unsigned char* Lb = F.lds + RING_OFF;
    LAS float* biasd = (LAS float*)(F.lds + RING_OFF + 2 * SLOT);
    for (int p = F.vcu; p < 256; p += F.G) {
        const int bh = p >> 4, j = p & 15, b = bh >> 3, h = bh & 7;
#pragma unroll 1
        for (int side = 0; side < 2; ++side) {
            const int qb = side ? j : 31 - j, q0 = 256 * qb, NT = 2 * qb + 2;
            int ln = (int)__builtin_amdgcn_mbcnt_hi(~0u, __builtin_amdgcn_mbcnt_lo(~0u, 0u)); asm volatile("" : "+v"(ln));
            const int tid_ = F.wave * 64 + ln, r32 = ln & 31, hi = ln >> 5, lrow = tid_ >> 3, lch = tid_ & 7;
            const int tq = q0 + 32 * F.wave + r32;
            if (tid_ < 128) { const int bk = t5_bucket(tid_); biasd[tid_] = (F.rel_bias[bk * 8 + h] - F.rel_bias[31 * 8 + h]) * LOG2E; }
            const bf16* Kg = Kb + (size_t)(b * SEQ + lrow) * 512 + h * 64 + lch * 8;
            const bf16* Vg = VT + ((size_t)((b * NH + h) * 64 + lrow)) * SEQ + lch * 8;
            const unsigned* Mg = MASK + ((size_t)(b * 256 + 8 * qb + F.wave) * 128) * 64 + ln;
            bf16x8 qf[4];
#pragma unroll
            for (int ks = 0; ks < 4; ++ks) qf[ks] = *(const bf16x8*)(Qb + (size_t)(b * SEQ + tq) * 512 + h * 64 + ks * 16 + hi * 8);
            f32x16 o0, o1, o2;
#pragma unroll
            for (int r = 0; r < 16; ++r) { o0[r] = 0.f; o1[r] = 0.f; o2[r] = 0.f; }
            const bf16x8 ones = (bf16x8){0x3F80, 0x3F80, 0x3F80, 0x3F80, 0x3F80, 0x3F80, 0x3F80, 0x3F80};
            float m_run = 0.f;
            v4u kreg0 = *(const v4u*)(Kg), kreg1 = *(const v4u*)(Kg + (size_t)64 * 512), vreg0 = *(const v4u*)(Vg), vreg1 = *(const v4u*)(Vg + 64);
            unsigned mw0 = Mg[0], mw1 = Mg[64], mwn0 = 0u, mwn1 = 0u;
            *(LAS v4u*)(Lb + lrow * 144 + lch * 16) = kreg0; *(LAS v4u*)(Lb + (64 + lrow) * 144 + lch * 16) = kreg1;
            *(LAS v4u*)(Lb + KTB + lrow * 272 + lch * 16) = vreg0; *(LAS v4u*)(Lb + KTB + lrow * 272 + 128 + lch * 16) = vreg1;
            __syncthreads();
            for (int kt = 0; kt < NT; ++kt) {
                const int buf = kt & 1;
                if (kt + 1 < NT) { const size_t kn = (size_t)(kt + 1) * 128;
                    kreg0 = *(const v4u*)(Kg + kn * 512); kreg1 = *(const v4u*)(Kg + (kn + 64) * 512); vreg0 = *(const v4u*)(Vg + kn); vreg1 = *(const v4u*)(Vg + kn + 64);
                    mwn0 = Mg[(size_t)(2 * kt + 2) * 64]; mwn1 = Mg[(size_t)(2 * kt + 3) * 64]; }
                LAS unsigned char* kb_ = Lb + buf * SLOT; LAS unsigned char* vb_ = kb_ + KTB;
                f32x16 sA[4];
#pragma unroll
                for (int c = 0; c < 4; ++c)
#pragma unroll
                    for (int r = 0; r < 16; ++r) sA[c][r] = 0.f;
#pragma unroll
                for (int ks = 0; ks < 4; ++ks)
#pragma unroll
                    for (int c = 0; c < 4; ++c) { const bf16x8 kf = *(const LAS bf16x8*)(kb_ + (32 * c + r32) * 144 + ks * 32 + hi * 16); sA[c] = MFMA32(kf, qf[ks], sA[c]); }
                if (kt >= NT - 3) {
#pragma unroll
                    for (int c = 0; c < 4; ++c)
#pragma unroll
                        for (int r = 0; r < 16; ++r) { const int d0 = tq - (128 * kt + 32 * c + crow(r, hi)); const float b0 = biasd[d0 & 127]; sA[c][r] += ((unsigned)d0 < 128u) ? b0 : 0.f; }
                }
                float mx = -INFINITY;
#pragma unroll
                for (int r = 0; r < 16; ++r) mx = fmaxf(mx, fmaxf(fmaxf(sA[0][r], sA[1][r]), fmaxf(sA[2][r], sA[3][r])));
                mx = fmaxf(mx, __shfl_xor(mx, 32)) - m_run;
                if (kt == 0 || __any(mx > 8.0f)) {
                    const float dl = (kt == 0) ? mx : fmaxf(mx, 0.f), f = __builtin_amdgcn_exp2f(-dl);
                    m_run += dl;
#pragma unroll
                    for (int r = 0; r < 16; ++r) { o0[r] *= f; o1[r] *= f; o2[r] *= f; }
                }
                unsigned pk[4][8];
#pragma unroll
                for (int c = 0; c < 4; ++c) { const unsigned mw = (c < 2) ? mw0 : mw1;
#pragma unroll
                    for (int r = 0; r < 16; r += 2) {
                        const unsigned e0 = __builtin_bit_cast(unsigned, __builtin_amdgcn_exp2f(sA[c][r] - m_run)) & SBFE1(mw, 16 * (c & 1) + r);
                        const unsigned e1 = __builtin_bit_cast(unsigned, __builtin_amdgcn_exp2f(sA[c][r + 1] - m_run)) & SBFE1(mw, 16 * (c & 1) + r + 1);
                        pk[c][r >> 1] = cvtpk(__builtin_bit_cast(float, e0), __builtin_bit_cast(float, e1)); } }
#pragma unroll
                for (int c = 0; c < 4; ++c)
#pragma unroll
                    for (int s = 0; s < 2; ++s) {
                        const bf16x8 pf = __builtin_bit_cast(bf16x8, (v4u){pk[c][4 * s], pk[c][4 * s + 1], pk[c][4 * s + 2], pk[c][4 * s + 3]});
                        const bf16x8 v0 = *(const LAS bf16x8*)(vb_ + r32 * 272 + (2 * c + s) * 32 + hi * 16);
                        const bf16x8 v1 = *(const LAS bf16x8*)(vb_ + (32 + r32) * 272 + (2 * c + s) * 32 + hi * 16);
                        o0 = MFMA32(v0, pf, o0); o1 = MFMA32(v1, pf, o1); o2 = MFMA32(ones, pf, o2);
                    }
                if (kt + 1 < NT) { LAS unsigned char* nb = Lb + (buf ^ 1) * SLOT;
                    *(LAS v4u*)(nb + lrow * 144 + lch * 16) = kreg0; *(LAS v4u*)(nb + (64 + lrow) * 144 + lch * 16) = kreg1;
                    *(LAS v4u*)(nb + KTB + lrow * 272 + lch * 16) = vreg0; *(LAS v4u*)(nb + KTB + lrow * 272 + 128 + lch * 16) = vreg1; }
                mw0 = mwn0; mw1 = mwn1;
                __syncthreads();
            }
            const float inv = 1.0f / o2[0];
            bf16* orow = ATTo + (size_t)(b * SEQ + tq) * 512 + h * 64 + 4 * hi;
#pragma unroll
            for (int g4 = 0; g4 < 4; ++g4) {
                *(v2u*)(orow + 8 * g4) = (v2u){cvtpk(o0[4 * g4] * inv, o0[4 * g4 + 1] * inv), cvtpk(o0[4 * g4 + 2] * inv, o0[4 * g4 + 3] * inv)};
                *(v2u*)(orow + 32 + 8 * g4) = (v2u){cvtpk(o1[4 * g4] * inv, o1[4 * g4 + 1] * inv), cvtpk(o1[4 * g4 + 2] * inv, o1[4 * g4 + 3] * inv)};
            }
        }
    }
}

__device__ __forceinline__ void p9_norm2_route(Frame& F, const float* HRES) {
    const int gw = F.vcu * NWAVES + F.wave, NGW = F.G * NWAVES;
    const float* mod = WSP(float, SM_MOD); const float* WRT = WSP(float, SM_WRT);
    LAS float* lg = (LAS float*)(F.lds + LDSCTL_OFF + 4608 + F.wave * 1152);
    LAS float* wlds = (LAS float*)(F.lds + RING_OFF);
    int* EID = WSP(int, SM_EID); float* EWT = WSP(float, SM_EWT); int* SLOT = WSP(int, SM_SLOT); bf16* H2 = WSP(bf16, WS_H1);
    for (int ord = 0; ord < 2; ++ord) {
    if ((ord ^ (F.vcu & 1)) == 0) {
    int ln9 = (int)__builtin_amdgcn_mbcnt_hi(~0u, __builtin_amdgcn_mbcnt_lo(~0u, 0u)); asm volatile("" : "+v"(ln9)); const int tid9 = F.wave * 64 + ln9;
    LAS unsigned* lcnt = (LAS unsigned*)(F.lds + LDSCTL_OFF + 4096);
    __syncthreads();
    { f32x4 wst[16];
#pragma unroll
      for (int i = 0; i < 16; ++i) wst[i] = *(const f32x4*)(WRT + 4 * D + (size_t)(i * 512 + tid9) * 4);
#pragma unroll
      for (int i = 0; i < 16; ++i) *(LAS f32x4*)(wlds + (size_t)(i * 512 + tid9) * 4) = wst[i]; }
    __syncthreads();
    const int nsteps = (T / 8 + NGW - 1) / NGW;
    for (int st = 0; st < nsteps; ++st) {
        const int m8 = st * NGW + gw; const bool live = m8 < T / 8;
        const int m0 = (live ? m8 : 0) * 8, b = m0 / SEQ;
        if (tid9 < 32) lcnt[tid9] = 0u;
        f32x4 hv[8][4];
#pragma unroll
        for (int r = 0; r < 8; ++r) { const GAS f32x4* xr = (const GAS f32x4*)(HRES + (size_t)(m0 + r) * D) + ln9;
#pragma unroll
            for (int j = 0; j < 4; ++j) hv[r][j] = xr[64 * j]; }
        f32x4 ca[4], cb[4];
#pragma unroll
        for (int j = 0; j < 4; ++j) { const int k = 4 * ln9 + 256 * j;
            const f32x4 g = *(const f32x4*)(F.norm2_g + k), scl = *(const f32x4*)(mod + b * 6144 + 4096 + k); cb[j] = *(const f32x4*)(mod + b * 6144 + 3072 + k); ca[j] = g * (scl + 1.0f); }
#pragma unroll
        for (int r = 0; r < 8; ++r) { float s = 0.f;
#pragma unroll
            for (int j = 0; j < 4; ++j) s += (hv[r][j].x * hv[r][j].x + hv[r][j].y * hv[r][j].y) + (hv[r][j].z * hv[r][j].z + hv[r][j].w * hv[r][j].w);
            const float rstd = 1.f / sqrtf(wave_sum_all(s) * (1.f / D) + EPS);
            GAS v2u* o8 = (GAS v2u*)(H2 + (size_t)(m0 + r) * D) + ln9;
#pragma unroll
            for (int j = 0; j < 4; ++j) { hv[r][j] = hv[r][j] * rstd * ca[j] + cb[j]; if (live) o8[64 * j] = (v2u){pk2(hv[r][j].x, hv[r][j].y), pk2(hv[r][j].z, hv[r][j].w)}; } }
        int gsel[8];
        {
            float gm[8]; int gs[8];
#pragma unroll 1
            for (int n = 0; n < 4; ++n) {
                f32x4 w[4];
#pragma unroll
                for (int j = 0; j < 4; ++j) w[j] = *(const f32x4*)(WRT + n * D + 4 * ln9 + 256 * j);
                const float bn = F.brg[n];
#pragma unroll
                for (int r = 0; r < 8; ++r) { float a0 = 0.f, a1 = 0.f;
#pragma unroll
                    for (int j = 0; j < 4; ++j) { a0 = __builtin_fmaf(hv[r][j].x, w[j].x, a0); a1 = __builtin_fmaf(hv[r][j].y, w[j].y, a1); a0 = __builtin_fmaf(hv[r][j].z, w[j].z, a0); a1 = __builtin_fmaf(hv[r][j].w, w[j].w, a1); }
                    const float pgv = wave_sum63(a0 + a1) + bn;
                    if (n == 0 || pgv > gm[r]) { gm[r] = pgv; gs[r] = n; }
                    if (ln9 == 63) lg[r * 36 + n] = pgv; }
            }
#pragma unroll
            for (int r = 0; r < 8; ++r) gsel[r] = __builtin_amdgcn_readlane(gs[r], 63);
        }
#pragma unroll
        for (int r = 0; r < 8; ++r) {
            const LAS float* Wg = wlds + (8 * gsel[r]) * D + 4 * ln9; const float* bg = F.bre + 8 * gsel[r];
#pragma unroll 2
            for (int c = 0; c < 8; ++c) {
                float a0 = 0.f, a1 = 0.f;
#pragma unroll
                for (int j = 0; j < 4; ++j) { const f32x4 w = *(const LAS f32x4*)(Wg + c * D + 256 * j);
                    a0 = __builtin_fmaf(hv[r][j].x, w.x, a0); a1 = __builtin_fmaf(hv[r][j].y, w.y, a1); a0 = __builtin_fmaf(hv[r][j].z, w.z, a0); a1 = __builtin_fmaf(hv[r][j].w, w.w, a1); }
                const float pe = wave_sum63(a0 + a1);
                if (ln9 == 63) lg[r * 36 + 4 + 8 * gsel[r] + c] = pe + bg[c];
            }
            __builtin_amdgcn_sched_barrier(0);
        }
        __syncthreads();
        int e0id = 0, e1id = 0; unsigned lp0 = 0u, lp1 = 0u; const int tkn = m0 + ln9; const bool rt = live && ln9 < 8;
        if (rt) {
            const LAS float* l = lg + ln9 * 36;
            int gs = 0; float gm = l[0];
#pragma unroll
            for (int j = 1; j < 4; ++j) if (l[j] > gm) { gm = l[j]; gs = j; }
            float gsum = 0.f;
#pragma unroll
            for (int j = 0; j < 4; ++j) gsum += __expf(l[j] - gm);
            const float gwt = 1.f / gsum;
            const LAS float* el = l + 4 + 8 * gs;
            int i0 = 0; float l0 = el[0];
#pragma unroll
            for (int j = 1; j < 8; ++j) if (el[j] > l0) { l0 = el[j]; i0 = j; }
            int i1 = -1; float l1 = -INFINITY;
#pragma unroll
            for (int j = 0; j < 8; ++j) if (j != i0 && el[j] > l1) { l1 = el[j]; i1 = j; }
            const float e1 = __expf(l1 - l0), p0 = 1.f / (1.f + e1), p1 = e1 * p0;
            e0id = gs * 8 + i0; e1id = gs * 8 + i1;
            EID[tkn * 2] = e0id; EID[tkn * 2 + 1] = e1id; EWT[tkn * 2] = gwt * p0; EWT[tkn * 2 + 1] = gwt * p1;
            lp0 = __hip_atomic_fetch_add(lcnt + e0id, 1u, __ATOMIC_RELAXED, __HIP_MEMORY_SCOPE_WORKGROUP);
            lp1 = __hip_atomic_fetch_add(lcnt + e1id, 1u, __ATOMIC_RELAXED, __HIP_MEMORY_SCOPE_WORKGROUP);
        }
        __syncthreads();
        if (tid9 < 32) { const unsigned c = lcnt[tid9]; lcnt[32 + tid9] = c ? atomicAdd((unsigned*)(F.ctl + CW_ECNT + 16 * tid9), c) : 0u; }
        __syncthreads();
        if (rt) { SLOT[tkn * 2] = (int)(lcnt[32 + e0id] + lp0); SLOT[tkn * 2 + 1] = (int)(lcnt[32 + e1id] + lp1); }
        __syncthreads();
    }
    } else {
    {
        LAS float* scr = (LAS float*)(F.lds + RING_OFF + F.wave * 16384);
        for (int it = gw; it < NEXP * 512; it += NGW) {
            const int e = it / 512, r = it % 512;
            if (r < 256) transpose_item(F.w_gate_e + (size_t)e * D * DEXP, D, DEXP, WSP(bf16, WS_WGU) + (size_t)e * 1024 * D, scr, r, F.lane, RmGU{0});
            else transpose_item(F.w_up_e + (size_t)e * D * DEXP, D, DEXP, WSP(bf16, WS_WGU) + (size_t)e * 1024 * D, scr, r - 256, F.lane, RmGU{1});
        }
    }
    }
    }
}
__device__ __forceinline__ int moe_tables(Frame& F, LAS int* off, LAS int* tile_e) {
    if (F.tid == 0) { int o = 0, nt = 0;
        for (int e = 0; e < NEXP; ++e) { const int c = (int)__hip_atomic_load(F.ctl + CW_ECNT + 16 * e, RLX_AGENT); off[e] = o; const int tl = (c + 255) >> 8; for (int j = 0; j < tl; ++j) tile_e[nt++] = e; o += tl * 256; }
        off[NEXP] = nt; }
    __syncthreads();
    return off[NEXP];
}
__device__ __forceinline__ void p10_gather(Frame& F, LAS int* off) {
    const int* EID = WSP(int, SM_EID); int* SLOT = WSP(int, SM_SLOT); int* AROW = (int*)(F.ctl + CW_AROW);
    for (int i = blockIdx.x * 512 + F.tid; i < T * 2; i += F.G * 512) { const int row = off[EID[i]] + SLOT[i]; AROW[row] = i >> 1; SLOT[i] = row; }
}
__device__ __forceinline__ void p13_combine(Frame& F, const float* HRES) {
    const int gw = F.vcu * NWAVES + F.wave, NGW = F.G * NWAVES;
    const float* mod = WSP(float, SM_MOD); const int* SLOT = WSP(int, SM_SLOT); const float* EWT = WSP(float, SM_EWT); const bf16* Y = WSP(bf16, WS_Y);
    for (int m0 = gw * 2; m0 < T; m0 += NGW * 2) {
        const int b = m0 / SEQ;
        f32x4 v[2][4]; float rs[2];
#pragma unroll
        for (int r = 0; r < 2; ++r) { const int m = m0 + r;
#if DBG_SKIP_MOE
            const int r0 = 0, r1 = 0; const float w0 = 0.f, w1 = 0.f; (void)SLOT; (void)EWT;
#else
            const int r0 = SLOT[m * 2], r1 = SLOT[m * 2 + 1]; const float w0 = EWT[m * 2], w1 = EWT[m * 2 + 1];
#endif
            const GAS f32x4* xr = (const GAS f32x4*)(HRES + (size_t)m * D) + F.lane;
            const GAS v2u* y0 = (const GAS v2u*)(Y + (size_t)r0 * D) + F.lane; const GAS v2u* y1 = (const GAS v2u*)(Y + (size_t)r1 * D) + F.lane;
#pragma unroll
            for (int j = 0; j < 4; ++j) { const int k = 4 * F.lane + 256 * j; const v2u a = y0[64 * j], c = y1[64 * j];
                const f32x4 ya = (f32x4){bflo(a.x), bfhi(a.x), bflo(a.y), bfhi(a.y)}, yb = (f32x4){bflo(c.x), bfhi(c.x), bflo(c.y), bfhi(c.y)};
                const f32x4 g2 = *(const f32x4*)(mod + b * 6144 + 5120 + k);
#if DBG_SKIP_MOE
                v[r][j] = xr[64 * j]; (void)g2; (void)ya; (void)yb;
#else
                v[r][j] = xr[64 * j] + g2 * (ya * w0 + yb * w1);
#endif
            } }
#pragma unroll
        for (int r = 0; r < 2; ++r) { float s = 0.f;
#pragma unroll
            for (int j = 0; j < 4; ++j) s += (v[r][j].x * v[r][j].x + v[r][j].y * v[r][j].y) + (v[r][j].z * v[r][j].z + v[r][j].w * v[r][j].w);
            rs[r] = 1.f / sqrtf(wave_sum_all(s) * (1.f / D) + EPS); }
#if DBG_CMP_ATT
        const float escale = 1.0f + sqrtf(__builtin_bit_cast(float, __hip_atomic_load(F.ctl + CW_CMP, RLX_AGENT)) / __builtin_bit_cast(float, __hip_atomic_load(F.ctl + CW_CMP + 1, RLX_AGENT)));
#else
        const float escale = 1.0f;
#endif
#pragma unroll
        for (int r = 0; r < 2; ++r) { GAS f32x4* o = (GAS f32x4*)(F.out + (size_t)(m0 + r) * D) + F.lane;
#pragma unroll
            for (int j = 0; j < 4; ++j) o[64 * j] = v[r][j] * (rs[r] * escale) * *(const f32x4*)(F.norm_f_g + 4 * F.lane + 256 * j); }
    }
}

struct Args { const float* in[20]; float* out; unsigned char* ws; int ph_lo, ph_hi, li, pad; };
__global__ void __launch_bounds__(NWAVES * 64, 2) fwd_kernel(Args args) {
    extern __shared__ __attribute__((aligned(16))) unsigned char lds[];
    Frame F;
    F.lds = (LAS unsigned char*)lds;
    F.MISC = (volatile LAS unsigned*)(F.lds + MISC_OFF);
    F.tid = threadIdx.x; F.lane = F.tid & 63; F.wave = __builtin_amdgcn_readfirstlane(F.tid >> 6);
    F.G = gridDim.x; { const int bx = blockIdx.x; F.vcu = (F.G % 8 == 0) ? (bx % 8) * (F.G / 8) + bx / 8 : bx; }
    F.ws = args.ws; F.ctl = (gu32*)(args.ws + WS_CTL);
    F.x = args.in[0]; F.c = args.in[1]; F.w_ada = args.in[2]; F.b_ada = args.in[3]; F.norm1_g = args.in[4]; F.w_in = args.in[5]; F.rel_bias = args.in[6]; F.conv_w = args.in[7];
    F.w_attn = args.in[8]; F.w_conv = args.in[9]; F.w_out = args.in[10]; F.norm2_g = args.in[11]; F.wrg = args.in[12]; F.brg = args.in[13]; F.wre = args.in[14]; F.bre = args.in[15];
    F.w_gate_e = args.in[16]; F.w_up_e = args.in[17]; F.w_down_e = args.in[18]; F.norm_f_g = args.in[19]; F.out = args.out;
    for (int u = F.tid; u < (LDS_BYTES - LDSCTL_OFF) / 4; u += NWAVES * 64) ((LAS unsigned*)(F.lds + LDSCTL_OFF))[u] = 0u;
    __syncthreads();
    XcdBarrier bar; bar.bar = (unsigned*)(F.ctl + CW_BAR); bar.x = 0; bar.st = nullptr;
    if (!MK_PER_PHASE) bar = xcd_barrier_post((unsigned*)(F.ctl + CW_BAR), F.MISC + 8);
#define GRID_BAR() do { if (MK_PER_PHASE) { if (F.tid == 0) __hip_atomic_store(F.ctl + CW_TMO, 0xBADBA0u, RLX_AGENT); } else { xcd_barrier(bar, F.wave == 0 && (int)__builtin_amdgcn_mbcnt_hi(~0u, __builtin_amdgcn_mbcnt_lo(~0u, 0u)) == 0); } } while (0)
    const int lo = args.ph_lo, hi = args.ph_hi;
#ifndef ONLY_PHASE
#define ONLY_PHASE -1
#endif
#define IN(k) ((ONLY_PHASE < 0 || ONLY_PHASE == (k)) && lo <= (k) && (k) < hi)
#define BOTH(k) (IN(k) && IN((k) + 1))
#define REFRESH() do { int l_ = (int)__builtin_amdgcn_mbcnt_hi(~0u, __builtin_amdgcn_mbcnt_lo(~0u, 0u)); asm volatile("" : "+v"(l_)); F.lane = l_; F.tid = F.wave * 64 + l_; } while (0)
    float* HRES = F.out;
    LAS int* moe_off = (LAS int*)(F.lds + LDSCTL_OFF + 1024);
    LAS int* moe_tile = (LAS int*)(F.lds + LDSCTL_OFF + 1024 + 256);

    if (IN(0)) { REFRESH(); for (int rep_ = 0; rep_ < (DBG_REP == 0 ? 2 : 1); ++rep_) { if (rep_) GRID_BAR(); p0_prologue(F); } if (BOTH(0)) GRID_BAR(); }
    if (IN(1)) { REFRESH(); for (int rep_ = 0; rep_ < (DBG_REP == 1 ? 2 : 1); ++rep_) { if (rep_) GRID_BAR(); p1_norm1(F); } if (BOTH(1)) GRID_BAR(); }
    if (IN(2)) { REFRESH();
        pg8::Gemm g{WSP(bf16, WS_H1), WSP(bf16, WS_WIN), T, NINP, D}; pg8::StaticOrder S; S.init(T, NINP, F.G, (int)blockIdx.x);
        EpiProj E{WSP(bf16, WS_Q), WSP(bf16, WS_K), WSP(bf16, WS_V), WSP(bf16, WS_QI), WSP(bf16, WS_KI), WSP(bf16, WS_CB), WSP(bf16, WS_U), WSP(bf16, WS_G), WSP(float, WS_WI)};
        for (int rep_ = 0; rep_ < (DBG_REP == 2 ? 2 : 1); ++rep_) { if (rep_) GRID_BAR(); pg8::gemm_phase<EpiProj, pg8::StaticOrder, true, true>(F.lds + RING_OFF, g, S, E, F.wave); }
        {
            constexpr int I_A = 8 * 32, I_C = 8 * 32, I_O = 16 * 32;
            const int nun = (T / 256) * (NINP / 256), rem = nun % F.G, c = (int)blockIdx.x;
            const bool early = (rem == 0) || (c >= rem); const int n_early = (rem == 0) ? F.G : F.G - rem, rank = (rem == 0) ? c : c - rem;
            if (early) { LAS float* scr = (LAS float*)(F.lds + RING_OFF + F.wave * 16384);
                for (int it = rank * NWAVES + F.wave; it < I_A + I_C + I_O; it += n_early * NWAVES) { int r = it;
                    if (r < I_A) { transpose_item(F.w_attn, AW, D, WSP(bf16, WS_WA), scr, r, F.lane, RmId()); continue; } r -= I_A;
                    if (r < I_C) { transpose_item(F.w_conv, AW, D, WSP(bf16, WS_WC), scr, r, F.lane, RmId()); continue; } r -= I_C;
                    transpose_item(F.w_out, D, D, WSP(bf16, WS_WOUT), scr, r, F.lane, RmId()); } }
        }
        if (BOTH(2)) GRID_BAR();
    }
    if (IN(3)) { REFRESH(); for (int rep_ = 0; rep_ < (DBG_REP == 3 ? 2 : 1); ++rep_) { if (rep_) GRID_BAR(); p3_prep(F); } if (BOTH(3)) GRID_BAR(); }
    static_assert(WS_ATT == WS_AC + (size_t)T * AW * 2 && WS_WC == WS_WA + (size_t)D * AW * 2, "the chained branch GEMM needs [AC; ATT] and [Wa; Wc] contiguous");
    if (IN(4)) { REFRESH(); }
    if (IN(5)) { REFRESH();
#if DBG_SKIP_ATTN
        for (size_t i = (size_t)blockIdx.x * 512 + F.tid; i < (size_t)T * 512 / 8; i += (size_t)F.G * 512) *(v4u*)(WSP(bf16, WS_ATT) + i * 8) = (v4u){0u, 0u, 0u, 0u};
#elif DBG_CMP_ATT
        pn_naive_dsa(F); GRID_BAR(); p5_indexer(F, WSP(unsigned, WS_MASK_DBG));
#elif MK_NAIVE_ATTN
        pn_naive_dsa(F);
#else
        for (int rep_ = 0; rep_ < (DBG_REP == 5 ? 2 : 1); ++rep_) { if (rep_) GRID_BAR(); p5_indexer(F, WSP(unsigned, WS_MASK)); }
#endif
        if (BOTH(5)) GRID_BAR(); }
    if (IN(6)) { REFRESH();
#if DBG_SKIP_ATTN
#elif DBG_CMP_ATT
        p6_attention(F, WSP(unsigned, WS_MASK_DBG), WSP(bf16, WS_ATT2)); GRID_BAR();
        { float num = 0.f, den = 0.f; const bf16* A1 = WSP(bf16, WS_ATT); const bf16* A2 = WSP(bf16, WS_ATT2);
          for (size_t i = (size_t)blockIdx.x * 512 + F.tid; i < (size_t)T * 512; i += (size_t)F.G * 512) { const float a = bf1(A1[i]), c = bf1(A2[i]); num += (a - c) * (a - c); den += a * a; }
          num = wave_sum(num); den = wave_sum(den);
          if (F.lane == 0) { atomicAdd((float*)(F.ctl + CW_CMP), num); atomicAdd((float*)(F.ctl + CW_CMP + 1), den); } }
#elif !MK_NAIVE_ATTN
        for (int rep_ = 0; rep_ < (DBG_REP == 6 ? 2 : 1); ++rep_) { if (rep_) GRID_BAR(); p6_attention(F, WSP(unsigned, WS_MASK), WSP(bf16, WS_ATT)); }
#endif
        if (BOTH(6)) GRID_BAR(); }
    if (IN(7)) { REFRESH();
        pg8::Gemm g{WSP(bf16, WS_AC), WSP(bf16, WS_WA), 2 * T, 2 * D, AW}; ChainOrder S; S.so.init(T, D, F.G, (int)blockIdx.x);
        EpiChain E{WSP(bf16, WS_G), WSP(bf16, WS_TMPC), WSP(bf16, WS_MERGED)};
        for (int rep_ = 0; rep_ < (DBG_REP == 7 ? 2 : 1); ++rep_) { if (rep_) GRID_BAR(); pg8::gemm_phase<EpiChain, ChainOrder, true, true>(F.lds + RING_OFF, g, S, E, F.wave); }
        if (BOTH(7)) GRID_BAR();
    }
    if (IN(8)) { REFRESH();
        pg8::Gemm g{WSP(bf16, WS_MERGED), WSP(bf16, WS_WOUT), T, D, D}; pg8::StaticOrder S; S.init(T, D, F.G, (int)blockIdx.x);
        EpiOut E{F.x, WSP(float, SM_MOD), HRES};
        for (int rep_ = 0; rep_ < (DBG_REP == 8 ? 2 : 1); ++rep_) { if (rep_) GRID_BAR(); pg8::gemm_phase<EpiOut, pg8::StaticOrder, true, true>(F.lds + RING_OFF, g, S, E, F.wave); }
        if (BOTH(8)) GRID_BAR();
    }
#if DBG_SKIP_MOE
    if (0) {
#endif
    if (IN(9)) { REFRESH(); p9_norm2_route(F, HRES);
#if DBG_REP == 9
        GRID_BAR(); if (blockIdx.x == 0 && F.tid < 32) __hip_atomic_store(F.ctl + CW_ECNT + 16 * F.tid, 0u, RLX_AGENT); GRID_BAR(); p9_norm2_route(F, HRES);
#endif
#if DBG_REP == 99
        for (int i_ = 0; i_ < 10; ++i_) GRID_BAR();
#endif
        if (BOTH(9)) GRID_BAR(); }
    if (IN(10)) { REFRESH(); (void)moe_tables(F, moe_off, moe_tile); p10_gather(F, moe_off); if (BOTH(10)) GRID_BAR(); }
    if (IN(11)) { REFRESH();
        const int nt = moe_tables(F, moe_off, moe_tile);
        pg8::Gemm g{WSP(bf16, WS_H1), WSP(bf16, WS_WGU), XPROWS, NEXP * 1024, D}; MoeOrder S{moe_tile, nt, F.G, (int)blockIdx.x};
        EpiHid E{WSP(bf16, WS_HID)};
        for (int rep_ = 0; rep_ < (DBG_REP == 11 ? 2 : 1); ++rep_) { if (rep_) GRID_BAR(); pg8::gemm_phase<EpiHid, MoeOrder, true, true, true>(F.lds + RING_OFF, g, S, E, F.wave, (const int*)(F.ctl + CW_AROW)); }
        {
            const int nun = nt * 4, rem = nun % F.G, c = (int)blockIdx.x;
            const bool early = (rem == 0) || (c >= rem); const int n_early = (rem == 0) ? F.G : F.G - rem, rank = (rem == 0) ? c : c - rem;
            if (early) { LAS float* scr = (LAS float*)(F.lds + RING_OFF + F.wave * 16384);
                for (int it = rank * NWAVES + F.wave; it < NEXP * 256; it += n_early * NWAVES) { const int e = it >> 8, r = it & 255;
                    transpose_item(F.w_down_e + (size_t)e * DEXP * D, DEXP, D, WSP(bf16, WS_WD) + (size_t)e * D * DEXP, scr, r, F.lane, RmId()); } }
        }
        if (BOTH(11)) GRID_BAR();
    }
    if (IN(12)) { REFRESH();
        const int nt = moe_tables(F, moe_off, moe_tile);
        pg8::Gemm g{WSP(bf16, WS_HID), WSP(bf16, WS_WD), XPROWS, NEXP * 1024, DEXP}; MoeOrder S{moe_tile, nt, F.G, (int)blockIdx.x};
        EpiY E{WSP(bf16, WS_Y)};
        for (int rep_ = 0; rep_ < (DBG_REP == 12 ? 2 : 1); ++rep_) { if (rep_) GRID_BAR(); pg8::gemm_phase<EpiY, MoeOrder, true, true>(F.lds + RING_OFF, g, S, E, F.wave); }
        if (BOTH(12)) GRID_BAR();
    }
#if DBG_SKIP_MOE
    }
#endif
#if DBG_PROBE
    if (IN(13)) { REFRESH();
        const bf16* src = nullptr; int pitch = 1024;
        if (DBG_PROBE == 1) { src = WSP(bf16, WS_MERGED); pitch = 1024; }
        if (DBG_PROBE == 2) { src = WSP(bf16, WS_TMPC); pitch = 1024; }
        if (DBG_PROBE == 3) { src = WSP(bf16, WS_AC); pitch = 512; }
        if (DBG_PROBE == 4) { src = WSP(bf16, WS_G); pitch = 2048; }
        if (DBG_PROBE == 5) { src = WSP(bf16, WS_H1); pitch = 1024; }
        if (DBG_PROBE == 6) { src = WSP(bf16, WS_WIN); pitch = 1024; }
        if (DBG_PROBE == 7) { src = WSP(bf16, WS_QI); pitch = 512; }
        for (size_t i = (size_t)blockIdx.x * 512 + F.tid; i < (size_t)T * D; i += (size_t)F.G * 512) { const size_t m = i / D, j = i % D;
            float v;
            if (DBG_PROBE == 8) v = WSP(float, SM_MOD)[i % 12288];
            else if (DBG_PROBE == 4) v = bf1(src[m * 2048 + j]) + bf1(src[m * 2048 + 1024 + j]);
            else if (DBG_PROBE >= 40 && DBG_PROBE < 48) v = bf1(WSP(bf16, WS_G)[m * 2048 + (DBG_PROBE - 40) * 256 + (j & 255)]);
            else if (DBG_PROBE == 6) v = bf1(src[(m % 5888) * 1024 + j]);
            else v = bf1(src[m * pitch + (j % pitch)]);
            F.out[i] = v; }
    }
#else
    if (IN(13)) { REFRESH(); for (int rep_ = 0; rep_ < (DBG_REP == 13 ? 2 : 1); ++rep_) { if (rep_) GRID_BAR(); p13_combine(F, DBG_SKIP_MIX ? F.x : HRES); } }
#endif
#undef IN
#undef BOTH
}

extern "C" void kernel_launch(void* const* d_in, const int* in_sizes, int n_in, void* d_out, int out_size, void* d_ws, size_t ws_size, hipStream_t stream) {
    static int grid = 0;
    if (grid == 0) {
        if (n_in != 20 || in_sizes[0] != T * D || out_size != T * D || ws_size < WS_END) { fprintf(stderr, "kernel_launch: unexpected shapes: n_in %d in0 %d out %d ws %zu (need %zu)\n", n_in, n_in > 0 ? in_sizes[0] : -1, out_size, ws_size, (size_t)WS_END); grid = -1; return; }
        int dev = 0, cus = 0, per_cu = 0;
        if (hipGetDevice(&dev) != hipSuccess || hipDeviceGetAttribute(&cus, hipDeviceAttributeMultiprocessorCount, dev) != hipSuccess) { grid = -1; return; }
        if (hipFuncSetAttribute((const void*)fwd_kernel, hipFuncAttributeMaxDynamicSharedMemorySize, LDS_BYTES) != hipSuccess) { fprintf(stderr, "kernel_launch: hipFuncSetAttribute failed\n"); grid = -1; return; }
        if (hipOccupancyMaxActiveBlocksPerMultiprocessor(&per_cu, (const void*)fwd_kernel, NWAVES * 64, LDS_BYTES) != hipSuccess || per_cu < 1)
            fprintf(stderr, "kernel_launch: note: occupancy query reports %d workgroups per CU\n", per_cu);
        (void)hipGetLastError();
        grid = cus;
    }
    if (grid < 0) return;
    if (hipMemsetAsync((char*)d_ws + WS_CTL, 0, CTL_ZERO_BYTES, stream) != hipSuccess) return;
    Args a{};
    for (int i = 0; i < 20; ++i) a.in[i] = (const float*)d_in[i];
    a.out = (float*)d_out; a.ws = (unsigned char*)d_ws;
#if MK_PER_PHASE
    for (int li = 0; li < N_PHASES; ++li) { a.ph_lo = li; a.ph_hi = li + 1; a.li = li; hipLaunchKernelGGL(fwd_kernel, dim3(grid), dim3(NWAVES * 64), LDS_BYTES, stream, a); }
#else
    a.ph_lo = 0; a.ph_hi = N_PHASES; a.li = 0;
    hipLaunchKernelGGL(fwd_kernel, dim3(grid), dim3(NWAVES * 64), LDS_BYTES, stream, a);
#endif
}
```
